# Optimizing an MI355X kernel written in HIP

```python
import jax, jax.numpy as jnp
from jax import lax
import numpy as np

D_MODEL = 1024
BATCH = 1
SEQ = 16384
DEPTH = 2

N_EVEN = (DEPTH + 1) // 2
N_ODD = DEPTH // 2

A_WIDTH = D_MODEL // 2
A_GROUP = 128
A_GROUPS = A_WIDTH // A_GROUP
A_CHUNK = 128
LN_EPS = 1e-5
B_WIDTH = D_MODEL // 2
B_HEAD = 64
B_HEADS = B_WIDTH // B_HEAD
LORA_W = 64
LORA_A = 64
LORA_G = 128
GN_EPS = 64e-5
SHIFT_W = 3 * B_WIDTH + LORA_W + LORA_A + LORA_G
EVEN_IN = 2 * A_WIDTH + SHIFT_W
C_HEAD = 64
C_HEADS = D_MODEL // C_HEAD
C_PATTERNS = ((128, 1), (512, 4), (2048, 16))
Q_BLOCK = 128
NEG_INF = -1e30
D_FF = 2816
CONV_WIDTH = 3
RMS_EPS = 1e-6

kernel_name = "hybrid_gmlp_rwkv7_dilated_attn_convffn"


def rmsnorm(x, g):
    xf = x.astype(jnp.float32)
    y = xf * lax.rsqrt(jnp.mean(xf * xf, axis=-1, keepdims=True) + RMS_EPS)
    return (y * g.astype(jnp.float32)).astype(x.dtype)


def shift_prev(h):
    return jnp.pad(h, ((0, 0), (1, 0), (0, 0)))[:, :-1]


def chunked_spatial_gating(u, v, ln_g, ln_b, w_s, b_s):
    bsz, t_len, _ = v.shape
    vf = v.astype(jnp.float32)
    mean = jnp.mean(vf, axis=-1, keepdims=True)
    var = jnp.mean(jnp.square(vf - mean), axis=-1, keepdims=True)
    vn = (vf - mean) * lax.rsqrt(var + LN_EPS) * ln_g.astype(jnp.float32) + ln_b.astype(jnp.float32)
    vc = vn.reshape(bsz, t_len // A_CHUNK, A_CHUNK, A_GROUPS, A_GROUP)
    causal = jnp.tril(jnp.ones((A_CHUNK, A_CHUNK), jnp.float32))
    mixed = jnp.einsum('gts,bnsgc->bntgc', w_s.astype(jnp.float32) * causal, vc)
    mixed = mixed + b_s.astype(jnp.float32).T[None, None, :, :, None]
    return u * mixed.reshape(bsz, t_len, A_WIDTH).astype(u.dtype)


def rwkv7_time_mix(p, mu, w0, w2, a0, a2, g2, k_k, k_a, r_k, gn_g, gn_b):
    bsz, t_len, _ = p.shape
    p = p + (shift_prev(p) - p) * mu
    cuts = np.cumsum([B_WIDTH, B_WIDTH, B_WIDTH, LORA_W, LORA_A])
    r, k, v, lw, la, lg = jnp.split(p, [int(c) for c in cuts], axis=-1)
    w = -jax.nn.softplus(-(w0 + jnp.tanh(lw) @ w2)) - 0.5
    decay = jnp.exp(-jnp.exp(w.astype(jnp.float32)))
    a = jax.nn.sigmoid(a0 + la @ a2)
    g = jax.nn.sigmoid(lg) @ g2

    def heads(z):
        return z.reshape(bsz, t_len, B_HEADS, B_HEAD).astype(jnp.float32)

    kk = heads(k * k_k)
    kk = kk * lax.rsqrt(jnp.maximum(jnp.sum(kk * kk, -1, keepdims=True), 1e-24))
    k = k * (1.0 + (a - 1.0) * k_a)
    rh, kh, vh, ah, wh = heads(r), heads(k), heads(v), heads(a), decay.reshape(bsz, t_len, B_HEADS, B_HEAD)

    def step(S, inp):
        r_t, w_t, k_t, v_t, kk_t, a_t = inp
        sa = jnp.einsum('bhvk,bhk->bhv', S, -kk_t)
        S = (S * w_t[:, :, None, :] + sa[..., None] * (kk_t * a_t)[:, :, None, :]
             + v_t[..., None] * k_t[:, :, None, :])
        return S, jnp.einsum('bhvk,bhk->bhv', S, r_t)

    tm = lambda z: jnp.swapaxes(z, 0, 1)
    S0 = jnp.zeros((bsz, B_HEADS, B_HEAD, B_HEAD), jnp.float32)
    _, o = lax.scan(step, S0, (tm(rh), tm(wh), tm(kh), tm(vh), tm(kk), tm(ah)))
    o = tm(o)
    mean = jnp.mean(o, -1, keepdims=True)
    var = jnp.mean(jnp.square(o - mean), -1, keepdims=True)
    o = ((o - mean) * lax.rsqrt(var + GN_EPS) * gn_g.reshape(B_HEADS, B_HEAD).astype(jnp.float32)
         + gn_b.reshape(B_HEADS, B_HEAD).astype(jnp.float32))
    bonus = jnp.sum(rh * kh * r_k.astype(jnp.float32), -1, keepdims=True) * vh
    out = (o + bonus).reshape(bsz, t_len, B_WIDTH).astype(p.dtype)
    return out * g


def dilated_attention(q, k, v):
    bsz, t_len = q.shape[:2]
    qf = q.astype(jnp.float32) * (C_HEAD ** -0.5)
    kf = k.astype(jnp.float32)
    vf = v.astype(jnp.float32)

    def block(t0):
        qb = lax.dynamic_slice_in_dim(qf, t0, Q_BLOCK, axis=1)
        i = t0 + jnp.arange(Q_BLOCK)
        outs, lses = [], []
        for window, dil in C_PATTERNS:
            j = jnp.arange(window // dil + 1)
            pos = i[:, None] - dil * j[None, :]
            valid = pos >= 0
            idx = jnp.maximum(pos, 0)
            kg = jnp.take(kf, idx, axis=1)
            vg = jnp.take(vf, idx, axis=1)
            s = jnp.einsum('bihd,bijhd->bhij', qb, kg)
            s = jnp.where(valid[None, None], s, NEG_INF)
            lse = jax.nn.logsumexp(s, axis=-1)
            pr = jnp.exp(s - lse[..., None])
            outs.append(jnp.einsum('bhij,bijhd->bihd', pr, vg))
            lses.append(lse)
        wts = jax.nn.softmax(jnp.stack(lses), axis=0)
        wts = jnp.transpose(wts, (0, 1, 3, 2))[..., None]
        return jnp.sum(wts * jnp.stack(outs), axis=0)

    starts = jnp.arange(t_len // Q_BLOCK) * Q_BLOCK
    ob = lax.map(block, starts)
    out = jnp.swapaxes(ob, 0, 1).reshape(bsz, t_len, C_HEADS * C_HEAD)
    return out.astype(q.dtype)


def conv_glu_ffn(h, w_up, conv_w, conv_b, w_down):
    z = h @ w_up
    z1 = shift_prev(z)
    z2 = shift_prev(z1)
    z = conv_w[0] * z2 + conv_w[1] * z1 + conv_w[2] * z + conv_b
    gate, val = jnp.split(z, 2, axis=-1)
    return (jax.nn.silu(gate) * val) @ w_down


def setup_inputs(seed: int = 0) -> dict:
    key = jax.random.key(seed)
    cnt = [0]

    def nk():
        cnt[0] += 1
        return jax.random.fold_in(key, cnt[0])

    def nrm(shape, scale):
        return scale * jax.random.normal(nk(), shape, jnp.float32)

    def gain(shape):
        return 1.0 + 0.02 * jax.random.normal(nk(), shape, jnp.float32)

    def unif(shape, lo, hi):
        return jax.random.uniform(nk(), shape, jnp.float32, lo, hi)

    D, E, O = D_MODEL, N_EVEN, N_ODD
    return {
        "x": nrm((BATCH, SEQ, D), 1.0),
        "ev_norm": gain((E, D)),
        "ev_w_in": nrm((E, D, EVEN_IN), D ** -0.5),
        "ev_ln_g": gain((E, A_WIDTH)),
        "ev_ln_b": nrm((E, A_WIDTH), 0.02),
        "ev_w_s": nrm((E, A_GROUPS, A_CHUNK, A_CHUNK), A_CHUNK ** -0.5),
        "ev_b_s": gain((E, A_GROUPS, A_CHUNK)),
        "ev_mu": unif((E, SHIFT_W), 0.0, 1.0),
        "ev_w0": unif((E, B_WIDTH), -6.5, -1.5),
        "ev_w2": nrm((E, LORA_W, B_WIDTH), 0.5 * LORA_W ** -0.5),
        "ev_a0": nrm((E, B_WIDTH), 0.1),
        "ev_a2": nrm((E, LORA_A, B_WIDTH), 0.5 * LORA_A ** -0.5),
        "ev_g2": nrm((E, LORA_G, B_WIDTH), LORA_G ** -0.5),
        "ev_k_k": 0.85 + nrm((E, B_WIDTH), 0.02),
        "ev_k_a": gain((E, B_WIDTH)),
        "ev_r_k": nrm((E, B_HEADS, B_HEAD), 0.1),
        "ev_gn_g": gain((E, B_WIDTH)),
        "ev_gn_b": nrm((E, B_WIDTH), 0.02),
        "ev_w_out": nrm((E, D, D), D ** -0.5),
        "od_norm": gain((O, D)),
        "od_w_qkv": nrm((O, D, 3 * D), D ** -0.5),
        "od_w_out": nrm((O, D, D), D ** -0.5),
        "ff_norm": gain((DEPTH, D)),
        "ff_w_up": nrm((DEPTH, D, 2 * D_FF), D ** -0.5),
        "ff_conv_w": nrm((DEPTH, CONV_WIDTH, 2 * D_FF), CONV_WIDTH ** -0.5),
        "ff_conv_b": nrm((DEPTH, 2 * D_FF), 0.02),
        "ff_w_down": nrm((DEPTH, D_FF, D), D_FF ** -0.5),
        "final_norm": gain((D,)),
    }


def reference(x, ev_norm, ev_w_in, ev_ln_g, ev_ln_b, ev_w_s, ev_b_s, ev_mu, ev_w0, ev_w2,
              ev_a0, ev_a2, ev_g2, ev_k_k, ev_k_a, ev_r_k, ev_gn_g, ev_gn_b, ev_w_out,
              od_norm, od_w_qkv, od_w_out, ff_norm, ff_w_up, ff_conv_w, ff_conv_b, ff_w_down,
              final_norm):
    bsz, t_len, _ = x.shape
    for layer in range(DEPTH):
        j = layer // 2
        if layer % 2 == 0:
            h = rmsnorm(x, ev_norm[j])
            p = h @ ev_w_in[j]
            y_a = chunked_spatial_gating(p[..., :A_WIDTH], p[..., A_WIDTH:2 * A_WIDTH],
                                         ev_ln_g[j], ev_ln_b[j], ev_w_s[j], ev_b_s[j])
            y_b = rwkv7_time_mix(p[..., 2 * A_WIDTH:], ev_mu[j], ev_w0[j], ev_w2[j], ev_a0[j],
                                 ev_a2[j], ev_g2[j], ev_k_k[j], ev_k_a[j], ev_r_k[j],
                                 ev_gn_g[j], ev_gn_b[j])
            x = x + jnp.concatenate([y_a, y_b], axis=-1) @ ev_w_out[j]
        else:
            h = rmsnorm(x, od_norm[j])
            qkv = (h @ od_w_qkv[j]).reshape(bsz, t_len, 3, C_HEADS, C_HEAD)
            y = dilated_attention(qkv[:, :, 0], qkv[:, :, 1], qkv[:, :, 2])
            x = x + y @ od_w_out[j]
        x = x + conv_glu_ffn(rmsnorm(x, ff_norm[layer]), ff_w_up[layer], ff_conv_w[layer],
                             ff_conv_b[layer], ff_w_down[layer])
    return rmsnorm(x, final_norm)
```

```cpp
#include <hip/hip_runtime.h>
#include <hip/hip_cooperative_groups.h>
#include <cstdio>
#include <cstdint>
namespace cg = cooperative_groups;
namespace pg8 {
#define PG8_LAS __attribute__((address_space(3)))
typedef unsigned short bf16_t;
typedef short bf16x8 __attribute__((ext_vector_type(8)));
typedef float f32x4 __attribute__((ext_vector_type(4)));
typedef unsigned u32x4 __attribute__((ext_vector_type(4)));
constexpr int BM = 256, BK = 64, HALF = 128, HTB = HALF * BK * 2  , STAGE_BYTES = 8 * HTB, NXCD = 8, WGM = 8;

__host__ __device__ __forceinline__ int lds_byte(int r, int c) { const int st = (r >> 4) * 2 + (c >> 5), rr = r & 15, cc = c & 31, ob = rr * 64 + cc * 2; return st * 1024 + (ob ^ (((ob >> 9) & 1) << 5)); }
__host__ __device__ __forceinline__ void stage_rc(int b, int& R, int& C) { const int st = b / 1024, sb = b % 1024, swz = sb ^ (((sb >> 9) & 1) << 5); R = (st >> 1) * 16 + swz / 64; C = (st & 1) * 32 + (swz % 64) / 2; }
__host__ __device__ __forceinline__ int perm32(int rho) { const int n = rho >> 4, i = rho & 15; return 8 * (i >> 2) + 4 * n + (i & 3); }

struct Unit { int pm, pn; };
struct Gemm { const bf16_t* A; const bf16_t* Bt; int M, N, K; long tA, hA, tB, hB; int remapA; };

struct StaticOrder {
    int nM, nN, nwg, G, c;
    __host__ __device__ void init(int M, int N, int G_, int c_) { nM = M / BM; nN = N / BM; nwg = nM * nN; G = G_; c = c_; }
    __host__ __device__ void init2(int nM_, int nN_, int G_, int c_) { nM = nM_; nN = nN_; nwg = nM * nN; G = G_; c = c_; }
    __host__ __device__ bool next(int i, Unit& u) const {
        const long L = (long)i * G + c; if (L >= nwg) return false;
        int wgid = (int)L; { const int q = nwg / NXCD, r = nwg % NXCD, xcd = wgid % NXCD, off = wgid / NXCD; wgid = (xcd < r ? xcd * (q + 1) : r * (q + 1) + (xcd - r) * q) + off; }
        const int nig = WGM * nN, gid = wgid / nig, fm = gid * WGM, gsz = (nM - fm) < WGM ? (nM - fm) : WGM;
        u.pm = fm + ((wgid % nig) % gsz); u.pn = (wgid % nig) / gsz; return true;
    }
    __device__ __forceinline__ void a_ready(const Unit&) const {}
    __device__ __forceinline__ void done(const Unit&) const {}
};

__device__ __forceinline__ unsigned cvt_pk_bf16(float lo, float hi) { unsigned r; asm volatile("v_cvt_pk_bf16_f32 %0, %1, %2" : "=v"(r) : "v"(lo), "v"(hi)); return r; }
typedef float f32x2 __attribute__((ext_vector_type(2)));
__device__ __forceinline__ f32x2 gelu_pk(f32x2 v) {
    const f32x2 av = __builtin_elementwise_abs(v), d = av * 0.2316418882f + 1.0f;
    f32x2 t; t.x = __builtin_amdgcn_rcpf(d.x); t.y = __builtin_amdgcn_rcpf(d.y);
    f32x2 q = t * 0.5307027145f + (-0.7265760135f); q = q * t + 0.7107068705f; q = q * t + (-0.142248368f); q = q * t + 0.127414796f; q = q * t;
    const f32x2 s = (v * v) * (-0.72134752044f);
    f32x2 e; e.x = __builtin_amdgcn_exp2f(s.x); e.y = __builtin_amdgcn_exp2f(s.y);
    const f32x2 m = v * (q * e), r = v - m;
    f32x2 o; o.x = v.x < 0.f ? m.x : r.x; o.y = v.y < 0.f ? m.y : r.y; return o;
}

template <int ACT  > struct EpiBf16 {
    static constexpr bool PERM = true, AFTER_DRAIN = false; static_assert(ACT == 0 || ACT == 1, "EpiBf16: ACT is 0 (none) or 1 (gelu_pk)");
    bf16_t* O; int ldc; const float* bias; int split_cols; size_t split_stride; float scale0;
    __device__ __forceinline__ void operator()(const f32x4 (&acc)[2][2][4][2], const Unit& u, int wr, int wc, int fr, int fq) const {
        const int row0 = u.pm * BM + wr * 64 + fr; int colt = u.pn * BM; bf16_t* base = O;
        float sc = 1.f; if (split_cols) { const int t = colt / split_cols; base += (size_t)t * split_stride; colt -= t * split_cols; if (t == 0) sc = scale0; }
        const int col0 = colt + wc * 32 + 8 * fq, bcol0 = u.pn * BM + wc * 32 + 8 * fq;
        f32x4 bv[2][2];
#pragma unroll
        for (int bj = 0; bj < 2; ++bj)
#pragma unroll
            for (int n = 0; n < 2; ++n) bv[bj][n] = bias ? *(const f32x4*)(bias + bcol0 + bj * HALF + 4 * n) : (f32x4){0.f, 0.f, 0.f, 0.f};
#pragma unroll
        for (int ai = 0; ai < 2; ++ai)
#pragma unroll
            for (int m = 0; m < 4; ++m) { bf16_t* rowp = base + (size_t)(row0 + ai * HALF + m * 16) * ldc + col0;
#pragma unroll
                for (int bj = 0; bj < 2; ++bj) { f32x4 v0 = acc[ai][bj][m][0] + bv[bj][0], v1 = acc[ai][bj][m][1] + bv[bj][1];
                    if (ACT == 1) { f32x2 a = gelu_pk((f32x2){v0[0], v0[1]}), b = gelu_pk((f32x2){v0[2], v0[3]}), c = gelu_pk((f32x2){v1[0], v1[1]}), d = gelu_pk((f32x2){v1[2], v1[3]});
                        v0 = (f32x4){a.x, a.y, b.x, b.y}; v1 = (f32x4){c.x, c.y, d.x, d.y}; }
                    v0 = v0 * sc; v1 = v1 * sc; u32x4 w; w.x = cvt_pk_bf16(v0[0], v0[1]); w.y = cvt_pk_bf16(v0[2], v0[3]); w.z = cvt_pk_bf16(v1[0], v1[1]); w.w = cvt_pk_bf16(v1[2], v1[3]);
                    *(u32x4*)(rowp + bj * HALF) = w; } }
    }
};

template <class Epi, class Sched, bool ALIGN_EPI = false, bool SP2 = false>
__device__ __forceinline__ void gemm_phase(PG8_LAS unsigned char* lds, const Gemm g, const Sched& S, const Epi& E) {
    const int tid = threadIdx.x, wid = __builtin_amdgcn_readfirstlane(tid >> 6), lane = tid & 63, wr = wid >> 2, wc = wid & 3, fr = lane & 15, fq = lane >> 4;
    const int K = g.K, nt = K / BK;
    unsigned voffA[2], voffB[2];
#pragma unroll
    for (int i = 0; i < 2; ++i) { int R, C; stage_rc(tid * 16 + i * 8192, R, C); const int Rb = Epi::PERM ? ((R & ~31) + perm32(R & 31)) : R;
        const int Ra = g.remapA ? (R - (R >= 64 ? 2 : 0)) : R; voffA[i] = (unsigned)(Ra * K + C) * 2u; voffB[i] = (unsigned)(Rb * K + C) * 2u; }
    const size_t kstep = (size_t)(BK * 2);
    const size_t hA = (size_t)g.hA, hB = (size_t)g.hB, tA = (size_t)g.tA, tB = (size_t)g.tB;
    const unsigned ldsw = (unsigned)wid * 1024u;
    const int aoff = lds_byte(wr * 64 + fr, fq * 8), boff = lds_byte(wc * 32 + fr, fq * 8);
#define PG8_SA(b, h) (((b) * 2 + (h)) * HTB)
#define PG8_SB(b, h) ((4 + (b) * 2 + (h)) * HTB)
#define PG8_STAGE(bufoff, gbase, voff) do { _Pragma("unroll") for (int _i = 0; _i < 2; ++_i) \
        __builtin_amdgcn_global_load_lds((const unsigned*)((const char*)(gbase) + (voff)[_i]), (PG8_LAS unsigned*)(lds + (bufoff) + ldsw + _i * 8192), 16, 0, 0); } while (0)
#define PG8_LDA(dst, b, h) do { _Pragma("unroll") for (int m = 0; m < 4; ++m) _Pragma("unroll") for (int k = 0; k < 2; ++k) dst[m][k] = *(const PG8_LAS bf16x8*)(lds + PG8_SA(b, h) + aoff + m * 2048 + k * 1024); } while (0)
#define PG8_LDB(dst, b, h) do { _Pragma("unroll") for (int n = 0; n < 2; ++n) _Pragma("unroll") for (int k = 0; k < 2; ++k) dst[n][k] = *(const PG8_LAS bf16x8*)(lds + PG8_SB(b, h) + boff + n * 2048 + k * 1024); } while (0)
#define PG8_MMA(ai, bj, At, Bt) do { __builtin_amdgcn_s_setprio(1); _Pragma("unroll") for (int m = 0; m < 4; ++m) _Pragma("unroll") for (int n = 0; n < 2; ++n) _Pragma("unroll") for (int k = 0; k < 2; ++k) \
        acc[ai][bj][m][n] = __builtin_amdgcn_mfma_f32_16x16x32_bf16(Bt[n][k], At[m][k], acc[ai][bj][m][n], 0, 0, 0); __builtin_amdgcn_s_setprio(0); } while (0)
#define PG8_WAIT_V(n) asm volatile("s_waitcnt vmcnt(" #n ")" ::: "memory")
#define PG8_WAIT_L(n) asm volatile("s_waitcnt lgkmcnt(" #n ")" ::: "memory")
#define PG8_BAR __builtin_amdgcn_s_barrier()
#define PG8_SCHED __builtin_amdgcn_sched_barrier(0)
    Unit cur, nxt; int ui = 0;
    if (!S.next(0, cur)) return;
    f32x4 acc[2][2][4][2];
#pragma unroll
    for (int a = 0; a < 2; ++a)
#pragma unroll
        for (int b = 0; b < 2; ++b)
#pragma unroll
            for (int m = 0; m < 4; ++m)
#pragma unroll
                for (int n = 0; n < 2; ++n) acc[a][b][m][n] = (f32x4){0.f, 0.f, 0.f, 0.f};
    bf16x8 At[4][2], B0[2][2], B1[2][2];
    const char* cA = (const char*)g.A + (size_t)cur.pm * tA; const char* cB = (const char*)g.Bt + (size_t)cur.pn * tB;
    S.a_ready(cur);
    if constexpr (SP2) {
        PG8_STAGE(PG8_SB(0, 0), cB, voffB); PG8_STAGE(PG8_SB(0, 1), cB + hB, voffB); PG8_STAGE(PG8_SA(0, 0), cA, voffA); PG8_STAGE(PG8_SA(0, 1), cA + hA, voffA);
        if (wr == 1) PG8_BAR;
        PG8_WAIT_V(2); PG8_BAR;
        PG8_STAGE(PG8_SB(1, 0), cB + kstep, voffB); PG8_STAGE(PG8_SA(1, 0), cA + kstep, voffA); PG8_STAGE(PG8_SB(1, 1), cB + hB + kstep, voffB);
        PG8_WAIT_V(6); PG8_BAR;
    } else {
        PG8_STAGE(PG8_SB(0, 0), cB, voffB); PG8_STAGE(PG8_SA(0, 0), cA, voffA); PG8_STAGE(PG8_SB(0, 1), cB + hB, voffB); PG8_STAGE(PG8_SA(0, 1), cA + hA, voffA);
        if (wr == 1) PG8_BAR;
        PG8_WAIT_V(4); PG8_BAR;
        PG8_STAGE(PG8_SB(1, 0), cB + kstep, voffB); PG8_STAGE(PG8_SA(1, 0), cA + kstep, voffA); PG8_STAGE(PG8_SB(1, 1), cB + hB + kstep, voffB);
        PG8_WAIT_V(6); PG8_BAR;
    }
    for (;;) {
        const bool has_next = S.next(ui + 1, nxt);
        const char* nA = has_next ? (const char*)g.A + (size_t)nxt.pm * tA : cA; const char* nB = has_next ? (const char*)g.Bt + (size_t)nxt.pn * tB : cB;
        for (int t = 0; t < nt; t += 2) {
            const bool last = (t == nt - 2);
            const char* a1 = cA + (size_t)(t + 1) * kstep;
            const char* a2 = last ? nA : cA + (size_t)(t + 2) * kstep; const char* b2 = last ? nB : cB + (size_t)(t + 2) * kstep;
            const char* a3 = a2 + kstep; const char* b3 = b2 + kstep;
            if (last && has_next) S.a_ready(nxt);
            if constexpr (SP2) {
            PG8_LDB(B0, 0, 0); PG8_LDB(B1, 0, 1); PG8_SCHED; PG8_LDA(At, 0, 0); PG8_STAGE(PG8_SA(1, 1), a1 + hA, voffA);
            PG8_WAIT_V(8); PG8_WAIT_L(0); PG8_BAR; PG8_MMA(0, 0, At, B0); PG8_MMA(0, 1, At, B1); PG8_BAR; PG8_SCHED;
            PG8_LDA(At, 0, 1); PG8_STAGE(PG8_SB(0, 0), b2, voffB); PG8_STAGE(PG8_SB(0, 1), b2 + hB, voffB); PG8_STAGE(PG8_SA(0, 0), a2, voffA);
            PG8_WAIT_V(8); PG8_WAIT_L(0); PG8_BAR; PG8_MMA(1, 0, At, B0); PG8_MMA(1, 1, At, B1); PG8_BAR; PG8_SCHED;
            PG8_LDB(B0, 1, 0); PG8_LDB(B1, 1, 1); PG8_SCHED; PG8_LDA(At, 1, 0); PG8_STAGE(PG8_SA(0, 1), a2 + hA, voffA);
            PG8_WAIT_V(8); PG8_WAIT_L(0); PG8_BAR; PG8_MMA(0, 0, At, B0); PG8_MMA(0, 1, At, B1); PG8_BAR; PG8_SCHED;
            PG8_LDA(At, 1, 1); PG8_STAGE(PG8_SB(1, 0), b3, voffB); PG8_STAGE(PG8_SB(1, 1), b3 + hB, voffB); PG8_STAGE(PG8_SA(1, 0), a3, voffA);
            PG8_WAIT_V(8); PG8_WAIT_L(0); PG8_BAR; PG8_MMA(1, 0, At, B0); PG8_MMA(1, 1, At, B1); PG8_BAR; PG8_SCHED;
            } else {
            PG8_LDB(B0, 0, 0); PG8_SCHED; PG8_LDA(At, 0, 0); PG8_STAGE(PG8_SA(1, 1), a1 + hA, voffA);
            PG8_WAIT_L(8); PG8_BAR; PG8_WAIT_L(0); PG8_MMA(0, 0, At, B0); PG8_BAR; PG8_SCHED;
            PG8_LDB(B1, 0, 1); PG8_STAGE(PG8_SB(0, 0), b2, voffB);
            PG8_BAR; PG8_WAIT_L(0); PG8_MMA(0, 1, At, B1); PG8_BAR;
            PG8_LDA(At, 0, 1); PG8_STAGE(PG8_SA(0, 0), a2, voffA);
            PG8_BAR; PG8_WAIT_L(0); PG8_MMA(1, 0, At, B0); PG8_BAR; PG8_SCHED;
            PG8_STAGE(PG8_SB(0, 1), b2 + hB, voffB);
            PG8_WAIT_V(6); PG8_BAR; PG8_MMA(1, 1, At, B1); PG8_BAR;
            PG8_LDB(B0, 1, 0); PG8_SCHED; PG8_LDA(At, 1, 0); PG8_STAGE(PG8_SA(0, 1), a2 + hA, voffA);
            PG8_WAIT_L(8); PG8_BAR; PG8_WAIT_L(0); PG8_MMA(0, 0, At, B0); PG8_BAR; PG8_SCHED;
            PG8_LDB(B1, 1, 1); PG8_STAGE(PG8_SB(1, 0), b3, voffB);
            PG8_BAR; PG8_WAIT_L(0); PG8_MMA(0, 1, At, B1); PG8_BAR;
            PG8_LDA(At, 1, 1); PG8_STAGE(PG8_SA(1, 0), a3, voffA);
            PG8_BAR; PG8_WAIT_L(0); PG8_MMA(1, 0, At, B0); PG8_BAR; PG8_SCHED;
            PG8_STAGE(PG8_SB(1, 1), b3 + hB, voffB);
            PG8_WAIT_V(6); PG8_BAR; PG8_MMA(1, 1, At, B1); PG8_BAR;
            }
        }
        if constexpr (ALIGN_EPI) { if (wr == 0) PG8_BAR; }
        if constexpr (!Epi::AFTER_DRAIN) { E(acc, cur, wr, wc, fr, fq); S.done(cur); }
        if (!has_next) break;
#pragma unroll
        for (int a = 0; a < 2; ++a)
#pragma unroll
            for (int b = 0; b < 2; ++b)
#pragma unroll
                for (int m = 0; m < 4; ++m)
#pragma unroll
                    for (int n = 0; n < 2; ++n) acc[a][b][m][n] = (f32x4){0.f, 0.f, 0.f, 0.f};
        cur = nxt; cA = nA; cB = nB; ++ui;
        if constexpr (ALIGN_EPI) { if (wr == 1) PG8_BAR; }
    }
    PG8_WAIT_V(0);
    if constexpr (!ALIGN_EPI) { if (wr == 0) PG8_BAR; }
    PG8_BAR;
    if constexpr (Epi::AFTER_DRAIN) { E.fused(acc, cur, wr, wc, fr, fq, lds, wid, lane); S.done(cur); }
#undef PG8_SA
#undef PG8_SB
#undef PG8_STAGE
#undef PG8_LDA
#undef PG8_LDB
#undef PG8_MMA
#undef PG8_WAIT_V
#undef PG8_WAIT_L
#undef PG8_BAR
#undef PG8_SCHED
}
}
namespace pg8 {
struct EpiRes {
    static constexpr bool PERM = false, AFTER_DRAIN = false;
    const float* base; float* out; int ldc;
    __device__ __forceinline__ void operator()(const f32x4 (&acc)[2][2][4][2], const Unit& u, int wr, int wc, int fr, int fq) const {
        const int col0 = u.pn * BM + wc * 32 + 4 * fq;
#pragma unroll
        for (int ai = 0; ai < 2; ++ai)
#pragma unroll
            for (int m = 0; m < 4; ++m) { const size_t off = (size_t)(u.pm * BM + ai * HALF + wr * 64 + m * 16 + fr) * ldc + col0;
#pragma unroll
                for (int bj = 0; bj < 2; ++bj)
#pragma unroll
                    for (int n = 0; n < 2; ++n) { const f32x4 b = *(const f32x4*)(base + off + bj * HALF + n * 16); *(f32x4*)(out + off + bj * HALF + n * 16) = b + acc[ai][bj][m][n]; } }
    }
};
struct EpiConvGlu {
    static constexpr bool PERM = false, AFTER_DRAIN = false;
    bf16_t* O; const float* cw; const float* cb; int M;
    __device__ __forceinline__ void operator()(const f32x4 (&acc)[2][2][4][2], const Unit& u, int wr, int wc, int fr, int fq) const {
        const int lane = fq * 16 + fr;
        const int src1 = fq * 16 + ((fr + 15) & 15), src2 = fq * 16 + ((fr + 14) & 15);
#pragma unroll
        for (int ai = 0; ai < 2; ++ai) {
            const int pb = 248 * u.pm + 62 * (2 * ai + wr) - 2;
#pragma unroll
            for (int n = 0; n < 2; ++n) {
                const int jg = 128 * u.pn + 32 * wc + 16 * n + 4 * fq;
                const f32x4 g0 = *(const f32x4*)(cw + jg), g1 = *(const f32x4*)(cw + 5632 + jg), g2 = *(const f32x4*)(cw + 2 * 5632 + jg), gb = *(const f32x4*)(cb + jg);
                const f32x4 v0 = *(const f32x4*)(cw + 2816 + jg), v1 = *(const f32x4*)(cw + 5632 + 2816 + jg), v2 = *(const f32x4*)(cw + 2 * 5632 + 2816 + jg), vb = *(const f32x4*)(cb + 2816 + jg);
                f32x4 pg1, pg2, pv1, pv2;
#pragma unroll
                for (int m = 0; m < 4; ++m) {
                    f32x4 zg = acc[ai][0][m][n], zv = acc[ai][1][m][n];
                    const int pos = pb + 16 * m + fr;
                    if (pos < 0) { zg = (f32x4){0.f, 0.f, 0.f, 0.f}; zv = zg; }
                    f32x4 rg1, rg2, rv1, rv2;
#pragma unroll
                    for (int e = 0; e < 4; ++e) { rg1[e] = __shfl(zg[e], src1); rg2[e] = __shfl(zg[e], src2); rv1[e] = __shfl(zv[e], src1); rv2[e] = __shfl(zv[e], src2); }
                    f32x4 zg1, zg2, zv1, zv2;
                    if (m == 0) { zg1 = rg1; zg2 = rg2; zv1 = rv1; zv2 = rv2; }
                    else {
#pragma unroll
                        for (int e = 0; e < 4; ++e) { zg1[e] = fr >= 1 ? rg1[e] : pg1[e]; zg2[e] = fr >= 2 ? rg2[e] : pg2[e]; zv1[e] = fr >= 1 ? rv1[e] : pv1[e]; zv2[e] = fr >= 2 ? rv2[e] : pv2[e]; }
                    }
                    pg1 = rg1; pg2 = rg2; pv1 = rv1; pv2 = rv2;
                    const f32x4 cg = g0 * zg2 + g1 * zg1 + g2 * zg + gb;
                    const f32x4 cv = v0 * zv2 + v1 * zv1 + v2 * zv + vb;
                    f32x4 a;
#pragma unroll
                    for (int e = 0; e < 4; ++e) a[e] = cg[e] / (1.0f + __expf(-cg[e])) * cv[e];
                    if ((16 * m + fr) >= 2 && pos < M) {
                        typedef unsigned u32x2 __attribute__((ext_vector_type(2)));
                        u32x2 w; w.x = cvt_pk_bf16(a[0], a[1]); w.y = cvt_pk_bf16(a[2], a[3]);
                        *(u32x2*)(O + (size_t)pos * 2816 + jg) = w;
                    }
                }
            }
        }
        (void)lane;
    }
};
}
#define LAS __attribute__((address_space(3)))
typedef unsigned short bf16;
typedef float f32x4 __attribute__((ext_vector_type(4)));
typedef short bf16x8 __attribute__((ext_vector_type(8)));
typedef unsigned v4u __attribute__((ext_vector_type(4)));
typedef unsigned v2u __attribute__((ext_vector_type(2)));
constexpr int NWAVES = 8;
constexpr int M = 16384, D = 1024, EIN = 2816, FF = 2816, FF2 = 5632, NQKV = 3072, BW = 512;
constexpr size_t MiB = 1u << 20;
constexpr size_t WS_W2T = 1 * MiB, WS_A2T = WS_W2T + 65536, WS_G2T = WS_A2T + 65536, WS_BS = WS_G2T + 131072;
constexpr size_t WS_WA = 2 * MiB, WS_WB = 13 * MiB, WS_XN = 20 * MiB, WS_GEN = 52 * MiB, WS_END = 256 * MiB;
constexpr size_t WS_P = WS_GEN, WS_LD = WS_GEN + 88 * MiB, WS_KK = WS_LD + 32 * MiB, WS_BB = WS_KK + 16 * MiB, WS_KP = WS_BB + 16 * MiB, WS_RR = WS_KP + 16 * MiB, WS_VV = WS_RR + 16 * MiB;
static_assert(WS_VV + 16 * MiB <= WS_END, "ws map");
constexpr size_t WS_QKV = WS_GEN, WS_VT1 = WS_GEN + 96 * MiB, WS_VT4 = WS_VT1 + 32 * MiB, WS_VT16 = WS_VT4 + 32 * MiB;
static_assert(WS_VT16 + 33 * MiB <= WS_END, "ws map");
constexpr int LDS_BYTES = 147456;

__device__ __forceinline__ float bf2f(unsigned short v) { return __uint_as_float(((unsigned)v) << 16); }
__device__ __forceinline__ unsigned f2bf(float f) { unsigned u = __float_as_uint(f); return (u + 0x7fffu + ((u >> 16) & 1u)) >> 16; }
__device__ __forceinline__ unsigned pk2(float lo, float hi) { return f2bf(lo) | (f2bf(hi) << 16); }
__device__ __forceinline__ float wave_sum(float v) {
#pragma unroll
    for (int o = 1; o < 64; o <<= 1) v += __shfl_xor(v, o);
    return v;
}
__device__ __forceinline__ float dpp_row_shr(float v, int n) {
    const int iv = __builtin_bit_cast(int, v); int r;
    switch (n) { case 1: r = __builtin_amdgcn_update_dpp(0, iv, 0x111, 0xf, 0xf, true); break; case 2: r = __builtin_amdgcn_update_dpp(0, iv, 0x112, 0xf, 0xf, true); break;
                 case 4: r = __builtin_amdgcn_update_dpp(0, iv, 0x114, 0xf, 0xf, true); break; default: r = __builtin_amdgcn_update_dpp(0, iv, 0x118, 0xf, 0xf, true); break; }
    return __builtin_bit_cast(float, r);
}
__device__ __forceinline__ float wave_sum_uniform(float v) {
    v += dpp_row_shr(v, 1); v += dpp_row_shr(v, 2); v += dpp_row_shr(v, 4); v += dpp_row_shr(v, 8);
    v += __builtin_bit_cast(float, __builtin_amdgcn_update_dpp(0, __builtin_bit_cast(int, v), 0x142, 0xa, 0xf, false));
    v += __builtin_bit_cast(float, __builtin_amdgcn_update_dpp(0, __builtin_bit_cast(int, v), 0x143, 0xc, 0xf, false));
    return __builtin_bit_cast(float, __builtin_amdgcn_readlane(__builtin_bit_cast(int, v), 63));
}
#define MFMA16(a, b, c) __builtin_amdgcn_mfma_f32_16x16x32_bf16((a), (b), (c), 0, 0, 0)

__device__ __forceinline__ void transpose_item(const float* W, int K, int N, bf16* WT, LAS float* scr, int item, int lane) {
    const int nblk = N / 32, kb = item / nblk, nb = item % nblk, k0 = 64 * kb, n0 = 32 * nb;
#pragma unroll 8
    for (int i = 0; i < 32; ++i) { const int kk = 2 * i + (lane >> 5); scr[kk * 33 + (lane & 31)] = W[(size_t)(k0 + kk) * N + n0 + (lane & 31)]; }
    asm volatile("s_waitcnt lgkmcnt(0)" ::: "memory");
    const int c = lane & 7;
#pragma unroll
    for (int j = 0; j < 4; ++j) { const int n = (lane >> 3) + 8 * j; const LAS float* s = scr + (8 * c) * 33 + n;
        v4u o; o.x = pk2(s[0 * 33], s[1 * 33]); o.y = pk2(s[2 * 33], s[3 * 33]); o.z = pk2(s[4 * 33], s[5 * 33]); o.w = pk2(s[6 * 33], s[7 * 33]);
        *(v4u*)(WT + (size_t)(n0 + n) * K + k0 + 8 * c) = o; }
    asm volatile("s_waitcnt lgkmcnt(0)" ::: "memory");
}
__device__ __forceinline__ void rms_row_to_bf16(const float* xrow, const float* gain, bf16* orow, int lane) {
    const f32x4* xr = (const f32x4*)xrow + lane; const f32x4* gr = (const f32x4*)gain + lane;
    f32x4 v[4]; float s = 0.f;
#pragma unroll
    for (int j = 0; j < 4; ++j) { v[j] = xr[64 * j]; s += (v[j].x * v[j].x + v[j].y * v[j].y) + (v[j].z * v[j].z + v[j].w * v[j].w); }
    const float rstd = 1.0f / sqrtf(wave_sum(s) * (1.f / D) + 1e-6f);
    v2u* o8 = (v2u*)orow + lane;
#pragma unroll
    for (int j = 0; j < 4; ++j) { const f32x4 g = gr[64 * j]; v2u w; w.x = pk2(v[j].x * rstd * g.x, v[j].y * rstd * g.y); w.y = pk2(v[j].z * rstd * g.z, v[j].w * rstd * g.w); o8[64 * j] = w; }
}
__device__ __forceinline__ void rms_row_inplace(float* xrow, const float* gain, int lane) {
    f32x4* xr = (f32x4*)xrow + lane; const f32x4* gr = (const f32x4*)gain + lane;
    f32x4 v[4]; float s = 0.f;
#pragma unroll
    for (int j = 0; j < 4; ++j) { v[j] = xr[64 * j]; s += (v[j].x * v[j].x + v[j].y * v[j].y) + (v[j].z * v[j].z + v[j].w * v[j].w); }
    const float rstd = 1.0f / sqrtf(wave_sum(s) * (1.f / D) + 1e-6f);
#pragma unroll
    for (int j = 0; j < 4; ++j) { const f32x4 g = gr[64 * j]; xr[64 * j] = v[j] * rstd * g; }
}
__device__ __forceinline__ void norm_phase(LAS unsigned char* lds, int gw, int NGW, int wave, int lane, const float* x, const float* gain, bf16* XN,
                                           const float* W1, int K1, int N1, bf16* W1t, const float* W2, int K2, int N2, bf16* W2t) {
    LAS float* scr = (LAS float*)(lds + wave * 16384);
    const int I1 = (K1 / 64) * (N1 / 32), I2 = (K2 / 64) * (N2 / 32);
    for (int it = gw; it < I1 + I2; it += NGW) {
        if (it < I1) transpose_item(W1, K1, N1, W1t, scr, it, lane); else transpose_item(W2, K2, N2, W2t, scr, it - I1, lane);
    }
    for (int m = gw; m < M; m += NGW) rms_row_to_bf16(x + (size_t)m * D, gain, XN + (size_t)m * D, lane);
}

__device__ __forceinline__ void gmlp_item(LAS unsigned char* lds, int item, int tid, int wave, int lane, const bf16* P, const float* ln_g, const float* ln_b,
                                          const float* w_s, const float* b_s, bf16* Y) {
    const int chunk = item >> 2, g = item & 3, t0 = chunk * 128;
    LAS bf16* Wm = (LAS bf16*)lds;
    LAS bf16* Vt = (LAS bf16*)(lds + 128 * 136 * 2);
    for (int i = 0; i < 16; ++i) {
        const int s = wave * 16 + i;
        const v4u raw = *(const v4u*)(P + (size_t)(t0 + s) * EIN + 512 + lane * 8);
        float v[8];
        v[0] = __uint_as_float(raw.x << 16); v[1] = __uint_as_float(raw.x & 0xffff0000u); v[2] = __uint_as_float(raw.y << 16); v[3] = __uint_as_float(raw.y & 0xffff0000u);
        v[4] = __uint_as_float(raw.z << 16); v[5] = __uint_as_float(raw.z & 0xffff0000u); v[6] = __uint_as_float(raw.w << 16); v[7] = __uint_as_float(raw.w & 0xffff0000u);
        float sum = 0.f;
#pragma unroll
        for (int e = 0; e < 8; ++e) sum += v[e];
        const float mean = wave_sum(sum) * (1.f / 512.f);
        float q = 0.f;
#pragma unroll
        for (int e = 0; e < 8; ++e) { v[e] -= mean; q += v[e] * v[e]; }
        const float rstd = 1.0f / sqrtf(wave_sum(q) * (1.f / 512.f) + 1e-5f);
        if ((lane >> 4) == g) {
#pragma unroll
            for (int e = 0; e < 8; ++e) { const int c = (lane & 15) * 8 + e, ch = g * 128 + c; Vt[c * 136 + s] = (bf16)f2bf(v[e] * rstd * ln_g[ch] + ln_b[ch]); }
        }
    }
    for (int idx = tid; idx < 128 * 32; idx += 512) {
        const int t = idx >> 5, s4 = (idx & 31) * 4;
        const f32x4 w = *(const f32x4*)(w_s + ((size_t)g * 128 + t) * 128 + s4);
        v2u o; o.x = pk2(s4 + 0 <= t ? w.x : 0.f, s4 + 1 <= t ? w.y : 0.f); o.y = pk2(s4 + 2 <= t ? w.z : 0.f, s4 + 3 <= t ? w.w : 0.f);
        *(LAS v2u*)(Wm + t * 136 + s4) = o;
    }
    __syncthreads();
    const int r = lane & 15, q4 = lane >> 4;
    f32x4 acc[8];
#pragma unroll
    for (int ct = 0; ct < 8; ++ct) acc[ct] = (f32x4){0.f, 0.f, 0.f, 0.f};
    const int nks = (16 * wave + 15) / 32 + 1;
    for (int ks = 0; ks < nks; ++ks) {
        const bf16x8 af = *(const LAS bf16x8*)(Wm + (16 * wave + r) * 136 + ks * 32 + q4 * 8);
#pragma unroll
        for (int ct = 0; ct < 8; ++ct) { const bf16x8 bfr = *(const LAS bf16x8*)(Vt + (16 * ct + r) * 136 + ks * 32 + q4 * 8); acc[ct] = MFMA16(af, bfr, acc[ct]); }
    }
#pragma unroll
    for (int ct = 0; ct < 8; ++ct)
#pragma unroll
        for (int e = 0; e < 4; ++e) {
            const int t = 16 * wave + 4 * q4 + e, c = 16 * ct + r;
            const float mixed = acc[ct][e] + b_s[g * 128 + t];
            const float u = bf2f(P[(size_t)(t0 + t) * EIN + g * 128 + c]);
            Y[(size_t)(t0 + t) * D + g * 128 + c] = (bf16)f2bf(u * mixed);
        }
    __syncthreads();
}

struct RwkvW { const float *mu, *w0, *a0, *k_k, *k_a, *r_k; const bf16 *w2t, *a2t, *g2t; };
__device__ __forceinline__ float shifted(const bf16* P, int t, int col, float mu) {
    const float cur = bf2f(P[(size_t)t * EIN + col]); const float prev = t > 0 ? bf2f(P[(size_t)(t - 1) * EIN + col]) : 0.f; return cur + (prev - cur) * mu;
}
__device__ __forceinline__ void rwkv_prep_item(LAS unsigned char* lds, int item, int tid, int wave, int lane, const bf16* P, const RwkvW& W,
                                               float* LD, bf16* KK, bf16* BB, bf16* KP, bf16* RR, bf16* VV, bf16* GG, float* BS) {
    const int t0 = item * 64;
    LAS bf16* Xl = (LAS bf16*)lds;
    for (int idx = tid; idx < 64 * 256; idx += 512) {
        const int t = idx >> 8, j = idx & 255;
        const float ps = shifted(P, t0 + t, 1024 + 1536 + j, W.mu[1536 + j]);
        const float val = j < 64 ? tanhf(ps) : (j < 128 ? ps : 1.0f / (1.0f + __expf(-ps)));
        Xl[t * 264 + j] = (bf16)f2bf(val);
    }
    __syncthreads();
    const int h = wave, r = lane & 15, q4 = lane >> 4;
    for (int tt = 0; tt < 4; ++tt) {
        f32x4 aW[4], aA[4], aG[4];
#pragma unroll
        for (int ct = 0; ct < 4; ++ct) { aW[ct] = (f32x4){0.f, 0.f, 0.f, 0.f}; aA[ct] = aW[ct]; aG[ct] = aW[ct]; }
#pragma unroll
        for (int ks = 0; ks < 2; ++ks) {
            const bf16x8 xw = *(const LAS bf16x8*)(Xl + (16 * tt + r) * 264 + ks * 32 + q4 * 8);
            const bf16x8 xa = *(const LAS bf16x8*)(Xl + (16 * tt + r) * 264 + 64 + ks * 32 + q4 * 8);
#pragma unroll
            for (int ct = 0; ct < 4; ++ct) {
                const bf16x8 yw = *(const bf16x8*)(W.w2t + (size_t)(h * 64 + 16 * ct + r) * 64 + ks * 32 + q4 * 8);
                const bf16x8 ya = *(const bf16x8*)(W.a2t + (size_t)(h * 64 + 16 * ct + r) * 64 + ks * 32 + q4 * 8);
                aW[ct] = MFMA16(xw, yw, aW[ct]); aA[ct] = MFMA16(xa, ya, aA[ct]);
            }
        }
#pragma unroll
        for (int ks = 0; ks < 4; ++ks) {
            const bf16x8 xg = *(const LAS bf16x8*)(Xl + (16 * tt + r) * 264 + 128 + ks * 32 + q4 * 8);
#pragma unroll
            for (int ct = 0; ct < 4; ++ct) {
                const bf16x8 yg = *(const bf16x8*)(W.g2t + (size_t)(h * 64 + 16 * ct + r) * 128 + ks * 32 + q4 * 8);
                aG[ct] = MFMA16(xg, yg, aG[ct]);
            }
        }
#pragma unroll
        for (int e = 0; e < 4; ++e) {
            const int t = t0 + 16 * tt + 4 * q4 + e;
            float kkr[4], av[4]; float ss = 0.f, bon = 0.f;
#pragma unroll
            for (int ct = 0; ct < 4; ++ct) {
                const int c = h * 64 + 16 * ct + r;
                const float r_ = shifted(P, t, 1024 + c, W.mu[c]);
                const float k_ = shifted(P, t, 1024 + 512 + c, W.mu[512 + c]);
                const float v_ = shifted(P, t, 1024 + 1024 + c, W.mu[1024 + c]);
                const float xw = -(W.w0[c] + aW[ct][e]);
                const float sp = xw > 20.f ? xw : log1pf(__expf(xw));
                const float wv = -sp - 0.5f;
                const float ld = -__expf(wv);
                const float a = 1.0f / (1.0f + __expf(-(W.a0[c] + aA[ct][e])));
                const float kr = k_ * W.k_k[c];
                const float kp = k_ * (1.0f + (a - 1.0f) * W.k_a[c]);
                kkr[ct] = kr; av[ct] = a; ss += kr * kr; bon += r_ * kp * W.r_k[c];
                const size_t o = (size_t)t * BW + c;
                LD[o] = ld; KP[o] = (bf16)f2bf(kp); RR[o] = (bf16)f2bf(r_); VV[o] = (bf16)f2bf(v_); GG[o] = (bf16)f2bf(aG[ct][e]);
            }
#pragma unroll
            for (int o = 1; o < 16; o <<= 1) { ss += __shfl_xor(ss, o); bon += __shfl_xor(bon, o); }
            const float inv = 1.0f / sqrtf(fmaxf(ss, 1e-24f));
#pragma unroll
            for (int ct = 0; ct < 4; ++ct) {
                const int c = h * 64 + 16 * ct + r; const size_t o = (size_t)t * BW + c;
                const float kk = kkr[ct] * inv;
                KK[o] = (bf16)f2bf(kk); BB[o] = (bf16)f2bf(kk * av[ct]);
            }
            if (r == 0) BS[(size_t)t * 8 + h] = bon;
        }
    }
    __syncthreads();
}

struct ScanRegs { unsigned short kk[8], bb[8], kp[8], rr[8], vv[8]; float ld[8]; };
__device__ __forceinline__ void scan_load(ScanRegs& R, int t0, int hc, int hv, const float* LD, const bf16* KK, const bf16* BB, const bf16* KP, const bf16* RR, const bf16* VV) {
#pragma unroll
    for (int i = 0; i < 8; ++i) { const size_t o = (size_t)(t0 + i) * BW;
        R.kk[i] = KK[o + hc]; R.bb[i] = BB[o + hc]; R.kp[i] = KP[o + hc]; R.rr[i] = RR[o + hc]; R.ld[i] = LD[o + hc]; R.vv[i] = VV[o + hv]; }
}
__device__ __forceinline__ void rwkv_scan_wave(int gwv, int lane, const float* LD, const bf16* KK, const bf16* BB, const bf16* KP, const bf16* RR, const bf16* VV, float* OSC) {
    const int h = gwv >> 6, v = gwv & 63, hc = h * 64 + lane, hv = h * 64 + v;
    float S = 0.f;
    ScanRegs cur, nxt;
    scan_load(cur, 0, hc, hv, LD, KK, BB, KP, RR, VV);
    for (int t0 = 0; t0 < M; t0 += 8) {
        const int tn = (t0 + 8 < M) ? t0 + 8 : t0;
        scan_load(nxt, tn, hc, hv, LD, KK, BB, KP, RR, VV);
#pragma unroll
        for (int i = 0; i < 8; ++i) {
            const float kk = bf2f(cur.kk[i]), bb = bf2f(cur.bb[i]), kp = bf2f(cur.kp[i]), rr = bf2f(cur.rr[i]), vv = bf2f(cur.vv[i]);
            const float dec = __expf(cur.ld[i]);
            const float sa = wave_sum_uniform(S * kk);
            S = S * dec - sa * bb + vv * kp;
            const float o = wave_sum_uniform(S * rr);
            if (lane == 0) OSC[(size_t)(t0 + i) * BW + hv] = o;
        }
        cur = nxt;
    }
}
__device__ __forceinline__ void rwkv_out_row(int t, int lane, const float* OSC, const float* BS, const bf16* VV, const bf16* GG, const float* gn_g, const float* gn_b, bf16* Y) {
    const int c0 = lane * 8;
    const f32x4 o0 = *(const f32x4*)(OSC + (size_t)t * BW + c0), o1 = *(const f32x4*)(OSC + (size_t)t * BW + c0 + 4);
    float v[8] = {o0.x, o0.y, o0.z, o0.w, o1.x, o1.y, o1.z, o1.w};
    float s = 0.f;
#pragma unroll
    for (int e = 0; e < 8; ++e) s += v[e];
    s += __shfl_xor(s, 1); s += __shfl_xor(s, 2); s += __shfl_xor(s, 4);
    const float mean = s * (1.f / 64.f);
    float q = 0.f;
#pragma unroll
    for (int e = 0; e < 8; ++e) { v[e] -= mean; q += v[e] * v[e]; }
    q += __shfl_xor(q, 1); q += __shfl_xor(q, 2); q += __shfl_xor(q, 4);
    const float rstd = 1.0f / sqrtf(q * (1.f / 64.f) + 64e-5f);
    const float bon = BS[(size_t)t * 8 + (lane >> 3)];
    const v4u vraw = *(const v4u*)(VV + (size_t)t * BW + c0), graw = *(const v4u*)(GG + (size_t)t * BW + c0);
    const unsigned vr[4] = {vraw.x, vraw.y, vraw.z, vraw.w}, gr[4] = {graw.x, graw.y, graw.z, graw.w};
    float outv[8];
#pragma unroll
    for (int e = 0; e < 8; ++e) {
        const float vv = (e & 1) ? __uint_as_float(vr[e >> 1] & 0xffff0000u) : __uint_as_float(vr[e >> 1] << 16);
        const float gg = (e & 1) ? __uint_as_float(gr[e >> 1] & 0xffff0000u) : __uint_as_float(gr[e >> 1] << 16);
        outv[e] = (v[e] * rstd * gn_g[c0 + e] + gn_b[c0 + e] + bon * vv) * gg;
    }
    v4u w; w.x = pk2(outv[0], outv[1]); w.y = pk2(outv[2], outv[3]); w.z = pk2(outv[4], outv[5]); w.w = pk2(outv[6], outv[7]);
    *(v4u*)(Y + (size_t)t * D + 512 + c0) = w;
}

__device__ __forceinline__ void vtrans_item(LAS unsigned char* lds, int item, int tid, const bf16* QKV, bf16* VT1, bf16* VT4, bf16* VT16) {
    const int h = item >> 6, blk = item & 63, t0 = blk * 256;
    LAS bf16* Vl = (LAS bf16*)lds;
#pragma unroll
    for (int i = 0; i < 4; ++i) { const int idx = tid + 512 * i, t = idx >> 3, ch = idx & 7;
        *(LAS v4u*)(Vl + t * 72 + ch * 8) = *(const v4u*)(QKV + (size_t)(t0 + t) * NQKV + 2048 + h * 64 + ch * 8); }
    __syncthreads();
#pragma unroll
    for (int i = 0; i < 4; ++i) {
        const int idx = tid + 512 * i, d = idx >> 5;
        { const int j = idx & 31; unsigned short e[8];
#pragma unroll
          for (int k = 0; k < 8; ++k) e[k] = Vl[(8 * j + k) * 72 + d];
          v4u o; o.x = e[0] | ((unsigned)e[1] << 16); o.y = e[2] | ((unsigned)e[3] << 16); o.z = e[4] | ((unsigned)e[5] << 16); o.w = e[6] | ((unsigned)e[7] << 16);
          *(v4u*)(VT1 + (size_t)(h * 64 + d) * 16384 + t0 + 8 * j) = o; }
        { const int c4 = (idx >> 3) & 3, j = idx & 7; unsigned short e[8];
#pragma unroll
          for (int k = 0; k < 8; ++k) e[k] = Vl[(4 * (8 * j + k) + c4) * 72 + d];
          v4u o; o.x = e[0] | ((unsigned)e[1] << 16); o.y = e[2] | ((unsigned)e[3] << 16); o.z = e[4] | ((unsigned)e[5] << 16); o.w = e[6] | ((unsigned)e[7] << 16);
          *(v4u*)(VT4 + ((size_t)(h * 64 + d) * 4 + c4) * 4096 + t0 / 4 + 8 * j) = o; }
        { const int c16 = (idx >> 1) & 15, j = idx & 1; unsigned short e[8];
#pragma unroll
          for (int k = 0; k < 8; ++k) e[k] = Vl[(16 * (8 * j + k) + c16) * 72 + d];
          v4u o; o.x = e[0] | ((unsigned)e[1] << 16); o.y = e[2] | ((unsigned)e[3] << 16); o.z = e[4] | ((unsigned)e[5] << 16); o.w = e[6] | ((unsigned)e[7] << 16);
          *(v4u*)(VT16 + ((size_t)(h * 64 + d) * 16 + c16) * 1024 + t0 / 16 + 8 * j) = o; }
    }
    __syncthreads();
}

template <int DIL, int NGRP>
__device__ __forceinline__ void attn_pattern(const bf16* QKV, const bf16* VT, int h, int blk, int cls, int lane, const bf16x8 (&qf)[2], f32x4 (&o)[4], float& mrun, float& lrun) {
    constexpr int TD = M / DIL;
    const int r = lane & 15, q4 = lane >> 4, m = r;
    const int cp = cls & (DIL - 1);
    const int nq = (256 * blk + cls - cp) / DIL + (16 / DIL) * m;
    const int nstart = (256 * blk) / DIL - 128;
    const int kA = 8 * (r >> 2) + (r & 3);
    const float C = 0.125f * 1.4426950408889634f;
    const bf16* Kb = QKV + 1024 + h * 64 + q4 * 8;
    for (int g = 0; g < NGRP; ++g) {
        const int nb = nstart + 32 * g;
        int posA = cp + DIL * (nb + kA), posB = posA + 4 * DIL;
        posA = posA < 0 ? 0 : (posA > M - 1 ? M - 1 : posA); posB = posB < 0 ? 0 : (posB > M - 1 ? M - 1 : posB);
        const bf16x8 ka0 = *(const bf16x8*)(Kb + (size_t)posA * NQKV), ka1 = *(const bf16x8*)(Kb + (size_t)posA * NQKV + 32);
        const bf16x8 kb0 = *(const bf16x8*)(Kb + (size_t)posB * NQKV), kb1 = *(const bf16x8*)(Kb + (size_t)posB * NQKV + 32);
        f32x4 sA = (f32x4){0.f, 0.f, 0.f, 0.f}, sB = sA;
        sA = MFMA16(ka0, qf[0], sA); sA = MFMA16(ka1, qf[1], sA);
        sB = MFMA16(kb0, qf[0], sB); sB = MFMA16(kb1, qf[1], sB);
        float s[8]; bool ok[8]; float tmax = -1e30f;
#pragma unroll
        for (int e = 0; e < 8; ++e) {
            const int n = nb + 8 * q4 + e;
            ok[e] = (n >= 0) && (n <= nq) && (n >= nq - 128);
            s[e] = ok[e] ? (e < 4 ? sA[e & 3] : sB[e & 3]) * C : -1e30f;
            tmax = fmaxf(tmax, s[e]);
        }
        tmax = fmaxf(tmax, __shfl_xor(tmax, 16)); tmax = fmaxf(tmax, __shfl_xor(tmax, 32));
        const float mnew = fmaxf(mrun, tmax);
        const float alpha = __builtin_amdgcn_exp2f(mrun - mnew);
        float p[8]; float ps = 0.f;
#pragma unroll
        for (int e = 0; e < 8; ++e) { p[e] = ok[e] ? __builtin_amdgcn_exp2f(s[e] - mnew) : 0.f; ps += p[e]; }
        lrun = lrun * alpha + ps; mrun = mnew;
#pragma unroll
        for (int dt = 0; dt < 4; ++dt) o[dt] = o[dt] * alpha;
        v4u pw; pw.x = pk2(p[0], p[1]); pw.y = pk2(p[2], p[3]); pw.z = pk2(p[4], p[5]); pw.w = pk2(p[6], p[7]);
        const bf16x8 pf = __builtin_bit_cast(bf16x8, pw);
        int nv = nb + 8 * q4; nv = nv < 0 ? 0 : (nv > TD - 8 ? TD - 8 : nv);
#pragma unroll
        for (int dt = 0; dt < 4; ++dt) {
            const bf16x8 vf = *(const bf16x8*)(VT + ((size_t)(h * 64 + 16 * dt + r) * DIL + cp) * TD + nv);
            o[dt] = MFMA16(vf, pf, o[dt]);
        }
    }
}
__device__ __forceinline__ void attn_wave_item(const bf16* QKV, const bf16* VT1, const bf16* VT4, const bf16* VT16, bf16* AO, int h, int blk, int cls, int lane) {
    const int r = lane & 15, q4 = lane >> 4;
    const int im = 256 * blk + cls + 16 * r;
    bf16x8 qf[2];
    qf[0] = *(const bf16x8*)(QKV + (size_t)im * NQKV + h * 64 + q4 * 8);
    qf[1] = *(const bf16x8*)(QKV + (size_t)im * NQKV + h * 64 + 32 + q4 * 8);
    f32x4 o[4];
#pragma unroll
    for (int dt = 0; dt < 4; ++dt) o[dt] = (f32x4){0.f, 0.f, 0.f, 0.f};
    float mrun = -1e30f, lrun = 0.f;
    attn_pattern<1, 12>(QKV, VT1, h, blk, cls, lane, qf, o, mrun, lrun);
    attn_pattern<4, 6>(QKV, VT4, h, blk, cls, lane, qf, o, mrun, lrun);
    attn_pattern<16, 5>(QKV, VT16, h, blk, cls, lane, qf, o, mrun, lrun);
    float l = lrun; l += __shfl_xor(l, 16); l += __shfl_xor(l, 32);
    const float inv = 1.0f / l;
#pragma unroll
    for (int dt = 0; dt < 4; ++dt) {
        v2u w; w.x = pk2(o[dt][0] * inv, o[dt][1] * inv); w.y = pk2(o[dt][2] * inv, o[dt][3] * inv);
        *(v2u*)(AO + (size_t)im * D + h * 64 + 16 * dt + 4 * q4) = w;
    }
}
struct Args { const float* in[28]; float* out; unsigned char* ws; };
#define GRID_SYNC() cg::this_grid().sync()
#define PHASE_VARS int tid = threadIdx.x; asm volatile("" : "+v"(tid)); const int lane = tid & 63; const int wave = __builtin_amdgcn_readfirstlane(tid >> 6); \
    int G = gridDim.x; asm volatile("" : "+s"(G)); int bx = blockIdx.x; asm volatile("" : "+s"(bx)); const int gw = bx * NWAVES + wave, NGW = G * NWAVES; (void)lane; (void)gw; (void)NGW; (void)tid
#define WSP(T, off) ((T*)(args.ws + (off)))
#define XIN (args.in[0])
#define OUTF (args.out)
#define WA WSP(bf16, WS_WA)
#define WB WSP(bf16, WS_WB)
#define XN WSP(bf16, WS_XN)
#define P WSP(bf16, WS_P)
#define LD WSP(float, WS_LD)
#define KK WSP(bf16, WS_KK)
#define BB WSP(bf16, WS_BB)
#define KP WSP(bf16, WS_KP)
#define RR WSP(bf16, WS_RR)
#define VV WSP(bf16, WS_VV)
#define GG ((bf16*)args.out)
#define OSC ((float*)((unsigned char*)args.out + 16 * MiB))
#define BS WSP(float, WS_BS)
#define W2T WSP(bf16, WS_W2T)
#define A2T WSP(bf16, WS_A2T)
#define G2T WSP(bf16, WS_G2T)
#define YC WSP(bf16, WS_XN)
#define ACT WSP(bf16, WS_GEN)
#define QKV WSP(bf16, WS_QKV)
#define VT1 WSP(bf16, WS_VT1)
#define VT4 WSP(bf16, WS_VT4)
#define VT16 WSP(bf16, WS_VT16)
__global__ void __launch_bounds__(NWAVES * 64, 2) hybrid_fwd(Args args) {
    extern __shared__ __attribute__((aligned(16))) unsigned char lds_raw[];
    LAS unsigned char* lds = (LAS unsigned char*)lds_raw;

    { PHASE_VARS;
    {
        LAS float* scr = (LAS float*)(lds + wave * 16384);
        const int IL = 16 + 16 + 32;
        for (int it = gw; it < IL; it += NGW) {
            if (it < 16) transpose_item(args.in[9], 64, 512, W2T, scr, it, lane);
            else if (it < 32) transpose_item(args.in[11], 64, 512, A2T, scr, it - 16, lane);
            else transpose_item(args.in[12], 128, 512, G2T, scr, it - 32, lane);
        }
        norm_phase(lds, gw, NGW, wave, lane, XIN, args.in[1], XN, args.in[2], D, EIN, WA, args.in[18], D, D, WB);
    }

    }
    GRID_SYNC();
    { PHASE_VARS;

    {
        pg8::Gemm g{XN, WA, M, EIN, D, 256L * D * 2, 128L * D * 2, 256L * D * 2, 128L * D * 2, 0}; pg8::StaticOrder S; S.init(M, EIN, G, bx);
        pg8::EpiBf16<0> E{P, EIN, nullptr, 0, 0, 1.f};
        pg8::gemm_phase<pg8::EpiBf16<0>, pg8::StaticOrder, true, true>(lds, g, S, E);
    }

    }
    GRID_SYNC();
    { PHASE_VARS;

    {
        RwkvW W{args.in[7], args.in[8], args.in[10], args.in[13], args.in[14], args.in[15], W2T, A2T, G2T};
        for (int it = bx; it < M / 64; it += G) rwkv_prep_item(lds, it, tid, wave, lane, P, W, LD, KK, BB, KP, RR, VV, GG, BS);
        for (int it = bx; it < (M / 128) * 4; it += G) gmlp_item(lds, it, tid, wave, lane, P, args.in[3], args.in[4], args.in[5], args.in[6], YC);
    }

    }
    GRID_SYNC();
    { PHASE_VARS;

    if (gw < 512) rwkv_scan_wave(gw, lane, LD, KK, BB, KP, RR, VV, OSC);

    }
    GRID_SYNC();
    { PHASE_VARS;

    for (int t = gw; t < M; t += NGW) rwkv_out_row(t, lane, OSC, BS, VV, GG, args.in[16], args.in[17], YC);

    }
    GRID_SYNC();
    { PHASE_VARS;

    {
        pg8::Gemm g{YC, WB, M, D, D, 256L * D * 2, 128L * D * 2, 256L * D * 2, 128L * D * 2, 0}; pg8::StaticOrder S; S.init(M, D, G, bx);
        pg8::EpiRes E{XIN, OUTF, D};
        pg8::gemm_phase<pg8::EpiRes, pg8::StaticOrder, true, true>(lds, g, S, E);
    }

    }
    GRID_SYNC();
    { PHASE_VARS;
        norm_phase(lds, gw, NGW, wave, lane, OUTF, args.in[22] + 0 * D, XN, args.in[23] + (size_t)0 * D * FF2, D, FF2, WA, args.in[26] + (size_t)0 * FF * D, FF, D, WB);
    }
    GRID_SYNC();
    { PHASE_VARS;
        pg8::Gemm g{XN - 2 * D, WA, M, FF2, D, 248L * D * 2, 124L * D * 2, 128L * D * 2, 2816L * D * 2, 1}; pg8::StaticOrder S; S.init2(67, 22, G, bx);
        pg8::EpiConvGlu E{ACT, args.in[24] + (size_t)0 * 3 * FF2, args.in[25] + (size_t)0 * FF2, M};
        pg8::gemm_phase<pg8::EpiConvGlu, pg8::StaticOrder, true, true>(lds, g, S, E);
    }
    GRID_SYNC();
    { PHASE_VARS;
        pg8::Gemm g{ACT, WB, M, D, FF, 256L * FF * 2, 128L * FF * 2, 256L * FF * 2, 128L * FF * 2, 0}; pg8::StaticOrder S; S.init(M, D, G, bx);
        pg8::EpiRes E{OUTF, OUTF, D};
        pg8::gemm_phase<pg8::EpiRes, pg8::StaticOrder, true, true>(lds, g, S, E);
    }
    GRID_SYNC();
    { PHASE_VARS;
        norm_phase(lds, gw, NGW, wave, lane, OUTF, args.in[19], XN, args.in[20], D, NQKV, WA, args.in[21], D, D, WB);
    }
    GRID_SYNC();
    { PHASE_VARS;
        pg8::Gemm g{XN, WA, M, NQKV, D, 256L * D * 2, 128L * D * 2, 256L * D * 2, 128L * D * 2, 0}; pg8::StaticOrder S; S.init(M, NQKV, G, bx);
        pg8::EpiBf16<0> E{QKV, NQKV, nullptr, 0, 0, 1.f};
        pg8::gemm_phase<pg8::EpiBf16<0>, pg8::StaticOrder, true, true>(lds, g, S, E);
    }
    GRID_SYNC();
    { PHASE_VARS;
        for (int it = bx; it < 16 * 64; it += G) vtrans_item(lds, it, tid, QKV, VT1, VT4, VT16);
    }
    GRID_SYNC();
    { PHASE_VARS;
        for (int it = bx; it < 16 * 64; it += G) {
            const int h = it >> 6, blk = it & 63;
            attn_wave_item(QKV, VT1, VT4, VT16, YC, h, blk, 2 * wave, lane);
            attn_wave_item(QKV, VT1, VT4, VT16, YC, h, blk, 2 * wave + 1, lane);
        }
    }
    GRID_SYNC();
    { PHASE_VARS;
        pg8::Gemm g{YC, WB, M, D, D, 256L * D * 2, 128L * D * 2, 256L * D * 2, 128L * D * 2, 0}; pg8::StaticOrder S; S.init(M, D, G, bx);
        pg8::EpiRes E{OUTF, OUTF, D};
        pg8::gemm_phase<pg8::EpiRes, pg8::StaticOrder, true, true>(lds, g, S, E);
    }
    GRID_SYNC();
    { PHASE_VARS;
        norm_phase(lds, gw, NGW, wave, lane, OUTF, args.in[22] + 1 * D, XN, args.in[23] + (size_t)1 * D * FF2, D, FF2, WA, args.in[26] + (size_t)1 * FF * D, FF, D, WB);
    }
    GRID_SYNC();
    { PHASE_VARS;
        pg8::Gemm g{XN - 2 * D, WA, M, FF2, D, 248L * D * 2, 124L * D * 2, 128L * D * 2, 2816L * D * 2, 1}; pg8::StaticOrder S; S.init2(67, 22, G, bx);
        pg8::EpiConvGlu E{ACT, args.in[24] + (size_t)1 * 3 * FF2, args.in[25] + (size_t)1 * FF2, M};
        pg8::gemm_phase<pg8::EpiConvGlu, pg8::StaticOrder, true, true>(lds, g, S, E);
    }
    GRID_SYNC();
    { PHASE_VARS;
        pg8::Gemm g{ACT, WB, M, D, FF, 256L * FF * 2, 128L * FF * 2, 256L * FF * 2, 128L * FF * 2, 0}; pg8::StaticOrder S; S.init(M, D, G, bx);
        pg8::EpiRes E{OUTF, OUTF, D};
        pg8::gemm_phase<pg8::EpiRes, pg8::StaticOrder, true, true>(lds, g, S, E);
    }
    GRID_SYNC();
    { PHASE_VARS;
        for (int m = gw; m < M; m += NGW) rms_row_inplace(OUTF + (size_t)m * D, args.in[27], lane);
    }
}

#undef WSP
#undef XIN
#undef OUTF
#undef WA
#undef WB
#undef XN
#undef P
#undef LD
#undef KK
#undef BB
#undef KP
#undef RR
#undef VV
#undef GG
#undef OSC
#undef BS
#undef W2T
#undef A2T
#undef G2T
#undef YC
#undef ACT
#undef QKV
#undef VT1
#undef VT4
#undef VT16
extern "C" void kernel_launch(void* const* d_in, const int* in_sizes, int n_in, void* d_out, int out_size, void* d_ws, size_t ws_size, hipStream_t stream) {
    static int grid = 0;
    if (grid == 0) {
        if (n_in != 28 || in_sizes[0] != M * D || out_size != M * D || ws_size < WS_END) { fprintf(stderr, "kernel_launch: unexpected shapes (n_in %d, in0 %d, out %d, ws %zu)\n", n_in, n_in > 0 ? in_sizes[0] : -1, out_size, ws_size); grid = -1; return; }
        int dev = 0, cus = 0, per_cu = 0;
        if (hipGetDevice(&dev) != hipSuccess || hipDeviceGetAttribute(&cus, hipDeviceAttributeMultiprocessorCount, dev) != hipSuccess) { grid = -1; return; }
        if (hipFuncSetAttribute((const void*)hybrid_fwd, hipFuncAttributeMaxDynamicSharedMemorySize, LDS_BYTES) != hipSuccess) { fprintf(stderr, "kernel_launch: hipFuncSetAttribute failed\n"); grid = -1; return; }
        if (hipOccupancyMaxActiveBlocksPerMultiprocessor(&per_cu, (const void*)hybrid_fwd, NWAVES * 64, LDS_BYTES) != hipSuccess || per_cu < 1) { fprintf(stderr, "kernel_launch: occupancy query says %d\n", per_cu); per_cu = 1; }
        (void)hipGetLastError();
        grid = cus;
    }
    if (grid < 0) return;
    Args a{};
    for (int i = 0; i < 28; ++i) a.in[i] = (const float*)d_in[i];
    a.out = (float*)d_out; a.ws = (unsigned char*)d_ws;
    void* kargs[] = {&a};
    hipError_t e = hipLaunchCooperativeKernel((const void*)hybrid_fwd, dim3(grid), dim3(NWAVES * 64), kargs, LDS_BYTES, stream);
    if (e != hipSuccess) fprintf(stderr, "kernel_launch: cooperative launch failed: %s (grid %d)\n", hipGetErrorString(e), grid);
}
```

```cpp
#include <hip/hip_runtime.h>
#include <hip/hip_cooperative_groups.h>
#include <cstdio>
#include <cstdint>
namespace cg = cooperative_groups;
namespace pg8 {
#define PG8_LAS __attribute__((address_space(3)))
typedef unsigned short bf16_t;
typedef short bf16x8 __attribute__((ext_vector_type(8)));
typedef float f32x4 __attribute__((ext_vector_type(4)));
typedef unsigned u32x4 __attribute__((ext_vector_type(4)));
constexpr int BM = 256, BK = 64, HALF = 128, HTB = HALF * BK * 2  , STAGE_BYTES = 8 * HTB, NXCD = 8, WGM = 8;

__host__ __device__ __forceinline__ int lds_byte(int r, int c) { const int st = (r >> 4) * 2 + (c >> 5), rr = r & 15, cc = c & 31, ob = rr * 64 + cc * 2; return st * 1024 + (ob ^ (((ob >> 9) & 1) << 5)); }
__host__ __device__ __forceinline__ void stage_rc(int b, int& R, int& C) { const int st = b / 1024, sb = b % 1024, swz = sb ^ (((sb >> 9) & 1) << 5); R = (st >> 1) * 16 + swz / 64; C = (st & 1) * 32 + (swz % 64) / 2; }
__host__ __device__ __forceinline__ int perm32(int rho) { const int n = rho >> 4, i = rho & 15; return 8 * (i >> 2) + 4 * n + (i & 3); }

struct Unit { int pm, pn; };
struct Gemm { const bf16_t* A; const bf16_t* Bt; int M, N, K; long tA, hA, tB, hB; int remapA; };

struct StaticOrder {
    int nM, nN, nwg, G, c;
    __host__ __device__ void init(int M, int N, int G_, int c_) { nM = M / BM; nN = N / BM; nwg = nM * nN; G = G_; c = c_; }
    __host__ __device__ void init2(int nM_, int nN_, int G_, int c_) { nM = nM_; nN = nN_; nwg = nM * nN; G = G_; c = c_; }
    __host__ __device__ bool next(int i, Unit& u) const {
        const long L = (long)i * G + c; if (L >= nwg) return false;
        int wgid = (int)L; { const int q = nwg / NXCD, r = nwg % NXCD, xcd = wgid % NXCD, off = wgid / NXCD; wgid = (xcd < r ? xcd * (q + 1) : r * (q + 1) + (xcd - r) * q) + off; }
        const int nig = WGM * nN, gid = wgid / nig, fm = gid * WGM, gsz = (nM - fm) < WGM ? (nM - fm) : WGM;
        u.pm = fm + ((wgid % nig) % gsz); u.pn = (wgid % nig) / gsz; return true;
    }
    __device__ __forceinline__ void a_ready(const Unit&) const {}
    __device__ __forceinline__ void done(const Unit&) const {}
};

__device__ __forceinline__ unsigned cvt_pk_bf16(float lo, float hi) { unsigned r; asm volatile("v_cvt_pk_bf16_f32 %0, %1, %2" : "=v"(r) : "v"(lo), "v"(hi)); return r; }
typedef float f32x2 __attribute__((ext_vector_type(2)));
__device__ __forceinline__ f32x2 gelu_pk(f32x2 v) {
    const f32x2 av = __builtin_elementwise_abs(v), d = av * 0.2316418882f + 1.0f;
    f32x2 t; t.x = __builtin_amdgcn_rcpf(d.x); t.y = __builtin_amdgcn_rcpf(d.y);
    f32x2 q = t * 0.5307027145f + (-0.7265760135f); q = q * t + 0.7107068705f; q = q * t + (-0.142248368f); q = q * t + 0.127414796f; q = q * t;
    const f32x2 s = (v * v) * (-0.72134752044f);
    f32x2 e; e.x = __builtin_amdgcn_exp2f(s.x); e.y = __builtin_amdgcn_exp2f(s.y);
    const f32x2 m = v * (q * e), r = v - m;
    f32x2 o; o.x = v.x < 0.f ? m.x : r.x; o.y = v.y < 0.f ? m.y : r.y; return o;
}

template <int ACT  > struct EpiBf16 {
    static constexpr bool PERM = true, AFTER_DRAIN = false; static_assert(ACT == 0 || ACT == 1, "EpiBf16: ACT is 0 (none) or 1 (gelu_pk)");
    bf16_t* O; int ldc; const float* bias; int split_cols; size_t split_stride; float scale0;
    __device__ __forceinline__ void operator()(const f32x4 (&acc)[2][2][4][2], const Unit& u, int wr, int wc, int fr, int fq) const {
        const int row0 = u.pm * BM + wr * 64 + fr; int colt = u.pn * BM; bf16_t* base = O;
        float sc = 1.f; if (split_cols) { const int t = colt / split_cols; base += (size_t)t * split_stride; colt -= t * split_cols; if (t == 0) sc = scale0; }
        const int col0 = colt + wc * 32 + 8 * fq, bcol0 = u.pn * BM + wc * 32 + 8 * fq;
        f32x4 bv[2][2];
#pragma unroll
        for (int bj = 0; bj < 2; ++bj)
#pragma unroll
            for (int n = 0; n < 2; ++n) bv[bj][n] = bias ? *(const f32x4*)(bias + bcol0 + bj * HALF + 4 * n) : (f32x4){0.f, 0.f, 0.f, 0.f};
#pragma unroll
        for (int ai = 0; ai < 2; ++ai)
#pragma unroll
            for (int m = 0; m < 4; ++m) { bf16_t* rowp = base + (size_t)(row0 + ai * HALF + m * 16) * ldc + col0;
#pragma unroll
                for (int bj = 0; bj < 2; ++bj) { f32x4 v0 = acc[ai][bj][m][0] + bv[bj][0], v1 = acc[ai][bj][m][1] + bv[bj][1];
                    if (ACT == 1) { f32x2 a = gelu_pk((f32x2){v0[0], v0[1]}), b = gelu_pk((f32x2){v0[2], v0[3]}), c = gelu_pk((f32x2){v1[0], v1[1]}), d = gelu_pk((f32x2){v1[2], v1[3]});
                        v0 = (f32x4){a.x, a.y, b.x, b.y}; v1 = (f32x4){c.x, c.y, d.x, d.y}; }
                    v0 = v0 * sc; v1 = v1 * sc; u32x4 w; w.x = cvt_pk_bf16(v0[0], v0[1]); w.y = cvt_pk_bf16(v0[2], v0[3]); w.z = cvt_pk_bf16(v1[0], v1[1]); w.w = cvt_pk_bf16(v1[2], v1[3]);
                    *(u32x4*)(rowp + bj * HALF) = w; } }
    }
};

template <class Epi, class Sched, bool ALIGN_EPI = false, bool SP2 = false>
__device__ __forceinline__ void gemm_phase(PG8_LAS unsigned char* lds, const Gemm g, const Sched& S, const Epi& E) {
    const int tid = threadIdx.x, wid = __builtin_amdgcn_readfirstlane(tid >> 6), lane = tid & 63, wr = wid >> 2, wc = wid & 3, fr = lane & 15, fq = lane >> 4;
    const int K = g.K, nt = K / BK;
    unsigned voffA[2], voffB[2];
#pragma unroll
    for (int i = 0; i < 2; ++i) { int R, C; stage_rc(tid * 16 + i * 8192, R, C); const int Rb = Epi::PERM ? ((R & ~31) + perm32(R & 31)) : R;
        const int Ra = g.remapA ? (R - (R >= 64 ? 2 : 0)) : R; voffA[i] = (unsigned)(Ra * K + C) * 2u; voffB[i] = (unsigned)(Rb * K + C) * 2u; }
    const size_t kstep = (size_t)(BK * 2);
    const size_t hA = (size_t)g.hA, hB = (size_t)g.hB, tA = (size_t)g.tA, tB = (size_t)g.tB;
    const unsigned ldsw = (unsigned)wid * 1024u;
    const int aoff = lds_byte(wr * 64 + fr, fq * 8), boff = lds_byte(wc * 32 + fr, fq * 8);
#define PG8_SA(b, h) (((b) * 2 + (h)) * HTB)
#define PG8_SB(b, h) ((4 + (b) * 2 + (h)) * HTB)
#define PG8_STAGE(bufoff, gbase, voff) do { _Pragma("unroll") for (int _i = 0; _i < 2; ++_i) \
        __builtin_amdgcn_global_load_lds((const unsigned*)((const char*)(gbase) + (voff)[_i]), (PG8_LAS unsigned*)(lds + (bufoff) + ldsw + _i * 8192), 16, 0, 0); } while (0)
#define PG8_LDA(dst, b, h) do { _Pragma("unroll") for (int m = 0; m < 4; ++m) _Pragma("unroll") for (int k = 0; k < 2; ++k) dst[m][k] = *(const PG8_LAS bf16x8*)(lds + PG8_SA(b, h) + aoff + m * 2048 + k * 1024); } while (0)
#define PG8_LDB(dst, b, h) do { _Pragma("unroll") for (int n = 0; n < 2; ++n) _Pragma("unroll") for (int k = 0; k < 2; ++k) dst[n][k] = *(const PG8_LAS bf16x8*)(lds + PG8_SB(b, h) + boff + n * 2048 + k * 1024); } while (0)
#define PG8_MMA(ai, bj, At, Bt) do { __builtin_amdgcn_s_setprio(1); _Pragma("unroll") for (int m = 0; m < 4; ++m) _Pragma("unroll") for (int n = 0; n < 2; ++n) _Pragma("unroll") for (int k = 0; k < 2; ++k) \
        acc[ai][bj][m][n] = __builtin_amdgcn_mfma_f32_16x16x32_bf16(Bt[n][k], At[m][k], acc[ai][bj][m][n], 0, 0, 0); __builtin_amdgcn_s_setprio(0); } while (0)
#define PG8_WAIT_V(n) asm volatile("s_waitcnt vmcnt(" #n ")" ::: "memory")
#define PG8_WAIT_L(n) asm volatile("s_waitcnt lgkmcnt(" #n ")" ::: "memory")
#define PG8_BAR __builtin_amdgcn_s_barrier()
#define PG8_SCHED __builtin_amdgcn_sched_barrier(0)
    Unit cur, nxt; int ui = 0;
    if (!S.next(0, cur)) return;
    f32x4 acc[2][2][4][2];
#pragma unroll
    for (int a = 0; a < 2; ++a)
#pragma unroll
        for (int b = 0; b < 2; ++b)
#pragma unroll
            for (int m = 0; m < 4; ++m)
#pragma unroll
                for (int n = 0; n < 2; ++n) acc[a][b][m][n] = (f32x4){0.f, 0.f, 0.f, 0.f};
    bf16x8 At[4][2], B0[2][2], B1[2][2];
    const char* cA = (const char*)g.A + (size_t)cur.pm * tA; const char* cB = (const char*)g.Bt + (size_t)cur.pn * tB;
    S.a_ready(cur);
    if constexpr (SP2) {
        PG8_STAGE(PG8_SB(0, 0), cB, voffB); PG8_STAGE(PG8_SB(0, 1), cB + hB, voffB); PG8_STAGE(PG8_SA(0, 0), cA, voffA); PG8_STAGE(PG8_SA(0, 1), cA + hA, voffA);
        if (wr == 1) PG8_BAR;
        PG8_WAIT_V(2); PG8_BAR;
        PG8_STAGE(PG8_SB(1, 0), cB + kstep, voffB); PG8_STAGE(PG8_SA(1, 0), cA + kstep, voffA); PG8_STAGE(PG8_SB(1, 1), cB + hB + kstep, voffB);
        PG8_WAIT_V(6); PG8_BAR;
    } else {
        PG8_STAGE(PG8_SB(0, 0), cB, voffB); PG8_STAGE(PG8_SA(0, 0), cA, voffA); PG8_STAGE(PG8_SB(0, 1), cB + hB, voffB); PG8_STAGE(PG8_SA(0, 1), cA + hA, voffA);
        if (wr == 1) PG8_BAR;
        PG8_WAIT_V(4); PG8_BAR;
        PG8_STAGE(PG8_SB(1, 0), cB + kstep, voffB); PG8_STAGE(PG8_SA(1, 0), cA + kstep, voffA); PG8_STAGE(PG8_SB(1, 1), cB + hB + kstep, voffB);
        PG8_WAIT_V(6); PG8_BAR;
    }
    for (;;) {
        const bool has_next = S.next(ui + 1, nxt);
        const char* nA = has_next ? (const char*)g.A + (size_t)nxt.pm * tA : cA; const char* nB = has_next ? (const char*)g.Bt + (size_t)nxt.pn * tB : cB;
        for (int t = 0; t < nt; t += 2) {
            const bool last = (t == nt - 2);
            const char* a1 = cA + (size_t)(t + 1) * kstep;
            const char* a2 = last ? nA : cA + (size_t)(t + 2) * kstep; const char* b2 = last ? nB : cB + (size_t)(t + 2) * kstep;
            const char* a3 = a2 + kstep; const char* b3 = b2 + kstep;
            if (last && has_next) S.a_ready(nxt);
            if constexpr (SP2) {
            PG8_LDB(B0, 0, 0); PG8_LDB(B1, 0, 1); PG8_SCHED; PG8_LDA(At, 0, 0); PG8_STAGE(PG8_SA(1, 1), a1 + hA, voffA);
            PG8_WAIT_V(8); PG8_WAIT_L(0); PG8_BAR; PG8_MMA(0, 0, At, B0); PG8_MMA(0, 1, At, B1); PG8_BAR; PG8_SCHED;
            PG8_LDA(At, 0, 1); PG8_STAGE(PG8_SB(0, 0), b2, voffB); PG8_STAGE(PG8_SB(0, 1), b2 + hB, voffB); PG8_STAGE(PG8_SA(0, 0), a2, voffA);
            PG8_WAIT_V(8); PG8_WAIT_L(0); PG8_BAR; PG8_MMA(1, 0, At, B0); PG8_MMA(1, 1, At, B1); PG8_BAR; PG8_SCHED;
            PG8_LDB(B0, 1, 0); PG8_LDB(B1, 1, 1); PG8_SCHED; PG8_LDA(At, 1, 0); PG8_STAGE(PG8_SA(0, 1), a2 + hA, voffA);
            PG8_WAIT_V(8); PG8_WAIT_L(0); PG8_BAR; PG8_MMA(0, 0, At, B0); PG8_MMA(0, 1, At, B1); PG8_BAR; PG8_SCHED;
            PG8_LDA(At, 1, 1); PG8_STAGE(PG8_SB(1, 0), b3, voffB); PG8_STAGE(PG8_SB(1, 1), b3 + hB, voffB); PG8_STAGE(PG8_SA(1, 0), a3, voffA);
            PG8_WAIT_V(8); PG8_WAIT_L(0); PG8_BAR; PG8_MMA(1, 0, At, B0); PG8_MMA(1, 1, At, B1); PG8_BAR; PG8_SCHED;
            } else {
            PG8_LDB(B0, 0, 0); PG8_SCHED; PG8_LDA(At, 0, 0); PG8_STAGE(PG8_SA(1, 1), a1 + hA, voffA);
            PG8_WAIT_L(8); PG8_BAR; PG8_WAIT_L(0); PG8_MMA(0, 0, At, B0); PG8_BAR; PG8_SCHED;
            PG8_LDB(B1, 0, 1); PG8_STAGE(PG8_SB(0, 0), b2, voffB);
            PG8_BAR; PG8_WAIT_L(0); PG8_MMA(0, 1, At, B1); PG8_BAR;
            PG8_LDA(At, 0, 1); PG8_STAGE(PG8_SA(0, 0), a2, voffA);
            PG8_BAR; PG8_WAIT_L(0); PG8_MMA(1, 0, At, B0); PG8_BAR; PG8_SCHED;
            PG8_STAGE(PG8_SB(0, 1), b2 + hB, voffB);
            PG8_WAIT_V(6); PG8_BAR; PG8_MMA(1, 1, At, B1); PG8_BAR;
            PG8_LDB(B0, 1, 0); PG8_SCHED; PG8_LDA(At, 1, 0); PG8_STAGE(PG8_SA(0, 1), a2 + hA, voffA);
            PG8_WAIT_L(8); PG8_BAR; PG8_WAIT_L(0); PG8_MMA(0, 0, At, B0); PG8_BAR; PG8_SCHED;
            PG8_LDB(B1, 1, 1); PG8_STAGE(PG8_SB(1, 0), b3, voffB);
            PG8_BAR; PG8_WAIT_L(0); PG8_MMA(0, 1, At, B1); PG8_BAR;
            PG8_LDA(At, 1, 1); PG8_STAGE(PG8_SA(1, 0), a3, voffA);
            PG8_BAR; PG8_WAIT_L(0); PG8_MMA(1, 0, At, B0); PG8_BAR; PG8_SCHED;
            PG8_STAGE(PG8_SB(1, 1), b3 + hB, voffB);
            PG8_WAIT_V(6); PG8_BAR; PG8_MMA(1, 1, At, B1); PG8_BAR;
            }
        }
        if constexpr (ALIGN_EPI) { if (wr == 0) PG8_BAR; }
        if constexpr (!Epi::AFTER_DRAIN) { E(acc, cur, wr, wc, fr, fq); S.done(cur); }
        if (!has_next) break;
#pragma unroll
        for (int a = 0; a < 2; ++a)
#pragma unroll
            for (int b = 0; b < 2; ++b)
#pragma unroll
                for (int m = 0; m < 4; ++m)
#pragma unroll
                    for (int n = 0; n < 2; ++n) acc[a][b][m][n] = (f32x4){0.f, 0.f, 0.f, 0.f};
        cur = nxt; cA = nA; cB = nB; ++ui;
        if constexpr (ALIGN_EPI) { if (wr == 1) PG8_BAR; }
    }
    PG8_WAIT_V(0);
    if constexpr (!ALIGN_EPI) { if (wr == 0) PG8_BAR; }
    PG8_BAR;
    if constexpr (Epi::AFTER_DRAIN) { E.fused(acc, cur, wr, wc, fr, fq, lds, wid, lane); S.done(cur); }
#undef PG8_SA
#undef PG8_SB
#undef PG8_STAGE
#undef PG8_LDA
#undef PG8_LDB
#undef PG8_MMA
#undef PG8_WAIT_V
#undef PG8_WAIT_L
#undef PG8_BAR
#undef PG8_SCHED
}
}
namespace pg8 {
struct EpiRes {
    static constexpr bool PERM = false, AFTER_DRAIN = false;
    const float* base; float* out; int ldc;
    __device__ __forceinline__ void operator()(const f32x4 (&acc)[2][2][4][2], const Unit& u, int wr, int wc, int fr, int fq) const {
        const int col0 = u.pn * BM + wc * 32 + 4 * fq;
#pragma unroll
        for (int ai = 0; ai < 2; ++ai)
#pragma unroll
            for (int m = 0; m < 4; ++m) { const size_t off = (size_t)(u.pm * BM + ai * HALF + wr * 64 + m * 16 + fr) * ldc + col0;
#pragma unroll
                for (int bj = 0; bj < 2; ++bj)
#pragma unroll
                    for (int n = 0; n < 2; ++n) { const f32x4 b = *(const f32x4*)(base + off + bj * HALF + n * 16); *(f32x4*)(out + off + bj * HALF + n * 16) = b + acc[ai][bj][m][n]; } }
    }
};
struct EpiConvGlu {
    static constexpr bool PERM = false, AFTER_DRAIN = false;
    bf16_t* O; const float* cw; const float* cb; int M;
    __device__ __forceinline__ void operator()(const f32x4 (&acc)[2][2][4][2], const Unit& u, int wr, int wc, int fr, int fq) const {
        const int lane = fq * 16 + fr;
        const int src1 = fq * 16 + ((fr + 15) & 15), src2 = fq * 16 + ((fr + 14) & 15);
#pragma unroll
        for (int ai = 0; ai < 2; ++ai) {
            const int pb = 248 * u.pm + 62 * (2 * ai + wr) - 2;
#pragma unroll
            for (int n = 0; n < 2; ++n) {
                const int jg = 128 * u.pn + 32 * wc + 16 * n + 4 * fq;
                const f32x4 g0 = *(const f32x4*)(cw + jg), g1 = *(const f32x4*)(cw + 5632 + jg), g2 = *(const f32x4*)(cw + 2 * 5632 + jg), gb = *(const f32x4*)(cb + jg);
                const f32x4 v0 = *(const f32x4*)(cw + 2816 + jg), v1 = *(const f32x4*)(cw + 5632 + 2816 + jg), v2 = *(const f32x4*)(cw + 2 * 5632 + 2816 + jg), vb = *(const f32x4*)(cb + 2816 + jg);
                f32x4 pg1, pg2, pv1, pv2;
#pragma unroll
                for (int m = 0; m < 4; ++m) {
                    f32x4 zg = acc[ai][0][m][n], zv = acc[ai][1][m][n];
                    const int pos = pb + 16 * m + fr;
                    if (pos < 0) { zg = (f32x4){0.f, 0.f, 0.f, 0.f}; zv = zg; }
                    f32x4 rg1, rg2, rv1, rv2;
#pragma unroll
                    for (int e = 0; e < 4; ++e) { rg1[e] = __shfl(zg[e], src1); rg2[e] = __shfl(zg[e], src2); rv1[e] = __shfl(zv[e], src1); rv2[e] = __shfl(zv[e], src2); }
                    f32x4 zg1, zg2, zv1, zv2;
                    if (m == 0) { zg1 = rg1; zg2 = rg2; zv1 = rv1; zv2 = rv2; }
                    else {
#pragma unroll
                        for (int e = 0; e < 4; ++e) { zg1[e] = fr >= 1 ? rg1[e] : pg1[e]; zg2[e] = fr >= 2 ? rg2[e] : pg2[e]; zv1[e] = fr >= 1 ? rv1[e] : pv1[e]; zv2[e] = fr >= 2 ? rv2[e] : pv2[e]; }
                    }
                    pg1 = rg1; pg2 = rg2; pv1 = rv1; pv2 = rv2;
                    const f32x4 cg = g0 * zg2 + g1 * zg1 + g2 * zg + gb;
                    const f32x4 cv = v0 * zv2 + v1 * zv1 + v2 * zv + vb;
                    f32x4 a;
#pragma unroll
                    for (int e = 0; e < 4; ++e) a[e] = cg[e] / (1.0f + __expf(-cg[e])) * cv[e];
                    if ((16 * m + fr) >= 2 && pos < M) {
                        typedef unsigned u32x2 __attribute__((ext_vector_type(2)));
                        u32x2 w; w.x = cvt_pk_bf16(a[0], a[1]); w.y = cvt_pk_bf16(a[2], a[3]);
                        *(u32x2*)(O + (size_t)pos * 2816 + jg) = w;
                    }
                }
            }
        }
        (void)lane;
    }
};
}
#define LAS __attribute__((address_space(3)))
typedef unsigned short bf16;
typedef float f32x4 __attribute__((ext_vector_type(4)));
typedef short bf16x8 __attribute__((ext_vector_type(8)));
typedef unsigned v4u __attribute__((ext_vector_type(4)));
typedef unsigned v2u __attribute__((ext_vector_type(2)));
constexpr int NWAVES = 8;
constexpr int M = 16384, D = 1024, EIN = 2816, FF = 2816, FF2 = 5632, NQKV = 3072, BW = 512;
constexpr size_t MiB = 1u << 20;
constexpr size_t WS_W2T = 1 * MiB, WS_A2T = WS_W2T + 65536, WS_G2T = WS_A2T + 65536, WS_BS = WS_G2T + 131072;
constexpr size_t WS_WA = 2 * MiB, WS_WB = 13 * MiB, WS_XN = 20 * MiB, WS_GEN = 52 * MiB, WS_END = 256 * MiB;
constexpr size_t WS_P = WS_GEN, WS_LD = WS_GEN + 88 * MiB, WS_KK = WS_LD + 32 * MiB, WS_BB = WS_KK + 16 * MiB, WS_KP = WS_BB + 16 * MiB, WS_RR = WS_KP + 16 * MiB, WS_VV = WS_RR + 16 * MiB;
static_assert(WS_VV + 16 * MiB <= WS_END, "ws map");
constexpr size_t WS_QKV = WS_GEN, WS_VT1 = WS_GEN + 96 * MiB, WS_VT4 = WS_VT1 + 32 * MiB, WS_VT16 = WS_VT4 + 32 * MiB;
static_assert(WS_VT16 + 33 * MiB <= WS_END, "ws map");
constexpr int LDS_BYTES = 147456;

__device__ __forceinline__ float bf2f(unsigned short v) { return __uint_as_float(((unsigned)v) << 16); }
__device__ __forceinline__ unsigned f2bf(float f) { unsigned u = __float_as_uint(f); return (u + 0x7fffu + ((u >> 16) & 1u)) >> 16; }
__device__ __forceinline__ unsigned pk2(float lo, float hi) { return f2bf(lo) | (f2bf(hi) << 16); }
__device__ __forceinline__ float wave_sum(float v) {
#pragma unroll
    for (int o = 1; o < 64; o <<= 1) v += __shfl_xor(v, o);
    return v;
}
__device__ __forceinline__ float dpp_row_shr(float v, int n) {
    const int iv = __builtin_bit_cast(int, v); int r;
    switch (n) { case 1: r = __builtin_amdgcn_update_dpp(0, iv, 0x111, 0xf, 0xf, true); break; case 2: r = __builtin_amdgcn_update_dpp(0, iv, 0x112, 0xf, 0xf, true); break;
                 case 4: r = __builtin_amdgcn_update_dpp(0, iv, 0x114, 0xf, 0xf, true); break; default: r = __builtin_amdgcn_update_dpp(0, iv, 0x118, 0xf, 0xf, true); break; }
    return __builtin_bit_cast(float, r);
}
__device__ __forceinline__ float wave_sum_uniform(float v) {
    v += dpp_row_shr(v, 1); v += dpp_row_shr(v, 2); v += dpp_row_shr(v, 4); v += dpp_row_shr(v, 8);
    v += __builtin_bit_cast(float, __builtin_amdgcn_update_dpp(0, __builtin_bit_cast(int, v), 0x142, 0xa, 0xf, false));
    v += __builtin_bit_cast(float, __builtin_amdgcn_update_dpp(0, __builtin_bit_cast(int, v), 0x143, 0xc, 0xf, false));
    return __builtin_bit_cast(float, __builtin_amdgcn_readlane(__builtin_bit_cast(int, v), 63));
}
#define MFMA16(a, b, c) __builtin_amdgcn_mfma_f32_16x16x32_bf16((a), (b), (c), 0, 0, 0)

__device__ __forceinline__ void transpose_item(const float* W, int K, int N, bf16* WT, LAS float* scr, int item, int lane) {
    const int nblk = N / 32, kb = item / nblk, nb = item % nblk, k0 = 64 * kb, n0 = 32 * nb;
#pragma unroll 8
    for (int i = 0; i < 32; ++i) { const int kk = 2 * i + (lane >> 5); scr[kk * 33 + (lane & 31)] = W[(size_t)(k0 + kk) * N + n0 + (lane & 31)]; }
    asm volatile("s_waitcnt lgkmcnt(0)" ::: "memory");
    const int c = lane & 7;
#pragma unroll
    for (int j = 0; j < 4; ++j) { const int n = (lane >> 3) + 8 * j; const LAS float* s = scr + (8 * c) * 33 + n;
        v4u o; o.x = pk2(s[0 * 33], s[1 * 33]); o.y = pk2(s[2 * 33], s[3 * 33]); o.z = pk2(s[4 * 33], s[5 * 33]); o.w = pk2(s[6 * 33], s[7 * 33]);
        *(v4u*)(WT + (size_t)(n0 + n) * K + k0 + 8 * c) = o; }
    asm volatile("s_waitcnt lgkmcnt(0)" ::: "memory");
}
__device__ __forceinline__ void rms_row_to_bf16(const float* xrow, const float* gain, bf16* orow, int lane) {
    const f32x4* xr = (const f32x4*)xrow + lane; const f32x4* gr = (const f32x4*)gain + lane;
    f32x4 v[4]; float s = 0.f;
#pragma unroll
    for (int j = 0; j < 4; ++j) { v[j] = xr[64 * j]; s += (v[j].x * v[j].x + v[j].y * v[j].y) + (v[j].z * v[j].z + v[j].w * v[j].w); }
    const float rstd = 1.0f / sqrtf(wave_sum(s) * (1.f / D) + 1e-6f);
    v2u* o8 = (v2u*)orow + lane;
#pragma unroll
    for (int j = 0; j < 4; ++j) { const f32x4 g = gr[64 * j]; v2u w; w.x = pk2(v[j].x * rstd * g.x, v[j].y * rstd * g.y); w.y = pk2(v[j].z * rstd * g.z, v[j].w * rstd * g.w); o8[64 * j] = w; }
}
__device__ __forceinline__ void rms_row_inplace(float* xrow, const float* gain, int lane) {
    f32x4* xr = (f32x4*)xrow + lane; const f32x4* gr = (const f32x4*)gain + lane;
    f32x4 v[4]; float s = 0.f;
#pragma unroll
    for (int j = 0; j < 4; ++j) { v[j] = xr[64 * j]; s += (v[j].x * v[j].x + v[j].y * v[j].y) + (v[j].z * v[j].z + v[j].w * v[j].w); }
    const float rstd = 1.0f / sqrtf(wave_sum(s) * (1.f / D) + 1e-6f);
#pragma unroll
    for (int j = 0; j < 4; ++j) { const f32x4 g = gr[64 * j]; xr[64 * j] = v[j] * rstd * g; }
}
__device__ __forceinline__ void norm_phase(LAS unsigned char* lds, int gw, int NGW, int wave, int lane, const float* x, const float* gain, bf16* XN,
                                           const float* W1, int K1, int N1, bf16* W1t, const float* W2, int K2, int N2, bf16* W2t) {
    LAS float* scr = (LAS float*)(lds + wave * 16384);
    const int I1 = (K1 / 64) * (N1 / 32), I2 = (K2 / 64) * (N2 / 32);
    for (int it = gw; it < I1 + I2; it += NGW) {
        if (it < I1) transpose_item(W1, K1, N1, W1t, scr, it, lane); else transpose_item(W2, K2, N2, W2t, scr, it - I1, lane);
    }
    for (int m = gw; m < M; m += NGW) rms_row_to_bf16(x + (size_t)m * D, gain, XN + (size_t)m * D, lane);
}

__device__ __forceinline__ void gmlp_item(LAS unsigned char* lds, int item, int tid, int wave, int lane, const bf16* P, const float* ln_g, const float* ln_b,
                                          const float* w_s, const float* b_s, bf16* Y) {
    const int chunk = item >> 2, g = item & 3, t0 = chunk * 128;
    LAS bf16* Wm = (LAS bf16*)lds;
    LAS bf16* Vt = (LAS bf16*)(lds + 128 * 136 * 2);
    for (int i = 0; i < 16; ++i) {
        const int s = wave * 16 + i;
        const v4u raw = *(const v4u*)(P + (size_t)(t0 + s) * EIN + 512 + lane * 8);
        float v[8];
        v[0] = __uint_as_float(raw.x << 16); v[1] = __uint_as_float(raw.x & 0xffff0000u); v[2] = __uint_as_float(raw.y << 16); v[3] = __uint_as_float(raw.y & 0xffff0000u);
        v[4] = __uint_as_float(raw.z << 16); v[5] = __uint_as_float(raw.z & 0xffff0000u); v[6] = __uint_as_float(raw.w << 16); v[7] = __uint_as_float(raw.w & 0xffff0000u);
        float sum = 0.f;
#pragma unroll
        for (int e = 0; e < 8; ++e) sum += v[e];
        const float mean = wave_sum(sum) * (1.f / 512.f);
        float q = 0.f;
#pragma unroll
        for (int e = 0; e < 8; ++e) { v[e] -= mean; q += v[e] * v[e]; }
        const float rstd = 1.0f / sqrtf(wave_sum(q) * (1.f / 512.f) + 1e-5f);
        if ((lane >> 4) == g) {
#pragma unroll
            for (int e = 0; e < 8; ++e) { const int c = (lane & 15) * 8 + e, ch = g * 128 + c; Vt[c * 136 + s] = (bf16)f2bf(v[e] * rstd * ln_g[ch] + ln_b[ch]); }
        }
    }
    for (int idx = tid; idx < 128 * 32; idx += 512) {
        const int t = idx >> 5, s4 = (idx & 31) * 4;
        const f32x4 w = *(const f32x4*)(w_s + ((size_t)g * 128 + t) * 128 + s4);
        v2u o; o.x = pk2(s4 + 0 <= t ? w.x : 0.f, s4 + 1 <= t ? w.y : 0.f); o.y = pk2(s4 + 2 <= t ? w.z : 0.f, s4 + 3 <= t ? w.w : 0.f);
        *(LAS v2u*)(Wm + t * 136 + s4) = o;
    }
    __syncthreads();
    const int r = lane & 15, q4 = lane >> 4;
    f32x4 acc[8];
#pragma unroll
    for (int ct = 0; ct < 8; ++ct) acc[ct] = (f32x4){0.f, 0.f, 0.f, 0.f};
    const int nks = (16 * wave + 15) / 32 + 1;
    for (int ks = 0; ks < nks; ++ks) {
        const bf16x8 af = *(const LAS bf16x8*)(Wm + (16 * wave + r) * 136 + ks * 32 + q4 * 8);
#pragma unroll
        for (int ct = 0; ct < 8; ++ct) { const bf16x8 bfr = *(const LAS bf16x8*)(Vt + (16 * ct + r) * 136 + ks * 32 + q4 * 8); acc[ct] = MFMA16(af, bfr, acc[ct]); }
    }
#pragma unroll
    for (int ct = 0; ct < 8; ++ct)
#pragma unroll
        for (int e = 0; e < 4; ++e) {
            const int t = 16 * wave + 4 * q4 + e, c = 16 * ct + r;
            const float mixed = acc[ct][e] + b_s[g * 128 + t];
            const float u = bf2f(P[(size_t)(t0 + t) * EIN + g * 128 + c]);
            Y[(size_t)(t0 + t) * D + g * 128 + c] = (bf16)f2bf(u * mixed);
        }
    __syncthreads();
}

struct RwkvW { const float *mu, *w0, *a0, *k_k, *k_a, *r_k; const bf16 *w2t, *a2t, *g2t; };
__device__ __forceinline__ float shifted(const bf16* P, int t, int col, float mu) {
    const float cur = bf2f(P[(size_t)t * EIN + col]); const float prev = t > 0 ? bf2f(P[(size_t)(t - 1) * EIN + col]) : 0.f; return cur + (prev - cur) * mu;
}
__device__ __forceinline__ void rwkv_prep_item(LAS unsigned char* lds, int item, int tid, int wave, int lane, const bf16* P, const RwkvW& W,
                                               float* LD, bf16* KK, bf16* BB, bf16* KP, bf16* RR, bf16* VV, bf16* GG, float* BS) {
    const int t0 = item * 64;
    LAS bf16* Xl = (LAS bf16*)lds;
    for (int idx = tid; idx < 64 * 256; idx += 512) {
        const int t = idx >> 8, j = idx & 255;
        const float ps = shifted(P, t0 + t, 1024 + 1536 + j, W.mu[1536 + j]);
        const float val = j < 64 ? tanhf(ps) : (j < 128 ? ps : 1.0f / (1.0f + __expf(-ps)));
        Xl[t * 264 + j] = (bf16)f2bf(val);
    }
    __syncthreads();
    const int h = wave, r = lane & 15, q4 = lane >> 4;
    for (int tt = 0; tt < 4; ++tt) {
        f32x4 aW[4], aA[4], aG[4];
#pragma unroll
        for (int ct = 0; ct < 4; ++ct) { aW[ct] = (f32x4){0.f, 0.f, 0.f, 0.f}; aA[ct] = aW[ct]; aG[ct] = aW[ct]; }
#pragma unroll
        for (int ks = 0; ks < 2; ++ks) {
            const bf16x8 xw = *(const LAS bf16x8*)(Xl + (16 * tt + r) * 264 + ks * 32 + q4 * 8);
            const bf16x8 xa = *(const LAS bf16x8*)(Xl + (16 * tt + r) * 264 + 64 + ks * 32 + q4 * 8);
#pragma unroll
            for (int ct = 0; ct < 4; ++ct) {
                const bf16x8 yw = *(const bf16x8*)(W.w2t + (size_t)(h * 64 + 16 * ct + r) * 64 + ks * 32 + q4 * 8);
                const bf16x8 ya = *(const bf16x8*)(W.a2t + (size_t)(h * 64 + 16 * ct + r) * 64 + ks * 32 + q4 * 8);
                aW[ct] = MFMA16(xw, yw, aW[ct]); aA[ct] = MFMA16(xa, ya, aA[ct]);
            }
        }
#pragma unroll
        for (int ks = 0; ks < 4; ++ks) {
            const bf16x8 xg = *(const LAS bf16x8*)(Xl + (16 * tt + r) * 264 + 128 + ks * 32 + q4 * 8);
#pragma unroll
            for (int ct = 0; ct < 4; ++ct) {
                const bf16x8 yg = *(const bf16x8*)(W.g2t + (size_t)(h * 64 + 16 * ct + r) * 128 + ks * 32 + q4 * 8);
                aG[ct] = MFMA16(xg, yg, aG[ct]);
            }
        }
#pragma unroll
        for (int e = 0; e < 4; ++e) {
            const int t = t0 + 16 * tt + 4 * q4 + e;
            float kkr[4], av[4]; float ss = 0.f, bon = 0.f;
#pragma unroll
            for (int ct = 0; ct < 4; ++ct) {
                const int c = h * 64 + 16 * ct + r;
                const float r_ = shifted(P, t, 1024 + c, W.mu[c]);
                const float k_ = shifted(P, t, 1024 + 512 + c, W.mu[512 + c]);
                const float v_ = shifted(P, t, 1024 + 1024 + c, W.mu[1024 + c]);
                const float xw = -(W.w0[c] + aW[ct][e]);
                const float sp = xw > 20.f ? xw : log1pf(__expf(xw));
                const float wv = -sp - 0.5f;
                const float ld = -__expf(wv);
                const float a = 1.0f / (1.0f + __expf(-(W.a0[c] + aA[ct][e])));
                const float kr = k_ * W.k_k[c];
                const float kp = k_ * (1.0f + (a - 1.0f) * W.k_a[c]);
                kkr[ct] = kr; av[ct] = a; ss += kr * kr; bon += r_ * kp * W.r_k[c];
                const size_t o = (size_t)t * BW + c;
                LD[o] = ld; KP[o] = (bf16)f2bf(kp); RR[o] = (bf16)f2bf(r_); VV[o] = (bf16)f2bf(v_); GG[o] = (bf16)f2bf(aG[ct][e]);
            }
#pragma unroll
            for (int o = 1; o < 16; o <<= 1) { ss += __shfl_xor(ss, o); bon += __shfl_xor(bon, o); }
            const float inv = 1.0f / sqrtf(fmaxf(ss, 1e-24f));
#pragma unroll
            for (int ct = 0; ct < 4; ++ct) {
                const int c = h * 64 + 16 * ct + r; const size_t o = (size_t)t * BW + c;
                const float kk = kkr[ct] * inv;
                KK[o] = (bf16)f2bf(kk); BB[o] = (bf16)f2bf(kk * av[ct]);
            }
            if (r == 0) BS[(size_t)t * 8 + h] = bon;
        }
    }
    __syncthreads();
}

struct ScanRegs { unsigned short kk[8], bb[8], kp[8], rr[8], vv[8]; float ld[8]; };
__device__ __forceinline__ void scan_load(ScanRegs& R, int t0, int hc, int hv, const float* LD, const bf16* KK, const bf16* BB, const bf16* KP, const bf16* RR, const bf16* VV) {
#pragma unroll
    for (int i = 0; i < 8; ++i) { const size_t o = (size_t)(t0 + i) * BW;
        R.kk[i] = KK[o + hc]; R.bb[i] = BB[o + hc]; R.kp[i] = KP[o + hc]; R.rr[i] = RR[o + hc]; R.ld[i] = LD[o + hc]; R.vv[i] = VV[o + hv]; }
}
__device__ __forceinline__ void rwkv_scan_wave(int gwv, int lane, const float* LD, const bf16* KK, const bf16* BB, const bf16* KP, const bf16* RR, const bf16* VV, float* OSC) {
    const int h = gwv >> 6, v = gwv & 63, hc = h * 64 + lane, hv = h * 64 + v;
    float S = 0.f;
    ScanRegs cur, nxt;
    scan_load(cur, 0, hc, hv, LD, KK, BB, KP, RR, VV);
    for (int t0 = 0; t0 < M; t0 += 8) {
        const int tn = (t0 + 8 < M) ? t0 + 8 : t0;
        scan_load(nxt, tn, hc, hv, LD, KK, BB, KP, RR, VV);
#pragma unroll
        for (int i = 0; i < 8; ++i) {
            const float kk = bf2f(cur.kk[i]), bb = bf2f(cur.bb[i]), kp = bf2f(cur.kp[i]), rr = bf2f(cur.rr[i]), vv = bf2f(cur.vv[i]);
            const float dec = __expf(cur.ld[i]);
            const float sa = wave_sum_uniform(S * kk);
            S = S * dec - sa * bb + vv * kp;
            const float o = wave_sum_uniform(S * rr);
            if (lane == 0) OSC[(size_t)(t0 + i) * BW + hv] = o;
        }
        cur = nxt;
    }
}
__device__ __forceinline__ void rwkv_out_row(int t, int lane, const float* OSC, const float* BS, const bf16* VV, const bf16* GG, const float* gn_g, const float* gn_b, bf16* Y) {
    const int c0 = lane * 8;
    const f32x4 o0 = *(const f32x4*)(OSC + (size_t)t * BW + c0), o1 = *(const f32x4*)(OSC + (size_t)t * BW + c0 + 4);
    float v[8] = {o0.x, o0.y, o0.z, o0.w, o1.x, o1.y, o1.z, o1.w};
    float s = 0.f;
#pragma unroll
    for (int e = 0; e < 8; ++e) s += v[e];
    s += __shfl_xor(s, 1); s += __shfl_xor(s, 2); s += __shfl_xor(s, 4);
    const float mean = s * (1.f / 64.f);
    float q = 0.f;
#pragma unroll
    for (int e = 0; e < 8; ++e) { v[e] -= mean; q += v[e] * v[e]; }
    q += __shfl_xor(q, 1); q += __shfl_xor(q, 2); q += __shfl_xor(q, 4);
    const float rstd = 1.0f / sqrtf(q * (1.f / 64.f) + 64e-5f);
    const float bon = BS[(size_t)t * 8 + (lane >> 3)];
    const v4u vraw = *(const v4u*)(VV + (size_t)t * BW + c0), graw = *(const v4u*)(GG + (size_t)t * BW + c0);
    const unsigned vr[4] = {vraw.x, vraw.y, vraw.z, vraw.w}, gr[4] = {graw.x, graw.y, graw.z, graw.w};
    float outv[8];
#pragma unroll
    for (int e = 0; e < 8; ++e) {
        const float vv = (e & 1) ? __uint_as_float(vr[e >> 1] & 0xffff0000u) : __uint_as_float(vr[e >> 1] << 16);
        const float gg = (e & 1) ? __uint_as_float(gr[e >> 1] & 0xffff0000u) : __uint_as_float(gr[e >> 1] << 16);
        outv[e] = (v[e] * rstd * gn_g[c0 + e] + gn_b[c0 + e] + bon * vv) * gg;
    }
    v4u w; w.x = pk2(outv[0], outv[1]); w.y = pk2(outv[2], outv[3]); w.z = pk2(outv[4], outv[5]); w.w = pk2(outv[6], outv[7]);
    *(v4u*)(Y + (size_t)t * D + 512 + c0) = w;
}

__device__ __forceinline__ void vtrans_item(LAS unsigned char* lds, int item, int tid, const bf16* QKV, bf16* VT1, bf16* VT4, bf16* VT16) {
    const int h = item >> 6, blk = item & 63, t0 = blk * 256;
    LAS bf16* Vl = (LAS bf16*)lds;
#pragma unroll
    for (int i = 0; i < 4; ++i) { const int idx = tid + 512 * i, t = idx >> 3, ch = idx & 7;
        *(LAS v4u*)(Vl + t * 72 + ch * 8) = *(const v4u*)(QKV + (size_t)(t0 + t) * NQKV + 2048 + h * 64 + ch * 8); }
    __syncthreads();
#pragma unroll
    for (int i = 0; i < 4; ++i) {
        const int idx = tid + 512 * i, d = idx >> 5;
        { const int j = idx & 31; unsigned short e[8];
#pragma unroll
          for (int k = 0; k < 8; ++k) e[k] = Vl[(8 * j + k) * 72 + d];
          v4u o; o.x = e[0] | ((unsigned)e[1] << 16); o.y = e[2] | ((unsigned)e[3] << 16); o.z = e[4] | ((unsigned)e[5] << 16); o.w = e[6] | ((unsigned)e[7] << 16);
          *(v4u*)(VT1 + (size_t)(h * 64 + d) * 16384 + t0 + 8 * j) = o; }
        { const int c4 = (idx >> 3) & 3, j = idx & 7; unsigned short e[8];
#pragma unroll
          for (int k = 0; k < 8; ++k) e[k] = Vl[(4 * (8 * j + k) + c4) * 72 + d];
          v4u o; o.x = e[0] | ((unsigned)e[1] << 16); o.y = e[2] | ((unsigned)e[3] << 16); o.z = e[4] | ((unsigned)e[5] << 16); o.w = e[6] | ((unsigned)e[7] << 16);
          *(v4u*)(VT4 + ((size_t)(h * 64 + d) * 4 + c4) * 4096 + t0 / 4 + 8 * j) = o; }
        { const int c16 = (idx >> 1) & 15, j = idx & 1; unsigned short e[8];
#pragma unroll
          for (int k = 0; k < 8; ++k) e[k] = Vl[(16 * (8 * j + k) + c16) * 72 + d];
          v4u o; o.x = e[0] | ((unsigned)e[1] << 16); o.y = e[2] | ((unsigned)e[3] << 16); o.z = e[4] | ((unsigned)e[5] << 16); o.w = e[6] | ((unsigned)e[7] << 16);
          *(v4u*)(VT16 + ((size_t)(h * 64 + d) * 16 + c16) * 1024 + t0 / 16 + 8 * j) = o; }
    }
    __syncthreads();
}

template <int DIL, int NGRP>
__device__ __forceinline__ void attn_pattern(const bf16* QKV, const bf16* VT, int h, int blk, int cls, int lane, const bf16x8 (&qf)[2], f32x4 (&o)[4], float& mrun, float& lrun) {
    constexpr int TD = M / DIL;
    const int r = lane & 15, q4 = lane >> 4, m = r;
    const int cp = cls & (DIL - 1);
    const int nq = (256 * blk + cls - cp) / DIL + (16 / DIL) * m;
    const int nstart = (256 * blk) / DIL - 128;
    const int kA = 8 * (r >> 2) + (r & 3);
    const float C = 0.125f * 1.4426950408889634f;
    const bf16* Kb = QKV + 1024 + h * 64 + q4 * 8;
    for (int g = 0; g < NGRP; ++g) {
        const int nb = nstart + 32 * g;
        int posA = cp + DIL * (nb + kA), posB = posA + 4 * DIL;
        posA = posA < 0 ? 0 : (posA > M - 1 ? M - 1 : posA); posB = posB < 0 ? 0 : (posB > M - 1 ? M - 1 : posB);
        const bf16x8 ka0 = *(const bf16x8*)(Kb + (size_t)posA * NQKV), ka1 = *(const bf16x8*)(Kb + (size_t)posA * NQKV + 32);
        const bf16x8 kb0 = *(const bf16x8*)(Kb + (size_t)posB * NQKV), kb1 = *(const bf16x8*)(Kb + (size_t)posB * NQKV + 32);
        f32x4 sA = (f32x4){0.f, 0.f, 0.f, 0.f}, sB = sA;
        sA = MFMA16(ka0, qf[0], sA); sA = MFMA16(ka1, qf[1], sA);
        sB = MFMA16(kb0, qf[0], sB); sB = MFMA16(kb1, qf[1], sB);
        float s[8]; bool ok[8]; float tmax = -1e30f;
#pragma unroll
        for (int e = 0; e < 8; ++e) {
            const int n = nb + 8 * q4 + e;
            ok[e] = (n >= 0) && (n <= nq) && (n >= nq - 128);
            s[e] = ok[e] ? (e < 4 ? sA[e & 3] : sB[e & 3]) * C : -1e30f;
            tmax = fmaxf(tmax, s[e]);
        }
        tmax = fmaxf(tmax, __shfl_xor(tmax, 16)); tmax = fmaxf(tmax, __shfl_xor(tmax, 32));
        const float mnew = fmaxf(mrun, tmax);
        const float alpha = __builtin_amdgcn_exp2f(mrun - mnew);
        float p[8]; float ps = 0.f;
#pragma unroll
        for (int e = 0; e < 8; ++e) { p[e] = ok[e] ? __builtin_amdgcn_exp2f(s[e] - mnew) : 0.f; ps += p[e]; }
        lrun = lrun * alpha + ps; mrun = mnew;
#pragma unroll
        for (int dt = 0; dt < 4; ++dt) o[dt] = o[dt] * alpha;
        v4u pw; pw.x = pk2(p[0], p[1]); pw.y = pk2(p[2], p[3]); pw.z = pk2(p[4], p[5]); pw.w = pk2(p[6], p[7]);
        const bf16x8 pf = __builtin_bit_cast(bf16x8, pw);
        int nv = nb + 8 * q4; nv = nv < 0 ? 0 : (nv > TD - 8 ? TD - 8 : nv);
#pragma unroll
        for (int dt = 0; dt < 4; ++dt) {
            const bf16x8 vf = *(const bf16x8*)(VT + ((size_t)(h * 64 + 16 * dt + r) * DIL + cp) * TD + nv);
            o[dt] = MFMA16(vf, pf, o[dt]);
        }
    }
}
__device__ __forceinline__ void attn_wave_item(const bf16* QKV, const bf16* VT1, const bf16* VT4, const bf16* VT16, bf16* AO, int h, int blk, int cls, int lane) {
    const int r = lane & 15, q4 = lane >> 4;
    const int im = 256 * blk + cls + 16 * r;
    bf16x8 qf[2];
    qf[0] = *(const bf16x8*)(QKV + (size_t)im * NQKV + h * 64 + q4 * 8);
    qf[1] = *(const bf16x8*)(QKV + (size_t)im * NQKV + h * 64 + 32 + q4 * 8);
    f32x4 o[4];
#pragma unroll
    for (int dt = 0; dt < 4; ++dt) o[dt] = (f32x4){0.f, 0.f, 0.f, 0.f};
    float mrun = -1e30f, lrun = 0.f;
    attn_pattern<1, 12>(QKV, VT1, h, blk, cls, lane, qf, o, mrun, lrun);
    attn_pattern<4, 6>(QKV, VT4, h, blk, cls, lane, qf, o, mrun, lrun);
    attn_pattern<16, 5>(QKV, VT16, h, blk, cls, lane, qf, o, mrun, lrun);
    float l = lrun; l += __shfl_xor(l, 16); l += __shfl_xor(l, 32);
    const float inv = 1.0f / l;
#pragma unroll
    for (int dt = 0; dt < 4; ++dt) {
        v2u w; w.x = pk2(o[dt][0] * inv, o[dt][1] * inv); w.y = pk2(o[dt][2] * inv, o[dt][3] * inv);
        *(v2u*)(AO + (size_t)im * D + h * 64 + 16 * dt + 4 * q4) = w;
    }
}
constexpr int CH_CL = 0, CH_AT = 17408, CH_RT = CH_AT + 9216, CH_BT = CH_RT + 9216, CH_KT = CH_BT + 9216, CH_BHT = CH_KT + 9216, CH_KHT = CH_BHT + 9216, CH_VT = CH_KHT + 9216,
              CH_MABF = CH_VT + 9216, CH_MAK = CH_MABF + 17408, CH_MBR = CH_MAK + 9216, CH_MKR = CH_MBR + 9216, CH_GL = CH_MKR + 9216, CH_MABB = CH_GL + 256, CH_TJ = CH_MABB + 9216, CH_END = CH_TJ + 2048;
static_assert(CH_END <= 147456, "chunk LDS map");
__device__ __forceinline__ void unpack8(const v4u raw, float (&v)[8]) {
    v[0] = __uint_as_float(raw.x << 16); v[1] = __uint_as_float(raw.x & 0xffff0000u); v[2] = __uint_as_float(raw.y << 16); v[3] = __uint_as_float(raw.y & 0xffff0000u);
    v[4] = __uint_as_float(raw.z << 16); v[5] = __uint_as_float(raw.z & 0xffff0000u); v[6] = __uint_as_float(raw.w << 16); v[7] = __uint_as_float(raw.w & 0xffff0000u);
}
__device__ __forceinline__ v4u pack8(const float (&v)[8]) { v4u o; o.x = pk2(v[0], v[1]); o.y = pk2(v[2], v[3]); o.z = pk2(v[4], v[5]); o.w = pk2(v[6], v[7]); return o; }

__device__ __forceinline__ void rwkv_chunk_item(LAS unsigned char* lds, int item, int tid, int wave, int lane, const float* LD, const bf16* KK, const bf16* BB, const bf16* KP, const bf16* RR, const bf16* VV,
                                                bf16* PMT, float* SLOC, bf16* QT, float* OLT) {
    const int c = item >> 3, h = item & 7, t0 = c * 64;
    LAS float* CL = (LAS float*)(lds + CH_CL); LAS float* Y5F = (LAS float*)(lds + CH_CL);
    LAS bf16* AT = (LAS bf16*)(lds + CH_AT); LAS bf16* RT = (LAS bf16*)(lds + CH_RT); LAS bf16* BT = (LAS bf16*)(lds + CH_BT); LAS bf16* KT = (LAS bf16*)(lds + CH_KT);
    LAS bf16* UB = BT; LAS bf16* WB = KT;
    LAS bf16* BHT = (LAS bf16*)(lds + CH_BHT); LAS bf16* KHT = (LAS bf16*)(lds + CH_KHT); LAS bf16* VT = (LAS bf16*)(lds + CH_VT);
    LAS float* MABF = (LAS float*)(lds + CH_MABF); LAS bf16* MAK = (LAS bf16*)(lds + CH_MAK); LAS bf16* MBR = (LAS bf16*)(lds + CH_MBR); LAS bf16* MKR = (LAS bf16*)(lds + CH_MKR);
    LAS float* GL = (LAS float*)(lds + CH_GL); LAS bf16* MABB = (LAS bf16*)(lds + CH_MABB); LAS bf16* TJB = (LAS bf16*)(lds + CH_TJ);
    const size_t gbase = (size_t)t0 * BW + h * 64;
    if (tid < 64) {
        float run = 0.f;
#pragma unroll 8
        for (int t = 0; t < 64; ++t) { run += LD[gbase + (size_t)t * BW + tid]; CL[t * 64 + tid] = run; }
        GL[tid] = __expf(run);
    }
    __syncthreads();
    {
        const int t = tid >> 3, k8 = (tid & 7) * 8; const size_t o = gbase + (size_t)t * BW + k8;
        float kk[8], bb[8], kp[8], rr[8], vv[8];
        unpack8(*(const v4u*)(KK + o), kk); unpack8(*(const v4u*)(BB + o), bb); unpack8(*(const v4u*)(KP + o), kp); unpack8(*(const v4u*)(RR + o), rr); unpack8(*(const v4u*)(VV + o), vv);
        const f32x4 l0 = *(const f32x4*)(LD + o), l1 = *(const f32x4*)(LD + o + 4);
        const float ldv[8] = {l0.x, l0.y, l0.z, l0.w, l1.x, l1.y, l1.z, l1.w};
        float at[8], rt[8], bt[8], kt[8];
#pragma unroll
        for (int e = 0; e < 8; ++e) {
            const float cl = CL[t * 64 + k8 + e], clL = CL[63 * 64 + k8 + e];
            const float en = __expf(-cl), eh = __expf(clL - cl);
            at[e] = -kk[e] * __expf(cl - ldv[e]); rt[e] = rr[e] * __expf(cl); bt[e] = bb[e] * en; kt[e] = kp[e] * en;
            BHT[(k8 + e) * 72 + t] = (bf16)f2bf(bb[e] * eh); KHT[(k8 + e) * 72 + t] = (bf16)f2bf(kp[e] * eh); VT[(k8 + e) * 72 + t] = (bf16)f2bf(vv[e]);
        }
        *(LAS v4u*)(AT + t * 72 + k8) = pack8(at); *(LAS v4u*)(RT + t * 72 + k8) = pack8(rt); *(LAS v4u*)(BT + t * 72 + k8) = pack8(bt); *(LAS v4u*)(KT + t * 72 + k8) = pack8(kt);
    }
    __syncthreads();
    const int r = lane & 15, q4 = lane >> 4, par = wave & 1;
    {
        const int mi = wave >> 1;
        const LAS bf16* X = (mi == 0 || mi == 2) ? BT : KT; const LAS bf16* Y = (mi < 2) ? AT : RT;
        f32x4 acc[2][4];
#pragma unroll
        for (int a = 0; a < 2; ++a)
#pragma unroll
            for (int b = 0; b < 4; ++b) acc[a][b] = (f32x4){0.f, 0.f, 0.f, 0.f};
#pragma unroll
        for (int ks = 0; ks < 2; ++ks) {
            bf16x8 xf[2], yf[4];
#pragma unroll
            for (int a = 0; a < 2; ++a) xf[a] = *(const LAS bf16x8*)(X + (16 * (2 * par + a) + r) * 72 + ks * 32 + q4 * 8);
#pragma unroll
            for (int b = 0; b < 4; ++b) yf[b] = *(const LAS bf16x8*)(Y + (16 * b + r) * 72 + ks * 32 + q4 * 8);
#pragma unroll
            for (int a = 0; a < 2; ++a)
#pragma unroll
                for (int b = 0; b < 4; ++b) acc[a][b] = MFMA16(xf[a], yf[b], acc[a][b]);
        }
#pragma unroll
        for (int a = 0; a < 2; ++a)
#pragma unroll
            for (int b = 0; b < 4; ++b) {
                const int s0 = 16 * (2 * par + a) + 4 * q4, t = 16 * b + r;
                f32x4 m;
#pragma unroll
                for (int e = 0; e < 4; ++e) m[e] = ((mi < 2) ? (s0 + e < t) : (s0 + e <= t)) ? acc[a][b][e] : 0.f;
                if (mi == 0) { *(LAS f32x4*)(MABF + t * 68 + s0) = m; v2u w; w.x = pk2(m[0], m[1]); w.y = pk2(m[2], m[3]); *(LAS v2u*)(MABB + t * 72 + s0) = w; }
                else { LAS bf16* Mo = (mi == 1) ? MAK : (mi == 2 ? MBR : MKR); v2u w; w.x = pk2(m[0], m[1]); w.y = pk2(m[2], m[3]); *(LAS v2u*)(Mo + t * 72 + s0) = w; }
            }
    }
    __syncthreads();
    {
        const int vt = wave >> 1;
        f32x4 acc[2];
        acc[0] = (f32x4){0.f, 0.f, 0.f, 0.f}; acc[1] = acc[0];
#pragma unroll
        for (int ks = 0; ks < 2; ++ks) {
            const bf16x8 xf = *(const LAS bf16x8*)(VT + (16 * vt + r) * 72 + ks * 32 + q4 * 8);
#pragma unroll
            for (int b = 0; b < 2; ++b) { const bf16x8 yf = *(const LAS bf16x8*)(MAK + (16 * (2 * par + b) + r) * 72 + ks * 32 + q4 * 8); acc[b] = MFMA16(xf, yf, acc[b]); }
        }
#pragma unroll
        for (int b = 0; b < 2; ++b)
#pragma unroll
            for (int e = 0; e < 4; ++e) Y5F[(16 * vt + 4 * q4 + e) * 68 + 16 * (2 * par + b) + r] = acc[b][e];
    }
    __syncthreads();
    if (wave == 0) {
        const int J = lane >> 4, i = lane & 15;
        float tr[16];
#pragma unroll
        for (int t = 0; t < 16; ++t) {
            float acc = (t == i) ? 1.f : 0.f;
#pragma unroll
            for (int s2 = 0; s2 < t; ++s2) acc += tr[s2] * MABF[(16 * J + t) * 68 + 16 * J + s2];
            tr[t] = acc;
        }
#pragma unroll
        for (int t = 0; t < 16; ++t) TJB[(16 * J + t) * 16 + i] = (bf16)f2bf(tr[t]);
    }
    __syncthreads();
    {
        unsigned xb[4][2];
#pragma unroll
        for (int J = 0; J < 4; ++J) {
            f32x4 z;
            if (wave < 4) z = *(const LAS f32x4*)(Y5F + (16 * wave + r) * 68 + 16 * J + 4 * q4);
            else {
#pragma unroll
                for (int e = 0; e < 4; ++e) z[e] = bf2f(AT[(16 * J + 4 * q4 + e) * 72 + 16 * (wave - 4) + r]);
            }
#pragma unroll
            for (int I = 0; I < J; I += 2) {
                const bool two = (I + 1 < J);
                const v2u m0 = *(const LAS v2u*)(MABB + (16 * J + r) * 72 + 16 * I + 4 * q4);
                v2u m1; m1.x = 0u; m1.y = 0u;
                if (two) m1 = *(const LAS v2u*)(MABB + (16 * J + r) * 72 + 16 * (I + 1) + 4 * q4);
                v4u fa; fa.x = m0.x; fa.y = m0.y; fa.z = m1.x; fa.w = m1.y;
                v4u fb; fb.x = xb[I][0]; fb.y = xb[I][1]; fb.z = two ? xb[I + 1 < 4 ? I + 1 : 3][0] : 0u; fb.w = two ? xb[I + 1 < 4 ? I + 1 : 3][1] : 0u;
                z = MFMA16(__builtin_bit_cast(bf16x8, fa), __builtin_bit_cast(bf16x8, fb), z);
            }
            const unsigned zh0 = pk2(z[0], z[1]), zh1 = pk2(z[2], z[3]);
            const unsigned zl0 = pk2(z[0] - __uint_as_float(zh0 << 16), z[1] - __uint_as_float(zh0 & 0xffff0000u)), zl1 = pk2(z[2] - __uint_as_float(zh1 << 16), z[3] - __uint_as_float(zh1 & 0xffff0000u));
            const v2u tw = *(const LAS v2u*)(TJB + (16 * J + r) * 16 + 4 * q4);
            v4u ft; ft.x = tw.x; ft.y = tw.y; ft.z = 0u; ft.w = 0u;
            v4u fh; fh.x = zh0; fh.y = zh1; fh.z = 0u; fh.w = 0u;
            v4u fl; fl.x = zl0; fl.y = zl1; fl.z = 0u; fl.w = 0u;
            f32x4 x = (f32x4){0.f, 0.f, 0.f, 0.f};
            x = MFMA16(__builtin_bit_cast(bf16x8, ft), __builtin_bit_cast(bf16x8, fh), x);
            x = MFMA16(__builtin_bit_cast(bf16x8, ft), __builtin_bit_cast(bf16x8, fl), x);
            xb[J][0] = pk2(x[0], x[1]); xb[J][1] = pk2(x[2], x[3]);
            LAS bf16* Xo = (wave < 4) ? (UB + (16 * wave + r) * 72) : (WB + (16 * (wave - 4) + r) * 72);
            v2u w; w.x = xb[J][0]; w.y = xb[J][1];
            *(LAS v2u*)(Xo + 16 * J + 4 * q4) = w;
        }
    }
    __syncthreads();
    {
        const int kind = wave >> 1;
        const LAS bf16* X1; const LAS bf16* Y1; const LAS bf16* X2 = nullptr; const LAS bf16* Y2 = nullptr;
        if (kind == 0) { X1 = UB; Y1 = MBR; X2 = VT; Y2 = MKR; }
        else if (kind == 1) { X1 = BHT; Y1 = UB; X2 = KHT; Y2 = VT; }
        else if (kind == 2) { X1 = WB; Y1 = MBR; }
        else { X1 = WB; Y1 = BHT; }
        f32x4 acc[2][4];
#pragma unroll
        for (int a = 0; a < 2; ++a)
#pragma unroll
            for (int b = 0; b < 4; ++b) acc[a][b] = (f32x4){0.f, 0.f, 0.f, 0.f};
#pragma unroll
        for (int ks = 0; ks < 2; ++ks) {
            bf16x8 xf[2], yf[4];
#pragma unroll
            for (int a = 0; a < 2; ++a) xf[a] = *(const LAS bf16x8*)(X1 + (16 * (2 * par + a) + r) * 72 + ks * 32 + q4 * 8);
#pragma unroll
            for (int b = 0; b < 4; ++b) yf[b] = *(const LAS bf16x8*)(Y1 + (16 * b + r) * 72 + ks * 32 + q4 * 8);
#pragma unroll
            for (int a = 0; a < 2; ++a)
#pragma unroll
                for (int b = 0; b < 4; ++b) acc[a][b] = MFMA16(xf[a], yf[b], acc[a][b]);
        }
        if (kind < 2) {
#pragma unroll
            for (int ks = 0; ks < 2; ++ks) {
                bf16x8 xf[2], yf[4];
#pragma unroll
                for (int a = 0; a < 2; ++a) xf[a] = *(const LAS bf16x8*)(X2 + (16 * (2 * par + a) + r) * 72 + ks * 32 + q4 * 8);
#pragma unroll
                for (int b = 0; b < 4; ++b) yf[b] = *(const LAS bf16x8*)(Y2 + (16 * b + r) * 72 + ks * 32 + q4 * 8);
#pragma unroll
                for (int a = 0; a < 2; ++a)
#pragma unroll
                    for (int b = 0; b < 4; ++b) acc[a][b] = MFMA16(xf[a], yf[b], acc[a][b]);
            }
        }
#pragma unroll
        for (int a = 0; a < 2; ++a)
#pragma unroll
            for (int b = 0; b < 4; ++b) {
                const int i0 = 16 * (2 * par + a) + 4 * q4, j = 16 * b + r;
                if (kind == 0) *(f32x4*)(OLT + ((size_t)item * 64 + j) * 64 + i0) = acc[a][b];
                else if (kind == 1) *(f32x4*)(SLOC + ((size_t)item * 64 + j) * 64 + i0) = acc[a][b];
                else if (kind == 2) {
                    const v2u rw = *(const LAS v2u*)(RT + j * 72 + i0);
                    v2u w; w.x = pk2(acc[a][b][0] + __uint_as_float(rw.x << 16), acc[a][b][1] + __uint_as_float(rw.x & 0xffff0000u));
                    w.y = pk2(acc[a][b][2] + __uint_as_float(rw.y << 16), acc[a][b][3] + __uint_as_float(rw.y & 0xffff0000u));
                    *(v2u*)(QT + ((size_t)item * 64 + j) * 64 + i0) = w;
                } else {
                    f32x4 m = acc[a][b];
#pragma unroll
                    for (int e = 0; e < 4; ++e) if (i0 + e == j) m[e] += GL[j];
                    v2u w; w.x = pk2(m[0], m[1]); w.y = pk2(m[2], m[3]);
                    *(v2u*)(PMT + ((size_t)item * 64 + j) * 64 + i0) = w;
                }
            }
    }
    __syncthreads();
}

struct ScanOps { bf16x8 pf[4][2]; f32x4 sl[4]; };
__device__ __forceinline__ void scan_ops_load(ScanOps& o, int it, int v, int r, int q4, const bf16* PMT, const float* SLOC) {
#pragma unroll
    for (int kt = 0; kt < 4; ++kt) {
        o.sl[kt] = *(const f32x4*)(SLOC + ((size_t)it * 64 + v) * 64 + 16 * kt + 4 * q4);
#pragma unroll
        for (int ks = 0; ks < 2; ++ks) {
            const bf16* p = PMT + ((size_t)it * 64 + 16 * kt + r) * 64 + 32 * ks + 4 * q4;
            const v2u lo = *(const v2u*)p, hi = *(const v2u*)(p + 16);
            v4u w; w.x = lo.x; w.y = lo.y; w.z = hi.x; w.w = hi.y;
            o.pf[kt][ks] = __builtin_bit_cast(bf16x8, w);
        }
    }
}
__device__ __forceinline__ void rwkv_state_scan(int gwv, int lane, const bf16* PMT, const float* SLOC, bf16* SC) {
    const int h = gwv >> 2, vt = gwv & 3, r = lane & 15, q4 = lane >> 4, v = 16 * vt + r;
    f32x4 S[4];
#pragma unroll
    for (int kt = 0; kt < 4; ++kt) S[kt] = (f32x4){0.f, 0.f, 0.f, 0.f};
    ScanOps cur, nxt;
    scan_ops_load(cur, h, v, r, q4, PMT, SLOC);
    for (int c = 0; c < M / 64; ++c) {
        const int it = c * 8 + h;
        const int itn = (c + 1 < M / 64) ? it + 8 : it;
        scan_ops_load(nxt, itn, v, r, q4, PMT, SLOC);
        unsigned hw[4][2], lw[4][2];
#pragma unroll
        for (int kt = 0; kt < 4; ++kt) {
            float lo[4];
#pragma unroll
            for (int e = 0; e < 4; ++e) { const float hi = __uint_as_float(f2bf(S[kt][e]) << 16); lo[e] = S[kt][e] - hi; }
            hw[kt][0] = pk2(S[kt][0], S[kt][1]); hw[kt][1] = pk2(S[kt][2], S[kt][3]);
            lw[kt][0] = pk2(lo[0], lo[1]); lw[kt][1] = pk2(lo[2], lo[3]);
            v2u w; w.x = hw[kt][0]; w.y = hw[kt][1];
            *(v2u*)(SC + ((size_t)it * 64 + v) * 64 + 16 * kt + 4 * q4) = w;
        }
        bf16x8 sh[2], sl[2];
#pragma unroll
        for (int ks = 0; ks < 2; ++ks) {
            v4u a; a.x = hw[2 * ks][0]; a.y = hw[2 * ks][1]; a.z = hw[2 * ks + 1][0]; a.w = hw[2 * ks + 1][1]; sh[ks] = __builtin_bit_cast(bf16x8, a);
            v4u b; b.x = lw[2 * ks][0]; b.y = lw[2 * ks][1]; b.z = lw[2 * ks + 1][0]; b.w = lw[2 * ks + 1][1]; sl[ks] = __builtin_bit_cast(bf16x8, b);
        }
#pragma unroll
        for (int kt = 0; kt < 4; ++kt) {
            f32x4 n = cur.sl[kt];
            n = MFMA16(cur.pf[kt][0], sh[0], n); n = MFMA16(cur.pf[kt][1], sh[1], n);
            n = MFMA16(cur.pf[kt][0], sl[0], n); n = MFMA16(cur.pf[kt][1], sl[1], n);
            S[kt] = n;
        }
        cur = nxt;
    }
}
__device__ __forceinline__ void rwkv_chunk_out(int item, int lane, const bf16* SC, const bf16* QT, const float* OLT, const float* BS, const bf16* VV, const bf16* GG,
                                               const float* gn_g, const float* gn_b, bf16* Y) {
    const int c = item >> 3, h = item & 7, r = lane & 15, q4 = lane >> 4;
    bf16x8 sf[4][2];
#pragma unroll
    for (int vt = 0; vt < 4; ++vt)
#pragma unroll
        for (int ks = 0; ks < 2; ++ks) sf[vt][ks] = *(const bf16x8*)(SC + ((size_t)item * 64 + 16 * vt + r) * 64 + 32 * ks + 8 * q4);
    f32x4 gg4[4], gb4[4];
#pragma unroll
    for (int vt = 0; vt < 4; ++vt) { gg4[vt] = *(const f32x4*)(gn_g + h * 64 + 16 * vt + 4 * q4); gb4[vt] = *(const f32x4*)(gn_b + h * 64 + 16 * vt + 4 * q4); }
    for (int tt = 0; tt < 4; ++tt) {
        const int tl = 16 * tt + r, t = c * 64 + tl;
        bf16x8 qf[2];
#pragma unroll
        for (int ks = 0; ks < 2; ++ks) qf[ks] = *(const bf16x8*)(QT + ((size_t)item * 64 + tl) * 64 + 32 * ks + 8 * q4);
        f32x4 o[4]; float s = 0.f;
#pragma unroll
        for (int vt = 0; vt < 4; ++vt) {
            o[vt] = *(const f32x4*)(OLT + ((size_t)item * 64 + tl) * 64 + 16 * vt + 4 * q4);
            o[vt] = MFMA16(sf[vt][0], qf[0], o[vt]); o[vt] = MFMA16(sf[vt][1], qf[1], o[vt]);
            s += (o[vt][0] + o[vt][1]) + (o[vt][2] + o[vt][3]);
        }
        s += __shfl_xor(s, 16); s += __shfl_xor(s, 32);
        const float mean = s * (1.f / 64.f);
        float qv = 0.f;
#pragma unroll
        for (int vt = 0; vt < 4; ++vt) { o[vt] = o[vt] - mean; qv += (o[vt][0] * o[vt][0] + o[vt][1] * o[vt][1]) + (o[vt][2] * o[vt][2] + o[vt][3] * o[vt][3]); }
        qv += __shfl_xor(qv, 16); qv += __shfl_xor(qv, 32);
        const float rstd = 1.0f / sqrtf(qv * (1.f / 64.f) + 64e-5f);
        const float bon = BS[(size_t)t * 8 + h];
#pragma unroll
        for (int vt = 0; vt < 4; ++vt) {
            const size_t oo = (size_t)t * BW + h * 64 + 16 * vt + 4 * q4;
            const v2u vr = *(const v2u*)(VV + oo), gr = *(const v2u*)(GG + oo);
            const float v0 = __uint_as_float(vr.x << 16), v1 = __uint_as_float(vr.x & 0xffff0000u), v2 = __uint_as_float(vr.y << 16), v3 = __uint_as_float(vr.y & 0xffff0000u);
            const float g0 = __uint_as_float(gr.x << 16), g1 = __uint_as_float(gr.x & 0xffff0000u), g2 = __uint_as_float(gr.y << 16), g3 = __uint_as_float(gr.y & 0xffff0000u);
            const f32x4 y = o[vt] * rstd * gg4[vt] + gb4[vt];
            v2u w; w.x = pk2((y[0] + bon * v0) * g0, (y[1] + bon * v1) * g1); w.y = pk2((y[2] + bon * v2) * g2, (y[3] + bon * v3) * g3);
            *(v2u*)(Y + (size_t)t * D + 512 + h * 64 + 16 * vt + 4 * q4) = w;
        }
    }
}
struct Args { const float* in[28]; float* out; unsigned char* ws; };
#define GRID_SYNC() cg::this_grid().sync()
#define PHASE_VARS int tid = threadIdx.x; asm volatile("" : "+v"(tid)); const int lane = tid & 63; const int wave = __builtin_amdgcn_readfirstlane(tid >> 6); \
    int G = gridDim.x; asm volatile("" : "+s"(G)); int bx = blockIdx.x; asm volatile("" : "+s"(bx)); const int gw = bx * NWAVES + wave, NGW = G * NWAVES; (void)lane; (void)gw; (void)NGW; (void)tid
#define WSP(T, off) ((T*)(args.ws + (off)))
#define XIN (args.in[0])
#define OUTF (args.out)
#define WA WSP(bf16, WS_WA)
#define WB WSP(bf16, WS_WB)
#define XN WSP(bf16, WS_XN)
#define P WSP(bf16, WS_P)
#define LD WSP(float, WS_LD)
#define KK WSP(bf16, WS_KK)
#define BB WSP(bf16, WS_BB)
#define KP WSP(bf16, WS_KP)
#define RR WSP(bf16, WS_RR)
#define VV WSP(bf16, WS_VV)
#define GG ((bf16*)args.out)
#define SCB ((bf16*)((unsigned char*)args.out + 16 * MiB))
#define OLT ((float*)((unsigned char*)args.out + 32 * MiB))
#define PMT WSP(bf16, WS_P)
#define SLOC WSP(float, WS_P + 16 * MiB)
#define QTB WSP(bf16, WS_P + 48 * MiB)
#define BS WSP(float, WS_BS)
#define W2T WSP(bf16, WS_W2T)
#define A2T WSP(bf16, WS_A2T)
#define G2T WSP(bf16, WS_G2T)
#define YC WSP(bf16, WS_XN)
#define ACT WSP(bf16, WS_GEN)
#define QKV WSP(bf16, WS_QKV)
#define VT1 WSP(bf16, WS_VT1)
#define VT4 WSP(bf16, WS_VT4)
#define VT16 WSP(bf16, WS_VT16)
__global__ void __launch_bounds__(NWAVES * 64, 2) hybrid_fwd(Args args) {
    extern __shared__ __attribute__((aligned(16))) unsigned char lds_raw[];
    LAS unsigned char* lds = (LAS unsigned char*)lds_raw;

    { PHASE_VARS;
    {
        LAS float* scr = (LAS float*)(lds + wave * 16384);
        const int IL = 16 + 16 + 32;
        for (int it = gw; it < IL; it += NGW) {
            if (it < 16) transpose_item(args.in[9], 64, 512, W2T, scr, it, lane);
            else if (it < 32) transpose_item(args.in[11], 64, 512, A2T, scr, it - 16, lane);
            else transpose_item(args.in[12], 128, 512, G2T, scr, it - 32, lane);
        }
        norm_phase(lds, gw, NGW, wave, lane, XIN, args.in[1], XN, args.in[2], D, EIN, WA, args.in[18], D, D, WB);
    }

    }
    GRID_SYNC();
    { PHASE_VARS;

    {
        pg8::Gemm g{XN, WA, M, EIN, D, 256L * D * 2, 128L * D * 2, 256L * D * 2, 128L * D * 2, 0}; pg8::StaticOrder S; S.init(M, EIN, G, bx);
        pg8::EpiBf16<0> E{P, EIN, nullptr, 0, 0, 1.f};
        pg8::gemm_phase<pg8::EpiBf16<0>, pg8::StaticOrder, true, true>(lds, g, S, E);
    }

    }
    GRID_SYNC();
    { PHASE_VARS;

    {
        RwkvW W{args.in[7], args.in[8], args.in[10], args.in[13], args.in[14], args.in[15], W2T, A2T, G2T};
        for (int it = bx; it < M / 64; it += G) rwkv_prep_item(lds, it, tid, wave, lane, P, W, LD, KK, BB, KP, RR, VV, GG, BS);
        for (int it = bx; it < (M / 128) * 4; it += G) gmlp_item(lds, it, tid, wave, lane, P, args.in[3], args.in[4], args.in[5], args.in[6], YC);
    }

    }
    GRID_SYNC();
    { PHASE_VARS;
        for (int it = bx; it < (M / 64) * 8; it += G) rwkv_chunk_item(lds, it, tid, wave, lane, LD, KK, BB, KP, RR, VV, PMT, SLOC, QTB, OLT);
    }
    GRID_SYNC();
    { PHASE_VARS;
        if (gw < 32) rwkv_state_scan(gw, lane, PMT, SLOC, SCB);
    }
    GRID_SYNC();
    { PHASE_VARS;
        for (int it = gw; it < (M / 64) * 8; it += NGW) rwkv_chunk_out(it, lane, SCB, QTB, OLT, BS, VV, GG, args.in[16], args.in[17], YC);
    }
    GRID_SYNC();
    { PHASE_VARS;

    {
        pg8::Gemm g{YC, WB, M, D, D, 256L * D * 2, 128L * D * 2, 256L * D * 2, 128L * D * 2, 0}; pg8::StaticOrder S; S.init(M, D, G, bx);
        pg8::EpiRes E{XIN, OUTF, D};
        pg8::gemm_phase<pg8::EpiRes, pg8::StaticOrder, true, true>(lds, g, S, E);
    }

    }
    GRID_SYNC();
    { PHASE_VARS;
        norm_phase(lds, gw, NGW, wave, lane, OUTF, args.in[22] + 0 * D, XN, args.in[23] + (size_t)0 * D * FF2, D, FF2, WA, args.in[26] + (size_t)0 * FF * D, FF, D, WB);
    }
    GRID_SYNC();
    { PHASE_VARS;
        pg8::Gemm g{XN - 2 * D, WA, M, FF2, D, 248L * D * 2, 124L * D * 2, 128L * D * 2, 2816L * D * 2, 1}; pg8::StaticOrder S; S.init2(67, 22, G, bx);
        pg8::EpiConvGlu E{ACT, args.in[24] + (size_t)0 * 3 * FF2, args.in[25] + (size_t)0 * FF2, M};
        pg8::gemm_phase<pg8::EpiConvGlu, pg8::StaticOrder, true, true>(lds, g, S, E);
    }
    GRID_SYNC();
    { PHASE_VARS;
        pg8::Gemm g{ACT, WB, M, D, FF, 256L * FF * 2, 128L * FF * 2, 256L * FF * 2, 128L * FF * 2, 0}; pg8::StaticOrder S; S.init(M, D, G, bx);
        pg8::EpiRes E{OUTF, OUTF, D};
        pg8::gemm_phase<pg8::EpiRes, pg8::StaticOrder, true, true>(lds, g, S, E);
    }
    GRID_SYNC();
    { PHASE_VARS;
        norm_phase(lds, gw, NGW, wave, lane, OUTF, args.in[19], XN, args.in[20], D, NQKV, WA, args.in[21], D, D, WB);
    }
    GRID_SYNC();
    { PHASE_VARS;
        pg8::Gemm g{XN, WA, M, NQKV, D, 256L * D * 2, 128L * D * 2, 256L * D * 2, 128L * D * 2, 0}; pg8::StaticOrder S; S.init(M, NQKV, G, bx);
        pg8::EpiBf16<0> E{QKV, NQKV, nullptr, 0, 0, 1.f};
        pg8::gemm_phase<pg8::EpiBf16<0>, pg8::StaticOrder, true, true>(lds, g, S, E);
    }
    GRID_SYNC();
    { PHASE_VARS;
        for (int it = bx; it < 16 * 64; it += G) vtrans_item(lds, it, tid, QKV, VT1, VT4, VT16);
    }
    GRID_SYNC();
    { PHASE_VARS;
        for (int it = bx; it < 16 * 64; it += G) {
            const int h = it >> 6, blk = it & 63;
            attn_wave_item(QKV, VT1, VT4, VT16, YC, h, blk, 2 * wave, lane);
            attn_wave_item(QKV, VT1, VT4, VT16, YC, h, blk, 2 * wave + 1, lane);
        }
    }
    GRID_SYNC();
    { PHASE_VARS;
        pg8::Gemm g{YC, WB, M, D, D, 256L * D * 2, 128L * D * 2, 256L * D * 2, 128L * D * 2, 0}; pg8::StaticOrder S; S.init(M, D, G, bx);
        pg8::EpiRes E{OUTF, OUTF, D};
        pg8::gemm_phase<pg8::EpiRes, pg8::StaticOrder, true, true>(lds, g, S, E);
    }
    GRID_SYNC();
    { PHASE_VARS;
        norm_phase(lds, gw, NGW, wave, lane, OUTF, args.in[22] + 1 * D, XN, args.in[23] + (size_t)1 * D * FF2, D, FF2, WA, args.in[26] + (size_t)1 * FF * D, FF, D, WB);
    }
    GRID_SYNC();
    { PHASE_VARS;
        pg8::Gemm g{XN - 2 * D, WA, M, FF2, D, 248L * D * 2, 124L * D * 2, 128L * D * 2, 2816L * D * 2, 1}; pg8::StaticOrder S; S.init2(67, 22, G, bx);
        pg8::EpiConvGlu E{ACT, args.in[24] + (size_t)1 * 3 * FF2, args.in[25] + (size_t)1 * FF2, M};
        pg8::gemm_phase<pg8::EpiConvGlu, pg8::StaticOrder, true, true>(lds, g, S, E);
    }
    GRID_SYNC();
    { PHASE_VARS;
        pg8::Gemm g{ACT, WB, M, D, FF, 256L * FF * 2, 128L * FF * 2, 256L * FF * 2, 128L * FF * 2, 0}; pg8::StaticOrder S; S.init(M, D, G, bx);
        pg8::EpiRes E{OUTF, OUTF, D};
        pg8::gemm_phase<pg8::EpiRes, pg8::StaticOrder, true, true>(lds, g, S, E);
    }
    GRID_SYNC();
    { PHASE_VARS;
        for (int m = gw; m < M; m += NGW) rms_row_inplace(OUTF + (size_t)m * D, args.in[27], lane);
    }
}

#undef WSP
#undef XIN
#undef OUTF
#undef WA
#undef WB
#undef XN
#undef P
#undef LD
#undef KK
#undef BB
#undef KP
#undef RR
#undef VV
#undef GG
#undef SCB
#undef OLT
#undef PMT
#undef SLOC
#undef QTB
#undef BS
#undef W2T
#undef A2T
#undef G2T
#undef YC
#undef ACT
#undef QKV
#undef VT1
#undef VT4
#undef VT16
extern "C" void kernel_launch(void* const* d_in, const int* in_sizes, int n_in, void* d_out, int out_size, void* d_ws, size_t ws_size, hipStream_t stream) {
    static int grid = 0;
    if (grid == 0) {
        if (n_in != 28 || in_sizes[0] != M * D || out_size != M * D || ws_size < WS_END) { fprintf(stderr, "kernel_launch: unexpected shapes (n_in %d, in0 %d, out %d, ws %zu)\n", n_in, n_in > 0 ? in_sizes[0] : -1, out_size, ws_size); grid = -1; return; }
        int dev = 0, cus = 0, per_cu = 0;
        if (hipGetDevice(&dev) != hipSuccess || hipDeviceGetAttribute(&cus, hipDeviceAttributeMultiprocessorCount, dev) != hipSuccess) { grid = -1; return; }
        if (hipFuncSetAttribute((const void*)hybrid_fwd, hipFuncAttributeMaxDynamicSharedMemorySize, LDS_BYTES) != hipSuccess) { fprintf(stderr, "kernel_launch: hipFuncSetAttribute failed\n"); grid = -1; return; }
        if (hipOccupancyMaxActiveBlocksPerMultiprocessor(&per_cu, (const void*)hybrid_fwd, NWAVES * 64, LDS_BYTES) != hipSuccess || per_cu < 1) { fprintf(stderr, "kernel_launch: occupancy query says %d\n", per_cu); per_cu = 1; }
        (void)hipGetLastError();
        grid = cus;
    }
    if (grid < 0) return;
    Args a{};
    for (int i = 0; i < 28; ++i) a.in[i] = (const float*)d_in[i];
    a.out = (float*)d_out; a.ws = (unsigned char*)d_ws;
    void* kargs[] = {&a};
    hipError_t e = hipLaunchCooperativeKernel((const void*)hybrid_fwd, dim3(grid), dim3(NWAVES * 64), kargs, LDS_BYTES, stream);
    if (e != hipSuccess) fprintf(stderr, "kernel_launch: cooperative launch failed: %s (grid %d)\n", hipGetErrorString(e), grid);
}
```

```cpp
#include <hip/hip_runtime.h>
#include <hip/hip_cooperative_groups.h>
#include <cstdio>
#include <cstdint>
namespace cg = cooperative_groups;
namespace pg8 {
#define PG8_LAS __attribute__((address_space(3)))
typedef unsigned short bf16_t;
typedef short bf16x8 __attribute__((ext_vector_type(8)));
typedef float f32x4 __attribute__((ext_vector_type(4)));
typedef unsigned u32x4 __attribute__((ext_vector_type(4)));
constexpr int BM = 256, BK = 64, HALF = 128, HTB = HALF * BK * 2  , STAGE_BYTES = 8 * HTB, NXCD = 8, WGM = 8;

__host__ __device__ __forceinline__ int lds_byte(int r, int c) { const int st = (r >> 4) * 2 + (c >> 5), rr = r & 15, cc = c & 31, ob = rr * 64 + cc * 2; return st * 1024 + (ob ^ (((ob >> 9) & 1) << 5)); }
__host__ __device__ __forceinline__ void stage_rc(int b, int& R, int& C) { const int st = b / 1024, sb = b % 1024, swz = sb ^ (((sb >> 9) & 1) << 5); R = (st >> 1) * 16 + swz / 64; C = (st & 1) * 32 + (swz % 64) / 2; }
__host__ __device__ __forceinline__ int perm32(int rho) { const int n = rho >> 4, i = rho & 15; return 8 * (i >> 2) + 4 * n + (i & 3); }

struct Unit { int pm, pn; };
struct Gemm { const bf16_t* A; const bf16_t* Bt; int M, N, K; long tA, hA, tB, hB; int remapA; };

struct StaticOrder {
    int nM, nN, nwg, G, c;
    __host__ __device__ void init(int M, int N, int G_, int c_) { nM = M / BM; nN = N / BM; nwg = nM * nN; G = G_; c = c_; }
    __host__ __device__ void init2(int nM_, int nN_, int G_, int c_) { nM = nM_; nN = nN_; nwg = nM * nN; G = G_; c = c_; }
    __host__ __device__ bool next(int i, Unit& u) const {
        const long L = (long)i * G + c; if (L >= nwg) return false;
        int wgid = (int)L; { const int q = nwg / NXCD, r = nwg % NXCD, xcd = wgid % NXCD, off = wgid / NXCD; wgid = (xcd < r ? xcd * (q + 1) : r * (q + 1) + (xcd - r) * q) + off; }
        const int nig = WGM * nN, gid = wgid / nig, fm = gid * WGM, gsz = (nM - fm) < WGM ? (nM - fm) : WGM;
        u.pm = fm + ((wgid % nig) % gsz); u.pn = (wgid % nig) / gsz; return true;
    }
    __device__ __forceinline__ void a_ready(const Unit&) const {}
    __device__ __forceinline__ void done(const Unit&) const {}
};

__device__ __forceinline__ unsigned cvt_pk_bf16(float lo, float hi) { unsigned r; asm volatile("v_cvt_pk_bf16_f32 %0, %1, %2" : "=v"(r) : "v"(lo), "v"(hi)); return r; }
typedef float f32x2 __attribute__((ext_vector_type(2)));
__device__ __forceinline__ f32x2 gelu_pk(f32x2 v) {
    const f32x2 av = __builtin_elementwise_abs(v), d = av * 0.2316418882f + 1.0f;
    f32x2 t; t.x = __builtin_amdgcn_rcpf(d.x); t.y = __builtin_amdgcn_rcpf(d.y);
    f32x2 q = t * 0.5307027145f + (-0.7265760135f); q = q * t + 0.7107068705f; q = q * t + (-0.142248368f); q = q * t + 0.127414796f; q = q * t;
    const f32x2 s = (v * v) * (-0.72134752044f);
    f32x2 e; e.x = __builtin_amdgcn_exp2f(s.x); e.y = __builtin_amdgcn_exp2f(s.y);
    const f32x2 m = v * (q * e), r = v - m;
    f32x2 o; o.x = v.x < 0.f ? m.x : r.x; o.y = v.y < 0.f ? m.y : r.y; return o;
}

template <int ACT  > struct EpiBf16 {
    static constexpr bool PERM = true, AFTER_DRAIN = false; static_assert(ACT == 0 || ACT == 1, "EpiBf16: ACT is 0 (none) or 1 (gelu_pk)");
    bf16_t* O; int ldc; const float* bias; int split_cols; size_t split_stride; float scale0;
    __device__ __forceinline__ void operator()(const f32x4 (&acc)[2][2][4][2], const Unit& u, int wr, int wc, int fr, int fq) const {
        const int row0 = u.pm * BM + wr * 64 + fr; int colt = u.pn * BM; bf16_t* base = O;
        float sc = 1.f; if (split_cols) { const int t = colt / split_cols; base += (size_t)t * split_stride; colt -= t * split_cols; if (t == 0) sc = scale0; }
        const int col0 = colt + wc * 32 + 8 * fq, bcol0 = u.pn * BM + wc * 32 + 8 * fq;
        f32x4 bv[2][2];
#pragma unroll
        for (int bj = 0; bj < 2; ++bj)
#pragma unroll
            for (int n = 0; n < 2; ++n) bv[bj][n] = bias ? *(const f32x4*)(bias + bcol0 + bj * HALF + 4 * n) : (f32x4){0.f, 0.f, 0.f, 0.f};
#pragma unroll
        for (int ai = 0; ai < 2; ++ai)
#pragma unroll
            for (int m = 0; m < 4; ++m) { bf16_t* rowp = base + (size_t)(row0 + ai * HALF + m * 16) * ldc + col0;
#pragma unroll
                for (int bj = 0; bj < 2; ++bj) { f32x4 v0 = acc[ai][bj][m][0] + bv[bj][0], v1 = acc[ai][bj][m][1] + bv[bj][1];
                    if (ACT == 1) { f32x2 a = gelu_pk((f32x2){v0[0], v0[1]}), b = gelu_pk((f32x2){v0[2], v0[3]}), c = gelu_pk((f32x2){v1[0], v1[1]}), d = gelu_pk((f32x2){v1[2], v1[3]});
                        v0 = (f32x4){a.x, a.y, b.x, b.y}; v1 = (f32x4){c.x, c.y, d.x, d.y}; }
                    v0 = v0 * sc; v1 = v1 * sc; u32x4 w; w.x = cvt_pk_bf16(v0[0], v0[1]); w.y = cvt_pk_bf16(v0[2], v0[3]); w.z = cvt_pk_bf16(v1[0], v1[1]); w.w = cvt_pk_bf16(v1[2], v1[3]);
                    *(u32x4*)(rowp + bj * HALF) = w; } }
    }
};

template <class Epi, class Sched, bool ALIGN_EPI = false, bool SP2 = false>
__device__ __forceinline__ void gemm_phase(PG8_LAS unsigned char* lds, const Gemm g, const Sched& S, const Epi& E) {
    const int tid = threadIdx.x, wid = __builtin_amdgcn_readfirstlane(tid >> 6), lane = tid & 63, wr = wid >> 2, wc = wid & 3, fr = lane & 15, fq = lane >> 4;
    const int K = g.K, nt = K / BK;
    unsigned voffA[2], voffB[2];
#pragma unroll
    for (int i = 0; i < 2; ++i) { int R, C; stage_rc(tid * 16 + i * 8192, R, C); const int Rb = Epi::PERM ? ((R & ~31) + perm32(R & 31)) : R;
        const int Ra = g.remapA ? (R - (R >= 64 ? 2 : 0)) : R; voffA[i] = (unsigned)(Ra * K + C) * 2u; voffB[i] = (unsigned)(Rb * K + C) * 2u; }
    const size_t kstep = (size_t)(BK * 2);
    const size_t hA = (size_t)g.hA, hB = (size_t)g.hB, tA = (size_t)g.tA, tB = (size_t)g.tB;
    const unsigned ldsw = (unsigned)wid * 1024u;
    const int aoff = lds_byte(wr * 64 + fr, fq * 8), boff = lds_byte(wc * 32 + fr, fq * 8);
#define PG8_SA(b, h) (((b) * 2 + (h)) * HTB)
#define PG8_SB(b, h) ((4 + (b) * 2 + (h)) * HTB)
#define PG8_STAGE(bufoff, gbase, voff) do { _Pragma("unroll") for (int _i = 0; _i < 2; ++_i) \
        __builtin_amdgcn_global_load_lds((const unsigned*)((const char*)(gbase) + (voff)[_i]), (PG8_LAS unsigned*)(lds + (bufoff) + ldsw + _i * 8192), 16, 0, 0); } while (0)
#define PG8_LDA(dst, b, h) do { _Pragma("unroll") for (int m = 0; m < 4; ++m) _Pragma("unroll") for (int k = 0; k < 2; ++k) dst[m][k] = *(const PG8_LAS bf16x8*)(lds + PG8_SA(b, h) + aoff + m * 2048 + k * 1024); } while (0)
#define PG8_LDB(dst, b, h) do { _Pragma("unroll") for (int n = 0; n < 2; ++n) _Pragma("unroll") for (int k = 0; k < 2; ++k) dst[n][k] = *(const PG8_LAS bf16x8*)(lds + PG8_SB(b, h) + boff + n * 2048 + k * 1024); } while (0)
#define PG8_MMA(ai, bj, At, Bt) do { __builtin_amdgcn_s_setprio(1); _Pragma("unroll") for (int m = 0; m < 4; ++m) _Pragma("unroll") for (int n = 0; n < 2; ++n) _Pragma("unroll") for (int k = 0; k < 2; ++k) \
        acc[ai][bj][m][n] = __builtin_amdgcn_mfma_f32_16x16x32_bf16(Bt[n][k], At[m][k], acc[ai][bj][m][n], 0, 0, 0); __builtin_amdgcn_s_setprio(0); } while (0)
#define PG8_WAIT_V(n) asm volatile("s_waitcnt vmcnt(" #n ")" ::: "memory")
#define PG8_WAIT_L(n) asm volatile("s_waitcnt lgkmcnt(" #n ")" ::: "memory")
#define PG8_BAR __builtin_amdgcn_s_barrier()
#define PG8_SCHED __builtin_amdgcn_sched_barrier(0)
    Unit cur, nxt; int ui = 0;
    if (!S.next(0, cur)) return;
    f32x4 acc[2][2][4][2];
#pragma unroll
    for (int a = 0; a < 2; ++a)
#pragma unroll
        for (int b = 0; b < 2; ++b)
#pragma unroll
            for (int m = 0; m < 4; ++m)
#pragma unroll
                for (int n = 0; n < 2; ++n) acc[a][b][m][n] = (f32x4){0.f, 0.f, 0.f, 0.f};
    bf16x8 At[4][2], B0[2][2], B1[2][2];
    const char* cA = (const char*)g.A + (size_t)cur.pm * tA; const char* cB = (const char*)g.Bt + (size_t)cur.pn * tB;
    S.a_ready(cur);
    if constexpr (SP2) {
        PG8_STAGE(PG8_SB(0, 0), cB, voffB); PG8_STAGE(PG8_SB(0, 1), cB + hB, voffB); PG8_STAGE(PG8_SA(0, 0), cA, voffA); PG8_STAGE(PG8_SA(0, 1), cA + hA, voffA);
        if (wr == 1) PG8_BAR;
        PG8_WAIT_V(2); PG8_BAR;
        PG8_STAGE(PG8_SB(1, 0), cB + kstep, voffB); PG8_STAGE(PG8_SA(1, 0), cA + kstep, voffA); PG8_STAGE(PG8_SB(1, 1), cB + hB + kstep, voffB);
        PG8_WAIT_V(6); PG8_BAR;
    } else {
        PG8_STAGE(PG8_SB(0, 0), cB, voffB); PG8_STAGE(PG8_SA(0, 0), cA, voffA); PG8_STAGE(PG8_SB(0, 1), cB + hB, voffB); PG8_STAGE(PG8_SA(0, 1), cA + hA, voffA);
        if (wr == 1) PG8_BAR;
        PG8_WAIT_V(4); PG8_BAR;
        PG8_STAGE(PG8_SB(1, 0), cB + kstep, voffB); PG8_STAGE(PG8_SA(1, 0), cA + kstep, voffA); PG8_STAGE(PG8_SB(1, 1), cB + hB + kstep, voffB);
        PG8_WAIT_V(6); PG8_BAR;
    }
    for (;;) {
        const bool has_next = S.next(ui + 1, nxt);
        const char* nA = has_next ? (const char*)g.A + (size_t)nxt.pm * tA : cA; const char* nB = has_next ? (const char*)g.Bt + (size_t)nxt.pn * tB : cB;
        for (int t = 0; t < nt; t += 2) {
            const bool last = (t == nt - 2);
            const char* a1 = cA + (size_t)(t + 1) * kstep;
            const char* a2 = last ? nA : cA + (size_t)(t + 2) * kstep; const char* b2 = last ? nB : cB + (size_t)(t + 2) * kstep;
            const char* a3 = a2 + kstep; const char* b3 = b2 + kstep;
            if (last && has_next) S.a_ready(nxt);
            if constexpr (SP2) {
            PG8_LDB(B0, 0, 0); PG8_LDB(B1, 0, 1); PG8_SCHED; PG8_LDA(At, 0, 0); PG8_STAGE(PG8_SA(1, 1), a1 + hA, voffA);
            PG8_WAIT_V(8); PG8_WAIT_L(0); PG8_BAR; PG8_MMA(0, 0, At, B0); PG8_MMA(0, 1, At, B1); PG8_BAR; PG8_SCHED;
            PG8_LDA(At, 0, 1); PG8_STAGE(PG8_SB(0, 0), b2, voffB); PG8_STAGE(PG8_SB(0, 1), b2 + hB, voffB); PG8_STAGE(PG8_SA(0, 0), a2, voffA);
            PG8_WAIT_V(8); PG8_WAIT_L(0); PG8_BAR; PG8_MMA(1, 0, At, B0); PG8_MMA(1, 1, At, B1); PG8_BAR; PG8_SCHED;
            PG8_LDB(B0, 1, 0); PG8_LDB(B1, 1, 1); PG8_SCHED; PG8_LDA(At, 1, 0); PG8_STAGE(PG8_SA(0, 1), a2 + hA, voffA);
            PG8_WAIT_V(8); PG8_WAIT_L(0); PG8_BAR; PG8_MMA(0, 0, At, B0); PG8_MMA(0, 1, At, B1); PG8_BAR; PG8_SCHED;
            PG8_LDA(At, 1, 1); PG8_STAGE(PG8_SB(1, 0), b3, voffB); PG8_STAGE(PG8_SB(1, 1), b3 + hB, voffB); PG8_STAGE(PG8_SA(1, 0), a3, voffA);
            PG8_WAIT_V(8); PG8_WAIT_L(0); PG8_BAR; PG8_MMA(1, 0, At, B0); PG8_MMA(1, 1, At, B1); PG8_BAR; PG8_SCHED;
            } else {
            PG8_LDB(B0, 0, 0); PG8_SCHED; PG8_LDA(At, 0, 0); PG8_STAGE(PG8_SA(1, 1), a1 + hA, voffA);
            PG8_WAIT_L(8); PG8_BAR; PG8_WAIT_L(0); PG8_MMA(0, 0, At, B0); PG8_BAR; PG8_SCHED;
            PG8_LDB(B1, 0, 1); PG8_STAGE(PG8_SB(0, 0), b2, voffB);
            PG8_BAR; PG8_WAIT_L(0); PG8_MMA(0, 1, At, B1); PG8_BAR;
            PG8_LDA(At, 0, 1); PG8_STAGE(PG8_SA(0, 0), a2, voffA);
            PG8_BAR; PG8_WAIT_L(0); PG8_MMA(1, 0, At, B0); PG8_BAR; PG8_SCHED;
            PG8_STAGE(PG8_SB(0, 1), b2 + hB, voffB);
            PG8_WAIT_V(6); PG8_BAR; PG8_MMA(1, 1, At, B1); PG8_BAR;
            PG8_LDB(B0, 1, 0); PG8_SCHED; PG8_LDA(At, 1, 0); PG8_STAGE(PG8_SA(0, 1), a2 + hA, voffA);
            PG8_WAIT_L(8); PG8_BAR; PG8_WAIT_L(0); PG8_MMA(0, 0, At, B0); PG8_BAR; PG8_SCHED;
            PG8_LDB(B1, 1, 1); PG8_STAGE(PG8_SB(1, 0), b3, voffB);
            PG8_BAR; PG8_WAIT_L(0); PG8_MMA(0, 1, At, B1); PG8_BAR;
            PG8_LDA(At, 1, 1); PG8_STAGE(PG8_SA(1, 0), a3, voffA);
            PG8_BAR; PG8_WAIT_L(0); PG8_MMA(1, 0, At, B0); PG8_BAR; PG8_SCHED;
            PG8_STAGE(PG8_SB(1, 1), b3 + hB, voffB);
            PG8_WAIT_V(6); PG8_BAR; PG8_MMA(1, 1, At, B1); PG8_BAR;
            }
        }
        if constexpr (ALIGN_EPI) { if (wr == 0) PG8_BAR; }
        if constexpr (!Epi::AFTER_DRAIN) { E(acc, cur, wr, wc, fr, fq); S.done(cur); }
        if (!has_next) break;
#pragma unroll
        for (int a = 0; a < 2; ++a)
#pragma unroll
            for (int b = 0; b < 2; ++b)
#pragma unroll
                for (int m = 0; m < 4; ++m)
#pragma unroll
                    for (int n = 0; n < 2; ++n) acc[a][b][m][n] = (f32x4){0.f, 0.f, 0.f, 0.f};
        cur = nxt; cA = nA; cB = nB; ++ui;
        if constexpr (ALIGN_EPI) { if (wr == 1) PG8_BAR; }
    }
    PG8_WAIT_V(0);
    if constexpr (!ALIGN_EPI) { if (wr == 0) PG8_BAR; }
    PG8_BAR;
    if constexpr (Epi::AFTER_DRAIN) { E.fused(acc, cur, wr, wc, fr, fq, lds, wid, lane); S.done(cur); }
#undef PG8_SA
#undef PG8_SB
#undef PG8_STAGE
#undef PG8_LDA
#undef PG8_LDB
#undef PG8_MMA
#undef PG8_WAIT_V
#undef PG8_WAIT_L
#undef PG8_BAR
#undef PG8_SCHED
}
}
namespace pg8 {
struct EpiRes {
    static constexpr bool PERM = false, AFTER_DRAIN = false;
    const float* base; float* out; int ldc;
    __device__ __forceinline__ void operator()(const f32x4 (&acc)[2][2][4][2], const Unit& u, int wr, int wc, int fr, int fq) const {
        const int col0 = u.pn * BM + wc * 32 + 4 * fq;
#pragma unroll
        for (int ai = 0; ai < 2; ++ai)
#pragma unroll
            for (int m = 0; m < 4; ++m) { const size_t off = (size_t)(u.pm * BM + ai * HALF + wr * 64 + m * 16 + fr) * ldc + col0;
#pragma unroll
                for (int bj = 0; bj < 2; ++bj)
#pragma unroll
                    for (int n = 0; n < 2; ++n) { const f32x4 b = *(const f32x4*)(base + off + bj * HALF + n * 16); *(f32x4*)(out + off + bj * HALF + n * 16) = b + acc[ai][bj][m][n]; } }
    }
};
struct EpiConvGlu {
    static constexpr bool PERM = false, AFTER_DRAIN = false;
    bf16_t* O; const float* cw; const float* cb; int M;
    __device__ __forceinline__ void operator()(const f32x4 (&acc)[2][2][4][2], const Unit& u, int wr, int wc, int fr, int fq) const {
        const int lane = fq * 16 + fr;
        const int src1 = fq * 16 + ((fr + 15) & 15), src2 = fq * 16 + ((fr + 14) & 15);
#pragma unroll
        for (int ai = 0; ai < 2; ++ai) {
            const int pb = 248 * u.pm + 62 * (2 * ai + wr) - 2;
#pragma unroll
            for (int n = 0; n < 2; ++n) {
                const int jg = 128 * u.pn + 32 * wc + 16 * n + 4 * fq;
                const f32x4 g0 = *(const f32x4*)(cw + jg), g1 = *(const f32x4*)(cw + 5632 + jg), g2 = *(const f32x4*)(cw + 2 * 5632 + jg), gb = *(const f32x4*)(cb + jg);
                const f32x4 v0 = *(const f32x4*)(cw + 2816 + jg), v1 = *(const f32x4*)(cw + 5632 + 2816 + jg), v2 = *(const f32x4*)(cw + 2 * 5632 + 2816 + jg), vb = *(const f32x4*)(cb + 2816 + jg);
                f32x4 pg1, pg2, pv1, pv2;
#pragma unroll
                for (int m = 0; m < 4; ++m) {
                    f32x4 zg = acc[ai][0][m][n], zv = acc[ai][1][m][n];
                    const int pos = pb + 16 * m + fr;
                    if (pos < 0) { zg = (f32x4){0.f, 0.f, 0.f, 0.f}; zv = zg; }
                    f32x4 rg1, rg2, rv1, rv2;
#pragma unroll
                    for (int e = 0; e < 4; ++e) { rg1[e] = __shfl(zg[e], src1); rg2[e] = __shfl(zg[e], src2); rv1[e] = __shfl(zv[e], src1); rv2[e] = __shfl(zv[e], src2); }
                    f32x4 zg1, zg2, zv1, zv2;
                    if (m == 0) { zg1 = rg1; zg2 = rg2; zv1 = rv1; zv2 = rv2; }
                    else {
#pragma unroll
                        for (int e = 0; e < 4; ++e) { zg1[e] = fr >= 1 ? rg1[e] : pg1[e]; zg2[e] = fr >= 2 ? rg2[e] : pg2[e]; zv1[e] = fr >= 1 ? rv1[e] : pv1[e]; zv2[e] = fr >= 2 ? rv2[e] : pv2[e]; }
                    }
                    pg1 = rg1; pg2 = rg2; pv1 = rv1; pv2 = rv2;
                    const f32x4 cg = g0 * zg2 + g1 * zg1 + g2 * zg + gb;
                    const f32x4 cv = v0 * zv2 + v1 * zv1 + v2 * zv + vb;
                    f32x4 a;
#pragma unroll
                    for (int e = 0; e < 4; ++e) a[e] = cg[e] / (1.0f + __expf(-cg[e])) * cv[e];
                    if ((16 * m + fr) >= 2 && pos < M) {
                        typedef unsigned u32x2 __attribute__((ext_vector_type(2)));
                        u32x2 w; w.x = cvt_pk_bf16(a[0], a[1]); w.y = cvt_pk_bf16(a[2], a[3]);
                        *(u32x2*)(O + (size_t)pos * 2816 + jg) = w;
                    }
                }
            }
        }
        (void)lane;
    }
};
}
#define LAS __attribute__((address_space(3)))
typedef unsigned short bf16;
typedef float f32x4 __attribute__((ext_vector_type(4)));
typedef short bf16x8 __attribute__((ext_vector_type(8)));
typedef unsigned v4u __attribute__((ext_vector_type(4)));
typedef unsigned v2u __attribute__((ext_vector_type(2)));
constexpr int NWAVES = 8;
constexpr int M = 16384, D = 1024, EIN = 2816, FF = 2816, FF2 = 5632, NQKV = 3072, BW = 512;
constexpr size_t MiB = 1u << 20;
constexpr size_t WS_W2T = 1 * MiB, WS_A2T = WS_W2T + 65536, WS_G2T = WS_A2T + 65536, WS_BS = WS_G2T + 131072;
constexpr size_t WS_WA = 2 * MiB, WS_WB = 13 * MiB, WS_XN = 20 * MiB, WS_GEN = 52 * MiB, WS_END = 256 * MiB;
constexpr size_t WS_P = WS_GEN, WS_LD = WS_GEN + 88 * MiB, WS_KK = WS_LD + 32 * MiB, WS_BB = WS_KK + 16 * MiB, WS_KP = WS_BB + 16 * MiB, WS_RR = WS_KP + 16 * MiB, WS_VV = WS_RR + 16 * MiB;
static_assert(WS_VV + 16 * MiB <= WS_END, "ws map");
constexpr size_t WS_QKV = WS_GEN, WS_VT1 = WS_GEN + 96 * MiB, WS_VT4 = WS_VT1 + 32 * MiB, WS_VT16 = WS_VT4 + 32 * MiB;
static_assert(WS_VT16 + 33 * MiB <= WS_END, "ws map");
constexpr int LDS_BYTES = 147456;

__device__ __forceinline__ float bf2f(unsigned short v) { return __uint_as_float(((unsigned)v) << 16); }
__device__ __forceinline__ unsigned f2bf(float f) { unsigned u = __float_as_uint(f); return (u + 0x7fffu + ((u >> 16) & 1u)) >> 16; }
__device__ __forceinline__ unsigned pk2(float lo, float hi) { return f2bf(lo) | (f2bf(hi) << 16); }
__device__ __forceinline__ float wave_sum(float v) {
#pragma unroll
    for (int o = 1; o < 64; o <<= 1) v += __shfl_xor(v, o);
    return v;
}
__device__ __forceinline__ float dpp_row_shr(float v, int n) {
    const int iv = __builtin_bit_cast(int, v); int r;
    switch (n) { case 1: r = __builtin_amdgcn_update_dpp(0, iv, 0x111, 0xf, 0xf, true); break; case 2: r = __builtin_amdgcn_update_dpp(0, iv, 0x112, 0xf, 0xf, true); break;
                 case 4: r = __builtin_amdgcn_update_dpp(0, iv, 0x114, 0xf, 0xf, true); break; default: r = __builtin_amdgcn_update_dpp(0, iv, 0x118, 0xf, 0xf, true); break; }
    return __builtin_bit_cast(float, r);
}
__device__ __forceinline__ float wave_sum_uniform(float v) {
    v += dpp_row_shr(v, 1); v += dpp_row_shr(v, 2); v += dpp_row_shr(v, 4); v += dpp_row_shr(v, 8);
    v += __builtin_bit_cast(float, __builtin_amdgcn_update_dpp(0, __builtin_bit_cast(int, v), 0x142, 0xa, 0xf, false));
    v += __builtin_bit_cast(float, __builtin_amdgcn_update_dpp(0, __builtin_bit_cast(int, v), 0x143, 0xc, 0xf, false));
    return __builtin_bit_cast(float, __builtin_amdgcn_readlane(__builtin_bit_cast(int, v), 63));
}
#define MFMA16(a, b, c) __builtin_amdgcn_mfma_f32_16x16x32_bf16((a), (b), (c), 0, 0, 0)

__device__ __forceinline__ void transpose_item(const float* W, int K, int N, bf16* WT, LAS float* scr, int item, int lane) {
    const int nblk = N / 32, kb = item / nblk, nb = item % nblk, k0 = 64 * kb, n0 = 32 * nb;
#pragma unroll 8
    for (int i = 0; i < 32; ++i) { const int kk = 2 * i + (lane >> 5); scr[kk * 33 + (lane & 31)] = W[(size_t)(k0 + kk) * N + n0 + (lane & 31)]; }
    asm volatile("s_waitcnt lgkmcnt(0)" ::: "memory");
    const int c = lane & 7;
#pragma unroll
    for (int j = 0; j < 4; ++j) { const int n = (lane >> 3) + 8 * j; const LAS float* s = scr + (8 * c) * 33 + n;
        v4u o; o.x = pk2(s[0 * 33], s[1 * 33]); o.y = pk2(s[2 * 33], s[3 * 33]); o.z = pk2(s[4 * 33], s[5 * 33]); o.w = pk2(s[6 * 33], s[7 * 33]);
        *(v4u*)(WT + (size_t)(n0 + n) * K + k0 + 8 * c) = o; }
    asm volatile("s_waitcnt lgkmcnt(0)" ::: "memory");
}
__device__ __forceinline__ void rms_row_to_bf16(const float* xrow, const float* gain, bf16* orow, int lane) {
    const f32x4* xr = (const f32x4*)xrow + lane; const f32x4* gr = (const f32x4*)gain + lane;
    f32x4 v[4]; float s = 0.f;
#pragma unroll
    for (int j = 0; j < 4; ++j) { v[j] = xr[64 * j]; s += (v[j].x * v[j].x + v[j].y * v[j].y) + (v[j].z * v[j].z + v[j].w * v[j].w); }
    const float rstd = 1.0f / sqrtf(wave_sum(s) * (1.f / D) + 1e-6f);
    v2u* o8 = (v2u*)orow + lane;
#pragma unroll
    for (int j = 0; j < 4; ++j) { const f32x4 g = gr[64 * j]; v2u w; w.x = pk2(v[j].x * rstd * g.x, v[j].y * rstd * g.y); w.y = pk2(v[j].z * rstd * g.z, v[j].w * rstd * g.w); o8[64 * j] = w; }
}
__device__ __forceinline__ void rms_row_inplace(float* xrow, const float* gain, int lane) {
    f32x4* xr = (f32x4*)xrow + lane; const f32x4* gr = (const f32x4*)gain + lane;
    f32x4 v[4]; float s = 0.f;
#pragma unroll
    for (int j = 0; j < 4; ++j) { v[j] = xr[64 * j]; s += (v[j].x * v[j].x + v[j].y * v[j].y) + (v[j].z * v[j].z + v[j].w * v[j].w); }
    const float rstd = 1.0f / sqrtf(wave_sum(s) * (1.f / D) + 1e-6f);
#pragma unroll
    for (int j = 0; j < 4; ++j) { const f32x4 g = gr[64 * j]; xr[64 * j] = v[j] * rstd * g; }
}
__device__ __forceinline__ void norm_phase(LAS unsigned char* lds, int gw, int NGW, int wave, int lane, const float* x, const float* gain, bf16* XN,
                                           const float* W1, int K1, int N1, bf16* W1t, const float* W2, int K2, int N2, bf16* W2t) {
    LAS float* scr = (LAS float*)(lds + wave * 16384);
    const int I1 = (K1 / 64) * (N1 / 32), I2 = (K2 / 64) * (N2 / 32);
    for (int it = gw; it < I1 + I2; it += NGW) {
        if (it < I1) transpose_item(W1, K1, N1, W1t, scr, it, lane); else transpose_item(W2, K2, N2, W2t, scr, it - I1, lane);
    }
    for (int m = gw; m < M; m += NGW) rms_row_to_bf16(x + (size_t)m * D, gain, XN + (size_t)m * D, lane);
}

__device__ __forceinline__ void gmlp_item(LAS unsigned char* lds, int item, int tid, int wave, int lane, const bf16* P, const float* ln_g, const float* ln_b,
                                          const float* w_s, const float* b_s, bf16* Y) {
    const int chunk = item >> 2, g = item & 3, t0 = chunk * 128;
    LAS bf16* Wm = (LAS bf16*)lds;
    LAS bf16* Vt = (LAS bf16*)(lds + 128 * 136 * 2);
    for (int i = 0; i < 16; ++i) {
        const int s = wave * 16 + i;
        const v4u raw = *(const v4u*)(P + (size_t)(t0 + s) * EIN + 512 + lane * 8);
        float v[8];
        v[0] = __uint_as_float(raw.x << 16); v[1] = __uint_as_float(raw.x & 0xffff0000u); v[2] = __uint_as_float(raw.y << 16); v[3] = __uint_as_float(raw.y & 0xffff0000u);
        v[4] = __uint_as_float(raw.z << 16); v[5] = __uint_as_float(raw.z & 0xffff0000u); v[6] = __uint_as_float(raw.w << 16); v[7] = __uint_as_float(raw.w & 0xffff0000u);
        float sum = 0.f;
#pragma unroll
        for (int e = 0; e < 8; ++e) sum += v[e];
        const float mean = wave_sum(sum) * (1.f / 512.f);
        float q = 0.f;
#pragma unroll
        for (int e = 0; e < 8; ++e) { v[e] -= mean; q += v[e] * v[e]; }
        const float rstd = 1.0f / sqrtf(wave_sum(q) * (1.f / 512.f) + 1e-5f);
        if ((lane >> 4) == g) {
#pragma unroll
            for (int e = 0; e < 8; ++e) { const int c = (lane & 15) * 8 + e, ch = g * 128 + c; Vt[c * 136 + s] = (bf16)f2bf(v[e] * rstd * ln_g[ch] + ln_b[ch]); }
        }
    }
    for (int idx = tid; idx < 128 * 32; idx += 512) {
        const int t = idx >> 5, s4 = (idx & 31) * 4;
        const f32x4 w = *(const f32x4*)(w_s + ((size_t)g * 128 + t) * 128 + s4);
        v2u o; o.x = pk2(s4 + 0 <= t ? w.x : 0.f, s4 + 1 <= t ? w.y : 0.f); o.y = pk2(s4 + 2 <= t ? w.z : 0.f, s4 + 3 <= t ? w.w : 0.f);
        *(LAS v2u*)(Wm + t * 136 + s4) = o;
    }
    __syncthreads();
    const int r = lane & 15, q4 = lane >> 4;
    f32x4 acc[8];
#pragma unroll
    for (int ct = 0; ct < 8; ++ct) acc[ct] = (f32x4){0.f, 0.f, 0.f, 0.f};
    const int nks = (16 * wave + 15) / 32 + 1;
    for (int ks = 0; ks < nks; ++ks) {
        const bf16x8 af = *(const LAS bf16x8*)(Wm + (16 * wave + r) * 136 + ks * 32 + q4 * 8);
#pragma unroll
        for (int ct = 0; ct < 8; ++ct) { const bf16x8 bfr = *(const LAS bf16x8*)(Vt + (16 * ct + r) * 136 + ks * 32 + q4 * 8); acc[ct] = MFMA16(af, bfr, acc[ct]); }
    }
#pragma unroll
    for (int ct = 0; ct < 8; ++ct)
#pragma unroll
        for (int e = 0; e < 4; ++e) {
            const int t = 16 * wave + 4 * q4 + e, c = 16 * ct + r;
            const float mixed = acc[ct][e] + b_s[g * 128 + t];
            const float u = bf2f(P[(size_t)(t0 + t) * EIN + g * 128 + c]);
            Y[(size_t)(t0 + t) * D + g * 128 + c] = (bf16)f2bf(u * mixed);
        }
    __syncthreads();
}

struct RwkvW { const float *mu, *w0, *a0, *k_k, *k_a, *r_k; const bf16 *w2t, *a2t, *g2t; };
__device__ __forceinline__ float shifted(const bf16* P, int t, int col, float mu) {
    const float cur = bf2f(P[(size_t)t * EIN + col]); const float prev = t > 0 ? bf2f(P[(size_t)(t - 1) * EIN + col]) : 0.f; return cur + (prev - cur) * mu;
}
__device__ __forceinline__ void rwkv_prep_item(LAS unsigned char* lds, int item, int tid, int wave, int lane, const bf16* P, const RwkvW& W,
                                               float* LD, bf16* KK, bf16* BB, bf16* KP, bf16* RR, bf16* VV, bf16* GG, float* BS) {
    const int t0 = item * 64;
    LAS bf16* Xl = (LAS bf16*)lds;
    for (int idx = tid; idx < 64 * 256; idx += 512) {
        const int t = idx >> 8, j = idx & 255;
        const float ps = shifted(P, t0 + t, 1024 + 1536 + j, W.mu[1536 + j]);
        const float val = j < 64 ? tanhf(ps) : (j < 128 ? ps : 1.0f / (1.0f + __expf(-ps)));
        Xl[t * 264 + j] = (bf16)f2bf(val);
    }
    __syncthreads();
    const int h = wave, r = lane & 15, q4 = lane >> 4;
    for (int tt = 0; tt < 4; ++tt) {
        f32x4 aW[4], aA[4], aG[4];
#pragma unroll
        for (int ct = 0; ct < 4; ++ct) { aW[ct] = (f32x4){0.f, 0.f, 0.f, 0.f}; aA[ct] = aW[ct]; aG[ct] = aW[ct]; }
#pragma unroll
        for (int ks = 0; ks < 2; ++ks) {
            const bf16x8 xw = *(const LAS bf16x8*)(Xl + (16 * tt + r) * 264 + ks * 32 + q4 * 8);
            const bf16x8 xa = *(const LAS bf16x8*)(Xl + (16 * tt + r) * 264 + 64 + ks * 32 + q4 * 8);
#pragma unroll
            for (int ct = 0; ct < 4; ++ct) {
                const bf16x8 yw = *(const bf16x8*)(W.w2t + (size_t)(h * 64 + 16 * ct + r) * 64 + ks * 32 + q4 * 8);
                const bf16x8 ya = *(const bf16x8*)(W.a2t + (size_t)(h * 64 + 16 * ct + r) * 64 + ks * 32 + q4 * 8);
                aW[ct] = MFMA16(xw, yw, aW[ct]); aA[ct] = MFMA16(xa, ya, aA[ct]);
            }
        }
#pragma unroll
        for (int ks = 0; ks < 4; ++ks) {
            const bf16x8 xg = *(const LAS bf16x8*)(Xl + (16 * tt + r) * 264 + 128 + ks * 32 + q4 * 8);
#pragma unroll
            for (int ct = 0; ct < 4; ++ct) {
                const bf16x8 yg = *(const bf16x8*)(W.g2t + (size_t)(h * 64 + 16 * ct + r) * 128 + ks * 32 + q4 * 8);
                aG[ct] = MFMA16(xg, yg, aG[ct]);
            }
        }
#pragma unroll
        for (int e = 0; e < 4; ++e) {
            const int t = t0 + 16 * tt + 4 * q4 + e;
            float kkr[4], av[4]; float ss = 0.f, bon = 0.f;
#pragma unroll
            for (int ct = 0; ct < 4; ++ct) {
                const int c = h * 64 + 16 * ct + r;
                const float r_ = shifted(P, t, 1024 + c, W.mu[c]);
                const float k_ = shifted(P, t, 1024 + 512 + c, W.mu[512 + c]);
                const float v_ = shifted(P, t, 1024 + 1024 + c, W.mu[1024 + c]);
                const float xw = -(W.w0[c] + aW[ct][e]);
                const float sp = xw > 20.f ? xw : log1pf(__expf(xw));
                const float wv = -sp - 0.5f;
                const float ld = -__expf(wv);
                const float a = 1.0f / (1.0f + __expf(-(W.a0[c] + aA[ct][e])));
                const float kr = k_ * W.k_k[c];
                const float kp = k_ * (1.0f + (a - 1.0f) * W.k_a[c]);
                kkr[ct] = kr; av[ct] = a; ss += kr * kr; bon += r_ * kp * W.r_k[c];
                const size_t o = (size_t)t * BW + c;
                LD[o] = ld; KP[o] = (bf16)f2bf(kp); RR[o] = (bf16)f2bf(r_); VV[o] = (bf16)f2bf(v_); GG[o] = (bf16)f2bf(aG[ct][e]);
            }
#pragma unroll
            for (int o = 1; o < 16; o <<= 1) { ss += __shfl_xor(ss, o); bon += __shfl_xor(bon, o); }
            const float inv = 1.0f / sqrtf(fmaxf(ss, 1e-24f));
#pragma unroll
            for (int ct = 0; ct < 4; ++ct) {
                const int c = h * 64 + 16 * ct + r; const size_t o = (size_t)t * BW + c;
                const float kk = kkr[ct] * inv;
                KK[o] = (bf16)f2bf(kk); BB[o] = (bf16)f2bf(kk * av[ct]);
            }
            if (r == 0) BS[(size_t)t * 8 + h] = bon;
        }
    }
    __syncthreads();
}

struct ScanRegs { unsigned short kk[8], bb[8], kp[8], rr[8], vv[8]; float ld[8]; };
__device__ __forceinline__ void scan_load(ScanRegs& R, int t0, int hc, int hv, const float* LD, const bf16* KK, const bf16* BB, const bf16* KP, const bf16* RR, const bf16* VV) {
#pragma unroll
    for (int i = 0; i < 8; ++i) { const size_t o = (size_t)(t0 + i) * BW;
        R.kk[i] = KK[o + hc]; R.bb[i] = BB[o + hc]; R.kp[i] = KP[o + hc]; R.rr[i] = RR[o + hc]; R.ld[i] = LD[o + hc]; R.vv[i] = VV[o + hv]; }
}
__device__ __forceinline__ void rwkv_scan_wave(int gwv, int lane, const float* LD, const bf16* KK, const bf16* BB, const bf16* KP, const bf16* RR, const bf16* VV, float* OSC) {
    const int h = gwv >> 6, v = gwv & 63, hc = h * 64 + lane, hv = h * 64 + v;
    float S = 0.f;
    ScanRegs cur, nxt;
    scan_load(cur, 0, hc, hv, LD, KK, BB, KP, RR, VV);
    for (int t0 = 0; t0 < M; t0 += 8) {
        const int tn = (t0 + 8 < M) ? t0 + 8 : t0;
        scan_load(nxt, tn, hc, hv, LD, KK, BB, KP, RR, VV);
#pragma unroll
        for (int i = 0; i < 8; ++i) {
            const float kk = bf2f(cur.kk[i]), bb = bf2f(cur.bb[i]), kp = bf2f(cur.kp[i]), rr = bf2f(cur.rr[i]), vv = bf2f(cur.vv[i]);
            const float dec = __expf(cur.ld[i]);
            const float sa = wave_sum_uniform(S * kk);
            S = S * dec - sa * bb + vv * kp;
            const float o = wave_sum_uniform(S * rr);
            if (lane == 0) OSC[(size_t)(t0 + i) * BW + hv] = o;
        }
        cur = nxt;
    }
}
__device__ __forceinline__ void rwkv_out_row(int t, int lane, const float* OSC, const float* BS, const bf16* VV, const bf16* GG, const float* gn_g, const float* gn_b, bf16* Y) {
    const int c0 = lane * 8;
    const f32x4 o0 = *(const f32x4*)(OSC + (size_t)t * BW + c0), o1 = *(const f32x4*)(OSC + (size_t)t * BW + c0 + 4);
    float v[8] = {o0.x, o0.y, o0.z, o0.w, o1.x, o1.y, o1.z, o1.w};
    float s = 0.f;
#pragma unroll
    for (int e = 0; e < 8; ++e) s += v[e];
    s += __shfl_xor(s, 1); s += __shfl_xor(s, 2); s += __shfl_xor(s, 4);
    const float mean = s * (1.f / 64.f);
    float q = 0.f;
#pragma unroll
    for (int e = 0; e < 8; ++e) { v[e] -= mean; q += v[e] * v[e]; }
    q += __shfl_xor(q, 1); q += __shfl_xor(q, 2); q += __shfl_xor(q, 4);
    const float rstd = 1.0f / sqrtf(q * (1.f / 64.f) + 64e-5f);
    const float bon = BS[(size_t)t * 8 + (lane >> 3)];
    const v4u vraw = *(const v4u*)(VV + (size_t)t * BW + c0), graw = *(const v4u*)(GG + (size_t)t * BW + c0);
    const unsigned vr[4] = {vraw.x, vraw.y, vraw.z, vraw.w}, gr[4] = {graw.x, graw.y, graw.z, graw.w};
    float outv[8];
#pragma unroll
    for (int e = 0; e < 8; ++e) {
        const float vv = (e & 1) ? __uint_as_float(vr[e >> 1] & 0xffff0000u) : __uint_as_float(vr[e >> 1] << 16);
        const float gg = (e & 1) ? __uint_as_float(gr[e >> 1] & 0xffff0000u) : __uint_as_float(gr[e >> 1] << 16);
        outv[e] = (v[e] * rstd * gn_g[c0 + e] + gn_b[c0 + e] + bon * vv) * gg;
    }
    v4u w; w.x = pk2(outv[0], outv[1]); w.y = pk2(outv[2], outv[3]); w.z = pk2(outv[4], outv[5]); w.w = pk2(outv[6], outv[7]);
    *(v4u*)(Y + (size_t)t * D + 512 + c0) = w;
}

__device__ __forceinline__ void vtrans_item(LAS unsigned char* lds, int item, int tid, const bf16* QKV, bf16* VT1, bf16* VT4, bf16* VT16) {
    const int h = item >> 6, blk = item & 63, t0 = blk * 256;
    LAS bf16* Vl = (LAS bf16*)lds;
#pragma unroll
    for (int i = 0; i < 4; ++i) { const int idx = tid + 512 * i, t = idx >> 3, ch = idx & 7;
        *(LAS v4u*)(Vl + t * 72 + ch * 8) = *(const v4u*)(QKV + (size_t)(t0 + t) * NQKV + 2048 + h * 64 + ch * 8); }
    __syncthreads();
#pragma unroll
    for (int i = 0; i < 4; ++i) {
        const int idx = tid + 512 * i, d = idx >> 5;
        { const int j = idx & 31; unsigned short e[8];
#pragma unroll
          for (int k = 0; k < 8; ++k) e[k] = Vl[(8 * j + k) * 72 + d];
          v4u o; o.x = e[0] | ((unsigned)e[1] << 16); o.y = e[2] | ((unsigned)e[3] << 16); o.z = e[4] | ((unsigned)e[5] << 16); o.w = e[6] | ((unsigned)e[7] << 16);
          *(v4u*)(VT1 + (size_t)(h * 64 + d) * 16384 + t0 + 8 * j) = o; }
        { const int c4 = (idx >> 3) & 3, j = idx & 7; unsigned short e[8];
#pragma unroll
          for (int k = 0; k < 8; ++k) e[k] = Vl[(4 * (8 * j + k) + c4) * 72 + d];
          v4u o; o.x = e[0] | ((unsigned)e[1] << 16); o.y = e[2] | ((unsigned)e[3] << 16); o.z = e[4] | ((unsigned)e[5] << 16); o.w = e[6] | ((unsigned)e[7] << 16);
          *(v4u*)(VT4 + ((size_t)(h * 64 + d) * 4 + c4) * 4096 + t0 / 4 + 8 * j) = o; }
        { const int c16 = (idx >> 1) & 15, j = idx & 1; unsigned short e[8];
#pragma unroll
          for (int k = 0; k < 8; ++k) e[k] = Vl[(16 * (8 * j + k) + c16) * 72 + d];
          v4u o; o.x = e[0] | ((unsigned)e[1] << 16); o.y = e[2] | ((unsigned)e[3] << 16); o.z = e[4] | ((unsigned)e[5] << 16); o.w = e[6] | ((unsigned)e[7] << 16);
          *(v4u*)(VT16 + ((size_t)(h * 64 + d) * 16 + c16) * 1024 + t0 / 16 + 8 * j) = o; }
    }
    __syncthreads();
}

template <int DIL, int NGRP>
__device__ __forceinline__ void attn_pattern(const bf16* QKV, const bf16* VT, int h, int blk, int cls, int lane, const bf16x8 (&qf)[2], f32x4 (&o)[4], float& mrun, float& lrun) {
    constexpr int TD = M / DIL;
    const int r = lane & 15, q4 = lane >> 4, m = r;
    const int cp = cls & (DIL - 1);
    const int nq = (256 * blk + cls - cp) / DIL + (16 / DIL) * m;
    const int nstart = (256 * blk) / DIL - 128;
    const int kA = 8 * (r >> 2) + (r & 3);
    const float C = 0.125f * 1.4426950408889634f;
    const bf16* Kb = QKV + 1024 + h * 64 + q4 * 8;
    for (int g = 0; g < NGRP; ++g) {
        const int nb = nstart + 32 * g;
        int posA = cp + DIL * (nb + kA), posB = posA + 4 * DIL;
        posA = posA < 0 ? 0 : (posA > M - 1 ? M - 1 : posA); posB = posB < 0 ? 0 : (posB > M - 1 ? M - 1 : posB);
        const bf16x8 ka0 = *(const bf16x8*)(Kb + (size_t)posA * NQKV), ka1 = *(const bf16x8*)(Kb + (size_t)posA * NQKV + 32);
        const bf16x8 kb0 = *(const bf16x8*)(Kb + (size_t)posB * NQKV), kb1 = *(const bf16x8*)(Kb + (size_t)posB * NQKV + 32);
        f32x4 sA = (f32x4){0.f, 0.f, 0.f, 0.f}, sB = sA;
        sA = MFMA16(ka0, qf[0], sA); sA = MFMA16(ka1, qf[1], sA);
        sB = MFMA16(kb0, qf[0], sB); sB = MFMA16(kb1, qf[1], sB);
        float s[8]; bool ok[8]; float tmax = -1e30f;
#pragma unroll
        for (int e = 0; e < 8; ++e) {
            const int n = nb + 8 * q4 + e;
            ok[e] = (n >= 0) && (n <= nq) && (n >= nq - 128);
            s[e] = ok[e] ? (e < 4 ? sA[e & 3] : sB[e & 3]) * C : -1e30f;
            tmax = fmaxf(tmax, s[e]);
        }
        tmax = fmaxf(tmax, __shfl_xor(tmax, 16)); tmax = fmaxf(tmax, __shfl_xor(tmax, 32));
        const float mnew = fmaxf(mrun, tmax);
        const float alpha = __builtin_amdgcn_exp2f(mrun - mnew);
        float p[8]; float ps = 0.f;
#pragma unroll
        for (int e = 0; e < 8; ++e) { p[e] = ok[e] ? __builtin_amdgcn_exp2f(s[e] - mnew) : 0.f; ps += p[e]; }
        lrun = lrun * alpha + ps; mrun = mnew;
#pragma unroll
        for (int dt = 0; dt < 4; ++dt) o[dt] = o[dt] * alpha;
        v4u pw; pw.x = pk2(p[0], p[1]); pw.y = pk2(p[2], p[3]); pw.z = pk2(p[4], p[5]); pw.w = pk2(p[6], p[7]);
        const bf16x8 pf = __builtin_bit_cast(bf16x8, pw);
        int nv = nb + 8 * q4; nv = nv < 0 ? 0 : (nv > TD - 8 ? TD - 8 : nv);
#pragma unroll
        for (int dt = 0; dt < 4; ++dt) {
            const bf16x8 vf = *(const bf16x8*)(VT + ((size_t)(h * 64 + 16 * dt + r) * DIL + cp) * TD + nv);
            o[dt] = MFMA16(vf, pf, o[dt]);
        }
    }
}
__device__ __forceinline__ void attn_wave_item(const bf16* QKV, const bf16* VT1, const bf16* VT4, const bf16* VT16, bf16* AO, int h, int blk, int cls, int lane) {
    const int r = lane & 15, q4 = lane >> 4;
    const int im = 256 * blk + cls + 16 * r;
    bf16x8 qf[2];
    qf[0] = *(const bf16x8*)(QKV + (size_t)im * NQKV + h * 64 + q4 * 8);
    qf[1] = *(const bf16x8*)(QKV + (size_t)im * NQKV + h * 64 + 32 + q4 * 8);
    f32x4 o[4];
#pragma unroll
    for (int dt = 0; dt < 4; ++dt) o[dt] = (f32x4){0.f, 0.f, 0.f, 0.f};
    float mrun = -1e30f, lrun = 0.f;
    attn_pattern<1, 12>(QKV, VT1, h, blk, cls, lane, qf, o, mrun, lrun);
    attn_pattern<4, 6>(QKV, VT4, h, blk, cls, lane, qf, o, mrun, lrun);
    attn_pattern<16, 5>(QKV, VT16, h, blk, cls, lane, qf, o, mrun, lrun);
    float l = lrun; l += __shfl_xor(l, 16); l += __shfl_xor(l, 32);
    const float inv = 1.0f / l;
#pragma unroll
    for (int dt = 0; dt < 4; ++dt) {
        v2u w; w.x = pk2(o[dt][0] * inv, o[dt][1] * inv); w.y = pk2(o[dt][2] * inv, o[dt][3] * inv);
        *(v2u*)(AO + (size_t)im * D + h * 64 + 16 * dt + 4 * q4) = w;
    }
}
constexpr int CH_CL = 0, CH_AT = 17408, CH_RT = CH_AT + 9216, CH_BT = CH_RT + 9216, CH_KT = CH_BT + 9216, CH_BHT = CH_KT + 9216, CH_KHT = CH_BHT + 9216, CH_VT = CH_KHT + 9216,
              CH_MABF = CH_VT + 9216, CH_MAK = CH_MABF + 17408, CH_MBR = CH_MAK + 9216, CH_MKR = CH_MBR + 9216, CH_GL = CH_MKR + 9216, CH_MABB = CH_GL + 256, CH_TJ = CH_MABB + 9216, CH_END = CH_TJ + 2048;
static_assert(CH_END <= 147456, "chunk LDS map");
__device__ __forceinline__ void unpack8(const v4u raw, float (&v)[8]) {
    v[0] = __uint_as_float(raw.x << 16); v[1] = __uint_as_float(raw.x & 0xffff0000u); v[2] = __uint_as_float(raw.y << 16); v[3] = __uint_as_float(raw.y & 0xffff0000u);
    v[4] = __uint_as_float(raw.z << 16); v[5] = __uint_as_float(raw.z & 0xffff0000u); v[6] = __uint_as_float(raw.w << 16); v[7] = __uint_as_float(raw.w & 0xffff0000u);
}
__device__ __forceinline__ v4u pack8(const float (&v)[8]) { v4u o; o.x = pk2(v[0], v[1]); o.y = pk2(v[2], v[3]); o.z = pk2(v[4], v[5]); o.w = pk2(v[6], v[7]); return o; }

__device__ __forceinline__ void rwkv_chunk_item(LAS unsigned char* lds, int item, int tid, int wave, int lane, const float* LD, const bf16* KK, const bf16* BB, const bf16* KP, const bf16* RR, const bf16* VV,
                                                bf16* PMT, float* SLOC, bf16* QT, float* OLT) {
    const int c = item >> 3, h = item & 7, t0 = c * 64;
    LAS float* CL = (LAS float*)(lds + CH_CL); LAS float* Y5F = (LAS float*)(lds + CH_CL);
    LAS bf16* AT = (LAS bf16*)(lds + CH_AT); LAS bf16* RT = (LAS bf16*)(lds + CH_RT); LAS bf16* BT = (LAS bf16*)(lds + CH_BT); LAS bf16* KT = (LAS bf16*)(lds + CH_KT);
    LAS bf16* UB = BT; LAS bf16* WB = KT;
    LAS bf16* BHT = (LAS bf16*)(lds + CH_BHT); LAS bf16* KHT = (LAS bf16*)(lds + CH_KHT); LAS bf16* VT = (LAS bf16*)(lds + CH_VT);
    LAS float* MABF = (LAS float*)(lds + CH_MABF); LAS bf16* MAK = (LAS bf16*)(lds + CH_MAK); LAS bf16* MBR = (LAS bf16*)(lds + CH_MBR); LAS bf16* MKR = (LAS bf16*)(lds + CH_MKR);
    LAS float* GL = (LAS float*)(lds + CH_GL); LAS bf16* MABB = (LAS bf16*)(lds + CH_MABB); LAS bf16* TJB = (LAS bf16*)(lds + CH_TJ);
    const size_t gbase = (size_t)t0 * BW + h * 64;
    if (tid < 64) {
        float run = 0.f;
#pragma unroll 8
        for (int t = 0; t < 64; ++t) { run += LD[gbase + (size_t)t * BW + tid]; CL[t * 64 + tid] = run; }
        GL[tid] = __expf(run);
    }
    __syncthreads();
    {
        const int t = tid >> 3, k8 = (tid & 7) * 8; const size_t o = gbase + (size_t)t * BW + k8;
        float kk[8], bb[8], kp[8], rr[8], vv[8];
        unpack8(*(const v4u*)(KK + o), kk); unpack8(*(const v4u*)(BB + o), bb); unpack8(*(const v4u*)(KP + o), kp); unpack8(*(const v4u*)(RR + o), rr); unpack8(*(const v4u*)(VV + o), vv);
        const f32x4 l0 = *(const f32x4*)(LD + o), l1 = *(const f32x4*)(LD + o + 4);
        const float ldv[8] = {l0.x, l0.y, l0.z, l0.w, l1.x, l1.y, l1.z, l1.w};
        float at[8], rt[8], bt[8], kt[8];
#pragma unroll
        for (int e = 0; e < 8; ++e) {
            const float cl = CL[t * 64 + k8 + e], clL = CL[63 * 64 + k8 + e];
            const float en = __expf(-cl), eh = __expf(clL - cl);
            at[e] = -kk[e] * __expf(cl - ldv[e]); rt[e] = rr[e] * __expf(cl); bt[e] = bb[e] * en; kt[e] = kp[e] * en;
            BHT[(k8 + e) * 72 + t] = (bf16)f2bf(bb[e] * eh); KHT[(k8 + e) * 72 + t] = (bf16)f2bf(kp[e] * eh); VT[(k8 + e) * 72 + t] = (bf16)f2bf(vv[e]);
        }
        *(LAS v4u*)(AT + t * 72 + k8) = pack8(at); *(LAS v4u*)(RT + t * 72 + k8) = pack8(rt); *(LAS v4u*)(BT + t * 72 + k8) = pack8(bt); *(LAS v4u*)(KT + t * 72 + k8) = pack8(kt);
    }
    __syncthreads();
    const int r = lane & 15, q4 = lane >> 4, par = wave & 1;
    {
        const int mi = wave >> 1;
        const LAS bf16* X = (mi == 0 || mi == 2) ? BT : KT; const LAS bf16* Y = (mi < 2) ? AT : RT;
        f32x4 acc[2][4];
#pragma unroll
        for (int a = 0; a < 2; ++a)
#pragma unroll
            for (int b = 0; b < 4; ++b) acc[a][b] = (f32x4){0.f, 0.f, 0.f, 0.f};
#pragma unroll
        for (int ks = 0; ks < 2; ++ks) {
            bf16x8 xf[2], yf[4];
#pragma unroll
            for (int a = 0; a < 2; ++a) xf[a] = *(const LAS bf16x8*)(X + (16 * (2 * par + a) + r) * 72 + ks * 32 + q4 * 8);
#pragma unroll
            for (int b = 0; b < 4; ++b) yf[b] = *(const LAS bf16x8*)(Y + (16 * b + r) * 72 + ks * 32 + q4 * 8);
#pragma unroll
            for (int a = 0; a < 2; ++a)
#pragma unroll
                for (int b = 0; b < 4; ++b) acc[a][b] = MFMA16(xf[a], yf[b], acc[a][b]);
        }
#pragma unroll
        for (int a = 0; a < 2; ++a)
#pragma unroll
            for (int b = 0; b < 4; ++b) {
                const int s0 = 16 * (2 * par + a) + 4 * q4, t = 16 * b + r;
                f32x4 m;
#pragma unroll
                for (int e = 0; e < 4; ++e) m[e] = ((mi < 2) ? (s0 + e < t) : (s0 + e <= t)) ? acc[a][b][e] : 0.f;
                if (mi == 0) { *(LAS f32x4*)(MABF + t * 68 + s0) = m; v2u w; w.x = pk2(m[0], m[1]); w.y = pk2(m[2], m[3]); *(LAS v2u*)(MABB + t * 72 + s0) = w; }
                else { LAS bf16* Mo = (mi == 1) ? MAK : (mi == 2 ? MBR : MKR); v2u w; w.x = pk2(m[0], m[1]); w.y = pk2(m[2], m[3]); *(LAS v2u*)(Mo + t * 72 + s0) = w; }
            }
    }
    __syncthreads();
    {
        const int vt = wave >> 1;
        f32x4 acc[2];
        acc[0] = (f32x4){0.f, 0.f, 0.f, 0.f}; acc[1] = acc[0];
#pragma unroll
        for (int ks = 0; ks < 2; ++ks) {
            const bf16x8 xf = *(const LAS bf16x8*)(VT + (16 * vt + r) * 72 + ks * 32 + q4 * 8);
#pragma unroll
            for (int b = 0; b < 2; ++b) { const bf16x8 yf = *(const LAS bf16x8*)(MAK + (16 * (2 * par + b) + r) * 72 + ks * 32 + q4 * 8); acc[b] = MFMA16(xf, yf, acc[b]); }
        }
#pragma unroll
        for (int b = 0; b < 2; ++b)
#pragma unroll
            for (int e = 0; e < 4; ++e) Y5F[(16 * vt + 4 * q4 + e) * 68 + 16 * (2 * par + b) + r] = acc[b][e];
    }
    __syncthreads();
    if (wave == 0) {
        const int J = lane >> 4, i = lane & 15;
        float tr[16];
#pragma unroll
        for (int t = 0; t < 16; ++t) {
            float acc = (t == i) ? 1.f : 0.f;
#pragma unroll
            for (int s2 = 0; s2 < t; ++s2) acc += tr[s2] * MABF[(16 * J + t) * 68 + 16 * J + s2];
            tr[t] = acc;
        }
#pragma unroll
        for (int t = 0; t < 16; ++t) TJB[(16 * J + t) * 16 + i] = (bf16)f2bf(tr[t]);
    }
    __syncthreads();
    {
        unsigned xb[4][2];
#pragma unroll
        for (int J = 0; J < 4; ++J) {
            f32x4 z;
            if (wave < 4) z = *(const LAS f32x4*)(Y5F + (16 * wave + r) * 68 + 16 * J + 4 * q4);
            else {
#pragma unroll
                for (int e = 0; e < 4; ++e) z[e] = bf2f(AT[(16 * J + 4 * q4 + e) * 72 + 16 * (wave - 4) + r]);
            }
#pragma unroll
            for (int I = 0; I < J; I += 2) {
                const bool two = (I + 1 < J);
                const v2u m0 = *(const LAS v2u*)(MABB + (16 * J + r) * 72 + 16 * I + 4 * q4);
                v2u m1; m1.x = 0u; m1.y = 0u;
                if (two) m1 = *(const LAS v2u*)(MABB + (16 * J + r) * 72 + 16 * (I + 1) + 4 * q4);
                v4u fa; fa.x = m0.x; fa.y = m0.y; fa.z = m1.x; fa.w = m1.y;
                v4u fb; fb.x = xb[I][0]; fb.y = xb[I][1]; fb.z = two ? xb[I + 1 < 4 ? I + 1 : 3][0] : 0u; fb.w = two ? xb[I + 1 < 4 ? I + 1 : 3][1] : 0u;
                z = MFMA16(__builtin_bit_cast(bf16x8, fa), __builtin_bit_cast(bf16x8, fb), z);
            }
            const unsigned zh0 = pk2(z[0], z[1]), zh1 = pk2(z[2], z[3]);
            const unsigned zl0 = pk2(z[0] - __uint_as_float(zh0 << 16), z[1] - __uint_as_float(zh0 & 0xffff0000u)), zl1 = pk2(z[2] - __uint_as_float(zh1 << 16), z[3] - __uint_as_float(zh1 & 0xffff0000u));
            const v2u tw = *(const LAS v2u*)(TJB + (16 * J + r) * 16 + 4 * q4);
            v4u ft; ft.x = tw.x; ft.y = tw.y; ft.z = 0u; ft.w = 0u;
            v4u fh; fh.x = zh0; fh.y = zh1; fh.z = 0u; fh.w = 0u;
            v4u fl; fl.x = zl0; fl.y = zl1; fl.z = 0u; fl.w = 0u;
            f32x4 x = (f32x4){0.f, 0.f, 0.f, 0.f};
            x = MFMA16(__builtin_bit_cast(bf16x8, ft), __builtin_bit_cast(bf16x8, fh), x);
            x = MFMA16(__builtin_bit_cast(bf16x8, ft), __builtin_bit_cast(bf16x8, fl), x);
            xb[J][0] = pk2(x[0], x[1]); xb[J][1] = pk2(x[2], x[3]);
            LAS bf16* Xo = (wave < 4) ? (UB + (16 * wave + r) * 72) : (WB + (16 * (wave - 4) + r) * 72);
            v2u w; w.x = xb[J][0]; w.y = xb[J][1];
            *(LAS v2u*)(Xo + 16 * J + 4 * q4) = w;
        }
    }
    __syncthreads();
    {
        const int kind = wave >> 1;
        const LAS bf16* X1; const LAS bf16* Y1; const LAS bf16* X2 = nullptr; const LAS bf16* Y2 = nullptr;
        if (kind == 0) { X1 = UB; Y1 = MBR; X2 = VT; Y2 = MKR; }
        else if (kind == 1) { X1 = BHT; Y1 = UB; X2 = KHT; Y2 = VT; }
        else if (kind == 2) { X1 = WB; Y1 = MBR; }
        else { X1 = WB; Y1 = BHT; }
        f32x4 acc[2][4];
#pragma unroll
        for (int a = 0; a < 2; ++a)
#pragma unroll
            for (int b = 0; b < 4; ++b) acc[a][b] = (f32x4){0.f, 0.f, 0.f, 0.f};
#pragma unroll
        for (int ks = 0; ks < 2; ++ks) {
            bf16x8 xf[2], yf[4];
#pragma unroll
            for (int a = 0; a < 2; ++a) xf[a] = *(const LAS bf16x8*)(X1 + (16 * (2 * par + a) + r) * 72 + ks * 32 + q4 * 8);
#pragma unroll
            for (int b = 0; b < 4; ++b) yf[b] = *(const LAS bf16x8*)(Y1 + (16 * b + r) * 72 + ks * 32 + q4 * 8);
#pragma unroll
            for (int a = 0; a < 2; ++a)
#pragma unroll
                for (int b = 0; b < 4; ++b) acc[a][b] = MFMA16(xf[a], yf[b], acc[a][b]);
        }
        if (kind < 2) {
#pragma unroll
            for (int ks = 0; ks < 2; ++ks) {
                bf16x8 xf[2], yf[4];
#pragma unroll
                for (int a = 0; a < 2; ++a) xf[a] = *(const LAS bf16x8*)(X2 + (16 * (2 * par + a) + r) * 72 + ks * 32 + q4 * 8);
#pragma unroll
                for (int b = 0; b < 4; ++b) yf[b] = *(const LAS bf16x8*)(Y2 + (16 * b + r) * 72 + ks * 32 + q4 * 8);
#pragma unroll
                for (int a = 0; a < 2; ++a)
#pragma unroll
                    for (int b = 0; b < 4; ++b) acc[a][b] = MFMA16(xf[a], yf[b], acc[a][b]);
            }
        }
#pragma unroll
        for (int a = 0; a < 2; ++a)
#pragma unroll
            for (int b = 0; b < 4; ++b) {
                const int i0 = 16 * (2 * par + a) + 4 * q4, j = 16 * b + r;
                if (kind == 0) *(f32x4*)(OLT + ((size_t)item * 64 + j) * 64 + i0) = acc[a][b];
                else if (kind == 1) *(f32x4*)(SLOC + ((size_t)item * 64 + j) * 64 + i0) = acc[a][b];
                else if (kind == 2) {
                    const v2u rw = *(const LAS v2u*)(RT + j * 72 + i0);
                    v2u w; w.x = pk2(acc[a][b][0] + __uint_as_float(rw.x << 16), acc[a][b][1] + __uint_as_float(rw.x & 0xffff0000u));
                    w.y = pk2(acc[a][b][2] + __uint_as_float(rw.y << 16), acc[a][b][3] + __uint_as_float(rw.y & 0xffff0000u));
                    *(v2u*)(QT + ((size_t)item * 64 + j) * 64 + i0) = w;
                } else {
                    f32x4 m = acc[a][b];
#pragma unroll
                    for (int e = 0; e < 4; ++e) if (i0 + e == j) m[e] += GL[j];
                    v2u w; w.x = pk2(m[0], m[1]); w.y = pk2(m[2], m[3]);
                    *(v2u*)(PMT + ((size_t)item * 64 + j) * 64 + i0) = w;
                }
            }
    }
    __syncthreads();
}

struct ScanOps { bf16x8 pf[4][2]; f32x4 sl[4]; };
__device__ __forceinline__ void scan_ops_load(ScanOps& o, int it, int v, int r, int q4, const bf16* PMT, const float* SLOC) {
#pragma unroll
    for (int kt = 0; kt < 4; ++kt) {
        o.sl[kt] = *(const f32x4*)(SLOC + ((size_t)it * 64 + v) * 64 + 16 * kt + 4 * q4);
#pragma unroll
        for (int ks = 0; ks < 2; ++ks) {
            const bf16* p = PMT + ((size_t)it * 64 + 16 * kt + r) * 64 + 32 * ks + 4 * q4;
            const v2u lo = *(const v2u*)p, hi = *(const v2u*)(p + 16);
            v4u w; w.x = lo.x; w.y = lo.y; w.z = hi.x; w.w = hi.y;
            o.pf[kt][ks] = __builtin_bit_cast(bf16x8, w);
        }
    }
}
__device__ __forceinline__ void scan_step(const ScanOps& o, int c, int it, int v, int q4, int lane, LAS unsigned char* lds, bf16* SC) {
    volatile LAS int* flag = (volatile LAS int*)(lds + 16384);
    LAS v4u* slot_in = (LAS v4u*)(lds + (c & 1) * 8192);
    LAS v4u* slot_out = (LAS v4u*)(lds + ((c + 1) & 1) * 8192);
    while (*flag != c) __builtin_amdgcn_s_sleep(1);
    asm volatile("" ::: "memory");
    const v4u h0 = slot_in[lane], h1 = slot_in[64 + lane], l0 = slot_in[128 + lane], l1 = slot_in[192 + lane];
    { bf16* sc = SC + ((size_t)it * 64 + v) * 64 + 4 * q4;
      v2u w; w.x = h0.x; w.y = h0.y; *(v2u*)(sc) = w; w.x = h0.z; w.y = h0.w; *(v2u*)(sc + 16) = w;
      w.x = h1.x; w.y = h1.y; *(v2u*)(sc + 32) = w; w.x = h1.z; w.y = h1.w; *(v2u*)(sc + 48) = w; }
    const bf16x8 sh0 = __builtin_bit_cast(bf16x8, h0), sh1 = __builtin_bit_cast(bf16x8, h1), sl0 = __builtin_bit_cast(bf16x8, l0), sl1 = __builtin_bit_cast(bf16x8, l1);
    unsigned hw[4][2], lw[4][2];
#pragma unroll
    for (int kt = 0; kt < 4; ++kt) {
        f32x4 n = o.sl[kt];
        n = MFMA16(o.pf[kt][0], sh0, n); n = MFMA16(o.pf[kt][1], sh1, n);
        n = MFMA16(o.pf[kt][0], sl0, n); n = MFMA16(o.pf[kt][1], sl1, n);
        hw[kt][0] = pk2(n[0], n[1]); hw[kt][1] = pk2(n[2], n[3]);
        lw[kt][0] = pk2(n[0] - __uint_as_float(hw[kt][0] << 16), n[1] - __uint_as_float(hw[kt][0] & 0xffff0000u));
        lw[kt][1] = pk2(n[2] - __uint_as_float(hw[kt][1] << 16), n[3] - __uint_as_float(hw[kt][1] & 0xffff0000u));
    }
    v4u o0, o1, o2, o3;
    o0.x = hw[0][0]; o0.y = hw[0][1]; o0.z = hw[1][0]; o0.w = hw[1][1];
    o1.x = hw[2][0]; o1.y = hw[2][1]; o1.z = hw[3][0]; o1.w = hw[3][1];
    o2.x = lw[0][0]; o2.y = lw[0][1]; o2.z = lw[1][0]; o2.w = lw[1][1];
    o3.x = lw[2][0]; o3.y = lw[2][1]; o3.z = lw[3][0]; o3.w = lw[3][1];
    slot_out[lane] = o0; slot_out[64 + lane] = o1; slot_out[128 + lane] = o2; slot_out[192 + lane] = o3;
    asm volatile("s_waitcnt lgkmcnt(0)" ::: "memory");
    if (lane == 0) *flag = c + 1;
}
__device__ __forceinline__ void rwkv_state_scan_wg(LAS unsigned char* lds, int hv, int tid, int wave, int lane, const bf16* PMT, const float* SLOC, bf16* SC) {
    const int h = hv >> 2, vt = hv & 3, r = lane & 15, q4 = lane >> 4, v = 16 * vt + r;
    constexpr int NC = M / 64;
    for (int i = tid; i < 16384 / 4 + 16; i += 512) ((LAS unsigned*)lds)[i] = 0u;
    __syncthreads();
    ScanOps A, B;
    scan_ops_load(A, wave * 8 + h, v, r, q4, PMT, SLOC);
    scan_ops_load(B, (wave + 8) * 8 + h, v, r, q4, PMT, SLOC);
    for (int j = 0; j < NC / 8; j += 2) {
        const int cA = wave + 8 * j, cB = cA + 8;
        scan_step(A, cA, cA * 8 + h, v, q4, lane, lds, SC);
        if (j + 2 < NC / 8) scan_ops_load(A, (cA + 16) * 8 + h, v, r, q4, PMT, SLOC);
        scan_step(B, cB, cB * 8 + h, v, q4, lane, lds, SC);
        if (j + 3 < NC / 8) scan_ops_load(B, (cB + 16) * 8 + h, v, r, q4, PMT, SLOC);
    }
    __syncthreads();
}
__device__ __forceinline__ void rwkv_chunk_out(int item, int lane, const bf16* SC, const bf16* QT, const float* OLT, const float* BS, const bf16* VV, const bf16* GG,
                                               const float* gn_g, const float* gn_b, bf16* Y) {
    const int c = item >> 3, h = item & 7, r = lane & 15, q4 = lane >> 4;
    bf16x8 sf[4][2];
#pragma unroll
    for (int vt = 0; vt < 4; ++vt)
#pragma unroll
        for (int ks = 0; ks < 2; ++ks) sf[vt][ks] = *(const bf16x8*)(SC + ((size_t)item * 64 + 16 * vt + r) * 64 + 32 * ks + 8 * q4);
    f32x4 gg4[4], gb4[4];
#pragma unroll
    for (int vt = 0; vt < 4; ++vt) { gg4[vt] = *(const f32x4*)(gn_g + h * 64 + 16 * vt + 4 * q4); gb4[vt] = *(const f32x4*)(gn_b + h * 64 + 16 * vt + 4 * q4); }
    for (int tt = 0; tt < 4; ++tt) {
        const int tl = 16 * tt + r, t = c * 64 + tl;
        bf16x8 qf[2];
#pragma unroll
        for (int ks = 0; ks < 2; ++ks) qf[ks] = *(const bf16x8*)(QT + ((size_t)item * 64 + tl) * 64 + 32 * ks + 8 * q4);
        f32x4 o[4]; float s = 0.f;
#pragma unroll
        for (int vt = 0; vt < 4; ++vt) {
            o[vt] = *(const f32x4*)(OLT + ((size_t)item * 64 + tl) * 64 + 16 * vt + 4 * q4);
            o[vt] = MFMA16(sf[vt][0], qf[0], o[vt]); o[vt] = MFMA16(sf[vt][1], qf[1], o[vt]);
            s += (o[vt][0] + o[vt][1]) + (o[vt][2] + o[vt][3]);
        }
        s += __shfl_xor(s, 16); s += __shfl_xor(s, 32);
        const float mean = s * (1.f / 64.f);
        float qv = 0.f;
#pragma unroll
        for (int vt = 0; vt < 4; ++vt) { o[vt] = o[vt] - mean; qv += (o[vt][0] * o[vt][0] + o[vt][1] * o[vt][1]) + (o[vt][2] * o[vt][2] + o[vt][3] * o[vt][3]); }
        qv += __shfl_xor(qv, 16); qv += __shfl_xor(qv, 32);
        const float rstd = 1.0f / sqrtf(qv * (1.f / 64.f) + 64e-5f);
        const float bon = BS[(size_t)t * 8 + h];
#pragma unroll
        for (int vt = 0; vt < 4; ++vt) {
            const size_t oo = (size_t)t * BW + h * 64 + 16 * vt + 4 * q4;
            const v2u vr = *(const v2u*)(VV + oo), gr = *(const v2u*)(GG + oo);
            const float v0 = __uint_as_float(vr.x << 16), v1 = __uint_as_float(vr.x & 0xffff0000u), v2 = __uint_as_float(vr.y << 16), v3 = __uint_as_float(vr.y & 0xffff0000u);
            const float g0 = __uint_as_float(gr.x << 16), g1 = __uint_as_float(gr.x & 0xffff0000u), g2 = __uint_as_float(gr.y << 16), g3 = __uint_as_float(gr.y & 0xffff0000u);
            const f32x4 y = o[vt] * rstd * gg4[vt] + gb4[vt];
            v2u w; w.x = pk2((y[0] + bon * v0) * g0, (y[1] + bon * v1) * g1); w.y = pk2((y[2] + bon * v2) * g2, (y[3] + bon * v3) * g3);
            *(v2u*)(Y + (size_t)t * D + 512 + h * 64 + 16 * vt + 4 * q4) = w;
        }
    }
}
#define XB_TMO      128
#define XB_XCNT(j)  (256  + 64 * (j))
#define XB_XSUB(j)  (1280 + 64 * (j))
#define XB_XGEN(j)  (2304 + 64 * (j))
#define XB_TOP      3328
#define XB_TOPGEN   3392
#define XCD_BAR_WORDS 3456
#define XB_SPIN_CAP (1u << 18)

__device__ __forceinline__ unsigned xb_ld(unsigned* p)              { return __hip_atomic_load(p, __ATOMIC_RELAXED, __HIP_MEMORY_SCOPE_AGENT); }
__device__ __forceinline__ unsigned xb_add(unsigned* p, unsigned v) { return __hip_atomic_fetch_add(p, v, __ATOMIC_RELAXED, __HIP_MEMORY_SCOPE_AGENT); }
__device__ __forceinline__ unsigned xb_xcc_id() { return (unsigned)__builtin_amdgcn_s_getreg((3 << 11) | 20) & 0xFu; }
#define XB_SPIN(cond, bar) do { unsigned _sp = 0; while (cond) { __builtin_amdgcn_s_sleep(1); \
    if ((++_sp & 255u) == 0u) { if (xb_ld(&(bar)[XB_TMO])) break; if (_sp > XB_SPIN_CAP) { atomicAdd(&(bar)[XB_TMO], 1u); break; } } } } while (0)

struct XcdBarrier {
    unsigned* bar; unsigned x;
    volatile LAS unsigned* st;
};

__device__ __forceinline__ XcdBarrier xcd_barrier_post(unsigned* bar, volatile LAS unsigned* st) {
    XcdBarrier b; b.bar = bar; b.x = xb_xcc_id(); b.st = st;
    if (threadIdx.x == 0) (void)xb_add(&bar[XB_XCNT(b.x)], 1u);
    return b;
}
__device__ __forceinline__ void xcd_barrier_complete(unsigned* bar, unsigned x, unsigned& nloc, unsigned& nx) {
    const unsigned G = gridDim.x * gridDim.y * gridDim.z;
    unsigned sum, cnt, mine, sp = 0u;
    for (;;) {
        sum = 0u; cnt = 0u; mine = 0u;
#pragma unroll
        for (unsigned j = 0; j < 16; ++j) { const unsigned c = xb_ld(&bar[XB_XCNT(j)]); sum += c; cnt += (c > 0u) ? 1u : 0u; mine = (j == x) ? c : mine; }
        if (sum == G) break;
        __builtin_amdgcn_s_sleep(1);
        if ((++sp & 255u) == 0u) { if (xb_ld(&bar[XB_TMO])) break; if (sp > XB_SPIN_CAP) { atomicAdd(&bar[XB_TMO], 1u); break; } }
    }
    nloc = mine > 0u ? mine : 1u; nx = cnt > 0u ? cnt : 1u;
}

__device__ __forceinline__ void xcd_barrier(const XcdBarrier& b) {
    asm volatile("s_waitcnt vmcnt(0)" ::: "memory");
    __syncthreads();
    if (threadIdx.x == 0) {
        unsigned* bar = b.bar;
        __builtin_amdgcn_s_waitcnt(0);
        unsigned nloc = b.st[0], nx = b.st[1];
        if (nloc == 0u) { xcd_barrier_complete(bar, b.x, nloc, nx); b.st[0] = nloc; b.st[1] = nx; }
        const unsigned old = xb_add(&bar[XB_XSUB(b.x)], 1u);
        const unsigned gen = old / nloc;
        if (old + 1u == (gen + 1u) * nloc) {
            __builtin_amdgcn_fence(__ATOMIC_RELEASE, "agent");
            asm volatile("s_waitcnt vmcnt(0)" ::: "memory");
            const unsigned og = xb_add(&bar[XB_TOP], 1u);
            const unsigned tg = og / nx;
            if (og + 1u == (tg + 1u) * nx) xb_add(&bar[XB_TOPGEN], 1u);
            else XB_SPIN(xb_ld(&bar[XB_TOPGEN]) == tg, bar);
            __builtin_amdgcn_fence(__ATOMIC_ACQUIRE, "agent");
            xb_add(&bar[XB_XGEN(b.x)], 1u);
            asm volatile("s_waitcnt vmcnt(0)" ::: "memory");
        } else {
            XB_SPIN(xb_ld(&bar[XB_XGEN(b.x)]) == gen, bar);
            __builtin_amdgcn_fence(__ATOMIC_ACQUIRE, "agent");
            asm volatile("s_waitcnt vmcnt(0)" ::: "memory");
        }
    }
    __syncthreads();
}
struct Args { const float* in[28]; float* out; unsigned char* ws; };
#define GRID_SYNC() xcd_barrier(xbar)
#define PHASE_VARS int tid = threadIdx.x; asm volatile("" : "+v"(tid)); const int lane = tid & 63; const int wave = __builtin_amdgcn_readfirstlane(tid >> 6); \
    int G = gridDim.x; asm volatile("" : "+s"(G)); int bx = blockIdx.x; asm volatile("" : "+s"(bx)); const int gw = bx * NWAVES + wave, NGW = G * NWAVES; (void)lane; (void)gw; (void)NGW; (void)tid
#define WSP(T, off) ((T*)(args.ws + (off)))
#define XIN (args.in[0])
#define OUTF (args.out)
#define WA WSP(bf16, WS_WA)
#define WB WSP(bf16, WS_WB)
#define XN WSP(bf16, WS_XN)
#define P WSP(bf16, WS_P)
#define LD WSP(float, WS_LD)
#define KK WSP(bf16, WS_KK)
#define BB WSP(bf16, WS_BB)
#define KP WSP(bf16, WS_KP)
#define RR WSP(bf16, WS_RR)
#define VV WSP(bf16, WS_VV)
#define GG ((bf16*)args.out)
#define SCB ((bf16*)((unsigned char*)args.out + 16 * MiB))
#define OLT ((float*)((unsigned char*)args.out + 32 * MiB))
#define PMT WSP(bf16, WS_P)
#define SLOC WSP(float, WS_P + 16 * MiB)
#define QTB WSP(bf16, WS_P + 48 * MiB)
#define BS WSP(float, WS_BS)
#define W2T WSP(bf16, WS_W2T)
#define A2T WSP(bf16, WS_A2T)
#define G2T WSP(bf16, WS_G2T)
#define YC WSP(bf16, WS_XN)
#define ACT WSP(bf16, WS_GEN)
#define QKV WSP(bf16, WS_QKV)
#define VT1 WSP(bf16, WS_VT1)
#define VT4 WSP(bf16, WS_VT4)
#define VT16 WSP(bf16, WS_VT16)
__global__ void __launch_bounds__(NWAVES * 64, 2) hybrid_fwd(Args args) {
    extern __shared__ __attribute__((aligned(16))) unsigned char lds_raw[];
    LAS unsigned char* lds = (LAS unsigned char*)lds_raw;
    if (threadIdx.x < 16) ((LAS unsigned*)(lds + LDS_BYTES - 64))[threadIdx.x] = 0u;
    __syncthreads();
    const XcdBarrier xbar = xcd_barrier_post((unsigned*)args.ws, (volatile LAS unsigned*)(lds + LDS_BYTES - 64));

    { PHASE_VARS;
    {
        LAS float* scr = (LAS float*)(lds + wave * 16384);
        const int IL = 16 + 16 + 32;
        for (int it = gw; it < IL; it += NGW) {
            if (it < 16) transpose_item(args.in[9], 64, 512, W2T, scr, it, lane);
            else if (it < 32) transpose_item(args.in[11], 64, 512, A2T, scr, it - 16, lane);
            else transpose_item(args.in[12], 128, 512, G2T, scr, it - 32, lane);
        }
        norm_phase(lds, gw, NGW, wave, lane, XIN, args.in[1], XN, args.in[2], D, EIN, WA, args.in[18], D, D, WB);
    }

    }
    cg::this_grid().sync();
    { PHASE_VARS;

    {
        pg8::Gemm g{XN, WA, M, EIN, D, 256L * D * 2, 128L * D * 2, 256L * D * 2, 128L * D * 2, 0}; pg8::StaticOrder S; S.init(M, EIN, G, bx);
        pg8::EpiBf16<0> E{P, EIN, nullptr, 0, 0, 1.f};
        pg8::gemm_phase<pg8::EpiBf16<0>, pg8::StaticOrder, true, true>(lds, g, S, E);
    }

    }
    GRID_SYNC();
    { PHASE_VARS;

    {
        RwkvW W{args.in[7], args.in[8], args.in[10], args.in[13], args.in[14], args.in[15], W2T, A2T, G2T};
        for (int it = bx; it < M / 64; it += G) rwkv_prep_item(lds, it, tid, wave, lane, P, W, LD, KK, BB, KP, RR, VV, GG, BS);
        for (int it = bx; it < (M / 128) * 4; it += G) gmlp_item(lds, it, tid, wave, lane, P, args.in[3], args.in[4], args.in[5], args.in[6], YC);
    }

    }
    GRID_SYNC();
    { PHASE_VARS;
        for (int it = bx; it < (M / 64) * 8; it += G) rwkv_chunk_item(lds, it, tid, wave, lane, LD, KK, BB, KP, RR, VV, PMT, SLOC, QTB, OLT);
    }
    GRID_SYNC();
    { PHASE_VARS;
        if (bx < 32) rwkv_state_scan_wg(lds, bx, tid, wave, lane, PMT, SLOC, SCB);
    }
    GRID_SYNC();
    { PHASE_VARS;
        for (int it = gw; it < (M / 64) * 8; it += NGW) rwkv_chunk_out(it, lane, SCB, QTB, OLT, BS, VV, GG, args.in[16], args.in[17], YC);
    }
    GRID_SYNC();
    { PHASE_VARS;

    {
        pg8::Gemm g{YC, WB, M, D, D, 256L * D * 2, 128L * D * 2, 256L * D * 2, 128L * D * 2, 0}; pg8::StaticOrder S; S.init(M, D, G, bx);
        pg8::EpiRes E{XIN, OUTF, D};
        pg8::gemm_phase<pg8::EpiRes, pg8::StaticOrder, true, true>(lds, g, S, E);
    }

    }
    GRID_SYNC();
    { PHASE_VARS;
        norm_phase(lds, gw, NGW, wave, lane, OUTF, args.in[22] + 0 * D, XN, args.in[23] + (size_t)0 * D * FF2, D, FF2, WA, args.in[26] + (size_t)0 * FF * D, FF, D, WB);
    }
    GRID_SYNC();
    { PHASE_VARS;
        pg8::Gemm g{XN - 2 * D, WA, M, FF2, D, 248L * D * 2, 124L * D * 2, 128L * D * 2, 2816L * D * 2, 1}; pg8::StaticOrder S; S.init2(67, 22, G, bx);
        pg8::EpiConvGlu E{ACT, args.in[24] + (size_t)0 * 3 * FF2, args.in[25] + (size_t)0 * FF2, M};
        pg8::gemm_phase<pg8::EpiConvGlu, pg8::StaticOrder, true, true>(lds, g, S, E);
    }
    GRID_SYNC();
    { PHASE_VARS;
        pg8::Gemm g{ACT, WB, M, D, FF, 256L * FF * 2, 128L * FF * 2, 256L * FF * 2, 128L * FF * 2, 0}; pg8::StaticOrder S; S.init(M, D, G, bx);
        pg8::EpiRes E{OUTF, OUTF, D};
        pg8::gemm_phase<pg8::EpiRes, pg8::StaticOrder, true, true>(lds, g, S, E);
    }
    GRID_SYNC();
    { PHASE_VARS;
        norm_phase(lds, gw, NGW, wave, lane, OUTF, args.in[19], XN, args.in[20], D, NQKV, WA, args.in[21], D, D, WB);
    }
    GRID_SYNC();
    { PHASE_VARS;
        pg8::Gemm g{XN, WA, M, NQKV, D, 256L * D * 2, 128L * D * 2, 256L * D * 2, 128L * D * 2, 0}; pg8::StaticOrder S; S.init(M, NQKV, G, bx);
        pg8::EpiBf16<0> E{QKV, NQKV, nullptr, 0, 0, 1.f};
        pg8::gemm_phase<pg8::EpiBf16<0>, pg8::StaticOrder, true, true>(lds, g, S, E);
    }
    GRID_SYNC();
    { PHASE_VARS;
        for (int it = bx; it < 16 * 64; it += G) vtrans_item(lds, it, tid, QKV, VT1, VT4, VT16);
    }
    GRID_SYNC();
    { PHASE_VARS;
        for (int it = bx; it < 16 * 64; it += G) {
            const int h = it >> 6, blk = it & 63;
            attn_wave_item(QKV, VT1, VT4, VT16, YC, h, blk, 2 * wave, lane);
            attn_wave_item(QKV, VT1, VT4, VT16, YC, h, blk, 2 * wave + 1, lane);
        }
    }
    GRID_SYNC();
    { PHASE_VARS;
        pg8::Gemm g{YC, WB, M, D, D, 256L * D * 2, 128L * D * 2, 256L * D * 2, 128L * D * 2, 0}; pg8::StaticOrder S; S.init(M, D, G, bx);
        pg8::EpiRes E{OUTF, OUTF, D};
        pg8::gemm_phase<pg8::EpiRes, pg8::StaticOrder, true, true>(lds, g, S, E);
    }
    GRID_SYNC();
    { PHASE_VARS;
        norm_phase(lds, gw, NGW, wave, lane, OUTF, args.in[22] + 1 * D, XN, args.in[23] + (size_t)1 * D * FF2, D, FF2, WA, args.in[26] + (size_t)1 * FF * D, FF, D, WB);
    }
    GRID_SYNC();
    { PHASE_VARS;
        pg8::Gemm g{XN - 2 * D, WA, M, FF2, D, 248L * D * 2, 124L * D * 2, 128L * D * 2, 2816L * D * 2, 1}; pg8::StaticOrder S; S.init2(67, 22, G, bx);
        pg8::EpiConvGlu E{ACT, args.in[24] + (size_t)1 * 3 * FF2, args.in[25] + (size_t)1 * FF2, M};
        pg8::gemm_phase<pg8::EpiConvGlu, pg8::StaticOrder, true, true>(lds, g, S, E);
    }
    GRID_SYNC();
    { PHASE_VARS;
        pg8::Gemm g{ACT, WB, M, D, FF, 256L * FF * 2, 128L * FF * 2, 256L * FF * 2, 128L * FF * 2, 0}; pg8::StaticOrder S; S.init(M, D, G, bx);
        pg8::EpiRes E{OUTF, OUTF, D};
        pg8::gemm_phase<pg8::EpiRes, pg8::StaticOrder, true, true>(lds, g, S, E);
    }
    GRID_SYNC();
    { PHASE_VARS;
        for (int m = gw; m < M; m += NGW) rms_row_inplace(OUTF + (size_t)m * D, args.in[27], lane);
    }
}

#undef WSP
#undef XIN
#undef OUTF
#undef WA
#undef WB
#undef XN
#undef P
#undef LD
#undef KK
#undef BB
#undef KP
#undef RR
#undef VV
#undef GG
#undef SCB
#undef OLT
#undef PMT
#undef SLOC
#undef QTB
#undef BS
#undef W2T
#undef A2T
#undef G2T
#undef YC
#undef ACT
#undef QKV
#undef VT1
#undef VT4
#undef VT16
extern "C" void kernel_launch(void* const* d_in, const int* in_sizes, int n_in, void* d_out, int out_size, void* d_ws, size_t ws_size, hipStream_t stream) {
    static int grid = 0;
    if (grid == 0) {
        if (n_in != 28 || in_sizes[0] != M * D || out_size != M * D || ws_size < WS_END) { fprintf(stderr, "kernel_launch: unexpected shapes (n_in %d, in0 %d, out %d, ws %zu)\n", n_in, n_in > 0 ? in_sizes[0] : -1, out_size, ws_size); grid = -1; return; }
        int dev = 0, cus = 0, per_cu = 0;
        if (hipGetDevice(&dev) != hipSuccess || hipDeviceGetAttribute(&cus, hipDeviceAttributeMultiprocessorCount, dev) != hipSuccess) { grid = -1; return; }
        if (hipFuncSetAttribute((const void*)hybrid_fwd, hipFuncAttributeMaxDynamicSharedMemorySize, LDS_BYTES) != hipSuccess) { fprintf(stderr, "kernel_launch: hipFuncSetAttribute failed\n"); grid = -1; return; }
        if (hipOccupancyMaxActiveBlocksPerMultiprocessor(&per_cu, (const void*)hybrid_fwd, NWAVES * 64, LDS_BYTES) != hipSuccess || per_cu < 1) { fprintf(stderr, "kernel_launch: occupancy query says %d\n", per_cu); per_cu = 1; }
        (void)hipGetLastError();
        grid = cus;
    }
    if (grid < 0) return;
    if (hipMemsetAsync(d_ws, 0, 65536, stream) != hipSuccess) { fprintf(stderr, "kernel_launch: hipMemsetAsync failed\n"); return; }
    Args a{};
    for (int i = 0; i < 28; ++i) a.in[i] = (const float*)d_in[i];
    a.out = (float*)d_out; a.ws = (unsigned char*)d_ws;
    void* kargs[] = {&a};
    hipError_t e = hipLaunchCooperativeKernel((const void*)hybrid_fwd, dim3(grid), dim3(NWAVES * 64), kargs, LDS_BYTES, stream);
    if (e != hipSuccess) fprintf(stderr, "kernel_launch: cooperative launch failed: %s (grid %d)\n", hipGetErrorString(e), grid);
}
```

```cpp
#include <hip/hip_runtime.h>
#include <hip/hip_cooperative_groups.h>
#include <cstdio>
#include <cstdint>
namespace cg = cooperative_groups;
namespace pg8 {
#define PG8_LAS __attribute__((address_space(3)))
typedef unsigned short bf16_t;
typedef short bf16x8 __attribute__((ext_vector_type(8)));
typedef float f32x4 __attribute__((ext_vector_type(4)));
typedef unsigned u32x4 __attribute__((ext_vector_type(4)));
constexpr int BM = 256, BK = 64, HALF = 128, HTB = HALF * BK * 2  , STAGE_BYTES = 8 * HTB, NXCD = 8, WGM = 8;

__host__ __device__ __forceinline__ int lds_byte(int r, int c) { const int st = (r >> 4) * 2 + (c >> 5), rr = r & 15, cc = c & 31, ob = rr * 64 + cc * 2; return st * 1024 + (ob ^ (((ob >> 9) & 1) << 5)); }
__host__ __device__ __forceinline__ void stage_rc(int b, int& R, int& C) { const int st = b / 1024, sb = b % 1024, swz = sb ^ (((sb >> 9) & 1) << 5); R = (st >> 1) * 16 + swz / 64; C = (st & 1) * 32 + (swz % 64) / 2; }
__host__ __device__ __forceinline__ int perm32(int rho) { const int n = rho >> 4, i = rho & 15; return 8 * (i >> 2) + 4 * n + (i & 3); }

struct Unit { int pm, pn; };
struct Gemm { const bf16_t* A; const bf16_t* Bt; int M, N, K; long tA, hA, tB, hB; int remapA; };

struct StaticOrder {
    int nM, nN, nwg, G, c;
    __host__ __device__ void init(int M, int N, int G_, int c_) { nM = M / BM; nN = N / BM; nwg = nM * nN; G = G_; c = c_; }
    __host__ __device__ void init2(int nM_, int nN_, int G_, int c_) { nM = nM_; nN = nN_; nwg = nM * nN; G = G_; c = c_; }
    __host__ __device__ bool next(int i, Unit& u) const {
        const long L = (long)i * G + c; if (L >= nwg) return false;
        int wgid = (int)L; { const int q = nwg / NXCD, r = nwg % NXCD, xcd = wgid % NXCD, off = wgid / NXCD; wgid = (xcd < r ? xcd * (q + 1) : r * (q + 1) + (xcd - r) * q) + off; }
        const int nig = WGM * nN, gid = wgid / nig, fm = gid * WGM, gsz = (nM - fm) < WGM ? (nM - fm) : WGM;
        u.pm = fm + ((wgid % nig) % gsz); u.pn = (wgid % nig) / gsz; return true;
    }
    __device__ __forceinline__ void a_ready(const Unit&) const {}
    __device__ __forceinline__ void done(const Unit&) const {}
};

__device__ __forceinline__ unsigned cvt_pk_bf16(float lo, float hi) { unsigned r; asm volatile("v_cvt_pk_bf16_f32 %0, %1, %2" : "=v"(r) : "v"(lo), "v"(hi)); return r; }
typedef float f32x2 __attribute__((ext_vector_type(2)));
__device__ __forceinline__ f32x2 gelu_pk(f32x2 v) {
    const f32x2 av = __builtin_elementwise_abs(v), d = av * 0.2316418882f + 1.0f;
    f32x2 t; t.x = __builtin_amdgcn_rcpf(d.x); t.y = __builtin_amdgcn_rcpf(d.y);
    f32x2 q = t * 0.5307027145f + (-0.7265760135f); q = q * t + 0.7107068705f; q = q * t + (-0.142248368f); q = q * t + 0.127414796f; q = q * t;
    const f32x2 s = (v * v) * (-0.72134752044f);
    f32x2 e; e.x = __builtin_amdgcn_exp2f(s.x); e.y = __builtin_amdgcn_exp2f(s.y);
    const f32x2 m = v * (q * e), r = v - m;
    f32x2 o; o.x = v.x < 0.f ? m.x : r.x; o.y = v.y < 0.f ? m.y : r.y; return o;
}

template <int ACT  > struct EpiBf16 {
    static constexpr bool PERM = true, AFTER_DRAIN = false; static_assert(ACT == 0 || ACT == 1, "EpiBf16: ACT is 0 (none) or 1 (gelu_pk)");
    bf16_t* O; int ldc; const float* bias; int split_cols; size_t split_stride; float scale0;
    __device__ __forceinline__ void operator()(const f32x4 (&acc)[2][2][4][2], const Unit& u, int wr, int wc, int fr, int fq) const {
        const int row0 = u.pm * BM + wr * 64 + fr; int colt = u.pn * BM; bf16_t* base = O;
        float sc = 1.f; if (split_cols) { const int t = colt / split_cols; base += (size_t)t * split_stride; colt -= t * split_cols; if (t == 0) sc = scale0; }
        const int col0 = colt + wc * 32 + 8 * fq, bcol0 = u.pn * BM + wc * 32 + 8 * fq;
        f32x4 bv[2][2];
#pragma unroll
        for (int bj = 0; bj < 2; ++bj)
#pragma unroll
            for (int n = 0; n < 2; ++n) bv[bj][n] = bias ? *(const f32x4*)(bias + bcol0 + bj * HALF + 4 * n) : (f32x4){0.f, 0.f, 0.f, 0.f};
#pragma unroll
        for (int ai = 0; ai < 2; ++ai)
#pragma unroll
            for (int m = 0; m < 4; ++m) { bf16_t* rowp = base + (size_t)(row0 + ai * HALF + m * 16) * ldc + col0;
#pragma unroll
                for (int bj = 0; bj < 2; ++bj) { f32x4 v0 = acc[ai][bj][m][0] + bv[bj][0], v1 = acc[ai][bj][m][1] + bv[bj][1];
                    if (ACT == 1) { f32x2 a = gelu_pk((f32x2){v0[0], v0[1]}), b = gelu_pk((f32x2){v0[2], v0[3]}), c = gelu_pk((f32x2){v1[0], v1[1]}), d = gelu_pk((f32x2){v1[2], v1[3]});
                        v0 = (f32x4){a.x, a.y, b.x, b.y}; v1 = (f32x4){c.x, c.y, d.x, d.y}; }
                    v0 = v0 * sc; v1 = v1 * sc; u32x4 w; w.x = cvt_pk_bf16(v0[0], v0[1]); w.y = cvt_pk_bf16(v0[2], v0[3]); w.z = cvt_pk_bf16(v1[0], v1[1]); w.w = cvt_pk_bf16(v1[2], v1[3]);
                    *(u32x4*)(rowp + bj * HALF) = w; } }
    }
};

template <class Epi, class Sched, bool ALIGN_EPI = false, bool SP2 = false>
__device__ __forceinline__ void gemm_phase(PG8_LAS unsigned char* lds, const Gemm g, const Sched& S, const Epi& E) {
    const int tid = threadIdx.x, wid = __builtin_amdgcn_readfirstlane(tid >> 6), lane = tid & 63, wr = wid >> 2, wc = wid & 3, fr = lane & 15, fq = lane >> 4;
    const int K = g.K, nt = K / BK;
    unsigned voffA[2], voffB[2];
#pragma unroll
    for (int i = 0; i < 2; ++i) { int R, C; stage_rc(tid * 16 + i * 8192, R, C); const int Rb = Epi::PERM ? ((R & ~31) + perm32(R & 31)) : R;
        const int Ra = g.remapA ? (R - (R >= 64 ? 2 : 0)) : R; voffA[i] = (unsigned)(Ra * K + C) * 2u; voffB[i] = (unsigned)(Rb * K + C) * 2u; }
    const size_t kstep = (size_t)(BK * 2);
    const size_t hA = (size_t)g.hA, hB = (size_t)g.hB, tA = (size_t)g.tA, tB = (size_t)g.tB;
    const unsigned ldsw = (unsigned)wid * 1024u;
    const int aoff = lds_byte(wr * 64 + fr, fq * 8), boff = lds_byte(wc * 32 + fr, fq * 8);
#define PG8_SA(b, h) (((b) * 2 + (h)) * HTB)
#define PG8_SB(b, h) ((4 + (b) * 2 + (h)) * HTB)
#define PG8_STAGE(bufoff, gbase, voff) do { _Pragma("unroll") for (int _i = 0; _i < 2; ++_i) \
        __builtin_amdgcn_global_load_lds((const unsigned*)((const char*)(gbase) + (voff)[_i]), (PG8_LAS unsigned*)(lds + (bufoff) + ldsw + _i * 8192), 16, 0, 0); } while (0)
#define PG8_LDA(dst, b, h) do { _Pragma("unroll") for (int m = 0; m < 4; ++m) _Pragma("unroll") for (int k = 0; k < 2; ++k) dst[m][k] = *(const PG8_LAS bf16x8*)(lds + PG8_SA(b, h) + aoff + m * 2048 + k * 1024); } while (0)
#define PG8_LDB(dst, b, h) do { _Pragma("unroll") for (int n = 0; n < 2; ++n) _Pragma("unroll") for (int k = 0; k < 2; ++k) dst[n][k] = *(const PG8_LAS bf16x8*)(lds + PG8_SB(b, h) + boff + n * 2048 + k * 1024); } while (0)
#define PG8_MMA(ai, bj, At, Bt) do { __builtin_amdgcn_s_setprio(1); _Pragma("unroll") for (int m = 0; m < 4; ++m) _Pragma("unroll") for (int n = 0; n < 2; ++n) _Pragma("unroll") for (int k = 0; k < 2; ++k) \
        acc[ai][bj][m][n] = __builtin_amdgcn_mfma_f32_16x16x32_bf16(Bt[n][k], At[m][k], acc[ai][bj][m][n], 0, 0, 0); __builtin_amdgcn_s_setprio(0); } while (0)
#define PG8_WAIT_V(n) asm volatile("s_waitcnt vmcnt(" #n ")" ::: "memory")
#define PG8_WAIT_L(n) asm volatile("s_waitcnt lgkmcnt(" #n ")" ::: "memory")
#define PG8_BAR __builtin_amdgcn_s_barrier()
#define PG8_SCHED __builtin_amdgcn_sched_barrier(0)
    Unit cur, nxt; int ui = 0;
    if (!S.next(0, cur)) return;
    f32x4 acc[2][2][4][2];
#pragma unroll
    for (int a = 0; a < 2; ++a)
#pragma unroll
        for (int b = 0; b < 2; ++b)
#pragma unroll
            for (int m = 0; m < 4; ++m)
#pragma unroll
                for (int n = 0; n < 2; ++n) acc[a][b][m][n] = (f32x4){0.f, 0.f, 0.f, 0.f};
    bf16x8 At[4][2], B0[2][2], B1[2][2];
    const char* cA = (const char*)g.A + (size_t)cur.pm * tA; const char* cB = (const char*)g.Bt + (size_t)cur.pn * tB;
    S.a_ready(cur);
    if constexpr (SP2) {
        PG8_STAGE(PG8_SB(0, 0), cB, voffB); PG8_STAGE(PG8_SB(0, 1), cB + hB, voffB); PG8_STAGE(PG8_SA(0, 0), cA, voffA); PG8_STAGE(PG8_SA(0, 1), cA + hA, voffA);
        if (wr == 1) PG8_BAR;
        PG8_WAIT_V(2); PG8_BAR;
        PG8_STAGE(PG8_SB(1, 0), cB + kstep, voffB); PG8_STAGE(PG8_SA(1, 0), cA + kstep, voffA); PG8_STAGE(PG8_SB(1, 1), cB + hB + kstep, voffB);
        PG8_WAIT_V(6); PG8_BAR;
    } else {
        PG8_STAGE(PG8_SB(0, 0), cB, voffB); PG8_STAGE(PG8_SA(0, 0), cA, voffA); PG8_STAGE(PG8_SB(0, 1), cB + hB, voffB); PG8_STAGE(PG8_SA(0, 1), cA + hA, voffA);
        if (wr == 1) PG8_BAR;
        PG8_WAIT_V(4); PG8_BAR;
        PG8_STAGE(PG8_SB(1, 0), cB + kstep, voffB); PG8_STAGE(PG8_SA(1, 0), cA + kstep, voffA); PG8_STAGE(PG8_SB(1, 1), cB + hB + kstep, voffB);
        PG8_WAIT_V(6); PG8_BAR;
    }
    for (;;) {
        const bool has_next = S.next(ui + 1, nxt);
        const char* nA = has_next ? (const char*)g.A + (size_t)nxt.pm * tA : cA; const char* nB = has_next ? (const char*)g.Bt + (size_t)nxt.pn * tB : cB;
        for (int t = 0; t < nt; t += 2) {
            const bool last = (t == nt - 2);
            const char* a1 = cA + (size_t)(t + 1) * kstep;
            const char* a2 = last ? nA : cA + (size_t)(t + 2) * kstep; const char* b2 = last ? nB : cB + (size_t)(t + 2) * kstep;
            const char* a3 = a2 + kstep; const char* b3 = b2 + kstep;
            if (last && has_next) S.a_ready(nxt);
            if constexpr (SP2) {
            PG8_LDB(B0, 0, 0); PG8_LDB(B1, 0, 1); PG8_SCHED; PG8_LDA(At, 0, 0); PG8_STAGE(PG8_SA(1, 1), a1 + hA, voffA);
            PG8_WAIT_V(8); PG8_WAIT_L(0); PG8_BAR; PG8_MMA(0, 0, At, B0); PG8_MMA(0, 1, At, B1); PG8_BAR; PG8_SCHED;
            PG8_LDA(At, 0, 1); PG8_STAGE(PG8_SB(0, 0), b2, voffB); PG8_STAGE(PG8_SB(0, 1), b2 + hB, voffB); PG8_STAGE(PG8_SA(0, 0), a2, voffA);
            PG8_WAIT_V(8); PG8_WAIT_L(0); PG8_BAR; PG8_MMA(1, 0, At, B0); PG8_MMA(1, 1, At, B1); PG8_BAR; PG8_SCHED;
            PG8_LDB(B0, 1, 0); PG8_LDB(B1, 1, 1); PG8_SCHED; PG8_LDA(At, 1, 0); PG8_STAGE(PG8_SA(0, 1), a2 + hA, voffA);
            PG8_WAIT_V(8); PG8_WAIT_L(0); PG8_BAR; PG8_MMA(0, 0, At, B0); PG8_MMA(0, 1, At, B1); PG8_BAR; PG8_SCHED;
            PG8_LDA(At, 1, 1); PG8_STAGE(PG8_SB(1, 0), b3, voffB); PG8_STAGE(PG8_SB(1, 1), b3 + hB, voffB); PG8_STAGE(PG8_SA(1, 0), a3, voffA);
            PG8_WAIT_V(8); PG8_WAIT_L(0); PG8_BAR; PG8_MMA(1, 0, At, B0); PG8_MMA(1, 1, At, B1); PG8_BAR; PG8_SCHED;
            } else {
            PG8_LDB(B0, 0, 0); PG8_SCHED; PG8_LDA(At, 0, 0); PG8_STAGE(PG8_SA(1, 1), a1 + hA, voffA);
            PG8_WAIT_L(8); PG8_BAR; PG8_WAIT_L(0); PG8_MMA(0, 0, At, B0); PG8_BAR; PG8_SCHED;
            PG8_LDB(B1, 0, 1); PG8_STAGE(PG8_SB(0, 0), b2, voffB);
            PG8_BAR; PG8_WAIT_L(0); PG8_MMA(0, 1, At, B1); PG8_BAR;
            PG8_LDA(At, 0, 1); PG8_STAGE(PG8_SA(0, 0), a2, voffA);
            PG8_BAR; PG8_WAIT_L(0); PG8_MMA(1, 0, At, B0); PG8_BAR; PG8_SCHED;
            PG8_STAGE(PG8_SB(0, 1), b2 + hB, voffB);
            PG8_WAIT_V(6); PG8_BAR; PG8_MMA(1, 1, At, B1); PG8_BAR;
            PG8_LDB(B0, 1, 0); PG8_SCHED; PG8_LDA(At, 1, 0); PG8_STAGE(PG8_SA(0, 1), a2 + hA, voffA);
            PG8_WAIT_L(8); PG8_BAR; PG8_WAIT_L(0); PG8_MMA(0, 0, At, B0); PG8_BAR; PG8_SCHED;
            PG8_LDB(B1, 1, 1); PG8_STAGE(PG8_SB(1, 0), b3, voffB);
            PG8_BAR; PG8_WAIT_L(0); PG8_MMA(0, 1, At, B1); PG8_BAR;
            PG8_LDA(At, 1, 1); PG8_STAGE(PG8_SA(1, 0), a3, voffA);
            PG8_BAR; PG8_WAIT_L(0); PG8_MMA(1, 0, At, B0); PG8_BAR; PG8_SCHED;
            PG8_STAGE(PG8_SB(1, 1), b3 + hB, voffB);
            PG8_WAIT_V(6); PG8_BAR; PG8_MMA(1, 1, At, B1); PG8_BAR;
            }
        }
        if constexpr (ALIGN_EPI) { if (wr == 0) PG8_BAR; }
        if constexpr (!Epi::AFTER_DRAIN) { E(acc, cur, wr, wc, fr, fq); S.done(cur); }
        if (!has_next) break;
#pragma unroll
        for (int a = 0; a < 2; ++a)
#pragma unroll
            for (int b = 0; b < 2; ++b)
#pragma unroll
                for (int m = 0; m < 4; ++m)
#pragma unroll
                    for (int n = 0; n < 2; ++n) acc[a][b][m][n] = (f32x4){0.f, 0.f, 0.f, 0.f};
        cur = nxt; cA = nA; cB = nB; ++ui;
        if constexpr (ALIGN_EPI) { if (wr == 1) PG8_BAR; }
    }
    PG8_WAIT_V(0);
    if constexpr (!ALIGN_EPI) { if (wr == 0) PG8_BAR; }
    PG8_BAR;
    if constexpr (Epi::AFTER_DRAIN) { E.fused(acc, cur, wr, wc, fr, fq, lds, wid, lane); S.done(cur); }
#undef PG8_SA
#undef PG8_SB
#undef PG8_STAGE
#undef PG8_LDA
#undef PG8_LDB
#undef PG8_MMA
#undef PG8_WAIT_V
#undef PG8_WAIT_L
#undef PG8_BAR
#undef PG8_SCHED
}
}
namespace pg8 {
struct EpiRes {
    static constexpr bool PERM = false, AFTER_DRAIN = false;
    const float* base; float* out; int ldc;
    __device__ __forceinline__ void operator()(const f32x4 (&acc)[2][2][4][2], const Unit& u, int wr, int wc, int fr, int fq) const {
        const int col0 = u.pn * BM + wc * 32 + 4 * fq;
#pragma unroll
        for (int ai = 0; ai < 2; ++ai)
#pragma unroll
            for (int m = 0; m < 4; ++m) { const size_t off = (size_t)(u.pm * BM + ai * HALF + wr * 64 + m * 16 + fr) * ldc + col0;
#pragma unroll
                for (int bj = 0; bj < 2; ++bj)
#pragma unroll
                    for (int n = 0; n < 2; ++n) { const f32x4 b = *(const f32x4*)(base + off + bj * HALF + n * 16); *(f32x4*)(out + off + bj * HALF + n * 16) = b + acc[ai][bj][m][n]; } }
    }
};
struct EpiConvGlu {
    static constexpr bool PERM = false, AFTER_DRAIN = false;
    bf16_t* O; const float* cw; const float* cb; int M;
    __device__ __forceinline__ void operator()(const f32x4 (&acc)[2][2][4][2], const Unit& u, int wr, int wc, int fr, int fq) const {
        const int lane = fq * 16 + fr;
        const int src1 = fq * 16 + ((fr + 15) & 15), src2 = fq * 16 + ((fr + 14) & 15);
#pragma unroll
        for (int ai = 0; ai < 2; ++ai) {
            const int pb = 248 * u.pm + 62 * (2 * ai + wr) - 2;
#pragma unroll
            for (int n = 0; n < 2; ++n) {
                const int jg = 128 * u.pn + 32 * wc + 16 * n + 4 * fq;
                const f32x4 g0 = *(const f32x4*)(cw + jg), g1 = *(const f32x4*)(cw + 5632 + jg), g2 = *(const f32x4*)(cw + 2 * 5632 + jg), gb = *(const f32x4*)(cb + jg);
                const f32x4 v0 = *(const f32x4*)(cw + 2816 + jg), v1 = *(const f32x4*)(cw + 5632 + 2816 + jg), v2 = *(const f32x4*)(cw + 2 * 5632 + 2816 + jg), vb = *(const f32x4*)(cb + 2816 + jg);
                f32x4 pg1, pg2, pv1, pv2;
#pragma unroll
                for (int m = 0; m < 4; ++m) {
                    f32x4 zg = acc[ai][0][m][n], zv = acc[ai][1][m][n];
                    const int pos = pb + 16 * m + fr;
                    if (pos < 0) { zg = (f32x4){0.f, 0.f, 0.f, 0.f}; zv = zg; }
                    f32x4 rg1, rg2, rv1, rv2;
#pragma unroll
                    for (int e = 0; e < 4; ++e) { rg1[e] = __shfl(zg[e], src1); rg2[e] = __shfl(zg[e], src2); rv1[e] = __shfl(zv[e], src1); rv2[e] = __shfl(zv[e], src2); }
                    f32x4 zg1, zg2, zv1, zv2;
                    if (m == 0) { zg1 = rg1; zg2 = rg2; zv1 = rv1; zv2 = rv2; }
                    else {
#pragma unroll
                        for (int e = 0; e < 4; ++e) { zg1[e] = fr >= 1 ? rg1[e] : pg1[e]; zg2[e] = fr >= 2 ? rg2[e] : pg2[e]; zv1[e] = fr >= 1 ? rv1[e] : pv1[e]; zv2[e] = fr >= 2 ? rv2[e] : pv2[e]; }
                    }
                    pg1 = rg1; pg2 = rg2; pv1 = rv1; pv2 = rv2;
                    const f32x4 cg = g0 * zg2 + g1 * zg1 + g2 * zg + gb;
                    const f32x4 cv = v0 * zv2 + v1 * zv1 + v2 * zv + vb;
                    f32x4 a;
#pragma unroll
                    for (int e = 0; e < 4; ++e) a[e] = cg[e] / (1.0f + __expf(-cg[e])) * cv[e];
                    if ((16 * m + fr) >= 2 && pos < M) {
                        typedef unsigned u32x2 __attribute__((ext_vector_type(2)));
                        u32x2 w; w.x = cvt_pk_bf16(a[0], a[1]); w.y = cvt_pk_bf16(a[2], a[3]);
                        *(u32x2*)(O + (size_t)pos * 2816 + jg) = w;
                    }
                }
            }
        }
        (void)lane;
    }
};
}
#define LAS __attribute__((address_space(3)))
typedef unsigned short bf16;
typedef float f32x4 __attribute__((ext_vector_type(4)));
typedef short bf16x8 __attribute__((ext_vector_type(8)));
typedef unsigned v4u __attribute__((ext_vector_type(4)));
typedef unsigned v2u __attribute__((ext_vector_type(2)));
constexpr int NWAVES = 8;
constexpr int M = 16384, D = 1024, EIN = 2816, FF = 2816, FF2 = 5632, NQKV = 3072, BW = 512;
constexpr size_t MiB = 1u << 20;
constexpr size_t WS_W2T = 1 * MiB, WS_A2T = WS_W2T + 65536, WS_G2T = WS_A2T + 65536, WS_BS = WS_G2T + 131072;
constexpr size_t WS_WA = 2 * MiB, WS_WB = 13 * MiB, WS_XN = 20 * MiB, WS_GEN = 52 * MiB, WS_END = 256 * MiB;
constexpr size_t WS_P = WS_GEN, WS_LD = WS_GEN + 88 * MiB, WS_KK = WS_LD + 32 * MiB, WS_BB = WS_KK + 16 * MiB, WS_KP = WS_BB + 16 * MiB, WS_RR = WS_KP + 16 * MiB, WS_VV = WS_RR + 16 * MiB;
static_assert(WS_VV + 16 * MiB <= WS_END, "ws map");
constexpr size_t WS_QKV = WS_GEN, WS_VT1 = WS_GEN + 96 * MiB, WS_VT4 = WS_VT1 + 32 * MiB, WS_VT16 = WS_VT4 + 32 * MiB;
static_assert(WS_VT16 + 33 * MiB <= WS_END, "ws map");
constexpr int LDS_BYTES = 147456;

__device__ __forceinline__ float bf2f(unsigned short v) { return __uint_as_float(((unsigned)v) << 16); }
__device__ __forceinline__ unsigned f2bf(float f) { unsigned u = __float_as_uint(f); return (u + 0x7fffu + ((u >> 16) & 1u)) >> 16; }
__device__ __forceinline__ unsigned pk2(float lo, float hi) { return f2bf(lo) | (f2bf(hi) << 16); }
__device__ __forceinline__ float wave_sum(float v) {
#pragma unroll
    for (int o = 1; o < 64; o <<= 1) v += __shfl_xor(v, o);
    return v;
}
__device__ __forceinline__ float dpp_row_shr(float v, int n) {
    const int iv = __builtin_bit_cast(int, v); int r;
    switch (n) { case 1: r = __builtin_amdgcn_update_dpp(0, iv, 0x111, 0xf, 0xf, true); break; case 2: r = __builtin_amdgcn_update_dpp(0, iv, 0x112, 0xf, 0xf, true); break;
                 case 4: r = __builtin_amdgcn_update_dpp(0, iv, 0x114, 0xf, 0xf, true); break; default: r = __builtin_amdgcn_update_dpp(0, iv, 0x118, 0xf, 0xf, true); break; }
    return __builtin_bit_cast(float, r);
}
__device__ __forceinline__ float wave_sum_uniform(float v) {
    v += dpp_row_shr(v, 1); v += dpp_row_shr(v, 2); v += dpp_row_shr(v, 4); v += dpp_row_shr(v, 8);
    v += __builtin_bit_cast(float, __builtin_amdgcn_update_dpp(0, __builtin_bit_cast(int, v), 0x142, 0xa, 0xf, false));
    v += __builtin_bit_cast(float, __builtin_amdgcn_update_dpp(0, __builtin_bit_cast(int, v), 0x143, 0xc, 0xf, false));
    return __builtin_bit_cast(float, __builtin_amdgcn_readlane(__builtin_bit_cast(int, v), 63));
}
#define MFMA16(a, b, c) __builtin_amdgcn_mfma_f32_16x16x32_bf16((a), (b), (c), 0, 0, 0)

__device__ __forceinline__ void transpose_item(const float* W, int K, int N, bf16* WT, LAS float* scr, int item, int lane) {
    const int nblk = N / 32, kb = item / nblk, nb = item % nblk, k0 = 64 * kb, n0 = 32 * nb;
#pragma unroll 8
    for (int i = 0; i < 32; ++i) { const int kk = 2 * i + (lane >> 5); scr[kk * 33 + (lane & 31)] = W[(size_t)(k0 + kk) * N + n0 + (lane & 31)]; }
    asm volatile("s_waitcnt lgkmcnt(0)" ::: "memory");
    const int c = lane & 7;
#pragma unroll
    for (int j = 0; j < 4; ++j) { const int n = (lane >> 3) + 8 * j; const LAS float* s = scr + (8 * c) * 33 + n;
        v4u o; o.x = pk2(s[0 * 33], s[1 * 33]); o.y = pk2(s[2 * 33], s[3 * 33]); o.z = pk2(s[4 * 33], s[5 * 33]); o.w = pk2(s[6 * 33], s[7 * 33]);
        *(v4u*)(WT + (size_t)(n0 + n) * K + k0 + 8 * c) = o; }
    asm volatile("s_waitcnt lgkmcnt(0)" ::: "memory");
}
__device__ __forceinline__ void rms_row_to_bf16(const float* xrow, const float* gain, bf16* orow, int lane) {
    const f32x4* xr = (const f32x4*)xrow + lane; const f32x4* gr = (const f32x4*)gain + lane;
    f32x4 v[4]; float s = 0.f;
#pragma unroll
    for (int j = 0; j < 4; ++j) { v[j] = xr[64 * j]; s += (v[j].x * v[j].x + v[j].y * v[j].y) + (v[j].z * v[j].z + v[j].w * v[j].w); }
    const float rstd = 1.0f / sqrtf(wave_sum(s) * (1.f / D) + 1e-6f);
    v2u* o8 = (v2u*)orow + lane;
#pragma unroll
    for (int j = 0; j < 4; ++j) { const f32x4 g = gr[64 * j]; v2u w; w.x = pk2(v[j].x * rstd * g.x, v[j].y * rstd * g.y); w.y = pk2(v[j].z * rstd * g.z, v[j].w * rstd * g.w); o8[64 * j] = w; }
}
__device__ __forceinline__ void rms_row_inplace(float* xrow, const float* gain, int lane) {
    f32x4* xr = (f32x4*)xrow + lane; const f32x4* gr = (const f32x4*)gain + lane;
    f32x4 v[4]; float s = 0.f;
#pragma unroll
    for (int j = 0; j < 4; ++j) { v[j] = xr[64 * j]; s += (v[j].x * v[j].x + v[j].y * v[j].y) + (v[j].z * v[j].z + v[j].w * v[j].w); }
    const float rstd = 1.0f / sqrtf(wave_sum(s) * (1.f / D) + 1e-6f);
#pragma unroll
    for (int j = 0; j < 4; ++j) { const f32x4 g = gr[64 * j]; xr[64 * j] = v[j] * rstd * g; }
}
__device__ __forceinline__ void norm_phase(LAS unsigned char* lds, int gw, int NGW, int wave, int lane, const float* x, const float* gain, bf16* XN,
                                           const float* W1, int K1, int N1, bf16* W1t, const float* W2, int K2, int N2, bf16* W2t) {
    LAS float* scr = (LAS float*)(lds + wave * 16384);
    const int I1 = (K1 / 64) * (N1 / 32), I2 = (K2 / 64) * (N2 / 32);
    for (int it = gw; it < I1 + I2; it += NGW) {
        if (it < I1) transpose_item(W1, K1, N1, W1t, scr, it, lane); else transpose_item(W2, K2, N2, W2t, scr, it - I1, lane);
    }
    for (int m = gw; m < M; m += NGW) rms_row_to_bf16(x + (size_t)m * D, gain, XN + (size_t)m * D, lane);
}

__device__ __forceinline__ void gmlp_item(LAS unsigned char* lds, int item, int tid, int wave, int lane, const bf16* P, const float* ln_g, const float* ln_b,
                                          const float* w_s, const float* b_s, bf16* Y) {
    const int chunk = item >> 2, g = item & 3, t0 = chunk * 128;
    LAS bf16* Wm = (LAS bf16*)lds;
    LAS bf16* Vt = (LAS bf16*)(lds + 128 * 136 * 2);
    for (int i = 0; i < 16; ++i) {
        const int s = wave * 16 + i;
        const v4u raw = *(const v4u*)(P + (size_t)(t0 + s) * EIN + 512 + lane * 8);
        float v[8];
        v[0] = __uint_as_float(raw.x << 16); v[1] = __uint_as_float(raw.x & 0xffff0000u); v[2] = __uint_as_float(raw.y << 16); v[3] = __uint_as_float(raw.y & 0xffff0000u);
        v[4] = __uint_as_float(raw.z << 16); v[5] = __uint_as_float(raw.z & 0xffff0000u); v[6] = __uint_as_float(raw.w << 16); v[7] = __uint_as_float(raw.w & 0xffff0000u);
        float sum = 0.f;
#pragma unroll
        for (int e = 0; e < 8; ++e) sum += v[e];
        const float mean = wave_sum(sum) * (1.f / 512.f);
        float q = 0.f;
#pragma unroll
        for (int e = 0; e < 8; ++e) { v[e] -= mean; q += v[e] * v[e]; }
        const float rstd = 1.0f / sqrtf(wave_sum(q) * (1.f / 512.f) + 1e-5f);
        if ((lane >> 4) == g) {
#pragma unroll
            for (int e = 0; e < 8; ++e) { const int c = (lane & 15) * 8 + e, ch = g * 128 + c; Vt[c * 136 + s] = (bf16)f2bf(v[e] * rstd * ln_g[ch] + ln_b[ch]); }
        }
    }
    for (int idx = tid; idx < 128 * 32; idx += 512) {
        const int t = idx >> 5, s4 = (idx & 31) * 4;
        const f32x4 w = *(const f32x4*)(w_s + ((size_t)g * 128 + t) * 128 + s4);
        v2u o; o.x = pk2(s4 + 0 <= t ? w.x : 0.f, s4 + 1 <= t ? w.y : 0.f); o.y = pk2(s4 + 2 <= t ? w.z : 0.f, s4 + 3 <= t ? w.w : 0.f);
        *(LAS v2u*)(Wm + t * 136 + s4) = o;
    }
    __syncthreads();
    const int r = lane & 15, q4 = lane >> 4;
    f32x4 acc[8];
#pragma unroll
    for (int ct = 0; ct < 8; ++ct) acc[ct] = (f32x4){0.f, 0.f, 0.f, 0.f};
    const int nks = (16 * wave + 15) / 32 + 1;
    for (int ks = 0; ks < nks; ++ks) {
        const bf16x8 af = *(const LAS bf16x8*)(Wm + (16 * wave + r) * 136 + ks * 32 + q4 * 8);
#pragma unroll
        for (int ct = 0; ct < 8; ++ct) { const bf16x8 bfr = *(const LAS bf16x8*)(Vt + (16 * ct + r) * 136 + ks * 32 + q4 * 8); acc[ct] = MFMA16(af, bfr, acc[ct]); }
    }
#pragma unroll
    for (int ct = 0; ct < 8; ++ct)
#pragma unroll
        for (int e = 0; e < 4; ++e) {
            const int t = 16 * wave + 4 * q4 + e, c = 16 * ct + r;
            const float mixed = acc[ct][e] + b_s[g * 128 + t];
            const float u = bf2f(P[(size_t)(t0 + t) * EIN + g * 128 + c]);
            Y[(size_t)(t0 + t) * D + g * 128 + c] = (bf16)f2bf(u * mixed);
        }
    __syncthreads();
}

struct RwkvW { const float *mu, *w0, *a0, *k_k, *k_a, *r_k; const bf16 *w2t, *a2t, *g2t; };
__device__ __forceinline__ float shifted(const bf16* P, int t, int col, float mu) {
    const float cur = bf2f(P[(size_t)t * EIN + col]); const float prev = t > 0 ? bf2f(P[(size_t)(t - 1) * EIN + col]) : 0.f; return cur + (prev - cur) * mu;
}
__device__ __forceinline__ void rwkv_prep_item(LAS unsigned char* lds, int item, int tid, int wave, int lane, const bf16* P, const RwkvW& W,
                                               float* LD, bf16* KK, bf16* BB, bf16* KP, bf16* RR, bf16* VV, bf16* GG, float* BS) {
    const int t0 = item * 64;
    LAS bf16* Xl = (LAS bf16*)lds;
    for (int idx = tid; idx < 64 * 256; idx += 512) {
        const int t = idx >> 8, j = idx & 255;
        const float ps = shifted(P, t0 + t, 1024 + 1536 + j, W.mu[1536 + j]);
        const float val = j < 64 ? tanhf(ps) : (j < 128 ? ps : 1.0f / (1.0f + __expf(-ps)));
        Xl[t * 264 + j] = (bf16)f2bf(val);
    }
    __syncthreads();
    const int h = wave, r = lane & 15, q4 = lane >> 4;
    for (int tt = 0; tt < 4; ++tt) {
        f32x4 aW[4], aA[4], aG[4];
#pragma unroll
        for (int ct = 0; ct < 4; ++ct) { aW[ct] = (f32x4){0.f, 0.f, 0.f, 0.f}; aA[ct] = aW[ct]; aG[ct] = aW[ct]; }
#pragma unroll
        for (int ks = 0; ks < 2; ++ks) {
            const bf16x8 xw = *(const LAS bf16x8*)(Xl + (16 * tt + r) * 264 + ks * 32 + q4 * 8);
            const bf16x8 xa = *(const LAS bf16x8*)(Xl + (16 * tt + r) * 264 + 64 + ks * 32 + q4 * 8);
#pragma unroll
            for (int ct = 0; ct < 4; ++ct) {
                const bf16x8 yw = *(const bf16x8*)(W.w2t + (size_t)(h * 64 + 16 * ct + r) * 64 + ks * 32 + q4 * 8);
                const bf16x8 ya = *(const bf16x8*)(W.a2t + (size_t)(h * 64 + 16 * ct + r) * 64 + ks * 32 + q4 * 8);
                aW[ct] = MFMA16(xw, yw, aW[ct]); aA[ct] = MFMA16(xa, ya, aA[ct]);
            }
        }
#pragma unroll
        for (int ks = 0; ks < 4; ++ks) {
            const bf16x8 xg = *(const LAS bf16x8*)(Xl + (16 * tt + r) * 264 + 128 + ks * 32 + q4 * 8);
#pragma unroll
            for (int ct = 0; ct < 4; ++ct) {
                const bf16x8 yg = *(const bf16x8*)(W.g2t + (size_t)(h * 64 + 16 * ct + r) * 128 + ks * 32 + q4 * 8);
                aG[ct] = MFMA16(xg, yg, aG[ct]);
            }
        }
#pragma unroll
        for (int e = 0; e < 4; ++e) {
            const int t = t0 + 16 * tt + 4 * q4 + e;
            float kkr[4], av[4]; float ss = 0.f, bon = 0.f;
#pragma unroll
            for (int ct = 0; ct < 4; ++ct) {
                const int c = h * 64 + 16 * ct + r;
                const float r_ = shifted(P, t, 1024 + c, W.mu[c]);
                const float k_ = shifted(P, t, 1024 + 512 + c, W.mu[512 + c]);
                const float v_ = shifted(P, t, 1024 + 1024 + c, W.mu[1024 + c]);
                const float xw = -(W.w0[c] + aW[ct][e]);
                const float sp = xw > 20.f ? xw : log1pf(__expf(xw));
                const float wv = -sp - 0.5f;
                const float ld = -__expf(wv);
                const float a = 1.0f / (1.0f + __expf(-(W.a0[c] + aA[ct][e])));
                const float kr = k_ * W.k_k[c];
                const float kp = k_ * (1.0f + (a - 1.0f) * W.k_a[c]);
                kkr[ct] = kr; av[ct] = a; ss += kr * kr; bon += r_ * kp * W.r_k[c];
                const size_t o = (size_t)t * BW + c;
                LD[o] = ld; KP[o] = (bf16)f2bf(kp); RR[o] = (bf16)f2bf(r_); VV[o] = (bf16)f2bf(v_); GG[o] = (bf16)f2bf(aG[ct][e]);
            }
#pragma unroll
            for (int o = 1; o < 16; o <<= 1) { ss += __shfl_xor(ss, o); bon += __shfl_xor(bon, o); }
            const float inv = 1.0f / sqrtf(fmaxf(ss, 1e-24f));
#pragma unroll
            for (int ct = 0; ct < 4; ++ct) {
                const int c = h * 64 + 16 * ct + r; const size_t o = (size_t)t * BW + c;
                const float kk = kkr[ct] * inv;
                KK[o] = (bf16)f2bf(kk); BB[o] = (bf16)f2bf(kk * av[ct]);
            }
            if (r == 0) BS[(size_t)t * 8 + h] = bon;
        }
    }
    __syncthreads();
}

struct ScanRegs { unsigned short kk[8], bb[8], kp[8], rr[8], vv[8]; float ld[8]; };
__device__ __forceinline__ void scan_load(ScanRegs& R, int t0, int hc, int hv, const float* LD, const bf16* KK, const bf16* BB, const bf16* KP, const bf16* RR, const bf16* VV) {
#pragma unroll
    for (int i = 0; i < 8; ++i) { const size_t o = (size_t)(t0 + i) * BW;
        R.kk[i] = KK[o + hc]; R.bb[i] = BB[o + hc]; R.kp[i] = KP[o + hc]; R.rr[i] = RR[o + hc]; R.ld[i] = LD[o + hc]; R.vv[i] = VV[o + hv]; }
}
__device__ __forceinline__ void rwkv_scan_wave(int gwv, int lane, const float* LD, const bf16* KK, const bf16* BB, const bf16* KP, const bf16* RR, const bf16* VV, float* OSC) {
    const int h = gwv >> 6, v = gwv & 63, hc = h * 64 + lane, hv = h * 64 + v;
    float S = 0.f;
    ScanRegs cur, nxt;
    scan_load(cur, 0, hc, hv, LD, KK, BB, KP, RR, VV);
    for (int t0 = 0; t0 < M; t0 += 8) {
        const int tn = (t0 + 8 < M) ? t0 + 8 : t0;
        scan_load(nxt, tn, hc, hv, LD, KK, BB, KP, RR, VV);
#pragma unroll
        for (int i = 0; i < 8; ++i) {
            const float kk = bf2f(cur.kk[i]), bb = bf2f(cur.bb[i]), kp = bf2f(cur.kp[i]), rr = bf2f(cur.rr[i]), vv = bf2f(cur.vv[i]);
            const float dec = __expf(cur.ld[i]);
            const float sa = wave_sum_uniform(S * kk);
            S = S * dec - sa * bb + vv * kp;
            const float o = wave_sum_uniform(S * rr);
            if (lane == 0) OSC[(size_t)(t0 + i) * BW + hv] = o;
        }
        cur = nxt;
    }
}
__device__ __forceinline__ void rwkv_out_row(int t, int lane, const float* OSC, const float* BS, const bf16* VV, const bf16* GG, const float* gn_g, const float* gn_b, bf16* Y) {
    const int c0 = lane * 8;
    const f32x4 o0 = *(const f32x4*)(OSC + (size_t)t * BW + c0), o1 = *(const f32x4*)(OSC + (size_t)t * BW + c0 + 4);
    float v[8] = {o0.x, o0.y, o0.z, o0.w, o1.x, o1.y, o1.z, o1.w};
    float s = 0.f;
#pragma unroll
    for (int e = 0; e < 8; ++e) s += v[e];
    s += __shfl_xor(s, 1); s += __shfl_xor(s, 2); s += __shfl_xor(s, 4);
    const float mean = s * (1.f / 64.f);
    float q = 0.f;
#pragma unroll
    for (int e = 0; e < 8; ++e) { v[e] -= mean; q += v[e] * v[e]; }
    q += __shfl_xor(q, 1); q += __shfl_xor(q, 2); q += __shfl_xor(q, 4);
    const float rstd = 1.0f / sqrtf(q * (1.f / 64.f) + 64e-5f);
    const float bon = BS[(size_t)t * 8 + (lane >> 3)];
    const v4u vraw = *(const v4u*)(VV + (size_t)t * BW + c0), graw = *(const v4u*)(GG + (size_t)t * BW + c0);
    const unsigned vr[4] = {vraw.x, vraw.y, vraw.z, vraw.w}, gr[4] = {graw.x, graw.y, graw.z, graw.w};
    float outv[8];
#pragma unroll
    for (int e = 0; e < 8; ++e) {
        const float vv = (e & 1) ? __uint_as_float(vr[e >> 1] & 0xffff0000u) : __uint_as_float(vr[e >> 1] << 16);
        const float gg = (e & 1) ? __uint_as_float(gr[e >> 1] & 0xffff0000u) : __uint_as_float(gr[e >> 1] << 16);
        outv[e] = (v[e] * rstd * gn_g[c0 + e] + gn_b[c0 + e] + bon * vv) * gg;
    }
    v4u w; w.x = pk2(outv[0], outv[1]); w.y = pk2(outv[2], outv[3]); w.z = pk2(outv[4], outv[5]); w.w = pk2(outv[6], outv[7]);
    *(v4u*)(Y + (size_t)t * D + 512 + c0) = w;
}

__device__ __forceinline__ void vtrans_item(LAS unsigned char* lds, int item, int tid, const bf16* QKV, bf16* VT1, bf16* VT4, bf16* VT16) {
    const int h = item >> 6, blk = item & 63, t0 = blk * 256;
    LAS bf16* Vl = (LAS bf16*)lds;
#pragma unroll
    for (int i = 0; i < 4; ++i) { const int idx = tid + 512 * i, t = idx >> 3, ch = idx & 7;
        *(LAS v4u*)(Vl + t * 72 + ch * 8) = *(const v4u*)(QKV + (size_t)(t0 + t) * NQKV + 2048 + h * 64 + ch * 8); }
    __syncthreads();
#pragma unroll
    for (int i = 0; i < 4; ++i) {
        const int idx = tid + 512 * i, d = idx >> 5;
        { const int j = idx & 31; unsigned short e[8];
#pragma unroll
          for (int k = 0; k < 8; ++k) e[k] = Vl[(8 * j + k) * 72 + d];
          v4u o; o.x = e[0] | ((unsigned)e[1] << 16); o.y = e[2] | ((unsigned)e[3] << 16); o.z = e[4] | ((unsigned)e[5] << 16); o.w = e[6] | ((unsigned)e[7] << 16);
          *(v4u*)(VT1 + (size_t)(h * 64 + d) * 16384 + t0 + 8 * j) = o; }
        { const int c4 = (idx >> 3) & 3, j = idx & 7; unsigned short e[8];
#pragma unroll
          for (int k = 0; k < 8; ++k) e[k] = Vl[(4 * (8 * j + k) + c4) * 72 + d];
          v4u o; o.x = e[0] | ((unsigned)e[1] << 16); o.y = e[2] | ((unsigned)e[3] << 16); o.z = e[4] | ((unsigned)e[5] << 16); o.w = e[6] | ((unsigned)e[7] << 16);
          *(v4u*)(VT4 + ((size_t)(h * 64 + d) * 4 + c4) * 4096 + t0 / 4 + 8 * j) = o; }
        { const int c16 = (idx >> 1) & 15, j = idx & 1; unsigned short e[8];
#pragma unroll
          for (int k = 0; k < 8; ++k) e[k] = Vl[(16 * (8 * j + k) + c16) * 72 + d];
          v4u o; o.x = e[0] | ((unsigned)e[1] << 16); o.y = e[2] | ((unsigned)e[3] << 16); o.z = e[4] | ((unsigned)e[5] << 16); o.w = e[6] | ((unsigned)e[7] << 16);
          *(v4u*)(VT16 + ((size_t)(h * 64 + d) * 16 + c16) * 1024 + t0 / 16 + 8 * j) = o; }
    }
    __syncthreads();
}

struct AttnFrags { bf16x8 ka0, ka1, kb0, kb1, vf[4]; };
template <int DIL>
__device__ __forceinline__ void attn_load(AttnFrags& f, const bf16* Kb, const bf16* VT, int h, int cp, int nb, int kA, int r, int q4) {
    constexpr int TD = M / DIL;
    int posA = cp + DIL * (nb + kA), posB = posA + 4 * DIL;
    posA = posA < 0 ? 0 : (posA > M - 1 ? M - 1 : posA); posB = posB < 0 ? 0 : (posB > M - 1 ? M - 1 : posB);
    f.ka0 = *(const bf16x8*)(Kb + (size_t)posA * NQKV); f.ka1 = *(const bf16x8*)(Kb + (size_t)posA * NQKV + 32);
    f.kb0 = *(const bf16x8*)(Kb + (size_t)posB * NQKV); f.kb1 = *(const bf16x8*)(Kb + (size_t)posB * NQKV + 32);
    int nv = nb + 8 * q4; nv = nv < 0 ? 0 : (nv > TD - 8 ? TD - 8 : nv);
#pragma unroll
    for (int dt = 0; dt < 4; ++dt) f.vf[dt] = *(const bf16x8*)(VT + ((size_t)(h * 64 + 16 * dt + r) * DIL + cp) * TD + nv);
}
__device__ __forceinline__ void attn_group(const AttnFrags& f, int nb, int nlo, int nhi, int q4, const bf16x8 (&qf)[2], f32x4 (&o)[4], float& lrun) {
    const float C = 0.125f * 1.4426950408889634f;
    f32x4 sA = (f32x4){0.f, 0.f, 0.f, 0.f}, sB = sA;
    sA = MFMA16(f.ka0, qf[0], sA); sA = MFMA16(f.ka1, qf[1], sA);
    sB = MFMA16(f.kb0, qf[0], sB); sB = MFMA16(f.kb1, qf[1], sB);
    float p[8]; float ps = 0.f;
    const int n0 = nb + 8 * q4;
#pragma unroll
    for (int e = 0; e < 8; ++e) {
        const int n = n0 + e;
        const float ex = __builtin_amdgcn_exp2f(fminf((e < 4 ? sA[e & 3] : sB[e & 3]) * C, 100.f));
        p[e] = (n >= nlo && n <= nhi) ? ex : 0.f; ps += p[e];
    }
    lrun += ps;
    v4u pw; pw.x = pg8::cvt_pk_bf16(p[0], p[1]); pw.y = pg8::cvt_pk_bf16(p[2], p[3]); pw.z = pg8::cvt_pk_bf16(p[4], p[5]); pw.w = pg8::cvt_pk_bf16(p[6], p[7]);
    const bf16x8 pf = __builtin_bit_cast(bf16x8, pw);
#pragma unroll
    for (int dt = 0; dt < 4; ++dt) o[dt] = MFMA16(f.vf[dt], pf, o[dt]);
}
template <int DIL, int NGRP>
__device__ __forceinline__ void attn_pattern(const bf16* QKV, const bf16* VT, int h, int blk, int cls, int lane, const bf16x8 (&qf)[2], f32x4 (&o)[4], float& lrun) {
    const int r = lane & 15, q4 = lane >> 4, m = r;
    const int cp = cls & (DIL - 1);
    const int nq = (256 * blk + cls - cp) / DIL + (16 / DIL) * m;
    const int nstart = (256 * blk) / DIL - 128;
    const int nlo = nq - 128 < 0 ? 0 : nq - 128, nhi = nq;
    const int kA = 8 * (r >> 2) + (r & 3);
    const bf16* Kb = QKV + 1024 + h * 64 + q4 * 8;
    AttnFrags fa, fb;
    attn_load<DIL>(fa, Kb, VT, h, cp, nstart, kA, r, q4);
#pragma unroll 1
    for (int g = 0; g < NGRP; g += 2) {
        if (g + 1 < NGRP) attn_load<DIL>(fb, Kb, VT, h, cp, nstart + 32 * (g + 1), kA, r, q4);
        attn_group(fa, nstart + 32 * g, nlo, nhi, q4, qf, o, lrun);
        if (g + 1 < NGRP) {
            if (g + 2 < NGRP) attn_load<DIL>(fa, Kb, VT, h, cp, nstart + 32 * (g + 2), kA, r, q4);
            attn_group(fb, nstart + 32 * (g + 1), nlo, nhi, q4, qf, o, lrun);
        }
    }
}
__device__ __forceinline__ void attn_wave_item(const bf16* QKV, const bf16* VT1, const bf16* VT4, const bf16* VT16, bf16* AO, int h, int blk, int cls, int lane) {
    const int r = lane & 15, q4 = lane >> 4;
    const int im = 256 * blk + cls + 16 * r;
    bf16x8 qf[2];
    qf[0] = *(const bf16x8*)(QKV + (size_t)im * NQKV + h * 64 + q4 * 8);
    qf[1] = *(const bf16x8*)(QKV + (size_t)im * NQKV + h * 64 + 32 + q4 * 8);
    f32x4 o[4];
#pragma unroll
    for (int dt = 0; dt < 4; ++dt) o[dt] = (f32x4){0.f, 0.f, 0.f, 0.f};
    float lrun = 0.f;
    attn_pattern<1, 12>(QKV, VT1, h, blk, cls, lane, qf, o, lrun);
    attn_pattern<4, 6>(QKV, VT4, h, blk, cls, lane, qf, o, lrun);
    attn_pattern<16, 5>(QKV, VT16, h, blk, cls, lane, qf, o, lrun);
    float l = lrun; l += __shfl_xor(l, 16); l += __shfl_xor(l, 32);
    const float inv = 1.0f / l;
#pragma unroll
    for (int dt = 0; dt < 4; ++dt) {
        v2u w; w.x = pg8::cvt_pk_bf16(o[dt][0] * inv, o[dt][1] * inv); w.y = pg8::cvt_pk_bf16(o[dt][2] * inv, o[dt][3] * inv);
        *(v2u*)(AO + (size_t)im * D + h * 64 + 16 * dt + 4 * q4) = w;
    }
}
constexpr int CH_CL = 0, CH_AT = 17408, CH_RT = CH_AT + 9216, CH_BT = CH_RT + 9216, CH_KT = CH_BT + 9216, CH_BHT = CH_KT + 9216, CH_KHT = CH_BHT + 9216, CH_VT = CH_KHT + 9216,
              CH_MABF = CH_VT + 9216, CH_MAK = CH_MABF + 17408, CH_MBR = CH_MAK + 9216, CH_MKR = CH_MBR + 9216, CH_GL = CH_MKR + 9216, CH_MABB = CH_GL + 256, CH_TJ = CH_MABB + 9216, CH_END = CH_TJ + 2048;
static_assert(CH_END <= 147456, "chunk LDS map");
__device__ __forceinline__ void unpack8(const v4u raw, float (&v)[8]) {
    v[0] = __uint_as_float(raw.x << 16); v[1] = __uint_as_float(raw.x & 0xffff0000u); v[2] = __uint_as_float(raw.y << 16); v[3] = __uint_as_float(raw.y & 0xffff0000u);
    v[4] = __uint_as_float(raw.z << 16); v[5] = __uint_as_float(raw.z & 0xffff0000u); v[6] = __uint_as_float(raw.w << 16); v[7] = __uint_as_float(raw.w & 0xffff0000u);
}
__device__ __forceinline__ v4u pack8(const float (&v)[8]) { v4u o; o.x = pk2(v[0], v[1]); o.y = pk2(v[2], v[3]); o.z = pk2(v[4], v[5]); o.w = pk2(v[6], v[7]); return o; }

__device__ __forceinline__ void rwkv_chunk_item(LAS unsigned char* lds, int item, int tid, int wave, int lane, const float* LD, const bf16* KK, const bf16* BB, const bf16* KP, const bf16* RR, const bf16* VV,
                                                bf16* PMT, float* SLOC, bf16* QT, float* OLT) {
    const int c = item >> 3, h = item & 7, t0 = c * 64;
    LAS float* CL = (LAS float*)(lds + CH_CL); LAS float* Y5F = (LAS float*)(lds + CH_CL);
    LAS bf16* AT = (LAS bf16*)(lds + CH_AT); LAS bf16* RT = (LAS bf16*)(lds + CH_RT); LAS bf16* BT = (LAS bf16*)(lds + CH_BT); LAS bf16* KT = (LAS bf16*)(lds + CH_KT);
    LAS bf16* UB = BT; LAS bf16* WB = KT;
    LAS bf16* BHT = (LAS bf16*)(lds + CH_BHT); LAS bf16* KHT = (LAS bf16*)(lds + CH_KHT); LAS bf16* VT = (LAS bf16*)(lds + CH_VT);
    LAS float* MABF = (LAS float*)(lds + CH_MABF); LAS bf16* MAK = (LAS bf16*)(lds + CH_MAK); LAS bf16* MBR = (LAS bf16*)(lds + CH_MBR); LAS bf16* MKR = (LAS bf16*)(lds + CH_MKR);
    LAS float* GL = (LAS float*)(lds + CH_GL); LAS bf16* MABB = (LAS bf16*)(lds + CH_MABB); LAS bf16* TJB = (LAS bf16*)(lds + CH_TJ);
    const size_t gbase = (size_t)t0 * BW + h * 64;
    if (tid < 64) {
        float run = 0.f;
#pragma unroll 8
        for (int t = 0; t < 64; ++t) { run += LD[gbase + (size_t)t * BW + tid]; CL[t * 64 + tid] = run; }
        GL[tid] = __expf(run);
    }
    __syncthreads();
    {
        const int t = tid >> 3, k8 = (tid & 7) * 8; const size_t o = gbase + (size_t)t * BW + k8;
        float kk[8], bb[8], kp[8], rr[8], vv[8];
        unpack8(*(const v4u*)(KK + o), kk); unpack8(*(const v4u*)(BB + o), bb); unpack8(*(const v4u*)(KP + o), kp); unpack8(*(const v4u*)(RR + o), rr); unpack8(*(const v4u*)(VV + o), vv);
        const f32x4 l0 = *(const f32x4*)(LD + o), l1 = *(const f32x4*)(LD + o + 4);
        const float ldv[8] = {l0.x, l0.y, l0.z, l0.w, l1.x, l1.y, l1.z, l1.w};
        float at[8], rt[8], bt[8], kt[8];
#pragma unroll
        for (int e = 0; e < 8; ++e) {
            const float cl = CL[t * 64 + k8 + e], clL = CL[63 * 64 + k8 + e];
            const float en = __expf(-cl), eh = __expf(clL - cl);
            at[e] = -kk[e] * __expf(cl - ldv[e]); rt[e] = rr[e] * __expf(cl); bt[e] = bb[e] * en; kt[e] = kp[e] * en;
            BHT[(k8 + e) * 72 + t] = (bf16)f2bf(bb[e] * eh); KHT[(k8 + e) * 72 + t] = (bf16)f2bf(kp[e] * eh); VT[(k8 + e) * 72 + t] = (bf16)f2bf(vv[e]);
        }
        *(LAS v4u*)(AT + t * 72 + k8) = pack8(at); *(LAS v4u*)(RT + t * 72 + k8) = pack8(rt); *(LAS v4u*)(BT + t * 72 + k8) = pack8(bt); *(LAS v4u*)(KT + t * 72 + k8) = pack8(kt);
    }
    __syncthreads();
    const int r = lane & 15, q4 = lane >> 4, par = wave & 1;
    {
        const int mi = wave >> 1;
        const LAS bf16* X = (mi == 0 || mi == 2) ? BT : KT; const LAS bf16* Y = (mi < 2) ? AT : RT;
        f32x4 acc[2][4];
#pragma unroll
        for (int a = 0; a < 2; ++a)
#pragma unroll
            for (int b = 0; b < 4; ++b) acc[a][b] = (f32x4){0.f, 0.f, 0.f, 0.f};
#pragma unroll
        for (int ks = 0; ks < 2; ++ks) {
            bf16x8 xf[2], yf[4];
#pragma unroll
            for (int a = 0; a < 2; ++a) xf[a] = *(const LAS bf16x8*)(X + (16 * (2 * par + a) + r) * 72 + ks * 32 + q4 * 8);
#pragma unroll
            for (int b = 0; b < 4; ++b) yf[b] = *(const LAS bf16x8*)(Y + (16 * b + r) * 72 + ks * 32 + q4 * 8);
#pragma unroll
            for (int a = 0; a < 2; ++a)
#pragma unroll
                for (int b = 0; b < 4; ++b) acc[a][b] = MFMA16(xf[a], yf[b], acc[a][b]);
        }
#pragma unroll
        for (int a = 0; a < 2; ++a)
#pragma unroll
            for (int b = 0; b < 4; ++b) {
                const int s0 = 16 * (2 * par + a) + 4 * q4, t = 16 * b + r;
                f32x4 m;
#pragma unroll
                for (int e = 0; e < 4; ++e) m[e] = ((mi < 2) ? (s0 + e < t) : (s0 + e <= t)) ? acc[a][b][e] : 0.f;
                if (mi == 0) { *(LAS f32x4*)(MABF + t * 68 + s0) = m; v2u w; w.x = pk2(m[0], m[1]); w.y = pk2(m[2], m[3]); *(LAS v2u*)(MABB + t * 72 + s0) = w; }
                else { LAS bf16* Mo = (mi == 1) ? MAK : (mi == 2 ? MBR : MKR); v2u w; w.x = pk2(m[0], m[1]); w.y = pk2(m[2], m[3]); *(LAS v2u*)(Mo + t * 72 + s0) = w; }
            }
    }
    __syncthreads();
    {
        const int vt = wave >> 1;
        f32x4 acc[2];
        acc[0] = (f32x4){0.f, 0.f, 0.f, 0.f}; acc[1] = acc[0];
#pragma unroll
        for (int ks = 0; ks < 2; ++ks) {
            const bf16x8 xf = *(const LAS bf16x8*)(VT + (16 * vt + r) * 72 + ks * 32 + q4 * 8);
#pragma unroll
            for (int b = 0; b < 2; ++b) { const bf16x8 yf = *(const LAS bf16x8*)(MAK + (16 * (2 * par + b) + r) * 72 + ks * 32 + q4 * 8); acc[b] = MFMA16(xf, yf, acc[b]); }
        }
#pragma unroll
        for (int b = 0; b < 2; ++b)
#pragma unroll
            for (int e = 0; e < 4; ++e) Y5F[(16 * vt + 4 * q4 + e) * 68 + 16 * (2 * par + b) + r] = acc[b][e];
    }
    __syncthreads();
    if (wave == 0) {
        const int J = lane >> 4, i = lane & 15;
        float tr[16];
#pragma unroll
        for (int t = 0; t < 16; ++t) {
            float acc = (t == i) ? 1.f : 0.f;
#pragma unroll
            for (int s2 = 0; s2 < t; ++s2) acc += tr[s2] * MABF[(16 * J + t) * 68 + 16 * J + s2];
            tr[t] = acc;
        }
#pragma unroll
        for (int t = 0; t < 16; ++t) TJB[(16 * J + t) * 16 + i] = (bf16)f2bf(tr[t]);
    }
    __syncthreads();
    {
        unsigned xb[4][2];
#pragma unroll
        for (int J = 0; J < 4; ++J) {
            f32x4 z;
            if (wave < 4) z = *(const LAS f32x4*)(Y5F + (16 * wave + r) * 68 + 16 * J + 4 * q4);
            else {
#pragma unroll
                for (int e = 0; e < 4; ++e) z[e] = bf2f(AT[(16 * J + 4 * q4 + e) * 72 + 16 * (wave - 4) + r]);
            }
#pragma unroll
            for (int I = 0; I < J; I += 2) {
                const bool two = (I + 1 < J);
                const v2u m0 = *(const LAS v2u*)(MABB + (16 * J + r) * 72 + 16 * I + 4 * q4);
                v2u m1; m1.x = 0u; m1.y = 0u;
                if (two) m1 = *(const LAS v2u*)(MABB + (16 * J + r) * 72 + 16 * (I + 1) + 4 * q4);
                v4u fa; fa.x = m0.x; fa.y = m0.y; fa.z = m1.x; fa.w = m1.y;
                v4u fb; fb.x = xb[I][0]; fb.y = xb[I][1]; fb.z = two ? xb[I + 1 < 4 ? I + 1 : 3][0] : 0u; fb.w = two ? xb[I + 1 < 4 ? I + 1 : 3][1] : 0u;
                z = MFMA16(__builtin_bit_cast(bf16x8, fa), __builtin_bit_cast(bf16x8, fb), z);
            }
            const unsigned zh0 = pk2(z[0], z[1]), zh1 = pk2(z[2], z[3]);
            const unsigned zl0 = pk2(z[0] - __uint_as_float(zh0 << 16), z[1] - __uint_as_float(zh0 & 0xffff0000u)), zl1 = pk2(z[2] - __uint_as_float(zh1 << 16), z[3] - __uint_as_float(zh1 & 0xffff0000u));
            const v2u tw = *(const LAS v2u*)(TJB + (16 * J + r) * 16 + 4 * q4);
            v4u ft; ft.x = tw.x; ft.y = tw.y; ft.z = 0u; ft.w = 0u;
            v4u fh; fh.x = zh0; fh.y = zh1; fh.z = 0u; fh.w = 0u;
            v4u fl; fl.x = zl0; fl.y = zl1; fl.z = 0u; fl.w = 0u;
            f32x4 x = (f32x4){0.f, 0.f, 0.f, 0.f};
            x = MFMA16(__builtin_bit_cast(bf16x8, ft), __builtin_bit_cast(bf16x8, fh), x);
            x = MFMA16(__builtin_bit_cast(bf16x8, ft), __builtin_bit_cast(bf16x8, fl), x);
            xb[J][0] = pk2(x[0], x[1]); xb[J][1] = pk2(x[2], x[3]);
            LAS bf16* Xo = (wave < 4) ? (UB + (16 * wave + r) * 72) : (WB + (16 * (wave - 4) + r) * 72);
            v2u w; w.x = xb[J][0]; w.y = xb[J][1];
            *(LAS v2u*)(Xo + 16 * J + 4 * q4) = w;
        }
    }
    __syncthreads();
    {
        const int kind = wave >> 1;
        const LAS bf16* X1; const LAS bf16* Y1; const LAS bf16* X2 = nullptr; const LAS bf16* Y2 = nullptr;
        if (kind == 0) { X1 = UB; Y1 = MBR; X2 = VT; Y2 = MKR; }
        else if (kind == 1) { X1 = BHT; Y1 = UB; X2 = KHT; Y2 = VT; }
        else if (kind == 2) { X1 = WB; Y1 = MBR; }
        else { X1 = WB; Y1 = BHT; }
        f32x4 acc[2][4];
#pragma unroll
        for (int a = 0; a < 2; ++a)
#pragma unroll
            for (int b = 0; b < 4; ++b) acc[a][b] = (f32x4){0.f, 0.f, 0.f, 0.f};
#pragma unroll
        for (int ks = 0; ks < 2; ++ks) {
            bf16x8 xf[2], yf[4];
#pragma unroll
            for (int a = 0; a < 2; ++a) xf[a] = *(const LAS bf16x8*)(X1 + (16 * (2 * par + a) + r) * 72 + ks * 32 + q4 * 8);
#pragma unroll
            for (int b = 0; b < 4; ++b) yf[b] = *(const LAS bf16x8*)(Y1 + (16 * b + r) * 72 + ks * 32 + q4 * 8);
#pragma unroll
            for (int a = 0; a < 2; ++a)
#pragma unroll
                for (int b = 0; b < 4; ++b) acc[a][b] = MFMA16(xf[a], yf[b], acc[a][b]);
        }
        if (kind < 2) {
#pragma unroll
            for (int ks = 0; ks < 2; ++ks) {
                bf16x8 xf[2], yf[4];
#pragma unroll
                for (int a = 0; a < 2; ++a) xf[a] = *(const LAS bf16x8*)(X2 + (16 * (2 * par + a) + r) * 72 + ks * 32 + q4 * 8);
#pragma unroll
                for (int b = 0; b < 4; ++b) yf[b] = *(const LAS bf16x8*)(Y2 + (16 * b + r) * 72 + ks * 32 + q4 * 8);
#pragma unroll
                for (int a = 0; a < 2; ++a)
#pragma unroll
                    for (int b = 0; b < 4; ++b) acc[a][b] = MFMA16(xf[a], yf[b], acc[a][b]);
            }
        }
#pragma unroll
        for (int a = 0; a < 2; ++a)
#pragma unroll
            for (int b = 0; b < 4; ++b) {
                const int i0 = 16 * (2 * par + a) + 4 * q4, j = 16 * b + r;
                if (kind == 0) *(f32x4*)(OLT + ((size_t)item * 64 + j) * 64 + i0) = acc[a][b];
                else if (kind == 1) *(f32x4*)(SLOC + ((size_t)item * 64 + j) * 64 + i0) = acc[a][b];
                else if (kind == 2) {
                    const v2u rw = *(const LAS v2u*)(RT + j * 72 + i0);
                    v2u w; w.x = pk2(acc[a][b][0] + __uint_as_float(rw.x << 16), acc[a][b][1] + __uint_as_float(rw.x & 0xffff0000u));
                    w.y = pk2(acc[a][b][2] + __uint_as_float(rw.y << 16), acc[a][b][3] + __uint_as_float(rw.y & 0xffff0000u));
                    *(v2u*)(QT + ((size_t)item * 64 + j) * 64 + i0) = w;
                } else {
                    f32x4 m = acc[a][b];
#pragma unroll
                    for (int e = 0; e < 4; ++e) if (i0 + e == j) m[e] += GL[j];
                    v2u w; w.x = pk2(m[0], m[1]); w.y = pk2(m[2], m[3]);
                    *(v2u*)(PMT + ((size_t)item * 64 + j) * 64 + i0) = w;
                }
            }
    }
    __syncthreads();
}

struct ScanOps { bf16x8 pf[4][2]; f32x4 sl[4]; };
__device__ __forceinline__ void scan_ops_load(ScanOps& o, int it, int v, int r, int q4, const bf16* PMT, const float* SLOC) {
#pragma unroll
    for (int kt = 0; kt < 4; ++kt) {
        o.sl[kt] = *(const f32x4*)(SLOC + ((size_t)it * 64 + v) * 64 + 16 * kt + 4 * q4);
#pragma unroll
        for (int ks = 0; ks < 2; ++ks) {
            const bf16* p = PMT + ((size_t)it * 64 + 16 * kt + r) * 64 + 32 * ks + 4 * q4;
            const v2u lo = *(const v2u*)p, hi = *(const v2u*)(p + 16);
            v4u w; w.x = lo.x; w.y = lo.y; w.z = hi.x; w.w = hi.y;
            o.pf[kt][ks] = __builtin_bit_cast(bf16x8, w);
        }
    }
}
__device__ __forceinline__ void scan_step(const ScanOps& o, int c, int it, int v, int q4, int lane, LAS unsigned char* lds, bf16* SC) {
    volatile LAS int* flag = (volatile LAS int*)(lds + 16384);
    LAS v4u* slot_in = (LAS v4u*)(lds + (c & 1) * 8192);
    LAS v4u* slot_out = (LAS v4u*)(lds + ((c + 1) & 1) * 8192);
    while (*flag != c) __builtin_amdgcn_s_sleep(1);
    asm volatile("" ::: "memory");
    const v4u h0 = slot_in[lane], h1 = slot_in[64 + lane], l0 = slot_in[128 + lane], l1 = slot_in[192 + lane];
    { bf16* sc = SC + ((size_t)it * 64 + v) * 64 + 4 * q4;
      v2u w; w.x = h0.x; w.y = h0.y; *(v2u*)(sc) = w; w.x = h0.z; w.y = h0.w; *(v2u*)(sc + 16) = w;
      w.x = h1.x; w.y = h1.y; *(v2u*)(sc + 32) = w; w.x = h1.z; w.y = h1.w; *(v2u*)(sc + 48) = w; }
    const bf16x8 sh0 = __builtin_bit_cast(bf16x8, h0), sh1 = __builtin_bit_cast(bf16x8, h1), sl0 = __builtin_bit_cast(bf16x8, l0), sl1 = __builtin_bit_cast(bf16x8, l1);
    unsigned hw[4][2], lw[4][2];
#pragma unroll
    for (int kt = 0; kt < 4; ++kt) {
        f32x4 n = o.sl[kt];
        n = MFMA16(o.pf[kt][0], sh0, n); n = MFMA16(o.pf[kt][1], sh1, n);
        n = MFMA16(o.pf[kt][0], sl0, n); n = MFMA16(o.pf[kt][1], sl1, n);
        hw[kt][0] = pk2(n[0], n[1]); hw[kt][1] = pk2(n[2], n[3]);
        lw[kt][0] = pk2(n[0] - __uint_as_float(hw[kt][0] << 16), n[1] - __uint_as_float(hw[kt][0] & 0xffff0000u));
        lw[kt][1] = pk2(n[2] - __uint_as_float(hw[kt][1] << 16), n[3] - __uint_as_float(hw[kt][1] & 0xffff0000u));
    }
    v4u o0, o1, o2, o3;
    o0.x = hw[0][0]; o0.y = hw[0][1]; o0.z = hw[1][0]; o0.w = hw[1][1];
    o1.x = hw[2][0]; o1.y = hw[2][1]; o1.z = hw[3][0]; o1.w = hw[3][1];
    o2.x = lw[0][0]; o2.y = lw[0][1]; o2.z = lw[1][0]; o2.w = lw[1][1];
    o3.x = lw[2][0]; o3.y = lw[2][1]; o3.z = lw[3][0]; o3.w = lw[3][1];
    slot_out[lane] = o0; slot_out[64 + lane] = o1; slot_out[128 + lane] = o2; slot_out[192 + lane] = o3;
    asm volatile("s_waitcnt lgkmcnt(0)" ::: "memory");
    if (lane == 0) *flag = c + 1;
}
__device__ __forceinline__ void rwkv_state_scan_wg(LAS unsigned char* lds, int hv, int tid, int wave, int lane, const bf16* PMT, const float* SLOC, bf16* SC) {
    const int h = hv >> 2, vt = hv & 3, r = lane & 15, q4 = lane >> 4, v = 16 * vt + r;
    constexpr int NC = M / 64;
    for (int i = tid; i < 16384 / 4 + 16; i += 512) ((LAS unsigned*)lds)[i] = 0u;
    __syncthreads();
    ScanOps A, B;
    scan_ops_load(A, wave * 8 + h, v, r, q4, PMT, SLOC);
    scan_ops_load(B, (wave + 8) * 8 + h, v, r, q4, PMT, SLOC);
    for (int j = 0; j < NC / 8; j += 2) {
        const int cA = wave + 8 * j, cB = cA + 8;
        scan_step(A, cA, cA * 8 + h, v, q4, lane, lds, SC);
        if (j + 2 < NC / 8) scan_ops_load(A, (cA + 16) * 8 + h, v, r, q4, PMT, SLOC);
        scan_step(B, cB, cB * 8 + h, v, q4, lane, lds, SC);
        if (j + 3 < NC / 8) scan_ops_load(B, (cB + 16) * 8 + h, v, r, q4, PMT, SLOC);
    }
    __syncthreads();
}
__device__ __forceinline__ void rwkv_chunk_out(int item, int lane, const bf16* SC, const bf16* QT, const float* OLT, const float* BS, const bf16* VV, const bf16* GG,
                                               const float* gn_g, const float* gn_b, bf16* Y) {
    const int c = item >> 3, h = item & 7, r = lane & 15, q4 = lane >> 4;
    bf16x8 sf[4][2];
#pragma unroll
    for (int vt = 0; vt < 4; ++vt)
#pragma unroll
        for (int ks = 0; ks < 2; ++ks) sf[vt][ks] = *(const bf16x8*)(SC + ((size_t)item * 64 + 16 * vt + r) * 64 + 32 * ks + 8 * q4);
    f32x4 gg4[4], gb4[4];
#pragma unroll
    for (int vt = 0; vt < 4; ++vt) { gg4[vt] = *(const f32x4*)(gn_g + h * 64 + 16 * vt + 4 * q4); gb4[vt] = *(const f32x4*)(gn_b + h * 64 + 16 * vt + 4 * q4); }
    for (int tt = 0; tt < 4; ++tt) {
        const int tl = 16 * tt + r, t = c * 64 + tl;
        bf16x8 qf[2];
#pragma unroll
        for (int ks = 0; ks < 2; ++ks) qf[ks] = *(const bf16x8*)(QT + ((size_t)item * 64 + tl) * 64 + 32 * ks + 8 * q4);
        f32x4 o[4]; float s = 0.f;
#pragma unroll
        for (int vt = 0; vt < 4; ++vt) {
            o[vt] = *(const f32x4*)(OLT + ((size_t)item * 64 + tl) * 64 + 16 * vt + 4 * q4);
            o[vt] = MFMA16(sf[vt][0], qf[0], o[vt]); o[vt] = MFMA16(sf[vt][1], qf[1], o[vt]);
            s += (o[vt][0] + o[vt][1]) + (o[vt][2] + o[vt][3]);
        }
        s += __shfl_xor(s, 16); s += __shfl_xor(s, 32);
        const float mean = s * (1.f / 64.f);
        float qv = 0.f;
#pragma unroll
        for (int vt = 0; vt < 4; ++vt) { o[vt] = o[vt] - mean; qv += (o[vt][0] * o[vt][0] + o[vt][1] * o[vt][1]) + (o[vt][2] * o[vt][2] + o[vt][3] * o[vt][3]); }
        qv += __shfl_xor(qv, 16); qv += __shfl_xor(qv, 32);
        const float rstd = 1.0f / sqrtf(qv * (1.f / 64.f) + 64e-5f);
        const float bon = BS[(size_t)t * 8 + h];
#pragma unroll
        for (int vt = 0; vt < 4; ++vt) {
            const size_t oo = (size_t)t * BW + h * 64 + 16 * vt + 4 * q4;
            const v2u vr = *(const v2u*)(VV + oo), gr = *(const v2u*)(GG + oo);
            const float v0 = __uint_as_float(vr.x << 16), v1 = __uint_as_float(vr.x & 0xffff0000u), v2 = __uint_as_float(vr.y << 16), v3 = __uint_as_float(vr.y & 0xffff0000u);
            const float g0 = __uint_as_float(gr.x << 16), g1 = __uint_as_float(gr.x & 0xffff0000u), g2 = __uint_as_float(gr.y << 16), g3 = __uint_as_float(gr.y & 0xffff0000u);
            const f32x4 y = o[vt] * rstd * gg4[vt] + gb4[vt];
            v2u w; w.x = pk2((y[0] + bon * v0) * g0, (y[1] + bon * v1) * g1); w.y = pk2((y[2] + bon * v2) * g2, (y[3] + bon * v3) * g3);
            *(v2u*)(Y + (size_t)t * D + 512 + h * 64 + 16 * vt + 4 * q4) = w;
        }
    }
}
#define XB_TMO      128
#define XB_XCNT(j)  (256  + 64 * (j))
#define XB_XSUB(j)  (1280 + 64 * (j))
#define XB_XGEN(j)  (2304 + 64 * (j))
#define XB_TOP      3328
#define XB_TOPGEN   3392
#define XCD_BAR_WORDS 3456
#define XB_SPIN_CAP (1u << 18)

__device__ __forceinline__ unsigned xb_ld(unsigned* p)              { return __hip_atomic_load(p, __ATOMIC_RELAXED, __HIP_MEMORY_SCOPE_AGENT); }
__device__ __forceinline__ unsigned xb_add(unsigned* p, unsigned v) { return __hip_atomic_fetch_add(p, v, __ATOMIC_RELAXED, __HIP_MEMORY_SCOPE_AGENT); }
__device__ __forceinline__ unsigned xb_xcc_id() { return (unsigned)__builtin_amdgcn_s_getreg((3 << 11) | 20) & 0xFu; }
#define XB_SPIN(cond, bar) do { unsigned _sp = 0; while (cond) { __builtin_amdgcn_s_sleep(1); \
    if ((++_sp & 255u) == 0u) { if (xb_ld(&(bar)[XB_TMO])) break; if (_sp > XB_SPIN_CAP) { atomicAdd(&(bar)[XB_TMO], 1u); break; } } } } while (0)

struct XcdBarrier {
    unsigned* bar; unsigned x;
    volatile LAS unsigned* st;
};

__device__ __forceinline__ XcdBarrier xcd_barrier_post(unsigned* bar, volatile LAS unsigned* st) {
    XcdBarrier b; b.bar = bar; b.x = xb_xcc_id(); b.st = st;
    if (threadIdx.x == 0) (void)xb_add(&bar[XB_XCNT(b.x)], 1u);
    return b;
}
__device__ __forceinline__ void xcd_barrier_complete(unsigned* bar, unsigned x, unsigned& nloc, unsigned& nx) {
    const unsigned G = gridDim.x * gridDim.y * gridDim.z;
    unsigned sum, cnt, mine, sp = 0u;
    for (;;) {
        sum = 0u; cnt = 0u; mine = 0u;
#pragma unroll
        for (unsigned j = 0; j < 16; ++j) { const unsigned c = xb_ld(&bar[XB_XCNT(j)]); sum += c; cnt += (c > 0u) ? 1u : 0u; mine = (j == x) ? c : mine; }
        if (sum == G) break;
        __builtin_amdgcn_s_sleep(1);
        if ((++sp & 255u) == 0u) { if (xb_ld(&bar[XB_TMO])) break; if (sp > XB_SPIN_CAP) { atomicAdd(&bar[XB_TMO], 1u); break; } }
    }
    nloc = mine > 0u ? mine : 1u; nx = cnt > 0u ? cnt : 1u;
}

__device__ __forceinline__ void xcd_barrier(const XcdBarrier& b) {
    asm volatile("s_waitcnt vmcnt(0)" ::: "memory");
    __syncthreads();
    if (threadIdx.x == 0) {
        unsigned* bar = b.bar;
        __builtin_amdgcn_s_waitcnt(0);
        unsigned nloc = b.st[0], nx = b.st[1];
        if (nloc == 0u) { xcd_barrier_complete(bar, b.x, nloc, nx); b.st[0] = nloc; b.st[1] = nx; }
        const unsigned old = xb_add(&bar[XB_XSUB(b.x)], 1u);
        const unsigned gen = old / nloc;
        if (old + 1u == (gen + 1u) * nloc) {
            __builtin_amdgcn_fence(__ATOMIC_RELEASE, "agent");
            asm volatile("s_waitcnt vmcnt(0)" ::: "memory");
            const unsigned og = xb_add(&bar[XB_TOP], 1u);
            const unsigned tg = og / nx;
            if (og + 1u == (tg + 1u) * nx) xb_add(&bar[XB_TOPGEN], 1u);
            else XB_SPIN(xb_ld(&bar[XB_TOPGEN]) == tg, bar);
            __builtin_amdgcn_fence(__ATOMIC_ACQUIRE, "agent");
            xb_add(&bar[XB_XGEN(b.x)], 1u);
            asm volatile("s_waitcnt vmcnt(0)" ::: "memory");
        } else {
            XB_SPIN(xb_ld(&bar[XB_XGEN(b.x)]) == gen, bar);
            __builtin_amdgcn_fence(__ATOMIC_ACQUIRE, "agent");
            asm volatile("s_waitcnt vmcnt(0)" ::: "memory");
        }
    }
    __syncthreads();
}
struct Args { const float* in[28]; float* out; unsigned char* ws; };
#define GRID_SYNC() xcd_barrier(xbar)
#define PHASE_VARS int tid = threadIdx.x; asm volatile("" : "+v"(tid)); const int lane = tid & 63; const int wave = __builtin_amdgcn_readfirstlane(tid >> 6); \
    int G = gridDim.x; asm volatile("" : "+s"(G)); int bx = blockIdx.x; asm volatile("" : "+s"(bx)); const int gw = bx * NWAVES + wave, NGW = G * NWAVES; (void)lane; (void)gw; (void)NGW; (void)tid
#define WSP(T, off) ((T*)(args.ws + (off)))
#define XIN (args.in[0])
#define OUTF (args.out)
#define WA WSP(bf16, WS_WA)
#define WB WSP(bf16, WS_WB)
#define XN WSP(bf16, WS_XN)
#define P WSP(bf16, WS_P)
#define LD WSP(float, WS_LD)
#define KK WSP(bf16, WS_KK)
#define BB WSP(bf16, WS_BB)
#define KP WSP(bf16, WS_KP)
#define RR WSP(bf16, WS_RR)
#define VV WSP(bf16, WS_VV)
#define GG ((bf16*)args.out)
#define SCB ((bf16*)((unsigned char*)args.out + 16 * MiB))
#define OLT ((float*)((unsigned char*)args.out + 32 * MiB))
#define PMT WSP(bf16, WS_P)
#define SLOC WSP(float, WS_P + 16 * MiB)
#define QTB WSP(bf16, WS_P + 48 * MiB)
#define BS WSP(float, WS_BS)
#define W2T WSP(bf16, WS_W2T)
#define A2T WSP(bf16, WS_A2T)
#define G2T WSP(bf16, WS_G2T)
#define YC WSP(bf16, WS_XN)
#define ACT WSP(bf16, WS_GEN)
#define QKV WSP(bf16, WS_QKV)
#define VT1 WSP(bf16, WS_VT1)
#define VT4 WSP(bf16, WS_VT4)
#define VT16 WSP(bf16, WS_VT16)
__global__ void __launch_bounds__(NWAVES * 64, 2) hybrid_fwd(Args args) {
    extern __shared__ __attribute__((aligned(16))) unsigned char lds_raw[];
    LAS unsigned char* lds = (LAS unsigned char*)lds_raw;
    if (threadIdx.x < 16) ((LAS unsigned*)(lds + LDS_BYTES - 64))[threadIdx.x] = 0u;
    __syncthreads();
    const XcdBarrier xbar = xcd_barrier_post((unsigned*)args.ws, (volatile LAS unsigned*)(lds + LDS_BYTES - 64));

    { PHASE_VARS;
    {
        LAS float* scr = (LAS float*)(lds + wave * 16384);
        const int IL = 16 + 16 + 32;
        for (int it = gw; it < IL; it += NGW) {
            if (it < 16) transpose_item(args.in[9], 64, 512, W2T, scr, it, lane);
            else if (it < 32) transpose_item(args.in[11], 64, 512, A2T, scr, it - 16, lane);
            else transpose_item(args.in[12], 128, 512, G2T, scr, it - 32, lane);
        }
        norm_phase(lds, gw, NGW, wave, lane, XIN, args.in[1], XN, args.in[2], D, EIN, WA, args.in[18], D, D, WB);
    }

    }
    cg::this_grid().sync();
    { PHASE_VARS;

    {
        pg8::Gemm g{XN, WA, M, EIN, D, 256L * D * 2, 128L * D * 2, 256L * D * 2, 128L * D * 2, 0}; pg8::StaticOrder S; S.init(M, EIN, G, bx);
        pg8::EpiBf16<0> E{P, EIN, nullptr, 0, 0, 1.f};
        pg8::gemm_phase<pg8::EpiBf16<0>, pg8::StaticOrder, true, true>(lds, g, S, E);
    }

    }
    GRID_SYNC();
    { PHASE_VARS;

    {
        RwkvW W{args.in[7], args.in[8], args.in[10], args.in[13], args.in[14], args.in[15], W2T, A2T, G2T};
        for (int it = bx; it < M / 64; it += G) rwkv_prep_item(lds, it, tid, wave, lane, P, W, LD, KK, BB, KP, RR, VV, GG, BS);
        for (int it = bx; it < (M / 128) * 4; it += G) gmlp_item(lds, it, tid, wave, lane, P, args.in[3], args.in[4], args.in[5], args.in[6], YC);
    }

    }
    GRID_SYNC();
    { PHASE_VARS;
        for (int it = bx; it < (M / 64) * 8; it += G) rwkv_chunk_item(lds, it, tid, wave, lane, LD, KK, BB, KP, RR, VV, PMT, SLOC, QTB, OLT);
    }
    GRID_SYNC();
    { PHASE_VARS;
        if (bx < 32) rwkv_state_scan_wg(lds, bx, tid, wave, lane, PMT, SLOC, SCB);
    }
    GRID_SYNC();
    { PHASE_VARS;
        for (int it = gw; it < (M / 64) * 8; it += NGW) rwkv_chunk_out(it, lane, SCB, QTB, OLT, BS, VV, GG, args.in[16], args.in[17], YC);
    }
    GRID_SYNC();
    { PHASE_VARS;

    {
        pg8::Gemm g{YC, WB, M, D, D, 256L * D * 2, 128L * D * 2, 256L * D * 2, 128L * D * 2, 0}; pg8::StaticOrder S; S.init(M, D, G, bx);
        pg8::EpiRes E{XIN, OUTF, D};
        pg8::gemm_phase<pg8::EpiRes, pg8::StaticOrder, true, true>(lds, g, S, E);
    }

    }
    GRID_SYNC();
    { PHASE_VARS;
        norm_phase(lds, gw, NGW, wave, lane, OUTF, args.in[22] + 0 * D, XN, args.in[23] + (size_t)0 * D * FF2, D, FF2, WA, args.in[26] + (size_t)0 * FF * D, FF, D, WB);
    }
    GRID_SYNC();
    { PHASE_VARS;
        pg8::Gemm g{XN - 2 * D, WA, M, FF2, D, 248L * D * 2, 124L * D * 2, 128L * D * 2, 2816L * D * 2, 1}; pg8::StaticOrder S; S.init2(67, 22, G, bx);
        pg8::EpiConvGlu E{ACT, args.in[24] + (size_t)0 * 3 * FF2, args.in[25] + (size_t)0 * FF2, M};
        pg8::gemm_phase<pg8::EpiConvGlu, pg8::StaticOrder, true, true>(lds, g, S, E);
    }
    GRID_SYNC();
    { PHASE_VARS;
        pg8::Gemm g{ACT, WB, M, D, FF, 256L * FF * 2, 128L * FF * 2, 256L * FF * 2, 128L * FF * 2, 0}; pg8::StaticOrder S; S.init(M, D, G, bx);
        pg8::EpiRes E{OUTF, OUTF, D};
        pg8::gemm_phase<pg8::EpiRes, pg8::StaticOrder, true, true>(lds, g, S, E);
    }
    GRID_SYNC();
    { PHASE_VARS;
        norm_phase(lds, gw, NGW, wave, lane, OUTF, args.in[19], XN, args.in[20], D, NQKV, WA, args.in[21], D, D, WB);
    }
    GRID_SYNC();
    { PHASE_VARS;
        pg8::Gemm g{XN, WA, M, NQKV, D, 256L * D * 2, 128L * D * 2, 256L * D * 2, 128L * D * 2, 0}; pg8::StaticOrder S; S.init(M, NQKV, G, bx);
        pg8::EpiBf16<0> E{QKV, NQKV, nullptr, 0, 0, 1.f};
        pg8::gemm_phase<pg8::EpiBf16<0>, pg8::StaticOrder, true, true>(lds, g, S, E);
    }
    GRID_SYNC();
    { PHASE_VARS;
        for (int it = bx; it < 16 * 64; it += G) vtrans_item(lds, it, tid, QKV, VT1, VT4, VT16);
    }
    GRID_SYNC();
    { PHASE_VARS;
        for (int it = bx; it < 16 * 64; it += G) {
            const int h = it >> 6, blk = it & 63;
            attn_wave_item(QKV, VT1, VT4, VT16, YC, h, blk, 2 * wave, lane);
            attn_wave_item(QKV, VT1, VT4, VT16, YC, h, blk, 2 * wave + 1, lane);
        }
    }
    GRID_SYNC();
    { PHASE_VARS;
        pg8::Gemm g{YC, WB, M, D, D, 256L * D * 2, 128L * D * 2, 256L * D * 2, 128L * D * 2, 0}; pg8::StaticOrder S; S.init(M, D, G, bx);
        pg8::EpiRes E{OUTF, OUTF, D};
        pg8::gemm_phase<pg8::EpiRes, pg8::StaticOrder, true, true>(lds, g, S, E);
    }
    GRID_SYNC();
    { PHASE_VARS;
        norm_phase(lds, gw, NGW, wave, lane, OUTF, args.in[22] + 1 * D, XN, args.in[23] + (size_t)1 * D * FF2, D, FF2, WA, args.in[26] + (size_t)1 * FF * D, FF, D, WB);
    }
    GRID_SYNC();
    { PHASE_VARS;
        pg8::Gemm g{XN - 2 * D, WA, M, FF2, D, 248L * D * 2, 124L * D * 2, 128L * D * 2, 2816L * D * 2, 1}; pg8::StaticOrder S; S.init2(67, 22, G, bx);
        pg8::EpiConvGlu E{ACT, args.in[24] + (size_t)1 * 3 * FF2, args.in[25] + (size_t)1 * FF2, M};
        pg8::gemm_phase<pg8::EpiConvGlu, pg8::StaticOrder, true, true>(lds, g, S, E);
    }
    GRID_SYNC();
    { PHASE_VARS;
        pg8::Gemm g{ACT, WB, M, D, FF, 256L * FF * 2, 128L * FF * 2, 256L * FF * 2, 128L * FF * 2, 0}; pg8::StaticOrder S; S.init(M, D, G, bx);
        pg8::EpiRes E{OUTF, OUTF, D};
        pg8::gemm_phase<pg8::EpiRes, pg8::StaticOrder, true, true>(lds, g, S, E);
    }
    GRID_SYNC();
    { PHASE_VARS;
        for (int m = gw; m < M; m += NGW) rms_row_inplace(OUTF + (size_t)m * D, args.in[27], lane);
    }
}

#undef WSP
#undef XIN
#undef OUTF
#undef WA
#undef WB
#undef XN
#undef P
#undef LD
#undef KK
#undef BB
#undef KP
#undef RR
#undef VV
#undef GG
#undef SCB
#undef OLT
#undef PMT
#undef SLOC
#undef QTB
#undef BS
#undef W2T
#undef A2T
#undef G2T
#undef YC
#undef ACT
#undef QKV
#undef VT1
#undef VT4
#undef VT16
extern "C" void kernel_launch(void* const* d_in, const int* in_sizes, int n_in, void* d_out, int out_size, void* d_ws, size_t ws_size, hipStream_t stream) {
    static int grid = 0;
    if (grid == 0) {
        if (n_in != 28 || in_sizes[0] != M * D || out_size != M * D || ws_size < WS_END) { fprintf(stderr, "kernel_launch: unexpected shapes (n_in %d, in0 %d, out %d, ws %zu)\n", n_in, n_in > 0 ? in_sizes[0] : -1, out_size, ws_size); grid = -1; return; }
        int dev = 0, cus = 0, per_cu = 0;
        if (hipGetDevice(&dev) != hipSuccess || hipDeviceGetAttribute(&cus, hipDeviceAttributeMultiprocessorCount, dev) != hipSuccess) { grid = -1; return; }
        if (hipFuncSetAttribute((const void*)hybrid_fwd, hipFuncAttributeMaxDynamicSharedMemorySize, LDS_BYTES) != hipSuccess) { fprintf(stderr, "kernel_launch: hipFuncSetAttribute failed\n"); grid = -1; return; }
        if (hipOccupancyMaxActiveBlocksPerMultiprocessor(&per_cu, (const void*)hybrid_fwd, NWAVES * 64, LDS_BYTES) != hipSuccess || per_cu < 1) { fprintf(stderr, "kernel_launch: occupancy query says %d\n", per_cu); per_cu = 1; }
        (void)hipGetLastError();
        grid = cus;
    }
    if (grid < 0) return;
    if (hipMemsetAsync(d_ws, 0, 65536, stream) != hipSuccess) { fprintf(stderr, "kernel_launch: hipMemsetAsync failed\n"); return; }
    Args a{};
    for (int i = 0; i < 28; ++i) a.in[i] = (const float*)d_in[i];
    a.out = (float*)d_out; a.ws = (unsigned char*)d_ws;
    void* kargs[] = {&a};
    hipError_t e = hipLaunchCooperativeKernel((const void*)hybrid_fwd, dim3(grid), dim3(NWAVES * 64), kargs, LDS_BYTES, stream);
    if (e != hipSuccess) fprintf(stderr, "kernel_launch: cooperative launch failed: %s (grid %d)\n", hipGetErrorString(e), grid);
}
```

```cpp
#include <hip/hip_runtime.h>
#include <hip/hip_cooperative_groups.h>
#include <cstdio>
#include <cstdint>
namespace cg = cooperative_groups;
namespace pg8 {
#define PG8_LAS __attribute__((address_space(3)))
typedef unsigned short bf16_t;
typedef short bf16x8 __attribute__((ext_vector_type(8)));
typedef float f32x4 __attribute__((ext_vector_type(4)));
typedef unsigned u32x4 __attribute__((ext_vector_type(4)));
constexpr int BM = 256, BK = 64, HALF = 128, HTB = HALF * BK * 2  , STAGE_BYTES = 8 * HTB, NXCD = 8, WGM = 8;

__host__ __device__ __forceinline__ int lds_byte(int r, int c) { const int st = (r >> 4) * 2 + (c >> 5), rr = r & 15, cc = c & 31, ob = rr * 64 + cc * 2; return st * 1024 + (ob ^ (((ob >> 9) & 1) << 5)); }
__host__ __device__ __forceinline__ void stage_rc(int b, int& R, int& C) { const int st = b / 1024, sb = b % 1024, swz = sb ^ (((sb >> 9) & 1) << 5); R = (st >> 1) * 16 + swz / 64; C = (st & 1) * 32 + (swz % 64) / 2; }
__host__ __device__ __forceinline__ int perm32(int rho) { const int n = rho >> 4, i = rho & 15; return 8 * (i >> 2) + 4 * n + (i & 3); }

struct Unit { int pm, pn; };
struct Gemm { const bf16_t* A; const bf16_t* Bt; int M, N, K; long tA, hA, tB, hB; int remapA; };

struct StaticOrder {
    int nM, nN, nwg, G, c;
    __host__ __device__ void init(int M, int N, int G_, int c_) { nM = M / BM; nN = N / BM; nwg = nM * nN; G = G_; c = c_; }
    __host__ __device__ void init2(int nM_, int nN_, int G_, int c_) { nM = nM_; nN = nN_; nwg = nM * nN; G = G_; c = c_; }
    __host__ __device__ bool next(int i, Unit& u) const {
        const long L = (long)i * G + c; if (L >= nwg) return false;
        int wgid = (int)L; { const int q = nwg / NXCD, r = nwg % NXCD, xcd = wgid % NXCD, off = wgid / NXCD; wgid = (xcd < r ? xcd * (q + 1) : r * (q + 1) + (xcd - r) * q) + off; }
        const int nig = WGM * nN, gid = wgid / nig, fm = gid * WGM, gsz = (nM - fm) < WGM ? (nM - fm) : WGM;
        u.pm = fm + ((wgid % nig) % gsz); u.pn = (wgid % nig) / gsz; return true;
    }
    __device__ __forceinline__ void a_ready(const Unit&) const {}
    __device__ __forceinline__ void done(const Unit&) const {}
};

__device__ __forceinline__ unsigned cvt_pk_bf16(float lo, float hi) { unsigned r; asm volatile("v_cvt_pk_bf16_f32 %0, %1, %2" : "=v"(r) : "v"(lo), "v"(hi)); return r; }
typedef float f32x2 __attribute__((ext_vector_type(2)));
__device__ __forceinline__ f32x2 gelu_pk(f32x2 v) {
    const f32x2 av = __builtin_elementwise_abs(v), d = av * 0.2316418882f + 1.0f;
    f32x2 t; t.x = __builtin_amdgcn_rcpf(d.x); t.y = __builtin_amdgcn_rcpf(d.y);
    f32x2 q = t * 0.5307027145f + (-0.7265760135f); q = q * t + 0.7107068705f; q = q * t + (-0.142248368f); q = q * t + 0.127414796f; q = q * t;
    const f32x2 s = (v * v) * (-0.72134752044f);
    f32x2 e; e.x = __builtin_amdgcn_exp2f(s.x); e.y = __builtin_amdgcn_exp2f(s.y);
    const f32x2 m = v * (q * e), r = v - m;
    f32x2 o; o.x = v.x < 0.f ? m.x : r.x; o.y = v.y < 0.f ? m.y : r.y; return o;
}

template <int ACT  > struct EpiBf16 {
    static constexpr bool PERM = true, AFTER_DRAIN = false; static_assert(ACT == 0 || ACT == 1, "EpiBf16: ACT is 0 (none) or 1 (gelu_pk)");
    bf16_t* O; int ldc; const float* bias; int split_cols; size_t split_stride; float scale0;
    __device__ __forceinline__ void operator()(const f32x4 (&acc)[2][2][4][2], const Unit& u, int wr, int wc, int fr, int fq) const {
        const int row0 = u.pm * BM + wr * 64 + fr; int colt = u.pn * BM; bf16_t* base = O;
        float sc = 1.f; if (split_cols) { const int t = colt / split_cols; base += (size_t)t * split_stride; colt -= t * split_cols; if (t == 0) sc = scale0; }
        const int col0 = colt + wc * 32 + 8 * fq, bcol0 = u.pn * BM + wc * 32 + 8 * fq;
        f32x4 bv[2][2];
#pragma unroll
        for (int bj = 0; bj < 2; ++bj)
#pragma unroll
            for (int n = 0; n < 2; ++n) bv[bj][n] = bias ? *(const f32x4*)(bias + bcol0 + bj * HALF + 4 * n) : (f32x4){0.f, 0.f, 0.f, 0.f};
#pragma unroll
        for (int ai = 0; ai < 2; ++ai)
#pragma unroll
            for (int m = 0; m < 4; ++m) { bf16_t* rowp = base + (size_t)(row0 + ai * HALF + m * 16) * ldc + col0;
#pragma unroll
                for (int bj = 0; bj < 2; ++bj) { f32x4 v0 = acc[ai][bj][m][0] + bv[bj][0], v1 = acc[ai][bj][m][1] + bv[bj][1];
                    if (ACT == 1) { f32x2 a = gelu_pk((f32x2){v0[0], v0[1]}), b = gelu_pk((f32x2){v0[2], v0[3]}), c = gelu_pk((f32x2){v1[0], v1[1]}), d = gelu_pk((f32x2){v1[2], v1[3]});
                        v0 = (f32x4){a.x, a.y, b.x, b.y}; v1 = (f32x4){c.x, c.y, d.x, d.y}; }
                    v0 = v0 * sc; v1 = v1 * sc; u32x4 w; w.x = cvt_pk_bf16(v0[0], v0[1]); w.y = cvt_pk_bf16(v0[2], v0[3]); w.z = cvt_pk_bf16(v1[0], v1[1]); w.w = cvt_pk_bf16(v1[2], v1[3]);
                    *(u32x4*)(rowp + bj * HALF) = w; } }
    }
};

template <class Epi, class Sched, bool ALIGN_EPI = false, bool SP2 = false>
__device__ __forceinline__ void gemm_phase(PG8_LAS unsigned char* lds, const Gemm g, const Sched& S, const Epi& E) {
    const int tid = threadIdx.x, wid = __builtin_amdgcn_readfirstlane(tid >> 6), lane = tid & 63, wr = wid >> 2, wc = wid & 3, fr = lane & 15, fq = lane >> 4;
    const int K = g.K, nt = K / BK;
    unsigned voffA[2], voffB[2];
#pragma unroll
    for (int i = 0; i < 2; ++i) { int R, C; stage_rc(tid * 16 + i * 8192, R, C); const int Rb = Epi::PERM ? ((R & ~31) + perm32(R & 31)) : R;
        const int Ra = g.remapA ? (R - (R >= 64 ? 2 : 0)) : R; voffA[i] = (unsigned)(Ra * K + C) * 2u; voffB[i] = (unsigned)(Rb * K + C) * 2u; }
    const size_t kstep = (size_t)(BK * 2);
    const size_t hA = (size_t)g.hA, hB = (size_t)g.hB, tA = (size_t)g.tA, tB = (size_t)g.tB;
    const unsigned ldsw = (unsigned)wid * 1024u;
    const int aoff = lds_byte(wr * 64 + fr, fq * 8), boff = lds_byte(wc * 32 + fr, fq * 8);
#define PG8_SA(b, h) (((b) * 2 + (h)) * HTB)
#define PG8_SB(b, h) ((4 + (b) * 2 + (h)) * HTB)
#define PG8_STAGE(bufoff, gbase, voff) do { _Pragma("unroll") for (int _i = 0; _i < 2; ++_i) \
        __builtin_amdgcn_global_load_lds((const unsigned*)((const char*)(gbase) + (voff)[_i]), (PG8_LAS unsigned*)(lds + (bufoff) + ldsw + _i * 8192), 16, 0, 0); } while (0)
#define PG8_LDA(dst, b, h) do { _Pragma("unroll") for (int m = 0; m < 4; ++m) _Pragma("unroll") for (int k = 0; k < 2; ++k) dst[m][k] = *(const PG8_LAS bf16x8*)(lds + PG8_SA(b, h) + aoff + m * 2048 + k * 1024); } while (0)
#define PG8_LDB(dst, b, h) do { _Pragma("unroll") for (int n = 0; n < 2; ++n) _Pragma("unroll") for (int k = 0; k < 2; ++k) dst[n][k] = *(const PG8_LAS bf16x8*)(lds + PG8_SB(b, h) + boff + n * 2048 + k * 1024); } while (0)
#define PG8_MMA(ai, bj, At, Bt) do { __builtin_amdgcn_s_setprio(1); _Pragma("unroll") for (int m = 0; m < 4; ++m) _Pragma("unroll") for (int n = 0; n < 2; ++n) _Pragma("unroll") for (int k = 0; k < 2; ++k) \
        acc[ai][bj][m][n] = __builtin_amdgcn_mfma_f32_16x16x32_bf16(Bt[n][k], At[m][k], acc[ai][bj][m][n], 0, 0, 0); __builtin_amdgcn_s_setprio(0); } while (0)
#define PG8_WAIT_V(n) asm volatile("s_waitcnt vmcnt(" #n ")" ::: "memory")
#define PG8_WAIT_L(n) asm volatile("s_waitcnt lgkmcnt(" #n ")" ::: "memory")
#define PG8_BAR __builtin_amdgcn_s_barrier()
#define PG8_SCHED __builtin_amdgcn_sched_barrier(0)
    Unit cur, nxt; int ui = 0;
    if (!S.next(0, cur)) return;
    f32x4 acc[2][2][4][2];
#pragma unroll
    for (int a = 0; a < 2; ++a)
#pragma unroll
        for (int b = 0; b < 2; ++b)
#pragma unroll
            for (int m = 0; m < 4; ++m)
#pragma unroll
                for (int n = 0; n < 2; ++n) acc[a][b][m][n] = (f32x4){0.f, 0.f, 0.f, 0.f};
    bf16x8 At[4][2], B0[2][2], B1[2][2];
    const char* cA = (const char*)g.A + (size_t)cur.pm * tA; const char* cB = (const char*)g.Bt + (size_t)cur.pn * tB;
    S.a_ready(cur);
    if constexpr (SP2) {
        PG8_STAGE(PG8_SB(0, 0), cB, voffB); PG8_STAGE(PG8_SB(0, 1), cB + hB, voffB); PG8_STAGE(PG8_SA(0, 0), cA, voffA); PG8_STAGE(PG8_SA(0, 1), cA + hA, voffA);
        if (wr == 1) PG8_BAR;
        PG8_WAIT_V(2); PG8_BAR;
        PG8_STAGE(PG8_SB(1, 0), cB + kstep, voffB); PG8_STAGE(PG8_SA(1, 0), cA + kstep, voffA); PG8_STAGE(PG8_SB(1, 1), cB + hB + kstep, voffB);
        PG8_WAIT_V(6); PG8_BAR;
    } else {
        PG8_STAGE(PG8_SB(0, 0), cB, voffB); PG8_STAGE(PG8_SA(0, 0), cA, voffA); PG8_STAGE(PG8_SB(0, 1), cB + hB, voffB); PG8_STAGE(PG8_SA(0, 1), cA + hA, voffA);
        if (wr == 1) PG8_BAR;
        PG8_WAIT_V(4); PG8_BAR;
        PG8_STAGE(PG8_SB(1, 0), cB + kstep, voffB); PG8_STAGE(PG8_SA(1, 0), cA + kstep, voffA); PG8_STAGE(PG8_SB(1, 1), cB + hB + kstep, voffB);
        PG8_WAIT_V(6); PG8_BAR;
    }
    for (;;) {
        const bool has_next = S.next(ui + 1, nxt);
        const char* nA = has_next ? (const char*)g.A + (size_t)nxt.pm * tA : cA; const char* nB = has_next ? (const char*)g.Bt + (size_t)nxt.pn * tB : cB;
        for (int t = 0; t < nt; t += 2) {
            const bool last = (t == nt - 2);
            const char* a1 = cA + (size_t)(t + 1) * kstep;
            const char* a2 = last ? nA : cA + (size_t)(t + 2) * kstep; const char* b2 = last ? nB : cB + (size_t)(t + 2) * kstep;
            const char* a3 = a2 + kstep; const char* b3 = b2 + kstep;
            if (last && has_next) S.a_ready(nxt);
            if constexpr (SP2) {
            PG8_LDB(B0, 0, 0); PG8_LDB(B1, 0, 1); PG8_SCHED; PG8_LDA(At, 0, 0); PG8_STAGE(PG8_SA(1, 1), a1 + hA, voffA);
            PG8_WAIT_V(8); PG8_WAIT_L(0); PG8_BAR; PG8_MMA(0, 0, At, B0); PG8_MMA(0, 1, At, B1); PG8_BAR; PG8_SCHED;
            PG8_LDA(At, 0, 1); PG8_STAGE(PG8_SB(0, 0), b2, voffB); PG8_STAGE(PG8_SB(0, 1), b2 + hB, voffB); PG8_STAGE(PG8_SA(0, 0), a2, voffA);
            PG8_WAIT_V(8); PG8_WAIT_L(0); PG8_BAR; PG8_MMA(1, 0, At, B0); PG8_MMA(1, 1, At, B1); PG8_BAR; PG8_SCHED;
            PG8_LDB(B0, 1, 0); PG8_LDB(B1, 1, 1); PG8_SCHED; PG8_LDA(At, 1, 0); PG8_STAGE(PG8_SA(0, 1), a2 + hA, voffA);
            PG8_WAIT_V(8); PG8_WAIT_L(0); PG8_BAR; PG8_MMA(0, 0, At, B0); PG8_MMA(0, 1, At, B1); PG8_BAR; PG8_SCHED;
            PG8_LDA(At, 1, 1); PG8_STAGE(PG8_SB(1, 0), b3, voffB); PG8_STAGE(PG8_SB(1, 1), b3 + hB, voffB); PG8_STAGE(PG8_SA(1, 0), a3, voffA);
            PG8_WAIT_V(8); PG8_WAIT_L(0); PG8_BAR; PG8_MMA(1, 0, At, B0); PG8_MMA(1, 1, At, B1); PG8_BAR; PG8_SCHED;
            } else {
            PG8_LDB(B0, 0, 0); PG8_SCHED; PG8_LDA(At, 0, 0); PG8_STAGE(PG8_SA(1, 1), a1 + hA, voffA);
            PG8_WAIT_L(8); PG8_BAR; PG8_WAIT_L(0); PG8_MMA(0, 0, At, B0); PG8_BAR; PG8_SCHED;
            PG8_LDB(B1, 0, 1); PG8_STAGE(PG8_SB(0, 0), b2, voffB);
            PG8_BAR; PG8_WAIT_L(0); PG8_MMA(0, 1, At, B1); PG8_BAR;
            PG8_LDA(At, 0, 1); PG8_STAGE(PG8_SA(0, 0), a2, voffA);
            PG8_BAR; PG8_WAIT_L(0); PG8_MMA(1, 0, At, B0); PG8_BAR; PG8_SCHED;
            PG8_STAGE(PG8_SB(0, 1), b2 + hB, voffB);
            PG8_WAIT_V(6); PG8_BAR; PG8_MMA(1, 1, At, B1); PG8_BAR;
            PG8_LDB(B0, 1, 0); PG8_SCHED; PG8_LDA(At, 1, 0); PG8_STAGE(PG8_SA(0, 1), a2 + hA, voffA);
            PG8_WAIT_L(8); PG8_BAR; PG8_WAIT_L(0); PG8_MMA(0, 0, At, B0); PG8_BAR; PG8_SCHED;
            PG8_LDB(B1, 1, 1); PG8_STAGE(PG8_SB(1, 0), b3, voffB);
            PG8_BAR; PG8_WAIT_L(0); PG8_MMA(0, 1, At, B1); PG8_BAR;
            PG8_LDA(At, 1, 1); PG8_STAGE(PG8_SA(1, 0), a3, voffA);
            PG8_BAR; PG8_WAIT_L(0); PG8_MMA(1, 0, At, B0); PG8_BAR; PG8_SCHED;
            PG8_STAGE(PG8_SB(1, 1), b3 + hB, voffB);
            PG8_WAIT_V(6); PG8_BAR; PG8_MMA(1, 1, At, B1); PG8_BAR;
            }
        }
        if constexpr (ALIGN_EPI) { if (wr == 0) PG8_BAR; }
        if constexpr (!Epi::AFTER_DRAIN) { E(acc, cur, wr, wc, fr, fq); S.done(cur); }
        if (!has_next) break;
#pragma unroll
        for (int a = 0; a < 2; ++a)
#pragma unroll
            for (int b = 0; b < 2; ++b)
#pragma unroll
                for (int m = 0; m < 4; ++m)
#pragma unroll
                    for (int n = 0; n < 2; ++n) acc[a][b][m][n] = (f32x4){0.f, 0.f, 0.f, 0.f};
        cur = nxt; cA = nA; cB = nB; ++ui;
        if constexpr (ALIGN_EPI) { if (wr == 1) PG8_BAR; }
    }
    PG8_WAIT_V(0);
    if constexpr (!ALIGN_EPI) { if (wr == 0) PG8_BAR; }
    PG8_BAR;
    if constexpr (Epi::AFTER_DRAIN) { E.fused(acc, cur, wr, wc, fr, fq, lds, wid, lane); S.done(cur); }
#undef PG8_SA
#undef PG8_SB
#undef PG8_STAGE
#undef PG8_LDA
#undef PG8_LDB
#undef PG8_MMA
#undef PG8_WAIT_V
#undef PG8_WAIT_L
#undef PG8_BAR
#undef PG8_SCHED
}
}
namespace pg8 {
template <int N> __device__ __forceinline__ float row_ror(float v) {
    const int iv = __builtin_bit_cast(int, v);
    const int a = __builtin_amdgcn_update_dpp(0, iv, 0x110 + N, 0xf, 0xf, true);
    const int b = __builtin_amdgcn_update_dpp(0, iv, 0x100 + (16 - N), 0xf, 0xf, true);
    return __builtin_bit_cast(float, a | b);
}
}
namespace pg8 {
struct EpiRes {
    static constexpr bool PERM = false, AFTER_DRAIN = false;
    const float* base; float* out; int ldc;
    __device__ __forceinline__ void operator()(const f32x4 (&acc)[2][2][4][2], const Unit& u, int wr, int wc, int fr, int fq) const {
        const int col0 = u.pn * BM + wc * 32 + 4 * fq;
#pragma unroll
        for (int ai = 0; ai < 2; ++ai)
#pragma unroll
            for (int m = 0; m < 4; ++m) { const size_t off = (size_t)(u.pm * BM + ai * HALF + wr * 64 + m * 16 + fr) * ldc + col0;
#pragma unroll
                for (int bj = 0; bj < 2; ++bj)
#pragma unroll
                    for (int n = 0; n < 2; ++n) { const f32x4 b = *(const f32x4*)(base + off + bj * HALF + n * 16); *(f32x4*)(out + off + bj * HALF + n * 16) = b + acc[ai][bj][m][n]; } }
    }
};
struct EpiConvGlu {
    static constexpr bool PERM = false, AFTER_DRAIN = false;
    bf16_t* O; const float* cw; const float* cb; int M;
    __device__ __forceinline__ void operator()(const f32x4 (&acc)[2][2][4][2], const Unit& u, int wr, int wc, int fr, int fq) const {
        const int lane = fq * 16 + fr;
        const int src1 = fq * 16 + ((fr + 15) & 15), src2 = fq * 16 + ((fr + 14) & 15);
#pragma unroll
        for (int ai = 0; ai < 2; ++ai) {
            const int pb = 248 * u.pm + 62 * (2 * ai + wr) - 2;
#pragma unroll
            for (int n = 0; n < 2; ++n) {
                const int jg = 128 * u.pn + 32 * wc + 16 * n + 4 * fq;
                const f32x4 g0 = *(const f32x4*)(cw + jg), g1 = *(const f32x4*)(cw + 5632 + jg), g2 = *(const f32x4*)(cw + 2 * 5632 + jg), gb = *(const f32x4*)(cb + jg);
                const f32x4 v0 = *(const f32x4*)(cw + 2816 + jg), v1 = *(const f32x4*)(cw + 5632 + 2816 + jg), v2 = *(const f32x4*)(cw + 2 * 5632 + 2816 + jg), vb = *(const f32x4*)(cb + 2816 + jg);
                f32x4 pg1, pg2, pv1, pv2;
#pragma unroll
                for (int m = 0; m < 4; ++m) {
                    f32x4 zg = acc[ai][0][m][n], zv = acc[ai][1][m][n];
                    const int pos = pb + 16 * m + fr;
                    if (pos < 0) { zg = (f32x4){0.f, 0.f, 0.f, 0.f}; zv = zg; }
                    f32x4 rg1, rg2, rv1, rv2;
#pragma unroll
                    for (int e = 0; e < 4; ++e) { rg1[e] = row_ror<1>(zg[e]); rg2[e] = row_ror<2>(zg[e]); rv1[e] = row_ror<1>(zv[e]); rv2[e] = row_ror<2>(zv[e]); }
                    f32x4 zg1, zg2, zv1, zv2;
                    if (m == 0) { zg1 = rg1; zg2 = rg2; zv1 = rv1; zv2 = rv2; }
                    else {
#pragma unroll
                        for (int e = 0; e < 4; ++e) { zg1[e] = fr >= 1 ? rg1[e] : pg1[e]; zg2[e] = fr >= 2 ? rg2[e] : pg2[e]; zv1[e] = fr >= 1 ? rv1[e] : pv1[e]; zv2[e] = fr >= 2 ? rv2[e] : pv2[e]; }
                    }
                    pg1 = rg1; pg2 = rg2; pv1 = rv1; pv2 = rv2;
                    const f32x4 cg = g0 * zg2 + g1 * zg1 + g2 * zg + gb;
                    const f32x4 cv = v0 * zv2 + v1 * zv1 + v2 * zv + vb;
                    f32x4 a;
#pragma unroll
                    for (int e = 0; e < 4; ++e) a[e] = cg[e] / (1.0f + __expf(-cg[e])) * cv[e];
                    if ((16 * m + fr) >= 2 && pos < M) {
                        typedef unsigned u32x2 __attribute__((ext_vector_type(2)));
                        u32x2 w; w.x = cvt_pk_bf16(a[0], a[1]); w.y = cvt_pk_bf16(a[2], a[3]);
                        *(u32x2*)(O + (size_t)pos * 2816 + jg) = w;
                    }
                }
            }
        }
        (void)lane;
    }
};
}
#define LAS __attribute__((address_space(3)))
typedef unsigned short bf16;
typedef float f32x4 __attribute__((ext_vector_type(4)));
typedef short bf16x8 __attribute__((ext_vector_type(8)));
typedef unsigned v4u __attribute__((ext_vector_type(4)));
typedef unsigned v2u __attribute__((ext_vector_type(2)));
constexpr int NWAVES = 8;
constexpr int M = 16384, D = 1024, EIN = 2816, FF = 2816, FF2 = 5632, NQKV = 3072, BW = 512;
constexpr size_t MiB = 1u << 20;
constexpr size_t WS_W2T = 1 * MiB, WS_A2T = WS_W2T + 65536, WS_G2T = WS_A2T + 65536, WS_BS = WS_G2T + 131072;
constexpr size_t WS_WA = 2 * MiB, WS_WB = 13 * MiB, WS_XN = 20 * MiB, WS_GEN = 52 * MiB, WS_END = 256 * MiB;
constexpr size_t WS_P = WS_GEN, WS_LD = WS_GEN + 88 * MiB, WS_KK = WS_LD + 32 * MiB, WS_BB = WS_KK + 16 * MiB, WS_KP = WS_BB + 16 * MiB, WS_RR = WS_KP + 16 * MiB, WS_VV = WS_RR + 16 * MiB;
static_assert(WS_VV + 16 * MiB <= WS_END, "ws map");
constexpr size_t WS_QKV = WS_GEN, WS_VT1 = WS_GEN + 96 * MiB, WS_VT4 = WS_VT1 + 32 * MiB, WS_VT16 = WS_VT4 + 32 * MiB;
static_assert(WS_VT16 + 33 * MiB <= WS_END, "ws map");
constexpr int LDS_BYTES = 147456;

__device__ __forceinline__ float bf2f(unsigned short v) { return __uint_as_float(((unsigned)v) << 16); }
typedef float f32x2_t __attribute__((ext_vector_type(2))); typedef __bf16 bf16x2_t __attribute__((ext_vector_type(2)));
__device__ __forceinline__ unsigned pk2(float lo, float hi) { f32x2_t v = {lo, hi}; bf16x2_t b = __builtin_convertvector(v, bf16x2_t); return __builtin_bit_cast(unsigned, b); }
__device__ __forceinline__ unsigned f2bf(float f) { return pk2(f, f) & 0xffffu; }
__device__ __forceinline__ float wave_sum(float v) {
#pragma unroll
    for (int o = 1; o < 64; o <<= 1) v += __shfl_xor(v, o);
    return v;
}
__device__ __forceinline__ float dpp_row_shr(float v, int n) {
    const int iv = __builtin_bit_cast(int, v); int r;
    switch (n) { case 1: r = __builtin_amdgcn_update_dpp(0, iv, 0x111, 0xf, 0xf, true); break; case 2: r = __builtin_amdgcn_update_dpp(0, iv, 0x112, 0xf, 0xf, true); break;
                 case 4: r = __builtin_amdgcn_update_dpp(0, iv, 0x114, 0xf, 0xf, true); break; default: r = __builtin_amdgcn_update_dpp(0, iv, 0x118, 0xf, 0xf, true); break; }
    return __builtin_bit_cast(float, r);
}
__device__ __forceinline__ float wave_sum_uniform(float v) {
    v += dpp_row_shr(v, 1); v += dpp_row_shr(v, 2); v += dpp_row_shr(v, 4); v += dpp_row_shr(v, 8);
    v += __builtin_bit_cast(float, __builtin_amdgcn_update_dpp(0, __builtin_bit_cast(int, v), 0x142, 0xa, 0xf, false));
    v += __builtin_bit_cast(float, __builtin_amdgcn_update_dpp(0, __builtin_bit_cast(int, v), 0x143, 0xc, 0xf, false));
    return __builtin_bit_cast(float, __builtin_amdgcn_readlane(__builtin_bit_cast(int, v), 63));
}
#define MFMA16(a, b, c) __builtin_amdgcn_mfma_f32_16x16x32_bf16((a), (b), (c), 0, 0, 0)

__device__ __forceinline__ void transpose_item(const float* W, int K, int N, bf16* WT, LAS float* scr, int item, int lane) {
    const int nblk = N / 32, kb = item / nblk, nb = item % nblk, k0 = 64 * kb, n0 = 32 * nb;
#pragma unroll 8
    for (int i = 0; i < 32; ++i) { const int kk = 2 * i + (lane >> 5); scr[kk * 33 + (lane & 31)] = W[(size_t)(k0 + kk) * N + n0 + (lane & 31)]; }
    asm volatile("s_waitcnt lgkmcnt(0)" ::: "memory");
    const int c = lane & 7;
#pragma unroll
    for (int j = 0; j < 4; ++j) { const int n = (lane >> 3) + 8 * j; const LAS float* s = scr + (8 * c) * 33 + n;
        v4u o; o.x = pk2(s[0 * 33], s[1 * 33]); o.y = pk2(s[2 * 33], s[3 * 33]); o.z = pk2(s[4 * 33], s[5 * 33]); o.w = pk2(s[6 * 33], s[7 * 33]);
        *(v4u*)(WT + (size_t)(n0 + n) * K + k0 + 8 * c) = o; }
    asm volatile("s_waitcnt lgkmcnt(0)" ::: "memory");
}
__device__ __forceinline__ void rms_row_to_bf16(const float* xrow, const float* gain, bf16* orow, int lane) {
    const f32x4* xr = (const f32x4*)xrow + lane; const f32x4* gr = (const f32x4*)gain + lane;
    f32x4 v[4]; float s = 0.f;
#pragma unroll
    for (int j = 0; j < 4; ++j) { v[j] = xr[64 * j]; s += (v[j].x * v[j].x + v[j].y * v[j].y) + (v[j].z * v[j].z + v[j].w * v[j].w); }
    const float rstd = 1.0f / sqrtf(wave_sum(s) * (1.f / D) + 1e-6f);
    v2u* o8 = (v2u*)orow + lane;
#pragma unroll
    for (int j = 0; j < 4; ++j) { const f32x4 g = gr[64 * j]; v2u w; w.x = pk2(v[j].x * rstd * g.x, v[j].y * rstd * g.y); w.y = pk2(v[j].z * rstd * g.z, v[j].w * rstd * g.w); o8[64 * j] = w; }
}
__device__ __forceinline__ void rms_row_inplace(float* xrow, const float* gain, int lane) {
    f32x4* xr = (f32x4*)xrow + lane; const f32x4* gr = (const f32x4*)gain + lane;
    f32x4 v[4]; float s = 0.f;
#pragma unroll
    for (int j = 0; j < 4; ++j) { v[j] = xr[64 * j]; s += (v[j].x * v[j].x + v[j].y * v[j].y) + (v[j].z * v[j].z + v[j].w * v[j].w); }
    const float rstd = 1.0f / sqrtf(wave_sum(s) * (1.f / D) + 1e-6f);
#pragma unroll
    for (int j = 0; j < 4; ++j) { const f32x4 g = gr[64 * j]; xr[64 * j] = v[j] * rstd * g; }
}
__device__ __forceinline__ void norm_phase(LAS unsigned char* lds, int gw, int NGW, int wave, int lane, const float* x, const float* gain, bf16* XN,
                                           const float* W1, int K1, int N1, bf16* W1t, const float* W2, int K2, int N2, bf16* W2t) {
    LAS float* scr = (LAS float*)(lds + wave * 16384);
    const int I1 = (K1 / 64) * (N1 / 32), I2 = (K2 / 64) * (N2 / 32);
    for (int it = gw; it < I1 + I2; it += NGW) {
        if (it < I1) transpose_item(W1, K1, N1, W1t, scr, it, lane); else transpose_item(W2, K2, N2, W2t, scr, it - I1, lane);
    }
    for (int m = gw; m < M; m += NGW) rms_row_to_bf16(x + (size_t)m * D, gain, XN + (size_t)m * D, lane);
}

__device__ __forceinline__ void gmlp_item(LAS unsigned char* lds, int item, int tid, int wave, int lane, const bf16* P, const float* ln_g, const float* ln_b,
                                          const float* w_s, const float* b_s, bf16* Y) {
    const int chunk = item >> 2, g = item & 3, t0 = chunk * 128;
    LAS bf16* Wm = (LAS bf16*)lds;
    LAS bf16* Vt = (LAS bf16*)(lds + 128 * 136 * 2);
    for (int i = 0; i < 16; ++i) {
        const int s = wave * 16 + i;
        const v4u raw = *(const v4u*)(P + (size_t)(t0 + s) * EIN + 512 + lane * 8);
        float v[8];
        v[0] = __uint_as_float(raw.x << 16); v[1] = __uint_as_float(raw.x & 0xffff0000u); v[2] = __uint_as_float(raw.y << 16); v[3] = __uint_as_float(raw.y & 0xffff0000u);
        v[4] = __uint_as_float(raw.z << 16); v[5] = __uint_as_float(raw.z & 0xffff0000u); v[6] = __uint_as_float(raw.w << 16); v[7] = __uint_as_float(raw.w & 0xffff0000u);
        float sum = 0.f;
#pragma unroll
        for (int e = 0; e < 8; ++e) sum += v[e];
        const float mean = wave_sum(sum) * (1.f / 512.f);
        float q = 0.f;
#pragma unroll
        for (int e = 0; e < 8; ++e) { v[e] -= mean; q += v[e] * v[e]; }
        const float rstd = 1.0f / sqrtf(wave_sum(q) * (1.f / 512.f) + 1e-5f);
        if ((lane >> 4) == g) {
#pragma unroll
            for (int e = 0; e < 8; ++e) { const int c = (lane & 15) * 8 + e, ch = g * 128 + c; Vt[c * 136 + s] = (bf16)f2bf(v[e] * rstd * ln_g[ch] + ln_b[ch]); }
        }
    }
    for (int idx = tid; idx < 128 * 32; idx += 512) {
        const int t = idx >> 5, s4 = (idx & 31) * 4;
        const f32x4 w = *(const f32x4*)(w_s + ((size_t)g * 128 + t) * 128 + s4);
        v2u o; o.x = pk2(s4 + 0 <= t ? w.x : 0.f, s4 + 1 <= t ? w.y : 0.f); o.y = pk2(s4 + 2 <= t ? w.z : 0.f, s4 + 3 <= t ? w.w : 0.f);
        *(LAS v2u*)(Wm + t * 136 + s4) = o;
    }
    __syncthreads();
    const int r = lane & 15, q4 = lane >> 4;
    f32x4 acc[8];
#pragma unroll
    for (int ct = 0; ct < 8; ++ct) acc[ct] = (f32x4){0.f, 0.f, 0.f, 0.f};
    const int nks = (16 * wave + 15) / 32 + 1;
    for (int ks = 0; ks < nks; ++ks) {
        const bf16x8 af = *(const LAS bf16x8*)(Wm + (16 * wave + r) * 136 + ks * 32 + q4 * 8);
#pragma unroll
        for (int ct = 0; ct < 8; ++ct) { const bf16x8 bfr = *(const LAS bf16x8*)(Vt + (16 * ct + r) * 136 + ks * 32 + q4 * 8); acc[ct] = MFMA16(af, bfr, acc[ct]); }
    }
#pragma unroll
    for (int ct = 0; ct < 8; ++ct)
#pragma unroll
        for (int e = 0; e < 4; ++e) {
            const int t = 16 * wave + 4 * q4 + e, c = 16 * ct + r;
            const float mixed = acc[ct][e] + b_s[g * 128 + t];
            const float u = bf2f(P[(size_t)(t0 + t) * EIN + g * 128 + c]);
            Y[(size_t)(t0 + t) * D + g * 128 + c] = (bf16)f2bf(u * mixed);
        }
    __syncthreads();
}

struct RwkvW { const float *mu, *w0, *a0, *k_k, *k_a, *r_k; const bf16 *w2t, *a2t, *g2t; };
__device__ __forceinline__ float shifted(const bf16* P, int t, int col, float mu) {
    const float cur = bf2f(P[(size_t)t * EIN + col]); const float prev = t > 0 ? bf2f(P[(size_t)(t - 1) * EIN + col]) : 0.f; return cur + (prev - cur) * mu;
}
__device__ __forceinline__ void rwkv_prep_item(LAS unsigned char* lds, int item, int tid, int wave, int lane, const bf16* P, const RwkvW& W,
                                               float* LD, bf16* KK, bf16* BB, bf16* KP, bf16* RR, bf16* VV, bf16* GG, float* BS) {
    const int t0 = item * 64;
    LAS bf16* Xl = (LAS bf16*)lds;
    for (int idx = tid; idx < 64 * 256; idx += 512) {
        const int t = idx >> 8, j = idx & 255;
        const float ps = shifted(P, t0 + t, 1024 + 1536 + j, W.mu[1536 + j]);
        const float val = j < 64 ? tanhf(ps) : (j < 128 ? ps : 1.0f / (1.0f + __expf(-ps)));
        Xl[t * 264 + j] = (bf16)f2bf(val);
    }
    __syncthreads();
    const int h = wave, r = lane & 15, q4 = lane >> 4;
    for (int tt = 0; tt < 4; ++tt) {
        f32x4 aW[4], aA[4], aG[4];
#pragma unroll
        for (int ct = 0; ct < 4; ++ct) { aW[ct] = (f32x4){0.f, 0.f, 0.f, 0.f}; aA[ct] = aW[ct]; aG[ct] = aW[ct]; }
#pragma unroll
        for (int ks = 0; ks < 2; ++ks) {
            const bf16x8 xw = *(const LAS bf16x8*)(Xl + (16 * tt + r) * 264 + ks * 32 + q4 * 8);
            const bf16x8 xa = *(const LAS bf16x8*)(Xl + (16 * tt + r) * 264 + 64 + ks * 32 + q4 * 8);
#pragma unroll
            for (int ct = 0; ct < 4; ++ct) {
                const bf16x8 yw = *(const bf16x8*)(W.w2t + (size_t)(h * 64 + 16 * ct + r) * 64 + ks * 32 + q4 * 8);
                const bf16x8 ya = *(const bf16x8*)(W.a2t + (size_t)(h * 64 + 16 * ct + r) * 64 + ks * 32 + q4 * 8);
                aW[ct] = MFMA16(xw, yw, aW[ct]); aA[ct] = MFMA16(xa, ya, aA[ct]);
            }
        }
#pragma unroll
        for (int ks = 0; ks < 4; ++ks) {
            const bf16x8 xg = *(const LAS bf16x8*)(Xl + (16 * tt + r) * 264 + 128 + ks * 32 + q4 * 8);
#pragma unroll
            for (int ct = 0; ct < 4; ++ct) {
                const bf16x8 yg = *(const bf16x8*)(W.g2t + (size_t)(h * 64 + 16 * ct + r) * 128 + ks * 32 + q4 * 8);
                aG[ct] = MFMA16(xg, yg, aG[ct]);
            }
        }
#pragma unroll
        for (int e = 0; e < 4; ++e) {
            const int t = t0 + 16 * tt + 4 * q4 + e;
            float kkr[4], av[4]; float ss = 0.f, bon = 0.f;
#pragma unroll
            for (int ct = 0; ct < 4; ++ct) {
                const int c = h * 64 + 16 * ct + r;
                const float r_ = shifted(P, t, 1024 + c, W.mu[c]);
                const float k_ = shifted(P, t, 1024 + 512 + c, W.mu[512 + c]);
                const float v_ = shifted(P, t, 1024 + 1024 + c, W.mu[1024 + c]);
                const float xw = -(W.w0[c] + aW[ct][e]);
                const float sp = xw > 20.f ? xw : log1pf(__expf(xw));
                const float wv = -sp - 0.5f;
                const float ld = -__expf(wv);
                const float a = 1.0f / (1.0f + __expf(-(W.a0[c] + aA[ct][e])));
                const float kr = k_ * W.k_k[c];
                const float kp = k_ * (1.0f + (a - 1.0f) * W.k_a[c]);
                kkr[ct] = kr; av[ct] = a; ss += kr * kr; bon += r_ * kp * W.r_k[c];
                const size_t o = (size_t)t * BW + c;
                LD[o] = ld; KP[o] = (bf16)f2bf(kp); RR[o] = (bf16)f2bf(r_); VV[o] = (bf16)f2bf(v_); GG[o] = (bf16)f2bf(aG[ct][e]);
            }
#pragma unroll
            for (int o = 1; o < 16; o <<= 1) { ss += __shfl_xor(ss, o); bon += __shfl_xor(bon, o); }
            const float inv = 1.0f / sqrtf(fmaxf(ss, 1e-24f));
#pragma unroll
            for (int ct = 0; ct < 4; ++ct) {
                const int c = h * 64 + 16 * ct + r; const size_t o = (size_t)t * BW + c;
                const float kk = kkr[ct] * inv;
                KK[o] = (bf16)f2bf(kk); BB[o] = (bf16)f2bf(kk * av[ct]);
            }
            if (r == 0) BS[(size_t)t * 8 + h] = bon;
        }
    }
    __syncthreads();
}

struct ScanRegs { unsigned short kk[8], bb[8], kp[8], rr[8], vv[8]; float ld[8]; };
__device__ __forceinline__ void scan_load(ScanRegs& R, int t0, int hc, int hv, const float* LD, const bf16* KK, const bf16* BB, const bf16* KP, const bf16* RR, const bf16* VV) {
#pragma unroll
    for (int i = 0; i < 8; ++i) { const size_t o = (size_t)(t0 + i) * BW;
        R.kk[i] = KK[o + hc]; R.bb[i] = BB[o + hc]; R.kp[i] = KP[o + hc]; R.rr[i] = RR[o + hc]; R.ld[i] = LD[o + hc]; R.vv[i] = VV[o + hv]; }
}
__device__ __forceinline__ void rwkv_scan_wave(int gwv, int lane, const float* LD, const bf16* KK, const bf16* BB, const bf16* KP, const bf16* RR, const bf16* VV, float* OSC) {
    const int h = gwv >> 6, v = gwv & 63, hc = h * 64 + lane, hv = h * 64 + v;
    float S = 0.f;
    ScanRegs cur, nxt;
    scan_load(cur, 0, hc, hv, LD, KK, BB, KP, RR, VV);
    for (int t0 = 0; t0 < M; t0 += 8) {
        const int tn = (t0 + 8 < M) ? t0 + 8 : t0;
        scan_load(nxt, tn, hc, hv, LD, KK, BB, KP, RR, VV);
#pragma unroll
        for (int i = 0; i < 8; ++i) {
            const float kk = bf2f(cur.kk[i]), bb = bf2f(cur.bb[i]), kp = bf2f(cur.kp[i]), rr = bf2f(cur.rr[i]), vv = bf2f(cur.vv[i]);
            const float dec = __expf(cur.ld[i]);
            const float sa = wave_sum_uniform(S * kk);
            S = S * dec - sa * bb + vv * kp;
            const float o = wave_sum_uniform(S * rr);
            if (lane == 0) OSC[(size_t)(t0 + i) * BW + hv] = o;
        }
        cur = nxt;
    }
}
__device__ __forceinline__ void rwkv_out_row(int t, int lane, const float* OSC, const float* BS, const bf16* VV, const bf16* GG, const float* gn_g, const float* gn_b, bf16* Y) {
    const int c0 = lane * 8;
    const f32x4 o0 = *(const f32x4*)(OSC + (size_t)t * BW + c0), o1 = *(const f32x4*)(OSC + (size_t)t * BW + c0 + 4);
    float v[8] = {o0.x, o0.y, o0.z, o0.w, o1.x, o1.y, o1.z, o1.w};
    float s = 0.f;
#pragma unroll
    for (int e = 0; e < 8; ++e) s += v[e];
    s += __shfl_xor(s, 1); s += __shfl_xor(s, 2); s += __shfl_xor(s, 4);
    const float mean = s * (1.f / 64.f);
    float q = 0.f;
#pragma unroll
    for (int e = 0; e < 8; ++e) { v[e] -= mean; q += v[e] * v[e]; }
    q += __shfl_xor(q, 1); q += __shfl_xor(q, 2); q += __shfl_xor(q, 4);
    const float rstd = 1.0f / sqrtf(q * (1.f / 64.f) + 64e-5f);
    const float bon = BS[(size_t)t * 8 + (lane >> 3)];
    const v4u vraw = *(const v4u*)(VV + (size_t)t * BW + c0), graw = *(const v4u*)(GG + (size_t)t * BW + c0);
    const unsigned vr[4] = {vraw.x, vraw.y, vraw.z, vraw.w}, gr[4] = {graw.x, graw.y, graw.z, graw.w};
    float outv[8];
#pragma unroll
    for (int e = 0; e < 8; ++e) {
        const float vv = (e & 1) ? __uint_as_float(vr[e >> 1] & 0xffff0000u) : __uint_as_float(vr[e >> 1] << 16);
        const float gg = (e & 1) ? __uint_as_float(gr[e >> 1] & 0xffff0000u) : __uint_as_float(gr[e >> 1] << 16);
        outv[e] = (v[e] * rstd * gn_g[c0 + e] + gn_b[c0 + e] + bon * vv) * gg;
    }
    v4u w; w.x = pk2(outv[0], outv[1]); w.y = pk2(outv[2], outv[3]); w.z = pk2(outv[4], outv[5]); w.w = pk2(outv[6], outv[7]);
    *(v4u*)(Y + (size_t)t * D + 512 + c0) = w;
}

__device__ __forceinline__ void vtrans_item(LAS unsigned char* lds, int item, int tid, const bf16* QKV, bf16* VT1, bf16* VT4, bf16* VT16) {
    const int h = item >> 6, blk = item & 63, t0 = blk * 256;
    LAS bf16* Vl = (LAS bf16*)lds;
#pragma unroll
    for (int i = 0; i < 4; ++i) { const int idx = tid + 512 * i, t = idx >> 3, ch = idx & 7;
        *(LAS v4u*)(Vl + t * 72 + ch * 8) = *(const v4u*)(QKV + (size_t)(t0 + t) * NQKV + 2048 + h * 64 + ch * 8); }
    __syncthreads();
#pragma unroll
    for (int i = 0; i < 4; ++i) {
        const int idx = tid + 512 * i, d = idx >> 5;
        { const int j = idx & 31; unsigned short e[8];
#pragma unroll
          for (int k = 0; k < 8; ++k) e[k] = Vl[(8 * j + k) * 72 + d];
          v4u o; o.x = e[0] | ((unsigned)e[1] << 16); o.y = e[2] | ((unsigned)e[3] << 16); o.z = e[4] | ((unsigned)e[5] << 16); o.w = e[6] | ((unsigned)e[7] << 16);
          *(v4u*)(VT1 + (size_t)(h * 64 + d) * 16384 + t0 + 8 * j) = o; }
        { const int c4 = (idx >> 3) & 3, j = idx & 7; unsigned short e[8];
#pragma unroll
          for (int k = 0; k < 8; ++k) e[k] = Vl[(4 * (8 * j + k) + c4) * 72 + d];
          v4u o; o.x = e[0] | ((unsigned)e[1] << 16); o.y = e[2] | ((unsigned)e[3] << 16); o.z = e[4] | ((unsigned)e[5] << 16); o.w = e[6] | ((unsigned)e[7] << 16);
          *(v4u*)(VT4 + ((size_t)(h * 64 + d) * 4 + c4) * 4096 + t0 / 4 + 8 * j) = o; }
        { const int c16 = (idx >> 1) & 15, j = idx & 1; unsigned short e[8];
#pragma unroll
          for (int k = 0; k < 8; ++k) e[k] = Vl[(16 * (8 * j + k) + c16) * 72 + d];
          v4u o; o.x = e[0] | ((unsigned)e[1] << 16); o.y = e[2] | ((unsigned)e[3] << 16); o.z = e[4] | ((unsigned)e[5] << 16); o.w = e[6] | ((unsigned)e[7] << 16);
          *(v4u*)(VT16 + ((size_t)(h * 64 + d) * 16 + c16) * 1024 + t0 / 16 + 8 * j) = o; }
    }
    __syncthreads();
}

struct AttnFrags { bf16x8 ka0, ka1, kb0, kb1, vf[4]; };
template <int DIL>
__device__ __forceinline__ void attn_load(AttnFrags& f, const bf16* Kb, const bf16* VT, int h, int cp, int nb, int kA, int r, int q4) {
    constexpr int TD = M / DIL;
    int posA = cp + DIL * (nb + kA), posB = posA + 4 * DIL;
    posA = posA < 0 ? 0 : (posA > M - 1 ? M - 1 : posA); posB = posB < 0 ? 0 : (posB > M - 1 ? M - 1 : posB);
    f.ka0 = *(const bf16x8*)(Kb + (size_t)posA * NQKV); f.ka1 = *(const bf16x8*)(Kb + (size_t)posA * NQKV + 32);
    f.kb0 = *(const bf16x8*)(Kb + (size_t)posB * NQKV); f.kb1 = *(const bf16x8*)(Kb + (size_t)posB * NQKV + 32);
    int nv = nb + 8 * q4; nv = nv < 0 ? 0 : (nv > TD - 8 ? TD - 8 : nv);
#pragma unroll
    for (int dt = 0; dt < 4; ++dt) f.vf[dt] = *(const bf16x8*)(VT + ((size_t)(h * 64 + 16 * dt + r) * DIL + cp) * TD + nv);
}
__device__ __forceinline__ void attn_group(const AttnFrags& f, int nb, int nlo, int nhi, int q4, const bf16x8 (&qf)[2], f32x4 (&o)[4], float& lrun) {
    const float C = 0.125f * 1.4426950408889634f;
    f32x4 sA = (f32x4){0.f, 0.f, 0.f, 0.f}, sB = sA;
    sA = MFMA16(f.ka0, qf[0], sA); sA = MFMA16(f.ka1, qf[1], sA);
    sB = MFMA16(f.kb0, qf[0], sB); sB = MFMA16(f.kb1, qf[1], sB);
    float p[8]; float ps = 0.f;
    const int n0 = nb + 8 * q4;
#pragma unroll
    for (int e = 0; e < 8; ++e) {
        const int n = n0 + e;
        const float ex = __builtin_amdgcn_exp2f(fminf((e < 4 ? sA[e & 3] : sB[e & 3]) * C, 100.f));
        p[e] = (n >= nlo && n <= nhi) ? ex : 0.f; ps += p[e];
    }
    lrun += ps;
    v4u pw; pw.x = pk2(p[0], p[1]); pw.y = pk2(p[2], p[3]); pw.z = pk2(p[4], p[5]); pw.w = pk2(p[6], p[7]);
    const bf16x8 pf = __builtin_bit_cast(bf16x8, pw);
#pragma unroll
    for (int dt = 0; dt < 4; ++dt) o[dt] = MFMA16(f.vf[dt], pf, o[dt]);
}
template <int DIL, int NGRP>
__device__ __forceinline__ void attn_pattern(const bf16* QKV, const bf16* VT, int h, int blk, int cls, int lane, const bf16x8 (&qf)[2], f32x4 (&o)[4], float& lrun) {
    const int r = lane & 15, q4 = lane >> 4, m = r;
    const int cp = cls & (DIL - 1);
    const int nq = (256 * blk + cls - cp) / DIL + (16 / DIL) * m;
    const int nstart = (256 * blk) / DIL - 128;
    const int nlo = nq - 128 < 0 ? 0 : nq - 128, nhi = nq;
    const int kA = 8 * (r >> 2) + (r & 3);
    const bf16* Kb = QKV + 1024 + h * 64 + q4 * 8;
    AttnFrags fa, fb;
    attn_load<DIL>(fa, Kb, VT, h, cp, nstart, kA, r, q4);
#pragma unroll 1
    for (int g = 0; g < NGRP; g += 2) {
        if (g + 1 < NGRP) attn_load<DIL>(fb, Kb, VT, h, cp, nstart + 32 * (g + 1), kA, r, q4);
        attn_group(fa, nstart + 32 * g, nlo, nhi, q4, qf, o, lrun);
        if (g + 1 < NGRP) {
            if (g + 2 < NGRP) attn_load<DIL>(fa, Kb, VT, h, cp, nstart + 32 * (g + 2), kA, r, q4);
            attn_group(fb, nstart + 32 * (g + 1), nlo, nhi, q4, qf, o, lrun);
        }
    }
}
__device__ __forceinline__ void attn_wave_item(const bf16* QKV, const bf16* VT1, const bf16* VT4, const bf16* VT16, bf16* AO, int h, int blk, int cls, int lane) {
    const int r = lane & 15, q4 = lane >> 4;
    const int im = 256 * blk + cls + 16 * r;
    bf16x8 qf[2];
    qf[0] = *(const bf16x8*)(QKV + (size_t)im * NQKV + h * 64 + q4 * 8);
    qf[1] = *(const bf16x8*)(QKV + (size_t)im * NQKV + h * 64 + 32 + q4 * 8);
    f32x4 o[4];
#pragma unroll
    for (int dt = 0; dt < 4; ++dt) o[dt] = (f32x4){0.f, 0.f, 0.f, 0.f};
    float lrun = 0.f;
    attn_pattern<1, 12>(QKV, VT1, h, blk, cls, lane, qf, o, lrun);
    attn_pattern<4, 6>(QKV, VT4, h, blk, cls, lane, qf, o, lrun);
    attn_pattern<16, 5>(QKV, VT16, h, blk, cls, lane, qf, o, lrun);
    float l = lrun; l += __shfl_xor(l, 16); l += __shfl_xor(l, 32);
    const float inv = 1.0f / l;
#pragma unroll
    for (int dt = 0; dt < 4; ++dt) {
        v2u w; w.x = pk2(o[dt][0] * inv, o[dt][1] * inv); w.y = pk2(o[dt][2] * inv, o[dt][3] * inv);
        *(v2u*)(AO + (size_t)im * D + h * 64 + 16 * dt + 4 * q4) = w;
    }
}
constexpr int CH_CL = 0, CH_AT = 17408, CH_RT = CH_AT + 9216, CH_BT = CH_RT + 9216, CH_KT = CH_BT + 9216, CH_BHT = CH_KT + 9216, CH_KHT = CH_BHT + 9216, CH_VT = CH_KHT + 9216,
              CH_MABF = CH_VT + 9216, CH_MAK = CH_MABF + 17408, CH_MBR = CH_MAK + 9216, CH_MKR = CH_MBR + 9216, CH_GL = CH_MKR + 9216, CH_MABB = CH_GL + 256, CH_TJ = CH_MABB + 9216, CH_END = CH_TJ + 2048;
static_assert(CH_END <= 147456, "chunk LDS map");
__device__ __forceinline__ void unpack8(const v4u raw, float (&v)[8]) {
    v[0] = __uint_as_float(raw.x << 16); v[1] = __uint_as_float(raw.x & 0xffff0000u); v[2] = __uint_as_float(raw.y << 16); v[3] = __uint_as_float(raw.y & 0xffff0000u);
    v[4] = __uint_as_float(raw.z << 16); v[5] = __uint_as_float(raw.z & 0xffff0000u); v[6] = __uint_as_float(raw.w << 16); v[7] = __uint_as_float(raw.w & 0xffff0000u);
}
__device__ __forceinline__ v4u pack8(const float (&v)[8]) { v4u o; o.x = pk2(v[0], v[1]); o.y = pk2(v[2], v[3]); o.z = pk2(v[4], v[5]); o.w = pk2(v[6], v[7]); return o; }

__device__ __forceinline__ void rwkv_chunk_item(LAS unsigned char* lds, int item, int tid, int wave, int lane, const float* LD, const bf16* KK, const bf16* BB, const bf16* KP, const bf16* RR, const bf16* VV,
                                                bf16* PMT, float* SLOC, bf16* QT, float* OLT) {
    const int c = item >> 3, h = item & 7, t0 = c * 64;
    LAS float* CL = (LAS float*)(lds + CH_CL); LAS float* Y5F = (LAS float*)(lds + CH_CL);
    LAS bf16* AT = (LAS bf16*)(lds + CH_AT); LAS bf16* RT = (LAS bf16*)(lds + CH_RT); LAS bf16* BT = (LAS bf16*)(lds + CH_BT); LAS bf16* KT = (LAS bf16*)(lds + CH_KT);
    LAS bf16* UB = BT; LAS bf16* WB = KT;
    LAS bf16* BHT = (LAS bf16*)(lds + CH_BHT); LAS bf16* KHT = (LAS bf16*)(lds + CH_KHT); LAS bf16* VT = (LAS bf16*)(lds + CH_VT);
    LAS float* MABF = (LAS float*)(lds + CH_MABF); LAS bf16* MAK = (LAS bf16*)(lds + CH_MAK); LAS bf16* MBR = (LAS bf16*)(lds + CH_MBR); LAS bf16* MKR = (LAS bf16*)(lds + CH_MKR);
    LAS float* GL = (LAS float*)(lds + CH_GL); LAS bf16* MABB = (LAS bf16*)(lds + CH_MABB); LAS bf16* TJB = (LAS bf16*)(lds + CH_TJ);
    const size_t gbase = (size_t)t0 * BW + h * 64;
    if (tid < 64) {
        float run = 0.f;
#pragma unroll 8
        for (int t = 0; t < 64; ++t) { run += LD[gbase + (size_t)t * BW + tid]; CL[t * 64 + tid] = run; }
        GL[tid] = __expf(run);
    }
    __syncthreads();
    {
        const int t = tid >> 3, k8 = (tid & 7) * 8; const size_t o = gbase + (size_t)t * BW + k8;
        float kk[8], bb[8], kp[8], rr[8], vv[8];
        unpack8(*(const v4u*)(KK + o), kk); unpack8(*(const v4u*)(BB + o), bb); unpack8(*(const v4u*)(KP + o), kp); unpack8(*(const v4u*)(RR + o), rr); unpack8(*(const v4u*)(VV + o), vv);
        const f32x4 l0 = *(const f32x4*)(LD + o), l1 = *(const f32x4*)(LD + o + 4);
        const float ldv[8] = {l0.x, l0.y, l0.z, l0.w, l1.x, l1.y, l1.z, l1.w};
        float at[8], rt[8], bt[8], kt[8];
#pragma unroll
        for (int e = 0; e < 8; ++e) {
            const float cl = CL[t * 64 + k8 + e], clL = CL[63 * 64 + k8 + e];
            const float en = __expf(-cl), eh = __expf(clL - cl);
            at[e] = -kk[e] * __expf(cl - ldv[e]); rt[e] = rr[e] * __expf(cl); bt[e] = bb[e] * en; kt[e] = kp[e] * en;
            BHT[(k8 + e) * 72 + t] = (bf16)f2bf(bb[e] * eh); KHT[(k8 + e) * 72 + t] = (bf16)f2bf(kp[e] * eh); VT[(k8 + e) * 72 + t] = (bf16)f2bf(vv[e]);
        }
        *(LAS v4u*)(AT + t * 72 + k8) = pack8(at); *(LAS v4u*)(RT + t * 72 + k8) = pack8(rt); *(LAS v4u*)(BT + t * 72 + k8) = pack8(bt); *(LAS v4u*)(KT + t * 72 + k8) = pack8(kt);
    }
    __syncthreads();
    const int r = lane & 15, q4 = lane >> 4, par = wave & 1;
    {
        const int mi = wave >> 1;
        const LAS bf16* X = (mi == 0 || mi == 2) ? BT : KT; const LAS bf16* Y = (mi < 2) ? AT : RT;
        f32x4 acc[2][4];
#pragma unroll
        for (int a = 0; a < 2; ++a)
#pragma unroll
            for (int b = 0; b < 4; ++b) acc[a][b] = (f32x4){0.f, 0.f, 0.f, 0.f};
#pragma unroll
        for (int ks = 0; ks < 2; ++ks) {
            bf16x8 xf[2], yf[4];
#pragma unroll
            for (int a = 0; a < 2; ++a) xf[a] = *(const LAS bf16x8*)(X + (16 * (2 * par + a) + r) * 72 + ks * 32 + q4 * 8);
#pragma unroll
            for (int b = 0; b < 4; ++b) yf[b] = *(const LAS bf16x8*)(Y + (16 * b + r) * 72 + ks * 32 + q4 * 8);
#pragma unroll
            for (int a = 0; a < 2; ++a)
#pragma unroll
                for (int b = 0; b < 4; ++b) acc[a][b] = MFMA16(xf[a], yf[b], acc[a][b]);
        }
#pragma unroll
        for (int a = 0; a < 2; ++a)
#pragma unroll
            for (int b = 0; b < 4; ++b) {
                const int s0 = 16 * (2 * par + a) + 4 * q4, t = 16 * b + r;
                f32x4 m;
#pragma unroll
                for (int e = 0; e < 4; ++e) m[e] = ((mi < 2) ? (s0 + e < t) : (s0 + e <= t)) ? acc[a][b][e] : 0.f;
                if (mi == 0) { *(LAS f32x4*)(MABF + t * 68 + s0) = m; v2u w; w.x = pk2(m[0], m[1]); w.y = pk2(m[2], m[3]); *(LAS v2u*)(MABB + t * 72 + s0) = w; }
                else { LAS bf16* Mo = (mi == 1) ? MAK : (mi == 2 ? MBR : MKR); v2u w; w.x = pk2(m[0], m[1]); w.y = pk2(m[2], m[3]); *(LAS v2u*)(Mo + t * 72 + s0) = w; }
            }
    }
    __syncthreads();
    {
        const int vt = wave >> 1;
        f32x4 acc[2];
        acc[0] = (f32x4){0.f, 0.f, 0.f, 0.f}; acc[1] = acc[0];
#pragma unroll
        for (int ks = 0; ks < 2; ++ks) {
            const bf16x8 xf = *(const LAS bf16x8*)(VT + (16 * vt + r) * 72 + ks * 32 + q4 * 8);
#pragma unroll
            for (int b = 0; b < 2; ++b) { const bf16x8 yf = *(const LAS bf16x8*)(MAK + (16 * (2 * par + b) + r) * 72 + ks * 32 + q4 * 8); acc[b] = MFMA16(xf, yf, acc[b]); }
        }
#pragma unroll
        for (int b = 0; b < 2; ++b)
#pragma unroll
            for (int e = 0; e < 4; ++e) Y5F[(16 * vt + 4 * q4 + e) * 68 + 16 * (2 * par + b) + r] = acc[b][e];
    }
    __syncthreads();
    if (wave == 0) {
        const int J = lane >> 4, i = lane & 15;
        float tr[16];
#pragma unroll
        for (int t = 0; t < 16; ++t) {
            float acc = (t == i) ? 1.f : 0.f;
#pragma unroll
            for (int s2 = 0; s2 < t; ++s2) acc += tr[s2] * MABF[(16 * J + t) * 68 + 16 * J + s2];
            tr[t] = acc;
        }
#pragma unroll
        for (int t = 0; t < 16; ++t) TJB[(16 * J + t) * 16 + i] = (bf16)f2bf(tr[t]);
    }
    __syncthreads();
    {
        unsigned xb[4][2];
#pragma unroll
        for (int J = 0; J < 4; ++J) {
            f32x4 z;
            if (wave < 4) z = *(const LAS f32x4*)(Y5F + (16 * wave + r) * 68 + 16 * J + 4 * q4);
            else {
#pragma unroll
                for (int e = 0; e < 4; ++e) z[e] = bf2f(AT[(16 * J + 4 * q4 + e) * 72 + 16 * (wave - 4) + r]);
            }
#pragma unroll
            for (int I = 0; I < J; I += 2) {
                const bool two = (I + 1 < J);
                const v2u m0 = *(const LAS v2u*)(MABB + (16 * J + r) * 72 + 16 * I + 4 * q4);
                v2u m1; m1.x = 0u; m1.y = 0u;
                if (two) m1 = *(const LAS v2u*)(MABB + (16 * J + r) * 72 + 16 * (I + 1) + 4 * q4);
                v4u fa; fa.x = m0.x; fa.y = m0.y; fa.z = m1.x; fa.w = m1.y;
                v4u fb; fb.x = xb[I][0]; fb.y = xb[I][1]; fb.z = two ? xb[I + 1 < 4 ? I + 1 : 3][0] : 0u; fb.w = two ? xb[I + 1 < 4 ? I + 1 : 3][1] : 0u;
                z = MFMA16(__builtin_bit_cast(bf16x8, fa), __builtin_bit_cast(bf16x8, fb), z);
            }
            const unsigned zh0 = pk2(z[0], z[1]), zh1 = pk2(z[2], z[3]);
            const unsigned zl0 = pk2(z[0] - __uint_as_float(zh0 << 16), z[1] - __uint_as_float(zh0 & 0xffff0000u)), zl1 = pk2(z[2] - __uint_as_float(zh1 << 16), z[3] - __uint_as_float(zh1 & 0xffff0000u));
            const v2u tw = *(const LAS v2u*)(TJB + (16 * J + r) * 16 + 4 * q4);
            v4u ft; ft.x = tw.x; ft.y = tw.y; ft.z = 0u; ft.w = 0u;
            v4u fh; fh.x = zh0; fh.y = zh1; fh.z = 0u; fh.w = 0u;
            v4u fl; fl.x = zl0; fl.y = zl1; fl.z = 0u; fl.w = 0u;
            f32x4 x = (f32x4){0.f, 0.f, 0.f, 0.f};
            x = MFMA16(__builtin_bit_cast(bf16x8, ft), __builtin_bit_cast(bf16x8, fh), x);
            x = MFMA16(__builtin_bit_cast(bf16x8, ft), __builtin_bit_cast(bf16x8, fl), x);
            xb[J][0] = pk2(x[0], x[1]); xb[J][1] = pk2(x[2], x[3]);
            LAS bf16* Xo = (wave < 4) ? (UB + (16 * wave + r) * 72) : (WB + (16 * (wave - 4) + r) * 72);
            v2u w; w.x = xb[J][0]; w.y = xb[J][1];
            *(LAS v2u*)(Xo + 16 * J + 4 * q4) = w;
        }
    }
    __syncthreads();
    {
        const int kind = wave >> 1;
        const LAS bf16* X1; const LAS bf16* Y1; const LAS bf16* X2 = nullptr; const LAS bf16* Y2 = nullptr;
        if (kind == 0) { X1 = UB; Y1 = MBR; X2 = VT; Y2 = MKR; }
        else if (kind == 1) { X1 = BHT; Y1 = UB; X2 = KHT; Y2 = VT; }
        else if (kind == 2) { X1 = WB; Y1 = MBR; }
        else { X1 = WB; Y1 = BHT; }
        f32x4 acc[2][4];
#pragma unroll
        for (int a = 0; a < 2; ++a)
#pragma unroll
            for (int b = 0; b < 4; ++b) acc[a][b] = (f32x4){0.f, 0.f, 0.f, 0.f};
#pragma unroll
        for (int ks = 0; ks < 2; ++ks) {
            bf16x8 xf[2], yf[4];
#pragma unroll
            for (int a = 0; a < 2; ++a) xf[a] = *(const LAS bf16x8*)(X1 + (16 * (2 * par + a) + r) * 72 + ks * 32 + q4 * 8);
#pragma unroll
            for (int b = 0; b < 4; ++b) yf[b] = *(const LAS bf16x8*)(Y1 + (16 * b + r) * 72 + ks * 32 + q4 * 8);
#pragma unroll
            for (int a = 0; a < 2; ++a)
#pragma unroll
                for (int b = 0; b < 4; ++b) acc[a][b] = MFMA16(xf[a], yf[b], acc[a][b]);
        }
        if (kind < 2) {
#pragma unroll
            for (int ks = 0; ks < 2; ++ks) {
                bf16x8 xf[2], yf[4];
#pragma unroll
                for (int a = 0; a < 2; ++a) xf[a] = *(const LAS bf16x8*)(X2 + (16 * (2 * par + a) + r) * 72 + ks * 32 + q4 * 8);
#pragma unroll
                for (int b = 0; b < 4; ++b) yf[b] = *(const LAS bf16x8*)(Y2 + (16 * b + r) * 72 + ks * 32 + q4 * 8);
#pragma unroll
                for (int a = 0; a < 2; ++a)
#pragma unroll
                    for (int b = 0; b < 4; ++b) acc[a][b] = MFMA16(xf[a], yf[b], acc[a][b]);
            }
        }
#pragma unroll
        for (int a = 0; a < 2; ++a)
#pragma unroll
            for (int b = 0; b < 4; ++b) {
                const int i0 = 16 * (2 * par + a) + 4 * q4, j = 16 * b + r;
                if (kind == 0) *(f32x4*)(OLT + ((size_t)item * 64 + j) * 64 + i0) = acc[a][b];
                else if (kind == 1) *(f32x4*)(SLOC + ((size_t)item * 64 + j) * 64 + i0) = acc[a][b];
                else if (kind == 2) {
                    const v2u rw = *(const LAS v2u*)(RT + j * 72 + i0);
                    v2u w; w.x = pk2(acc[a][b][0] + __uint_as_float(rw.x << 16), acc[a][b][1] + __uint_as_float(rw.x & 0xffff0000u));
                    w.y = pk2(acc[a][b][2] + __uint_as_float(rw.y << 16), acc[a][b][3] + __uint_as_float(rw.y & 0xffff0000u));
                    *(v2u*)(QT + ((size_t)item * 64 + j) * 64 + i0) = w;
                } else {
                    f32x4 m = acc[a][b];
#pragma unroll
                    for (int e = 0; e < 4; ++e) if (i0 + e == j) m[e] += GL[j];
                    v2u w; w.x = pk2(m[0], m[1]); w.y = pk2(m[2], m[3]);
                    *(v2u*)(PMT + ((size_t)item * 64 + j) * 64 + i0) = w;
                }
            }
    }
    __syncthreads();
}

struct ScanOps { bf16x8 pf[4][2]; f32x4 sl[4]; };
__device__ __forceinline__ void scan_ops_load(ScanOps& o, int it, int v, int r, int q4, const bf16* PMT, const float* SLOC) {
#pragma unroll
    for (int kt = 0; kt < 4; ++kt) {
        o.sl[kt] = *(const f32x4*)(SLOC + ((size_t)it * 64 + v) * 64 + 16 * kt + 4 * q4);
#pragma unroll
        for (int ks = 0; ks < 2; ++ks) {
            const bf16* p = PMT + ((size_t)it * 64 + 16 * kt + r) * 64 + 32 * ks + 4 * q4;
            const v2u lo = *(const v2u*)p, hi = *(const v2u*)(p + 16);
            v4u w; w.x = lo.x; w.y = lo.y; w.z = hi.x; w.w = hi.y;
            o.pf[kt][ks] = __builtin_bit_cast(bf16x8, w);
        }
    }
}
__device__ __forceinline__ void scan_step(const ScanOps& o, int c, int it, int v, int q4, int lane, LAS unsigned char* lds, bf16* SC) {
    volatile LAS int* flag = (volatile LAS int*)(lds + 16384);
    LAS v4u* slot_in = (LAS v4u*)(lds + (c & 1) * 8192);
    LAS v4u* slot_out = (LAS v4u*)(lds + ((c + 1) & 1) * 8192);
    while (*flag != c) __builtin_amdgcn_s_sleep(1);
    asm volatile("" ::: "memory");
    const v4u h0 = slot_in[lane], h1 = slot_in[64 + lane], l0 = slot_in[128 + lane], l1 = slot_in[192 + lane];
    { bf16* sc = SC + ((size_t)it * 64 + v) * 64 + 4 * q4;
      v2u w; w.x = h0.x; w.y = h0.y; *(v2u*)(sc) = w; w.x = h0.z; w.y = h0.w; *(v2u*)(sc + 16) = w;
      w.x = h1.x; w.y = h1.y; *(v2u*)(sc + 32) = w; w.x = h1.z; w.y = h1.w; *(v2u*)(sc + 48) = w; }
    const bf16x8 sh0 = __builtin_bit_cast(bf16x8, h0), sh1 = __builtin_bit_cast(bf16x8, h1), sl0 = __builtin_bit_cast(bf16x8, l0), sl1 = __builtin_bit_cast(bf16x8, l1);
    unsigned hw[4][2], lw[4][2];
#pragma unroll
    for (int kt = 0; kt < 4; ++kt) {
        f32x4 n = o.sl[kt];
        n = MFMA16(o.pf[kt][0], sh0, n); n = MFMA16(o.pf[kt][1], sh1, n);
        n = MFMA16(o.pf[kt][0], sl0, n); n = MFMA16(o.pf[kt][1], sl1, n);
        hw[kt][0] = pk2(n[0], n[1]); hw[kt][1] = pk2(n[2], n[3]);
        lw[kt][0] = pk2(n[0] - __uint_as_float(hw[kt][0] << 16), n[1] - __uint_as_float(hw[kt][0] & 0xffff0000u));
        lw[kt][1] = pk2(n[2] - __uint_as_float(hw[kt][1] << 16), n[3] - __uint_as_float(hw[kt][1] & 0xffff0000u));
    }
    v4u o0, o1, o2, o3;
    o0.x = hw[0][0]; o0.y = hw[0][1]; o0.z = hw[1][0]; o0.w = hw[1][1];
    o1.x = hw[2][0]; o1.y = hw[2][1]; o1.z = hw[3][0]; o1.w = hw[3][1];
    o2.x = lw[0][0]; o2.y = lw[0][1]; o2.z = lw[1][0]; o2.w = lw[1][1];
    o3.x = lw[2][0]; o3.y = lw[2][1]; o3.z = lw[3][0]; o3.w = lw[3][1];
    slot_out[lane] = o0; slot_out[64 + lane] = o1; slot_out[128 + lane] = o2; slot_out[192 + lane] = o3;
    asm volatile("s_waitcnt lgkmcnt(0)" ::: "memory");
    if (lane == 0) *flag = c + 1;
}
__device__ __forceinline__ void rwkv_state_scan_wg(LAS unsigned char* lds, int hv, int tid, int wave, int lane, const bf16* PMT, const float* SLOC, bf16* SC) {
    const int h = hv >> 2, vt = hv & 3, r = lane & 15, q4 = lane >> 4, v = 16 * vt + r;
    constexpr int NC = M / 64;
    for (int i = tid; i < 16384 / 4 + 16; i += 512) ((LAS unsigned*)lds)[i] = 0u;
    __syncthreads();
    ScanOps A, B;
    scan_ops_load(A, wave * 8 + h, v, r, q4, PMT, SLOC);
    scan_ops_load(B, (wave + 8) * 8 + h, v, r, q4, PMT, SLOC);
    for (int j = 0; j < NC / 8; j += 2) {
        const int cA = wave + 8 * j, cB = cA + 8;
        scan_step(A, cA, cA * 8 + h, v, q4, lane, lds, SC);
        if (j + 2 < NC / 8) scan_ops_load(A, (cA + 16) * 8 + h, v, r, q4, PMT, SLOC);
        scan_step(B, cB, cB * 8 + h, v, q4, lane, lds, SC);
        if (j + 3 < NC / 8) scan_ops_load(B, (cB + 16) * 8 + h, v, r, q4, PMT, SLOC);
    }
    __syncthreads();
}
__device__ __forceinline__ void rwkv_chunk_out(int item, int lane, const bf16* SC, const bf16* QT, const float* OLT, const float* BS, const bf16* VV, const bf16* GG,
                                               const float* gn_g, const float* gn_b, bf16* Y) {
    const int c = item >> 3, h = item & 7, r = lane & 15, q4 = lane >> 4;
    bf16x8 sf[4][2];
#pragma unroll
    for (int vt = 0; vt < 4; ++vt)
#pragma unroll
        for (int ks = 0; ks < 2; ++ks) sf[vt][ks] = *(const bf16x8*)(SC + ((size_t)item * 64 + 16 * vt + r) * 64 + 32 * ks + 8 * q4);
    f32x4 gg4[4], gb4[4];
#pragma unroll
    for (int vt = 0; vt < 4; ++vt) { gg4[vt] = *(const f32x4*)(gn_g + h * 64 + 16 * vt + 4 * q4); gb4[vt] = *(const f32x4*)(gn_b + h * 64 + 16 * vt + 4 * q4); }
    for (int tt = 0; tt < 4; ++tt) {
        const int tl = 16 * tt + r, t = c * 64 + tl;
        bf16x8 qf[2];
#pragma unroll
        for (int ks = 0; ks < 2; ++ks) qf[ks] = *(const bf16x8*)(QT + ((size_t)item * 64 + tl) * 64 + 32 * ks + 8 * q4);
        f32x4 o[4]; float s = 0.f;
#pragma unroll
        for (int vt = 0; vt < 4; ++vt) {
            o[vt] = *(const f32x4*)(OLT + ((size_t)item * 64 + tl) * 64 + 16 * vt + 4 * q4);
            o[vt] = MFMA16(sf[vt][0], qf[0], o[vt]); o[vt] = MFMA16(sf[vt][1], qf[1], o[vt]);
            s += (o[vt][0] + o[vt][1]) + (o[vt][2] + o[vt][3]);
        }
        s += __shfl_xor(s, 16); s += __shfl_xor(s, 32);
        const float mean = s * (1.f / 64.f);
        float qv = 0.f;
#pragma unroll
        for (int vt = 0; vt < 4; ++vt) { o[vt] = o[vt] - mean; qv += (o[vt][0] * o[vt][0] + o[vt][1] * o[vt][1]) + (o[vt][2] * o[vt][2] + o[vt][3] * o[vt][3]); }
        qv += __shfl_xor(qv, 16); qv += __shfl_xor(qv, 32);
        const float rstd = 1.0f / sqrtf(qv * (1.f / 64.f) + 64e-5f);
        const float bon = BS[(size_t)t * 8 + h];
#pragma unroll
        for (int vt = 0; vt < 4; ++vt) {
            const size_t oo = (size_t)t * BW + h * 64 + 16 * vt + 4 * q4;
            const v2u vr = *(const v2u*)(VV + oo), gr = *(const v2u*)(GG + oo);
            const float v0 = __uint_as_float(vr.x << 16), v1 = __uint_as_float(vr.x & 0xffff0000u), v2 = __uint_as_float(vr.y << 16), v3 = __uint_as_float(vr.y & 0xffff0000u);
            const float g0 = __uint_as_float(gr.x << 16), g1 = __uint_as_float(gr.x & 0xffff0000u), g2 = __uint_as_float(gr.y << 16), g3 = __uint_as_float(gr.y & 0xffff0000u);
            const f32x4 y = o[vt] * rstd * gg4[vt] + gb4[vt];
            v2u w; w.x = pk2((y[0] + bon * v0) * g0, (y[1] + bon * v1) * g1); w.y = pk2((y[2] + bon * v2) * g2, (y[3] + bon * v3) * g3);
            *(v2u*)(Y + (size_t)t * D + 512 + h * 64 + 16 * vt + 4 * q4) = w;
        }
    }
}
#define XB_TMO      128
#define XB_XCNT(j)  (256  + 64 * (j))
#define XB_XSUB(j)  (1280 + 64 * (j))
#define XB_XGEN(j)  (2304 + 64 * (j))
#define XB_TOP      3328
#define XB_TOPGEN   3392
#define XCD_BAR_WORDS 3456
#define XB_SPIN_CAP (1u << 18)

__device__ __forceinline__ unsigned xb_ld(unsigned* p)              { return __hip_atomic_load(p, __ATOMIC_RELAXED, __HIP_MEMORY_SCOPE_AGENT); }
__device__ __forceinline__ unsigned xb_add(unsigned* p, unsigned v) { return __hip_atomic_fetch_add(p, v, __ATOMIC_RELAXED, __HIP_MEMORY_SCOPE_AGENT); }
__device__ __forceinline__ unsigned xb_xcc_id() { return (unsigned)__builtin_amdgcn_s_getreg((3 << 11) | 20) & 0xFu; }
#define XB_SPIN(cond, bar) do { unsigned _sp = 0; while (cond) { __builtin_amdgcn_s_sleep(1); \
    if ((++_sp & 255u) == 0u) { if (xb_ld(&(bar)[XB_TMO])) break; if (_sp > XB_SPIN_CAP) { atomicAdd(&(bar)[XB_TMO], 1u); break; } } } } while (0)

struct XcdBarrier {
    unsigned* bar; unsigned x;
    volatile LAS unsigned* st;
};

__device__ __forceinline__ XcdBarrier xcd_barrier_post(unsigned* bar, volatile LAS unsigned* st) {
    XcdBarrier b; b.bar = bar; b.x = xb_xcc_id(); b.st = st;
    if (threadIdx.x == 0) (void)xb_add(&bar[XB_XCNT(b.x)], 1u);
    return b;
}
__device__ __forceinline__ void xcd_barrier_complete(unsigned* bar, unsigned x, unsigned& nloc, unsigned& nx) {
    const unsigned G = gridDim.x * gridDim.y * gridDim.z;
    unsigned sum, cnt, mine, sp = 0u;
    for (;;) {
        sum = 0u; cnt = 0u; mine = 0u;
#pragma unroll
        for (unsigned j = 0; j < 16; ++j) { const unsigned c = xb_ld(&bar[XB_XCNT(j)]); sum += c; cnt += (c > 0u) ? 1u : 0u; mine = (j == x) ? c : mine; }
        if (sum == G) break;
        __builtin_amdgcn_s_sleep(1);
        if ((++sp & 255u) == 0u) { if (xb_ld(&bar[XB_TMO])) break; if (sp > XB_SPIN_CAP) { atomicAdd(&bar[XB_TMO], 1u); break; } }
    }
    nloc = mine > 0u ? mine : 1u; nx = cnt > 0u ? cnt : 1u;
}

__device__ __forceinline__ void xcd_barrier(const XcdBarrier& b) {
    asm volatile("s_waitcnt vmcnt(0)" ::: "memory");
    __syncthreads();
    if (threadIdx.x == 0) {
        unsigned* bar = b.bar;
        __builtin_amdgcn_s_waitcnt(0);
        unsigned nloc = b.st[0], nx = b.st[1];
        if (nloc == 0u) { xcd_barrier_complete(bar, b.x, nloc, nx); b.st[0] = nloc; b.st[1] = nx; }
        const unsigned old = xb_add(&bar[XB_XSUB(b.x)], 1u);
        const unsigned gen = old / nloc;
        if (old + 1u == (gen + 1u) * nloc) {
            __builtin_amdgcn_fence(__ATOMIC_RELEASE, "agent");
            asm volatile("s_waitcnt vmcnt(0)" ::: "memory");
            const unsigned og = xb_add(&bar[XB_TOP], 1u);
            const unsigned tg = og / nx;
            if (og + 1u == (tg + 1u) * nx) xb_add(&bar[XB_TOPGEN], 1u);
            else XB_SPIN(xb_ld(&bar[XB_TOPGEN]) == tg, bar);
            __builtin_amdgcn_fence(__ATOMIC_ACQUIRE, "agent");
            xb_add(&bar[XB_XGEN(b.x)], 1u);
            asm volatile("s_waitcnt vmcnt(0)" ::: "memory");
        } else {
            XB_SPIN(xb_ld(&bar[XB_XGEN(b.x)]) == gen, bar);
            __builtin_amdgcn_fence(__ATOMIC_ACQUIRE, "agent");
            asm volatile("s_waitcnt vmcnt(0)" ::: "memory");
        }
    }
    __syncthreads();
}
struct Args { const float* in[28]; float* out; unsigned char* ws; };
#define GRID_SYNC() xcd_barrier(xbar)
#define PHASE_VARS int tid = threadIdx.x; asm volatile("" : "+v"(tid)); const int lane = tid & 63; const int wave = __builtin_amdgcn_readfirstlane(tid >> 6); \
    int G = gridDim.x; asm volatile("" : "+s"(G)); int bx = blockIdx.x; asm volatile("" : "+s"(bx)); const int gw = bx * NWAVES + wave, NGW = G * NWAVES; (void)lane; (void)gw; (void)NGW; (void)tid
#define WSP(T, off) ((T*)(args.ws + (off)))
#define XIN (args.in[0])
#define OUTF (args.out)
#define WA WSP(bf16, WS_WA)
#define WB WSP(bf16, WS_WB)
#define XN WSP(bf16, WS_XN)
#define P WSP(bf16, WS_P)
#define LD WSP(float, WS_LD)
#define KK WSP(bf16, WS_KK)
#define BB WSP(bf16, WS_BB)
#define KP WSP(bf16, WS_KP)
#define RR WSP(bf16, WS_RR)
#define VV WSP(bf16, WS_VV)
#define GG ((bf16*)args.out)
#define SCB ((bf16*)((unsigned char*)args.out + 16 * MiB))
#define OLT ((float*)((unsigned char*)args.out + 32 * MiB))
#define PMT WSP(bf16, WS_P)
#define SLOC WSP(float, WS_P + 16 * MiB)
#define QTB WSP(bf16, WS_P + 48 * MiB)
#define BS WSP(float, WS_BS)
#define W2T WSP(bf16, WS_W2T)
#define A2T WSP(bf16, WS_A2T)
#define G2T WSP(bf16, WS_G2T)
#define YC WSP(bf16, WS_XN)
#define ACT WSP(bf16, WS_GEN)
#define QKV WSP(bf16, WS_QKV)
#define VT1 WSP(bf16, WS_VT1)
#define VT4 WSP(bf16, WS_VT4)
#define VT16 WSP(bf16, WS_VT16)
__global__ void __launch_bounds__(NWAVES * 64, 2) hybrid_fwd(Args args) {
    extern __shared__ __attribute__((aligned(16))) unsigned char lds_raw[];
    LAS unsigned char* lds = (LAS unsigned char*)lds_raw;
    if (threadIdx.x < 16) ((LAS unsigned*)(lds + LDS_BYTES - 64))[threadIdx.x] = 0u;
    __syncthreads();
    const XcdBarrier xbar = xcd_barrier_post((unsigned*)args.ws, (volatile LAS unsigned*)(lds + LDS_BYTES - 64));

    { PHASE_VARS;
    {
        LAS float* scr = (LAS float*)(lds + wave * 16384);
        const int IL = 16 + 16 + 32;
        for (int it = gw; it < IL; it += NGW) {
            if (it < 16) transpose_item(args.in[9], 64, 512, W2T, scr, it, lane);
            else if (it < 32) transpose_item(args.in[11], 64, 512, A2T, scr, it - 16, lane);
            else transpose_item(args.in[12], 128, 512, G2T, scr, it - 32, lane);
        }
        norm_phase(lds, gw, NGW, wave, lane, XIN, args.in[1], XN, args.in[2], D, EIN, WA, args.in[18], D, D, WB);
    }

    }
    cg::this_grid().sync();
    { PHASE_VARS;

    {
        pg8::Gemm g{XN, WA, M, EIN, D, 256L * D * 2, 128L * D * 2, 256L * D * 2, 128L * D * 2, 0}; pg8::StaticOrder S; S.init(M, EIN, G, bx);
        pg8::EpiBf16<0> E{P, EIN, nullptr, 0, 0, 1.f};
        pg8::gemm_phase<pg8::EpiBf16<0>, pg8::StaticOrder, true, true>(lds, g, S, E);
    }

    }
    GRID_SYNC();
    { PHASE_VARS;

    {
        RwkvW W{args.in[7], args.in[8], args.in[10], args.in[13], args.in[14], args.in[15], W2T, A2T, G2T};
        for (int it = bx; it < M / 64; it += G) rwkv_prep_item(lds, it, tid, wave, lane, P, W, LD, KK, BB, KP, RR, VV, GG, BS);
        for (int it = bx; it < (M / 128) * 4; it += G) gmlp_item(lds, it, tid, wave, lane, P, args.in[3], args.in[4], args.in[5], args.in[6], YC);
    }

    }
    GRID_SYNC();
    { PHASE_VARS;
        for (int it = bx; it < (M / 64) * 8; it += G) rwkv_chunk_item(lds, it, tid, wave, lane, LD, KK, BB, KP, RR, VV, PMT, SLOC, QTB, OLT);
    }
    GRID_SYNC();
    { PHASE_VARS;
        if (bx < 32) rwkv_state_scan_wg(lds, bx, tid, wave, lane, PMT, SLOC, SCB);
    }
    GRID_SYNC();
    { PHASE_VARS;
        for (int it = gw; it < (M / 64) * 8; it += NGW) rwkv_chunk_out(it, lane, SCB, QTB, OLT, BS, VV, GG, args.in[16], args.in[17], YC);
    }
    GRID_SYNC();
    { PHASE_VARS;

    {
        pg8::Gemm g{YC, WB, M, D, D, 256L * D * 2, 128L * D * 2, 256L * D * 2, 128L * D * 2, 0}; pg8::StaticOrder S; S.init(M, D, G, bx);
        pg8::EpiRes E{XIN, OUTF, D};
        pg8::gemm_phase<pg8::EpiRes, pg8::StaticOrder, true, true>(lds, g, S, E);
    }

    }
    GRID_SYNC();
    { PHASE_VARS;
        norm_phase(lds, gw, NGW, wave, lane, OUTF, args.in[22] + 0 * D, XN, args.in[23] + (size_t)0 * D * FF2, D, FF2, WA, args.in[26] + (size_t)0 * FF * D, FF, D, WB);
    }
    GRID_SYNC();
    { PHASE_VARS;
        pg8::Gemm g{XN - 2 * D, WA, M, FF2, D, 248L * D * 2, 124L * D * 2, 128L * D * 2, 2816L * D * 2, 1}; pg8::StaticOrder S; S.init2(67, 22, G, bx);
        pg8::EpiConvGlu E{ACT, args.in[24] + (size_t)0 * 3 * FF2, args.in[25] + (size_t)0 * FF2, M};
        pg8::gemm_phase<pg8::EpiConvGlu, pg8::StaticOrder, true, true>(lds, g, S, E);
    }
    GRID_SYNC();
    { PHASE_VARS;
        pg8::Gemm g{ACT, WB, M, D, FF, 256L * FF * 2, 128L * FF * 2, 256L * FF * 2, 128L * FF * 2, 0}; pg8::StaticOrder S; S.init(M, D, G, bx);
        pg8::EpiRes E{OUTF, OUTF, D};
        pg8::gemm_phase<pg8::EpiRes, pg8::StaticOrder, true, true>(lds, g, S, E);
    }
    GRID_SYNC();
    { PHASE_VARS;
        norm_phase(lds, gw, NGW, wave, lane, OUTF, args.in[19], XN, args.in[20], D, NQKV, WA, args.in[21], D, D, WB);
    }
    GRID_SYNC();
    { PHASE_VARS;
        pg8::Gemm g{XN, WA, M, NQKV, D, 256L * D * 2, 128L * D * 2, 256L * D * 2, 128L * D * 2, 0}; pg8::StaticOrder S; S.init(M, NQKV, G, bx);
        pg8::EpiBf16<0> E{QKV, NQKV, nullptr, 0, 0, 1.f};
        pg8::gemm_phase<pg8::EpiBf16<0>, pg8::StaticOrder, true, true>(lds, g, S, E);
    }
    GRID_SYNC();
    { PHASE_VARS;
        for (int it = bx; it < 16 * 64; it += G) vtrans_item(lds, it, tid, QKV, VT1, VT4, VT16);
    }
    GRID_SYNC();
    { PHASE_VARS;
        for (int it = bx; it < 16 * 64; it += G) {
            const int h = it >> 6, blk = it & 63;
            attn_wave_item(QKV, VT1, VT4, VT16, YC, h, blk, 2 * wave, lane);
            attn_wave_item(QKV, VT1, VT4, VT16, YC, h, blk, 2 * wave + 1, lane);
        }
    }
    GRID_SYNC();
    { PHASE_VARS;
        pg8::Gemm g{YC, WB, M, D, D, 256L * D * 2, 128L * D * 2, 256L * D * 2, 128L * D * 2, 0}; pg8::StaticOrder S; S.init(M, D, G, bx);
        pg8::EpiRes E{OUTF, OUTF, D};
        pg8::gemm_phase<pg8::EpiRes, pg8::StaticOrder, true, true>(lds, g, S, E);
    }
    GRID_SYNC();
    { PHASE_VARS;
        norm_phase(lds, gw, NGW, wave, lane, OUTF, args.in[22] + 1 * D, XN, args.in[23] + (size_t)1 * D * FF2, D, FF2, WA, args.in[26] + (size_t)1 * FF * D, FF, D, WB);
    }
    GRID_SYNC();
    { PHASE_VARS;
        pg8::Gemm g{XN - 2 * D, WA, M, FF2, D, 248L * D * 2, 124L * D * 2, 128L * D * 2, 2816L * D * 2, 1}; pg8::StaticOrder S; S.init2(67, 22, G, bx);
        pg8::EpiConvGlu E{ACT, args.in[24] + (size_t)1 * 3 * FF2, args.in[25] + (size_t)1 * FF2, M};
        pg8::gemm_phase<pg8::EpiConvGlu, pg8::StaticOrder, true, true>(lds, g, S, E);
    }
    GRID_SYNC();
    { PHASE_VARS;
        pg8::Gemm g{ACT, WB, M, D, FF, 256L * FF * 2, 128L * FF * 2, 256L * FF * 2, 128L * FF * 2, 0}; pg8::StaticOrder S; S.init(M, D, G, bx);
        pg8::EpiRes E{OUTF, OUTF, D};
        pg8::gemm_phase<pg8::EpiRes, pg8::StaticOrder, true, true>(lds, g, S, E);
    }
    GRID_SYNC();
    { PHASE_VARS;
        for (int m = gw; m < M; m += NGW) rms_row_inplace(OUTF + (size_t)m * D, args.in[27], lane);
    }
}

#undef WSP
#undef XIN
#undef OUTF
#undef WA
#undef WB
#undef XN
#undef P
#undef LD
#undef KK
#undef BB
#undef KP
#undef RR
#undef VV
#undef GG
#undef SCB
#undef OLT
#undef PMT
#undef SLOC
#undef QTB
#undef BS
#undef W2T
#undef A2T
#undef G2T
#undef YC
#undef ACT
#undef QKV
#undef VT1
#undef VT4
#undef VT16
extern "C" void kernel_launch(void* const* d_in, const int* in_sizes, int n_in, void* d_out, int out_size, void* d_ws, size_t ws_size, hipStream_t stream) {
    static int grid = 0;
    if (grid == 0) {
        if (n_in != 28 || in_sizes[0] != M * D || out_size != M * D || ws_size < WS_END) { fprintf(stderr, "kernel_launch: unexpected shapes (n_in %d, in0 %d, out %d, ws %zu)\n", n_in, n_in > 0 ? in_sizes[0] : -1, out_size, ws_size); grid = -1; return; }
        int dev = 0, cus = 0, per_cu = 0;
        if (hipGetDevice(&dev) != hipSuccess || hipDeviceGetAttribute(&cus, hipDeviceAttributeMultiprocessorCount, dev) != hipSuccess) { grid = -1; return; }
        if (hipFuncSetAttribute((const void*)hybrid_fwd, hipFuncAttributeMaxDynamicSharedMemorySize, LDS_BYTES) != hipSuccess) { fprintf(stderr, "kernel_launch: hipFuncSetAttribute failed\n"); grid = -1; return; }
        if (hipOccupancyMaxActiveBlocksPerMultiprocessor(&per_cu, (const void*)hybrid_fwd, NWAVES * 64, LDS_BYTES) != hipSuccess || per_cu < 1) { fprintf(stderr, "kernel_launch: occupancy query says %d\n", per_cu); per_cu = 1; }
        (void)hipGetLastError();
        grid = cus;
    }
    if (grid < 0) return;
    if (hipMemsetAsync(d_ws, 0, 65536, stream) != hipSuccess) { fprintf(stderr, "kernel_launch: hipMemsetAsync failed\n"); return; }
    Args a{};
    for (int i = 0; i < 28; ++i) a.in[i] = (const float*)d_in[i];
    a.out = (float*)d_out; a.ws = (unsigned char*)d_ws;
    void* kargs[] = {&a};
    hipError_t e = hipLaunchCooperativeKernel((const void*)hybrid_fwd, dim3(grid), dim3(NWAVES * 64), kargs, LDS_BYTES, stream);
    if (e != hipSuccess) fprintf(stderr, "kernel_launch: cooperative launch failed: %s (grid %d)\n", hipGetErrorString(e), grid);
}
```

```cpp
#include <hip/hip_runtime.h>
#include <hip/hip_cooperative_groups.h>
#include <cstdio>
#include <cstdint>
namespace cg = cooperative_groups;
namespace pg8 {
#define PG8_LAS __attribute__((address_space(3)))
typedef unsigned short bf16_t;
typedef short bf16x8 __attribute__((ext_vector_type(8)));
typedef float f32x4 __attribute__((ext_vector_type(4)));
typedef unsigned u32x4 __attribute__((ext_vector_type(4)));
constexpr int BM = 256, BK = 64, HALF = 128, HTB = HALF * BK * 2  , STAGE_BYTES = 8 * HTB, NXCD = 8, WGM = 8;

__host__ __device__ __forceinline__ int lds_byte(int r, int c) { const int st = (r >> 4) * 2 + (c >> 5), rr = r & 15, cc = c & 31, ob = rr * 64 + cc * 2; return st * 1024 + (ob ^ (((ob >> 9) & 1) << 5)); }
__host__ __device__ __forceinline__ void stage_rc(int b, int& R, int& C) { const int st = b / 1024, sb = b % 1024, swz = sb ^ (((sb >> 9) & 1) << 5); R = (st >> 1) * 16 + swz / 64; C = (st & 1) * 32 + (swz % 64) / 2; }
__host__ __device__ __forceinline__ int perm32(int rho) { const int n = rho >> 4, i = rho & 15; return 8 * (i >> 2) + 4 * n + (i & 3); }

struct Unit { int pm, pn; };
struct Gemm { const bf16_t* A; const bf16_t* Bt; int M, N, K; long tA, hA, tB, hB; int remapA; };

struct StaticOrder {
    int nM, nN, nwg, G, c;
    __host__ __device__ void init(int M, int N, int G_, int c_) { nM = M / BM; nN = N / BM; nwg = nM * nN; G = G_; c = c_; }
    __host__ __device__ void init2(int nM_, int nN_, int G_, int c_) { nM = nM_; nN = nN_; nwg = nM * nN; G = G_; c = c_; }
    __host__ __device__ bool next(int i, Unit& u) const {
        const long L = (long)i * G + c; if (L >= nwg) return false;
        int wgid = (int)L; { const int q = nwg / NXCD, r = nwg % NXCD, xcd = wgid % NXCD, off = wgid / NXCD; wgid = (xcd < r ? xcd * (q + 1) : r * (q + 1) + (xcd - r) * q) + off; }
        const int nig = WGM * nN, gid = wgid / nig, fm = gid * WGM, gsz = (nM - fm) < WGM ? (nM - fm) : WGM;
        u.pm = fm + ((wgid % nig) % gsz); u.pn = (wgid % nig) / gsz; return true;
    }
    __device__ __forceinline__ void a_ready(const Unit&) const {}
    __device__ __forceinline__ void done(const Unit&) const {}
};

__device__ __forceinline__ unsigned cvt_pk_bf16(float lo, float hi) { unsigned r; asm volatile("v_cvt_pk_bf16_f32 %0, %1, %2" : "=v"(r) : "v"(lo), "v"(hi)); return r; }
typedef float f32x2 __attribute__((ext_vector_type(2)));
__device__ __forceinline__ f32x2 gelu_pk(f32x2 v) {
    const f32x2 av = __builtin_elementwise_abs(v), d = av * 0.2316418882f + 1.0f;
    f32x2 t; t.x = __builtin_amdgcn_rcpf(d.x); t.y = __builtin_amdgcn_rcpf(d.y);
    f32x2 q = t * 0.5307027145f + (-0.7265760135f); q = q * t + 0.7107068705f; q = q * t + (-0.142248368f); q = q * t + 0.127414796f; q = q * t;
    const f32x2 s = (v * v) * (-0.72134752044f);
    f32x2 e; e.x = __builtin_amdgcn_exp2f(s.x); e.y = __builtin_amdgcn_exp2f(s.y);
    const f32x2 m = v * (q * e), r = v - m;
    f32x2 o; o.x = v.x < 0.f ? m.x : r.x; o.y = v.y < 0.f ? m.y : r.y; return o;
}

template <int ACT  > struct EpiBf16 {
    static constexpr bool PERM = true, AFTER_DRAIN = false; static_assert(ACT == 0 || ACT == 1, "EpiBf16: ACT is 0 (none) or 1 (gelu_pk)");
    bf16_t* O; int ldc; const float* bias; int split_cols; size_t split_stride; float scale0;
    __device__ __forceinline__ void operator()(const f32x4 (&acc)[2][2][4][2], const Unit& u, int wr, int wc, int fr, int fq) const {
        const int row0 = u.pm * BM + wr * 64 + fr; int colt = u.pn * BM; bf16_t* base = O;
        float sc = 1.f; if (split_cols) { const int t = colt / split_cols; base += (size_t)t * split_stride; colt -= t * split_cols; if (t == 0) sc = scale0; }
        const int col0 = colt + wc * 32 + 8 * fq, bcol0 = u.pn * BM + wc * 32 + 8 * fq;
        f32x4 bv[2][2];
#pragma unroll
        for (int bj = 0; bj < 2; ++bj)
#pragma unroll
            for (int n = 0; n < 2; ++n) bv[bj][n] = bias ? *(const f32x4*)(bias + bcol0 + bj * HALF + 4 * n) : (f32x4){0.f, 0.f, 0.f, 0.f};
#pragma unroll
        for (int ai = 0; ai < 2; ++ai)
#pragma unroll
            for (int m = 0; m < 4; ++m) { bf16_t* rowp = base + (size_t)(row0 + ai * HALF + m * 16) * ldc + col0;
#pragma unroll
                for (int bj = 0; bj < 2; ++bj) { f32x4 v0 = acc[ai][bj][m][0] + bv[bj][0], v1 = acc[ai][bj][m][1] + bv[bj][1];
                    if (ACT == 1) { f32x2 a = gelu_pk((f32x2){v0[0], v0[1]}), b = gelu_pk((f32x2){v0[2], v0[3]}), c = gelu_pk((f32x2){v1[0], v1[1]}), d = gelu_pk((f32x2){v1[2], v1[3]});
                        v0 = (f32x4){a.x, a.y, b.x, b.y}; v1 = (f32x4){c.x, c.y, d.x, d.y}; }
                    v0 = v0 * sc; v1 = v1 * sc; u32x4 w; w.x = cvt_pk_bf16(v0[0], v0[1]); w.y = cvt_pk_bf16(v0[2], v0[3]); w.z = cvt_pk_bf16(v1[0], v1[1]); w.w = cvt_pk_bf16(v1[2], v1[3]);
                    *(u32x4*)(rowp + bj * HALF) = w; } }
    }
};

template <class Epi, class Sched, bool ALIGN_EPI = false, bool SP2 = false>
__device__ __forceinline__ void gemm_phase(PG8_LAS unsigned char* lds, const Gemm g, const Sched& S, const Epi& E) {
    const int tid = threadIdx.x, wid = __builtin_amdgcn_readfirstlane(tid >> 6), lane = tid & 63, wr = wid >> 2, wc = wid & 3, fr = lane & 15, fq = lane >> 4;
    const int K = g.K, nt = K / BK;
    unsigned voffA[2], voffB[2];
#pragma unroll
    for (int i = 0; i < 2; ++i) { int R, C; stage_rc(tid * 16 + i * 8192, R, C); const int Rb = Epi::PERM ? ((R & ~31) + perm32(R & 31)) : R;
        const int Ra = g.remapA ? (R - (R >= 64 ? 2 : 0)) : R; voffA[i] = (unsigned)(Ra * K + C) * 2u; voffB[i] = (unsigned)(Rb * K + C) * 2u; }
    const size_t kstep = (size_t)(BK * 2);
    const size_t hA = (size_t)g.hA, hB = (size_t)g.hB, tA = (size_t)g.tA, tB = (size_t)g.tB;
    const unsigned ldsw = (unsigned)wid * 1024u;
    const int aoff = lds_byte(wr * 64 + fr, fq * 8), boff = lds_byte(wc * 32 + fr, fq * 8);
#define PG8_SA(b, h) (((b) * 2 + (h)) * HTB)
#define PG8_SB(b, h) ((4 + (b) * 2 + (h)) * HTB)
#define PG8_STAGE(bufoff, gbase, voff) do { _Pragma("unroll") for (int _i = 0; _i < 2; ++_i) \
        __builtin_amdgcn_global_load_lds((const unsigned*)((const char*)(gbase) + (voff)[_i]), (PG8_LAS unsigned*)(lds + (bufoff) + ldsw + _i * 8192), 16, 0, 0); } while (0)
#define PG8_LDA(dst, b, h) do { _Pragma("unroll") for (int m = 0; m < 4; ++m) _Pragma("unroll") for (int k = 0; k < 2; ++k) dst[m][k] = *(const PG8_LAS bf16x8*)(lds + PG8_SA(b, h) + aoff + m * 2048 + k * 1024); } while (0)
#define PG8_LDB(dst, b, h) do { _Pragma("unroll") for (int n = 0; n < 2; ++n) _Pragma("unroll") for (int k = 0; k < 2; ++k) dst[n][k] = *(const PG8_LAS bf16x8*)(lds + PG8_SB(b, h) + boff + n * 2048 + k * 1024); } while (0)
#define PG8_MMA(ai, bj, At, Bt) do { __builtin_amdgcn_s_setprio(1); _Pragma("unroll") for (int m = 0; m < 4; ++m) _Pragma("unroll") for (int n = 0; n < 2; ++n) _Pragma("unroll") for (int k = 0; k < 2; ++k) \
        acc[ai][bj][m][n] = __builtin_amdgcn_mfma_f32_16x16x32_bf16(Bt[n][k], At[m][k], acc[ai][bj][m][n], 0, 0, 0); __builtin_amdgcn_s_setprio(0); } while (0)
#define PG8_WAIT_V(n) asm volatile("s_waitcnt vmcnt(" #n ")" ::: "memory")
#define PG8_WAIT_L(n) asm volatile("s_waitcnt lgkmcnt(" #n ")" ::: "memory")
#define PG8_BAR __builtin_amdgcn_s_barrier()
#define PG8_SCHED __builtin_amdgcn_sched_barrier(0)
    Unit cur, nxt; int ui = 0;
    if (!S.next(0, cur)) return;
    f32x4 acc[2][2][4][2];
#pragma unroll
    for (int a = 0; a < 2; ++a)
#pragma unroll
        for (int b = 0; b < 2; ++b)
#pragma unroll
            for (int m = 0; m < 4; ++m)
#pragma unroll
                for (int n = 0; n < 2; ++n) acc[a][b][m][n] = (f32x4){0.f, 0.f, 0.f, 0.f};
    bf16x8 At[4][2], B0[2][2], B1[2][2];
    const char* cA = (const char*)g.A + (size_t)cur.pm * tA; const char* cB = (const char*)g.Bt + (size_t)cur.pn * tB;
    S.a_ready(cur);
    if constexpr (SP2) {
        PG8_STAGE(PG8_SB(0, 0), cB, voffB); PG8_STAGE(PG8_SB(0, 1), cB + hB, voffB); PG8_STAGE(PG8_SA(0, 0), cA, voffA); PG8_STAGE(PG8_SA(0, 1), cA + hA, voffA);
        if (wr == 1) PG8_BAR;
        PG8_WAIT_V(2); PG8_BAR;
        PG8_STAGE(PG8_SB(1, 0), cB + kstep, voffB); PG8_STAGE(PG8_SA(1, 0), cA + kstep, voffA); PG8_STAGE(PG8_SB(1, 1), cB + hB + kstep, voffB);
        PG8_WAIT_V(6); PG8_BAR;
    } else {
        PG8_STAGE(PG8_SB(0, 0), cB, voffB); PG8_STAGE(PG8_SA(0, 0), cA, voffA); PG8_STAGE(PG8_SB(0, 1), cB + hB, voffB); PG8_STAGE(PG8_SA(0, 1), cA + hA, voffA);
        if (wr == 1) PG8_BAR;
        PG8_WAIT_V(4); PG8_BAR;
        PG8_STAGE(PG8_SB(1, 0), cB + kstep, voffB); PG8_STAGE(PG8_SA(1, 0), cA + kstep, voffA); PG8_STAGE(PG8_SB(1, 1), cB + hB + kstep, voffB);
        PG8_WAIT_V(6); PG8_BAR;
    }
    for (;;) {
        const bool has_next = S.next(ui + 1, nxt);
        const char* nA = has_next ? (const char*)g.A + (size_t)nxt.pm * tA : cA; const char* nB = has_next ? (const char*)g.Bt + (size_t)nxt.pn * tB : cB;
        for (int t = 0; t < nt; t += 2) {
            const bool last = (t == nt - 2);
            const char* a1 = cA + (size_t)(t + 1) * kstep;
            const char* a2 = last ? nA : cA + (size_t)(t + 2) * kstep; const char* b2 = last ? nB : cB + (size_t)(t + 2) * kstep;
            const char* a3 = a2 + kstep; const char* b3 = b2 + kstep;
            if (last && has_next) S.a_ready(nxt);
            if constexpr (SP2) {
            PG8_LDB(B0, 0, 0); PG8_LDB(B1, 0, 1); PG8_SCHED; PG8_LDA(At, 0, 0); PG8_STAGE(PG8_SA(1, 1), a1 + hA, voffA);
            PG8_WAIT_V(8); PG8_WAIT_L(0); PG8_BAR; PG8_MMA(0, 0, At, B0); PG8_MMA(0, 1, At, B1); PG8_BAR; PG8_SCHED;
            PG8_LDA(At, 0, 1); PG8_STAGE(PG8_SB(0, 0), b2, voffB); PG8_STAGE(PG8_SB(0, 1), b2 + hB, voffB); PG8_STAGE(PG8_SA(0, 0), a2, voffA);
            PG8_WAIT_V(8); PG8_WAIT_L(0); PG8_BAR; PG8_MMA(1, 0, At, B0); PG8_MMA(1, 1, At, B1); PG8_BAR; PG8_SCHED;
            PG8_LDB(B0, 1, 0); PG8_LDB(B1, 1, 1); PG8_SCHED; PG8_LDA(At, 1, 0); PG8_STAGE(PG8_SA(0, 1), a2 + hA, voffA);
            PG8_WAIT_V(8); PG8_WAIT_L(0); PG8_BAR; PG8_MMA(0, 0, At, B0); PG8_MMA(0, 1, At, B1); PG8_BAR; PG8_SCHED;
            PG8_LDA(At, 1, 1); PG8_STAGE(PG8_SB(1, 0), b3, voffB); PG8_STAGE(PG8_SB(1, 1), b3 + hB, voffB); PG8_STAGE(PG8_SA(1, 0), a3, voffA);
            PG8_WAIT_V(8); PG8_WAIT_L(0); PG8_BAR; PG8_MMA(1, 0, At, B0); PG8_MMA(1, 1, At, B1); PG8_BAR; PG8_SCHED;
            } else {
            PG8_LDB(B0, 0, 0); PG8_SCHED; PG8_LDA(At, 0, 0); PG8_STAGE(PG8_SA(1, 1), a1 + hA, voffA);
            PG8_WAIT_L(8); PG8_BAR; PG8_WAIT_L(0); PG8_MMA(0, 0, At, B0); PG8_BAR; PG8_SCHED;
            PG8_LDB(B1, 0, 1); PG8_STAGE(PG8_SB(0, 0), b2, voffB);
            PG8_BAR; PG8_WAIT_L(0); PG8_MMA(0, 1, At, B1); PG8_BAR;
            PG8_LDA(At, 0, 1); PG8_STAGE(PG8_SA(0, 0), a2, voffA);
            PG8_BAR; PG8_WAIT_L(0); PG8_MMA(1, 0, At, B0); PG8_BAR; PG8_SCHED;
            PG8_STAGE(PG8_SB(0, 1), b2 + hB, voffB);
            PG8_WAIT_V(6); PG8_BAR; PG8_MMA(1, 1, At, B1); PG8_BAR;
            PG8_LDB(B0, 1, 0); PG8_SCHED; PG8_LDA(At, 1, 0); PG8_STAGE(PG8_SA(0, 1), a2 + hA, voffA);
            PG8_WAIT_L(8); PG8_BAR; PG8_WAIT_L(0); PG8_MMA(0, 0, At, B0); PG8_BAR; PG8_SCHED;
            PG8_LDB(B1, 1, 1); PG8_STAGE(PG8_SB(1, 0), b3, voffB);
            PG8_BAR; PG8_WAIT_L(0); PG8_MMA(0, 1, At, B1); PG8_BAR;
            PG8_LDA(At, 1, 1); PG8_STAGE(PG8_SA(1, 0), a3, voffA);
            PG8_BAR; PG8_WAIT_L(0); PG8_MMA(1, 0, At, B0); PG8_BAR; PG8_SCHED;
            PG8_STAGE(PG8_SB(1, 1), b3 + hB, voffB);
            PG8_WAIT_V(6); PG8_BAR; PG8_MMA(1, 1, At, B1); PG8_BAR;
            }
        }
        if constexpr (ALIGN_EPI) { if (wr == 0) PG8_BAR; }
        if constexpr (!Epi::AFTER_DRAIN) { E(acc, cur, wr, wc, fr, fq); S.done(cur); }
        if (!has_next) break;
#pragma unroll
        for (int a = 0; a < 2; ++a)
#pragma unroll
            for (int b = 0; b < 2; ++b)
#pragma unroll
                for (int m = 0; m < 4; ++m)
#pragma unroll
                    for (int n = 0; n < 2; ++n) acc[a][b][m][n] = (f32x4){0.f, 0.f, 0.f, 0.f};
        cur = nxt; cA = nA; cB = nB; ++ui;
        if constexpr (ALIGN_EPI) { if (wr == 1) PG8_BAR; }
    }
    PG8_WAIT_V(0);
    if constexpr (!ALIGN_EPI) { if (wr == 0) PG8_BAR; }
    PG8_BAR;
    if constexpr (Epi::AFTER_DRAIN) { E.fused(acc, cur, wr, wc, fr, fq, lds, wid, lane); S.done(cur); }
#undef PG8_SA
#undef PG8_SB
#undef PG8_STAGE
#undef PG8_LDA
#undef PG8_LDB
#undef PG8_MMA
#undef PG8_WAIT_V
#undef PG8_WAIT_L
#undef PG8_BAR
#undef PG8_SCHED
}
}
namespace pg8 {
template <int N> __device__ __forceinline__ float row_ror(float v) {
    const int iv = __builtin_bit_cast(int, v);
    const int a = __builtin_amdgcn_update_dpp(0, iv, 0x110 + N, 0xf, 0xf, true);
    const int b = __builtin_amdgcn_update_dpp(0, iv, 0x100 + (16 - N), 0xf, 0xf, true);
    return __builtin_bit_cast(float, a | b);
}
}
namespace pg8 {
struct EpiRes {
    static constexpr bool PERM = false, AFTER_DRAIN = false;
    const float* base; float* out; int ldc;
    __device__ __forceinline__ void operator()(const f32x4 (&acc)[2][2][4][2], const Unit& u, int wr, int wc, int fr, int fq) const {
        const int col0 = u.pn * BM + wc * 32 + 4 * fq;
#pragma unroll
        for (int ai = 0; ai < 2; ++ai)
#pragma unroll
            for (int m = 0; m < 4; ++m) { const size_t off = (size_t)(u.pm * BM + ai * HALF + wr * 64 + m * 16 + fr) * ldc + col0;
#pragma unroll
                for (int bj = 0; bj < 2; ++bj)
#pragma unroll
                    for (int n = 0; n < 2; ++n) { const f32x4 b = *(const f32x4*)(base + off + bj * HALF + n * 16); *(f32x4*)(out + off + bj * HALF + n * 16) = b + acc[ai][bj][m][n]; } }
    }
};
struct EpiConvGlu {
    static constexpr bool PERM = false, AFTER_DRAIN = false;
    bf16_t* O; const float* cw; const float* cb; int M;
    __device__ __forceinline__ void operator()(const f32x4 (&acc)[2][2][4][2], const Unit& u, int wr, int wc, int fr, int fq) const {
        const int lane = fq * 16 + fr;
        const int src1 = fq * 16 + ((fr + 15) & 15), src2 = fq * 16 + ((fr + 14) & 15);
#pragma unroll
        for (int ai = 0; ai < 2; ++ai) {
            const int pb = 248 * u.pm + 62 * (2 * ai + wr) - 2;
#pragma unroll
            for (int n = 0; n < 2; ++n) {
                const int jg = 128 * u.pn + 32 * wc + 16 * n + 4 * fq;
                const f32x4 g0 = *(const f32x4*)(cw + jg), g1 = *(const f32x4*)(cw + 5632 + jg), g2 = *(const f32x4*)(cw + 2 * 5632 + jg), gb = *(const f32x4*)(cb + jg);
                const f32x4 v0 = *(const f32x4*)(cw + 2816 + jg), v1 = *(const f32x4*)(cw + 5632 + 2816 + jg), v2 = *(const f32x4*)(cw + 2 * 5632 + 2816 + jg), vb = *(const f32x4*)(cb + 2816 + jg);
                f32x4 pg1, pg2, pv1, pv2;
#pragma unroll
                for (int m = 0; m < 4; ++m) {
                    f32x4 zg = acc[ai][0][m][n], zv = acc[ai][1][m][n];
                    const int pos = pb + 16 * m + fr;
                    if (pos < 0) { zg = (f32x4){0.f, 0.f, 0.f, 0.f}; zv = zg; }
                    f32x4 rg1, rg2, rv1, rv2;
#pragma unroll
                    for (int e = 0; e < 4; ++e) { rg1[e] = row_ror<1>(zg[e]); rg2[e] = row_ror<2>(zg[e]); rv1[e] = row_ror<1>(zv[e]); rv2[e] = row_ror<2>(zv[e]); }
                    f32x4 zg1, zg2, zv1, zv2;
                    if (m == 0) { zg1 = rg1; zg2 = rg2; zv1 = rv1; zv2 = rv2; }
                    else {
#pragma unroll
                        for (int e = 0; e < 4; ++e) { zg1[e] = fr >= 1 ? rg1[e] : pg1[e]; zg2[e] = fr >= 2 ? rg2[e] : pg2[e]; zv1[e] = fr >= 1 ? rv1[e] : pv1[e]; zv2[e] = fr >= 2 ? rv2[e] : pv2[e]; }
                    }
                    pg1 = rg1; pg2 = rg2; pv1 = rv1; pv2 = rv2;
                    const f32x4 cg = g0 * zg2 + g1 * zg1 + g2 * zg + gb;
                    const f32x4 cv = v0 * zv2 + v1 * zv1 + v2 * zv + vb;
                    f32x4 a;
#pragma unroll
                    for (int e = 0; e < 4; ++e) a[e] = cg[e] / (1.0f + __expf(-cg[e])) * cv[e];
                    if ((16 * m + fr) >= 2 && pos < M) {
                        typedef unsigned u32x2 __attribute__((ext_vector_type(2)));
                        u32x2 w; w.x = cvt_pk_bf16(a[0], a[1]); w.y = cvt_pk_bf16(a[2], a[3]);
                        *(u32x2*)(O + (size_t)pos * 2816 + jg) = w;
                    }
                }
            }
        }
        (void)lane;
    }
};
}
#define LAS __attribute__((address_space(3)))
typedef unsigned short bf16;
typedef float f32x4 __attribute__((ext_vector_type(4)));
typedef short bf16x8 __attribute__((ext_vector_type(8)));
typedef unsigned v4u __attribute__((ext_vector_type(4)));
typedef unsigned v2u __attribute__((ext_vector_type(2)));
constexpr int NWAVES = 8;
constexpr int M = 16384, D = 1024, EIN = 2816, FF = 2816, FF2 = 5632, NQKV = 3072, BW = 512;
constexpr size_t MiB = 1u << 20;
constexpr size_t WS_W2T = 1 * MiB, WS_A2T = WS_W2T + 65536, WS_G2T = WS_A2T + 65536, WS_BS = WS_G2T + 131072;
constexpr size_t WS_WA = 2 * MiB, WS_WB = 13 * MiB, WS_XN = 20 * MiB, WS_GEN = 52 * MiB, WS_END = 256 * MiB;
constexpr size_t WS_P = WS_GEN, WS_LD = WS_GEN + 88 * MiB, WS_KK = WS_LD + 32 * MiB, WS_BB = WS_KK + 16 * MiB, WS_KP = WS_BB + 16 * MiB, WS_RR = WS_KP + 16 * MiB, WS_VV = WS_RR + 16 * MiB;
static_assert(WS_VV + 16 * MiB <= WS_END, "ws map");
constexpr size_t WS_QKV = WS_GEN, WS_VT1 = WS_GEN + 96 * MiB, WS_VT4 = WS_VT1 + 32 * MiB, WS_VT16 = WS_VT4 + 32 * MiB;
static_assert(WS_VT16 + 33 * MiB <= WS_END, "ws map");
constexpr int LDS_BYTES = 147456;

__device__ __forceinline__ float bf2f(unsigned short v) { return __uint_as_float(((unsigned)v) << 16); }
typedef float f32x2_t __attribute__((ext_vector_type(2))); typedef __bf16 bf16x2_t __attribute__((ext_vector_type(2)));
__device__ __forceinline__ unsigned pk2(float lo, float hi) { f32x2_t v = {lo, hi}; bf16x2_t b = __builtin_convertvector(v, bf16x2_t); return __builtin_bit_cast(unsigned, b); }
__device__ __forceinline__ unsigned f2bf(float f) { return pk2(f, f) & 0xffffu; }
__device__ __forceinline__ float wave_sum(float v) {
#pragma unroll
    for (int o = 1; o < 64; o <<= 1) v += __shfl_xor(v, o);
    return v;
}
__device__ __forceinline__ float dpp_row_shr(float v, int n) {
    const int iv = __builtin_bit_cast(int, v); int r;
    switch (n) { case 1: r = __builtin_amdgcn_update_dpp(0, iv, 0x111, 0xf, 0xf, true); break; case 2: r = __builtin_amdgcn_update_dpp(0, iv, 0x112, 0xf, 0xf, true); break;
                 case 4: r = __builtin_amdgcn_update_dpp(0, iv, 0x114, 0xf, 0xf, true); break; default: r = __builtin_amdgcn_update_dpp(0, iv, 0x118, 0xf, 0xf, true); break; }
    return __builtin_bit_cast(float, r);
}
__device__ __forceinline__ float wave_sum_uniform(float v) {
    v += dpp_row_shr(v, 1); v += dpp_row_shr(v, 2); v += dpp_row_shr(v, 4); v += dpp_row_shr(v, 8);
    v += __builtin_bit_cast(float, __builtin_amdgcn_update_dpp(0, __builtin_bit_cast(int, v), 0x142, 0xa, 0xf, false));
    v += __builtin_bit_cast(float, __builtin_amdgcn_update_dpp(0, __builtin_bit_cast(int, v), 0x143, 0xc, 0xf, false));
    return __builtin_bit_cast(float, __builtin_amdgcn_readlane(__builtin_bit_cast(int, v), 63));
}
#define MFMA16(a, b, c) __builtin_amdgcn_mfma_f32_16x16x32_bf16((a), (b), (c), 0, 0, 0)

__device__ __forceinline__ void transpose_item(const float* W, int K, int N, bf16* WT, LAS float* scr, int item, int lane) {
    const int nblk = N / 32, kb = item / nblk, nb = item % nblk, k0 = 64 * kb, n0 = 32 * nb;
#pragma unroll 8
    for (int i = 0; i < 32; ++i) { const int kk = 2 * i + (lane >> 5); scr[kk * 33 + (lane & 31)] = W[(size_t)(k0 + kk) * N + n0 + (lane & 31)]; }
    asm volatile("s_waitcnt lgkmcnt(0)" ::: "memory");
    const int c = lane & 7;
#pragma unroll
    for (int j = 0; j < 4; ++j) { const int n = (lane >> 3) + 8 * j; const LAS float* s = scr + (8 * c) * 33 + n;
        v4u o; o.x = pk2(s[0 * 33], s[1 * 33]); o.y = pk2(s[2 * 33], s[3 * 33]); o.z = pk2(s[4 * 33], s[5 * 33]); o.w = pk2(s[6 * 33], s[7 * 33]);
        *(v4u*)(WT + (size_t)(n0 + n) * K + k0 + 8 * c) = o; }
    asm volatile("s_waitcnt lgkmcnt(0)" ::: "memory");
}
__device__ __forceinline__ void rms_row_to_bf16(const float* xrow, const float* gain, bf16* orow, int lane) {
    const f32x4* xr = (const f32x4*)xrow + lane; const f32x4* gr = (const f32x4*)gain + lane;
    f32x4 v[4]; float s = 0.f;
#pragma unroll
    for (int j = 0; j < 4; ++j) { v[j] = xr[64 * j]; s += (v[j].x * v[j].x + v[j].y * v[j].y) + (v[j].z * v[j].z + v[j].w * v[j].w); }
    const float rstd = 1.0f / sqrtf(wave_sum(s) * (1.f / D) + 1e-6f);
    v2u* o8 = (v2u*)orow + lane;
#pragma unroll
    for (int j = 0; j < 4; ++j) { const f32x4 g = gr[64 * j]; v2u w; w.x = pk2(v[j].x * rstd * g.x, v[j].y * rstd * g.y); w.y = pk2(v[j].z * rstd * g.z, v[j].w * rstd * g.w); o8[64 * j] = w; }
}
__device__ __forceinline__ void rms_row_inplace(float* xrow, const float* gain, int lane) {
    f32x4* xr = (f32x4*)xrow + lane; const f32x4* gr = (const f32x4*)gain + lane;
    f32x4 v[4]; float s = 0.f;
#pragma unroll
    for (int j = 0; j < 4; ++j) { v[j] = xr[64 * j]; s += (v[j].x * v[j].x + v[j].y * v[j].y) + (v[j].z * v[j].z + v[j].w * v[j].w); }
    const float rstd = 1.0f / sqrtf(wave_sum(s) * (1.f / D) + 1e-6f);
#pragma unroll
    for (int j = 0; j < 4; ++j) { const f32x4 g = gr[64 * j]; xr[64 * j] = v[j] * rstd * g; }
}
__device__ __forceinline__ void norm_phase(LAS unsigned char* lds, int gw, int NGW, int wave, int lane, const float* x, const float* gain, bf16* XN,
                                           const float* W1, int K1, int N1, bf16* W1t, const float* W2, int K2, int N2, bf16* W2t) {
    LAS float* scr = (LAS float*)(lds + wave * 16384);
    const int I1 = (K1 / 64) * (N1 / 32), I2 = (K2 / 64) * (N2 / 32);
    for (int it = gw; it < I1 + I2; it += NGW) {
        if (it < I1) transpose_item(W1, K1, N1, W1t, scr, it, lane); else transpose_item(W2, K2, N2, W2t, scr, it - I1, lane);
    }
    for (int m = gw; m < M; m += NGW) rms_row_to_bf16(x + (size_t)m * D, gain, XN + (size_t)m * D, lane);
}

__device__ __forceinline__ void gmlp_item(LAS unsigned char* lds, int item, int tid, int wave, int lane, const bf16* P, const float* ln_g, const float* ln_b,
                                          const float* w_s, const float* b_s, bf16* Y) {
    const int chunk = item >> 2, g = item & 3, t0 = chunk * 128;
    LAS bf16* Wm = (LAS bf16*)lds;
    LAS bf16* Vt = (LAS bf16*)(lds + 128 * 136 * 2);
    for (int i = 0; i < 16; ++i) {
        const int s = wave * 16 + i;
        const v4u raw = *(const v4u*)(P + (size_t)(t0 + s) * EIN + 512 + lane * 8);
        float v[8];
        v[0] = __uint_as_float(raw.x << 16); v[1] = __uint_as_float(raw.x & 0xffff0000u); v[2] = __uint_as_float(raw.y << 16); v[3] = __uint_as_float(raw.y & 0xffff0000u);
        v[4] = __uint_as_float(raw.z << 16); v[5] = __uint_as_float(raw.z & 0xffff0000u); v[6] = __uint_as_float(raw.w << 16); v[7] = __uint_as_float(raw.w & 0xffff0000u);
        float sum = 0.f;
#pragma unroll
        for (int e = 0; e < 8; ++e) sum += v[e];
        const float mean = wave_sum(sum) * (1.f / 512.f);
        float q = 0.f;
#pragma unroll
        for (int e = 0; e < 8; ++e) { v[e] -= mean; q += v[e] * v[e]; }
        const float rstd = 1.0f / sqrtf(wave_sum(q) * (1.f / 512.f) + 1e-5f);
        if ((lane >> 4) == g) {
#pragma unroll
            for (int e = 0; e < 8; ++e) { const int c = (lane & 15) * 8 + e, ch = g * 128 + c; Vt[c * 136 + s] = (bf16)f2bf(v[e] * rstd * ln_g[ch] + ln_b[ch]); }
        }
    }
    for (int idx = tid; idx < 128 * 32; idx += 512) {
        const int t = idx >> 5, s4 = (idx & 31) * 4;
        const f32x4 w = *(const f32x4*)(w_s + ((size_t)g * 128 + t) * 128 + s4);
        v2u o; o.x = pk2(s4 + 0 <= t ? w.x : 0.f, s4 + 1 <= t ? w.y : 0.f); o.y = pk2(s4 + 2 <= t ? w.z : 0.f, s4 + 3 <= t ? w.w : 0.f);
        *(LAS v2u*)(Wm + t * 136 + s4) = o;
    }
    __syncthreads();
    const int r = lane & 15, q4 = lane >> 4;
    f32x4 acc[8];
#pragma unroll
    for (int ct = 0; ct < 8; ++ct) acc[ct] = (f32x4){0.f, 0.f, 0.f, 0.f};
    const int nks = (16 * wave + 15) / 32 + 1;
    for (int ks = 0; ks < nks; ++ks) {
        const bf16x8 af = *(const LAS bf16x8*)(Wm + (16 * wave + r) * 136 + ks * 32 + q4 * 8);
#pragma unroll
        for (int ct = 0; ct < 8; ++ct) { const bf16x8 bfr = *(const LAS bf16x8*)(Vt + (16 * ct + r) * 136 + ks * 32 + q4 * 8); acc[ct] = MFMA16(af, bfr, acc[ct]); }
    }
#pragma unroll
    for (int ct = 0; ct < 8; ++ct)
#pragma unroll
        for (int e = 0; e < 4; ++e) {
            const int t = 16 * wave + 4 * q4 + e, c = 16 * ct + r;
            const float mixed = acc[ct][e] + b_s[g * 128 + t];
            const float u = bf2f(P[(size_t)(t0 + t) * EIN + g * 128 + c]);
            Y[(size_t)(t0 + t) * D + g * 128 + c] = (bf16)f2bf(u * mixed);
        }
    __syncthreads();
}

struct RwkvW { const float *mu, *w0, *a0, *k_k, *k_a, *r_k; const bf16 *w2t, *a2t, *g2t; };
__device__ __forceinline__ float shifted(const bf16* P, int t, int col, float mu) {
    const float cur = bf2f(P[(size_t)t * EIN + col]); const float prev = t > 0 ? bf2f(P[(size_t)(t - 1) * EIN + col]) : 0.f; return cur + (prev - cur) * mu;
}
__device__ __forceinline__ void rwkv_prep_item(LAS unsigned char* lds, int item, int tid, int wave, int lane, const bf16* P, const RwkvW& W,
                                               float* LD, bf16* KK, bf16* BB, bf16* KP, bf16* RR, bf16* VV, bf16* GG, float* BS) {
    const int t0 = item * 64;
    LAS bf16* Xl = (LAS bf16*)lds;
    for (int idx = tid; idx < 64 * 256; idx += 512) {
        const int t = idx >> 8, j = idx & 255;
        const float ps = shifted(P, t0 + t, 1024 + 1536 + j, W.mu[1536 + j]);
        const float val = j < 64 ? tanhf(ps) : (j < 128 ? ps : 1.0f / (1.0f + __expf(-ps)));
        Xl[t * 264 + j] = (bf16)f2bf(val);
    }
    __syncthreads();
    const int h = wave, r = lane & 15, q4 = lane >> 4;
    for (int tt = 0; tt < 4; ++tt) {
        f32x4 aW[4], aA[4], aG[4];
#pragma unroll
        for (int ct = 0; ct < 4; ++ct) { aW[ct] = (f32x4){0.f, 0.f, 0.f, 0.f}; aA[ct] = aW[ct]; aG[ct] = aW[ct]; }
#pragma unroll
        for (int ks = 0; ks < 2; ++ks) {
            const bf16x8 xw = *(const LAS bf16x8*)(Xl + (16 * tt + r) * 264 + ks * 32 + q4 * 8);
            const bf16x8 xa = *(const LAS bf16x8*)(Xl + (16 * tt + r) * 264 + 64 + ks * 32 + q4 * 8);
#pragma unroll
            for (int ct = 0; ct < 4; ++ct) {
                const bf16x8 yw = *(const bf16x8*)(W.w2t + (size_t)(h * 64 + 16 * ct + r) * 64 + ks * 32 + q4 * 8);
                const bf16x8 ya = *(const bf16x8*)(W.a2t + (size_t)(h * 64 + 16 * ct + r) * 64 + ks * 32 + q4 * 8);
                aW[ct] = MFMA16(xw, yw, aW[ct]); aA[ct] = MFMA16(xa, ya, aA[ct]);
            }
        }
#pragma unroll
        for (int ks = 0; ks < 4; ++ks) {
            const bf16x8 xg = *(const LAS bf16x8*)(Xl + (16 * tt + r) * 264 + 128 + ks * 32 + q4 * 8);
#pragma unroll
            for (int ct = 0; ct < 4; ++ct) {
                const bf16x8 yg = *(const bf16x8*)(W.g2t + (size_t)(h * 64 + 16 * ct + r) * 128 + ks * 32 + q4 * 8);
                aG[ct] = MFMA16(xg, yg, aG[ct]);
            }
        }
#pragma unroll
        for (int e = 0; e < 4; ++e) {
            const int t = t0 + 16 * tt + 4 * q4 + e;
            float kkr[4], av[4]; float ss = 0.f, bon = 0.f;
#pragma unroll
            for (int ct = 0; ct < 4; ++ct) {
                const int c = h * 64 + 16 * ct + r;
                const float r_ = shifted(P, t, 1024 + c, W.mu[c]);
                const float k_ = shifted(P, t, 1024 + 512 + c, W.mu[512 + c]);
                const float v_ = shifted(P, t, 1024 + 1024 + c, W.mu[1024 + c]);
                const float xw = -(W.w0[c] + aW[ct][e]);
                const float sp = xw > 20.f ? xw : log1pf(__expf(xw));
                const float wv = -sp - 0.5f;
                const float ld = -__expf(wv);
                const float a = 1.0f / (1.0f + __expf(-(W.a0[c] + aA[ct][e])));
                const float kr = k_ * W.k_k[c];
                const float kp = k_ * (1.0f + (a - 1.0f) * W.k_a[c]);
                kkr[ct] = kr; av[ct] = a; ss += kr * kr; bon += r_ * kp * W.r_k[c];
                const size_t o = (size_t)t * BW + c;
                LD[o] = ld; KP[o] = (bf16)f2bf(kp); RR[o] = (bf16)f2bf(r_); VV[o] = (bf16)f2bf(v_); GG[o] = (bf16)f2bf(aG[ct][e]);
            }
#pragma unroll
            for (int o = 1; o < 16; o <<= 1) { ss += __shfl_xor(ss, o); bon += __shfl_xor(bon, o); }
            const float inv = 1.0f / sqrtf(fmaxf(ss, 1e-24f));
#pragma unroll
            for (int ct = 0; ct < 4; ++ct) {
                const int c = h * 64 + 16 * ct + r; const size_t o = (size_t)t * BW + c;
                const float kk = kkr[ct] * inv;
                KK[o] = (bf16)f2bf(kk); BB[o] = (bf16)f2bf(kk * av[ct]);
            }
            if (r == 0) BS[(size_t)t * 8 + h] = bon;
        }
    }
    __syncthreads();
}

struct ScanRegs { unsigned short kk[8], bb[8], kp[8], rr[8], vv[8]; float ld[8]; };
__device__ __forceinline__ void scan_load(ScanRegs& R, int t0, int hc, int hv, const float* LD, const bf16* KK, const bf16* BB, const bf16* KP, const bf16* RR, const bf16* VV) {
#pragma unroll
    for (int i = 0; i < 8; ++i) { const size_t o = (size_t)(t0 + i) * BW;
        R.kk[i] = KK[o + hc]; R.bb[i] = BB[o + hc]; R.kp[i] = KP[o + hc]; R.rr[i] = RR[o + hc]; R.ld[i] = LD[o + hc]; R.vv[i] = VV[o + hv]; }
}
__device__ __forceinline__ void rwkv_scan_wave(int gwv, int lane, const float* LD, const bf16* KK, const bf16* BB, const bf16* KP, const bf16* RR, const bf16* VV, float* OSC) {
    const int h = gwv >> 6, v = gwv & 63, hc = h * 64 + lane, hv = h * 64 + v;
    float S = 0.f;
    ScanRegs cur, nxt;
    scan_load(cur, 0, hc, hv, LD, KK, BB, KP, RR, VV);
    for (int t0 = 0; t0 < M; t0 += 8) {
        const int tn = (t0 + 8 < M) ? t0 + 8 : t0;
        scan_load(nxt, tn, hc, hv, LD, KK, BB, KP, RR, VV);
#pragma unroll
        for (int i = 0; i < 8; ++i) {
            const float kk = bf2f(cur.kk[i]), bb = bf2f(cur.bb[i]), kp = bf2f(cur.kp[i]), rr = bf2f(cur.rr[i]), vv = bf2f(cur.vv[i]);
            const float dec = __expf(cur.ld[i]);
            const float sa = wave_sum_uniform(S * kk);
            S = S * dec - sa * bb + vv * kp;
            const float o = wave_sum_uniform(S * rr);
            if (lane == 0) OSC[(size_t)(t0 + i) * BW + hv] = o;
        }
        cur = nxt;
    }
}
__device__ __forceinline__ void rwkv_out_row(int t, int lane, const float* OSC, const float* BS, const bf16* VV, const bf16* GG, const float* gn_g, const float* gn_b, bf16* Y) {
    const int c0 = lane * 8;
    const f32x4 o0 = *(const f32x4*)(OSC + (size_t)t * BW + c0), o1 = *(const f32x4*)(OSC + (size_t)t * BW + c0 + 4);
    float v[8] = {o0.x, o0.y, o0.z, o0.w, o1.x, o1.y, o1.z, o1.w};
    float s = 0.f;
#pragma unroll
    for (int e = 0; e < 8; ++e) s += v[e];
    s += __shfl_xor(s, 1); s += __shfl_xor(s, 2); s += __shfl_xor(s, 4);
    const float mean = s * (1.f / 64.f);
    float q = 0.f;
#pragma unroll
    for (int e = 0; e < 8; ++e) { v[e] -= mean; q += v[e] * v[e]; }
    q += __shfl_xor(q, 1); q += __shfl_xor(q, 2); q += __shfl_xor(q, 4);
    const float rstd = 1.0f / sqrtf(q * (1.f / 64.f) + 64e-5f);
    const float bon = BS[(size_t)t * 8 + (lane >> 3)];
    const v4u vraw = *(const v4u*)(VV + (size_t)t * BW + c0), graw = *(const v4u*)(GG + (size_t)t * BW + c0);
    const unsigned vr[4] = {vraw.x, vraw.y, vraw.z, vraw.w}, gr[4] = {graw.x, graw.y, graw.z, graw.w};
    float outv[8];
#pragma unroll
    for (int e = 0; e < 8; ++e) {
        const float vv = (e & 1) ? __uint_as_float(vr[e >> 1] & 0xffff0000u) : __uint_as_float(vr[e >> 1] << 16);
        const float gg = (e & 1) ? __uint_as_float(gr[e >> 1] & 0xffff0000u) : __uint_as_float(gr[e >> 1] << 16);
        outv[e] = (v[e] * rstd * gn_g[c0 + e] + gn_b[c0 + e] + bon * vv) * gg;
    }
    v4u w; w.x = pk2(outv[0], outv[1]); w.y = pk2(outv[2], outv[3]); w.z = pk2(outv[4], outv[5]); w.w = pk2(outv[6], outv[7]);
    *(v4u*)(Y + (size_t)t * D + 512 + c0) = w;
}

__device__ __forceinline__ void vtrans_item(LAS unsigned char* lds, int item, int tid, const bf16* QKV, bf16* VT1, bf16* VT4, bf16* VT16) {
    const int h = item >> 6, blk = item & 63, t0 = blk * 256;
    LAS bf16* Vl = (LAS bf16*)lds;
#pragma unroll
    for (int i = 0; i < 4; ++i) { const int idx = tid + 512 * i, t = idx >> 3, ch = idx & 7;
        *(LAS v4u*)(Vl + t * 72 + ch * 8) = *(const v4u*)(QKV + (size_t)(t0 + t) * NQKV + 2048 + h * 64 + ch * 8); }
    __syncthreads();
#pragma unroll
    for (int i = 0; i < 4; ++i) {
        const int idx = tid + 512 * i, d = idx >> 5;
        { const int j = idx & 31; unsigned short e[8];
#pragma unroll
          for (int k = 0; k < 8; ++k) e[k] = Vl[(8 * j + k) * 72 + d];
          v4u o; o.x = e[0] | ((unsigned)e[1] << 16); o.y = e[2] | ((unsigned)e[3] << 16); o.z = e[4] | ((unsigned)e[5] << 16); o.w = e[6] | ((unsigned)e[7] << 16);
          *(v4u*)(VT1 + (size_t)(h * 64 + d) * 16384 + t0 + 8 * j) = o; }
        { const int c4 = (idx >> 3) & 3, j = idx & 7; unsigned short e[8];
#pragma unroll
          for (int k = 0; k < 8; ++k) e[k] = Vl[(4 * (8 * j + k) + c4) * 72 + d];
          v4u o; o.x = e[0] | ((unsigned)e[1] << 16); o.y = e[2] | ((unsigned)e[3] << 16); o.z = e[4] | ((unsigned)e[5] << 16); o.w = e[6] | ((unsigned)e[7] << 16);
          *(v4u*)(VT4 + ((size_t)(h * 64 + d) * 4 + c4) * 4096 + t0 / 4 + 8 * j) = o; }
        { const int c16 = (idx >> 1) & 15, j = idx & 1; unsigned short e[8];
#pragma unroll
          for (int k = 0; k < 8; ++k) e[k] = Vl[(16 * (8 * j + k) + c16) * 72 + d];
          v4u o; o.x = e[0] | ((unsigned)e[1] << 16); o.y = e[2] | ((unsigned)e[3] << 16); o.z = e[4] | ((unsigned)e[5] << 16); o.w = e[6] | ((unsigned)e[7] << 16);
          *(v4u*)(VT16 + ((size_t)(h * 64 + d) * 16 + c16) * 1024 + t0 / 16 + 8 * j) = o; }
    }
    __syncthreads();
}

struct AttnFrags { bf16x8 ka0, ka1, kb0, kb1, vf[4]; };
template <int DIL>
__device__ __forceinline__ void attn_load(AttnFrags& f, const bf16* Kb, const bf16* VT, int h, int cp, int nb, int kA, int r, int q4) {
    constexpr int TD = M / DIL;
    int posA = cp + DIL * (nb + kA), posB = posA + 4 * DIL;
    posA = posA < 0 ? 0 : (posA > M - 1 ? M - 1 : posA); posB = posB < 0 ? 0 : (posB > M - 1 ? M - 1 : posB);
    f.ka0 = *(const bf16x8*)(Kb + (size_t)posA * NQKV); f.ka1 = *(const bf16x8*)(Kb + (size_t)posA * NQKV + 32);
    f.kb0 = *(const bf16x8*)(Kb + (size_t)posB * NQKV); f.kb1 = *(const bf16x8*)(Kb + (size_t)posB * NQKV + 32);
    int nv = nb + 8 * q4; nv = nv < 0 ? 0 : (nv > TD - 8 ? TD - 8 : nv);
#pragma unroll
    for (int dt = 0; dt < 4; ++dt) f.vf[dt] = *(const bf16x8*)(VT + ((size_t)(h * 64 + 16 * dt + r) * DIL + cp) * TD + nv);
}
__device__ __forceinline__ void attn_group(const AttnFrags& f, int nb, int nlo, int nhi, int q4, const bf16x8 (&qf)[2], f32x4 (&o)[4], float& lrun) {
    const float C = 0.125f * 1.4426950408889634f;
    f32x4 sA = (f32x4){0.f, 0.f, 0.f, 0.f}, sB = sA;
    sA = MFMA16(f.ka0, qf[0], sA); sA = MFMA16(f.ka1, qf[1], sA);
    sB = MFMA16(f.kb0, qf[0], sB); sB = MFMA16(f.kb1, qf[1], sB);
    float p[8]; float ps = 0.f;
    const int n0 = nb + 8 * q4;
#pragma unroll
    for (int e = 0; e < 8; ++e) {
        const int n = n0 + e;
        const float ex = __builtin_amdgcn_exp2f(fminf((e < 4 ? sA[e & 3] : sB[e & 3]) * C, 100.f));
        p[e] = (n >= nlo && n <= nhi) ? ex : 0.f; ps += p[e];
    }
    lrun += ps;
    v4u pw; pw.x = pk2(p[0], p[1]); pw.y = pk2(p[2], p[3]); pw.z = pk2(p[4], p[5]); pw.w = pk2(p[6], p[7]);
    const bf16x8 pf = __builtin_bit_cast(bf16x8, pw);
#pragma unroll
    for (int dt = 0; dt < 4; ++dt) o[dt] = MFMA16(f.vf[dt], pf, o[dt]);
}
template <int DIL, int NGRP>
__device__ __forceinline__ void attn_pattern(const bf16* QKV, const bf16* VT, int h, int blk, int cls, int lane, const bf16x8 (&qf)[2], f32x4 (&o)[4], float& lrun) {
    const int r = lane & 15, q4 = lane >> 4, m = r;
    const int cp = cls & (DIL - 1);
    const int nq = (256 * blk + cls - cp) / DIL + (16 / DIL) * m;
    const int nstart = (256 * blk) / DIL - 128;
    const int nlo = nq - 128 < 0 ? 0 : nq - 128, nhi = nq;
    const int kA = 8 * (r >> 2) + (r & 3);
    const bf16* Kb = QKV + 1024 + h * 64 + q4 * 8;
    AttnFrags fa, fb;
    attn_load<DIL>(fa, Kb, VT, h, cp, nstart, kA, r, q4);
#pragma unroll 1
    for (int g = 0; g < NGRP; g += 2) {
        if (g + 1 < NGRP) attn_load<DIL>(fb, Kb, VT, h, cp, nstart + 32 * (g + 1), kA, r, q4);
        attn_group(fa, nstart + 32 * g, nlo, nhi, q4, qf, o, lrun);
        if (g + 1 < NGRP) {
            if (g + 2 < NGRP) attn_load<DIL>(fa, Kb, VT, h, cp, nstart + 32 * (g + 2), kA, r, q4);
            attn_group(fb, nstart + 32 * (g + 1), nlo, nhi, q4, qf, o, lrun);
        }
    }
}
__device__ __forceinline__ void attn_wave_item(const bf16* QKV, const bf16* VT1, const bf16* VT4, const bf16* VT16, bf16* AO, int h, int blk, int cls, int lane) {
    const int r = lane & 15, q4 = lane >> 4;
    const int im = 256 * blk + cls + 16 * r;
    bf16x8 qf[2];
    qf[0] = *(const bf16x8*)(QKV + (size_t)im * NQKV + h * 64 + q4 * 8);
    qf[1] = *(const bf16x8*)(QKV + (size_t)im * NQKV + h * 64 + 32 + q4 * 8);
    f32x4 o[4];
#pragma unroll
    for (int dt = 0; dt < 4; ++dt) o[dt] = (f32x4){0.f, 0.f, 0.f, 0.f};
    float lrun = 0.f;
    attn_pattern<1, 12>(QKV, VT1, h, blk, cls, lane, qf, o, lrun);
    attn_pattern<4, 6>(QKV, VT4, h, blk, cls, lane, qf, o, lrun);
    attn_pattern<16, 5>(QKV, VT16, h, blk, cls, lane, qf, o, lrun);
    float l = lrun; l += __shfl_xor(l, 16); l += __shfl_xor(l, 32);
    const float inv = 1.0f / l;
#pragma unroll
    for (int dt = 0; dt < 4; ++dt) {
        v2u w; w.x = pk2(o[dt][0] * inv, o[dt][1] * inv); w.y = pk2(o[dt][2] * inv, o[dt][3] * inv);
        *(v2u*)(AO + (size_t)im * D + h * 64 + 16 * dt + 4 * q4) = w;
    }
}
constexpr int CH_CL = 0, CH_AT = 17408, CH_RT = CH_AT + 9216, CH_BT = CH_RT + 9216, CH_KT = CH_BT + 9216, CH_BHT = CH_KT + 9216, CH_KHT = CH_BHT + 9216, CH_VT = CH_KHT + 9216,
              CH_MABF = CH_VT + 9216, CH_MAK = CH_MABF + 17408, CH_MBR = CH_MAK + 9216, CH_MKR = CH_MBR + 9216, CH_GL = CH_MKR + 9216, CH_MABB = CH_GL + 256, CH_TJ = CH_MABB + 9216, CH_END = CH_TJ + 2048;
static_assert(CH_END <= 147456, "chunk LDS map");
__device__ __forceinline__ void unpack8(const v4u raw, float (&v)[8]) {
    v[0] = __uint_as_float(raw.x << 16); v[1] = __uint_as_float(raw.x & 0xffff0000u); v[2] = __uint_as_float(raw.y << 16); v[3] = __uint_as_float(raw.y & 0xffff0000u);
    v[4] = __uint_as_float(raw.z << 16); v[5] = __uint_as_float(raw.z & 0xffff0000u); v[6] = __uint_as_float(raw.w << 16); v[7] = __uint_as_float(raw.w & 0xffff0000u);
}
__device__ __forceinline__ v4u pack8(const float (&v)[8]) { v4u o; o.x = pk2(v[0], v[1]); o.y = pk2(v[2], v[3]); o.z = pk2(v[4], v[5]); o.w = pk2(v[6], v[7]); return o; }

__device__ __forceinline__ void rwkv_chunk_item(LAS unsigned char* lds, int item, int tid, int wave, int lane, const bf16* P, const RwkvW& W, bf16* VV, bf16* GG, float* BS,
                                                bf16* PMT, float* SLOC, bf16* QT, float* OLT) {
    const int c = item >> 3, h = item & 7, t0 = c * 64;
    LAS float* CL = (LAS float*)(lds + CH_CL); LAS float* Y5F = (LAS float*)(lds + CH_CL);
    LAS bf16* AT = (LAS bf16*)(lds + CH_AT); LAS bf16* RT = (LAS bf16*)(lds + CH_RT); LAS bf16* BT = (LAS bf16*)(lds + CH_BT); LAS bf16* KT = (LAS bf16*)(lds + CH_KT);
    LAS bf16* UB = BT; LAS bf16* WB = KT;
    LAS bf16* BHT = (LAS bf16*)(lds + CH_BHT); LAS bf16* KHT = (LAS bf16*)(lds + CH_KHT); LAS bf16* VT = (LAS bf16*)(lds + CH_VT);
    LAS float* MABF = (LAS float*)(lds + CH_MABF); LAS bf16* MAK = (LAS bf16*)(lds + CH_MAK); LAS bf16* MBR = (LAS bf16*)(lds + CH_MBR); LAS bf16* MKR = (LAS bf16*)(lds + CH_MKR);
    LAS float* GL = (LAS float*)(lds + CH_GL); LAS bf16* MABB = (LAS bf16*)(lds + CH_MABB); LAS bf16* TJB = (LAS bf16*)(lds + CH_TJ);
    LAS bf16* Xl = (LAS bf16*)(lds + CH_MABF);
    LAS float* LDv = (LAS float*)(lds + CH_AT);
    LAS float* SSP = (LAS float*)(lds + CH_TJ);
    const int r = lane & 15, q4 = lane >> 4, par = wave & 1;
    for (int idx = tid; idx < 64 * 256; idx += 512) {
        const int t = idx >> 8, j = idx & 255;
        const float ps = shifted(P, t0 + t, 1024 + 1536 + j, W.mu[1536 + j]);
        const float val = j < 64 ? tanhf(ps) : (j < 128 ? ps : 1.0f / (1.0f + __expf(-ps)));
        Xl[t * 264 + j] = (bf16)f2bf(val);
    }
    __syncthreads();
    const int tt = wave >> 1;
    float kr_[2][4], a_[2][4], kp_[2][4], r_s[2][4], v_s[2][4];
    {
        f32x4 aW[2], aA[2], aG[2];
#pragma unroll
        for (int ci = 0; ci < 2; ++ci) { aW[ci] = (f32x4){0.f, 0.f, 0.f, 0.f}; aA[ci] = aW[ci]; aG[ci] = aW[ci]; }
#pragma unroll
        for (int ks = 0; ks < 2; ++ks) {
            const bf16x8 xw = *(const LAS bf16x8*)(Xl + (16 * tt + r) * 264 + ks * 32 + q4 * 8);
            const bf16x8 xa = *(const LAS bf16x8*)(Xl + (16 * tt + r) * 264 + 64 + ks * 32 + q4 * 8);
#pragma unroll
            for (int ci = 0; ci < 2; ++ci) {
                const int crow = h * 64 + 16 * (2 * par + ci) + r;
                const bf16x8 yw = *(const bf16x8*)(W.w2t + (size_t)crow * 64 + ks * 32 + q4 * 8);
                const bf16x8 ya = *(const bf16x8*)(W.a2t + (size_t)crow * 64 + ks * 32 + q4 * 8);
                aW[ci] = MFMA16(xw, yw, aW[ci]); aA[ci] = MFMA16(xa, ya, aA[ci]);
            }
        }
#pragma unroll
        for (int ks = 0; ks < 4; ++ks) {
            const bf16x8 xg = *(const LAS bf16x8*)(Xl + (16 * tt + r) * 264 + 128 + ks * 32 + q4 * 8);
#pragma unroll
            for (int ci = 0; ci < 2; ++ci) {
                const bf16x8 yg = *(const bf16x8*)(W.g2t + (size_t)(h * 64 + 16 * (2 * par + ci) + r) * 128 + ks * 32 + q4 * 8);
                aG[ci] = MFMA16(xg, yg, aG[ci]);
            }
        }
#pragma unroll
        for (int e = 0; e < 4; ++e) {
            const int tl = 16 * tt + 4 * q4 + e, t = t0 + tl;
            float ss = 0.f, bon = 0.f;
#pragma unroll
            for (int ci = 0; ci < 2; ++ci) {
                const int cl_ = 16 * (2 * par + ci) + r, cc = h * 64 + cl_;
                const float rv = shifted(P, t, 1024 + cc, W.mu[cc]);
                const float kv = shifted(P, t, 1024 + 512 + cc, W.mu[512 + cc]);
                const float vv = shifted(P, t, 1024 + 1024 + cc, W.mu[1024 + cc]);
                const float xw = -(W.w0[cc] + aW[ci][e]);
                const float sp = xw > 20.f ? xw : log1pf(__expf(xw));
                const float ld = -__expf(-sp - 0.5f);
                const float a = 1.0f / (1.0f + __expf(-(W.a0[cc] + aA[ci][e])));
                const float kr = kv * W.k_k[cc];
                const float kp = kv * (1.0f + (a - 1.0f) * W.k_a[cc]);
                kr_[ci][e] = kr; a_[ci][e] = a; kp_[ci][e] = bf2f((bf16)f2bf(kp)); r_s[ci][e] = bf2f((bf16)f2bf(rv)); v_s[ci][e] = vv;
                ss += kr * kr; bon += rv * kp * W.r_k[cc];
                LDv[tl * 64 + cl_] = ld;
                const size_t o = (size_t)t * BW + cc;
                VV[o] = (bf16)f2bf(vv); GG[o] = (bf16)f2bf(aG[ci][e]);
            }
#pragma unroll
            for (int o = 1; o < 16; o <<= 1) { ss += __shfl_xor(ss, o); bon += __shfl_xor(bon, o); }
            if (r == 0) { SSP[tl * 2 + par] = ss; SSP[128 + tl * 2 + par] = bon; }
        }
    }
    __syncthreads();
    if (tid < 64) {
        float run = 0.f;
#pragma unroll 16
        for (int t = 0; t < 64; ++t) { run += LDv[t * 64 + tid]; CL[t * 64 + tid] = run; }
        GL[tid] = __expf(run);
    } else if (tid < 128) {
        const int tl = tid - 64;
        BS[(size_t)(t0 + tl) * 8 + h] = SSP[128 + tl * 2] + SSP[128 + tl * 2 + 1];
    }
    __syncthreads();
    {
#pragma unroll
        for (int ci = 0; ci < 2; ++ci) {
            const int k = 16 * (2 * par + ci) + r;
            const float clL = CL[63 * 64 + k];
            float bh[4], kh[4], vq[4];
#pragma unroll
            for (int e = 0; e < 4; ++e) {
                const int tl = 16 * tt + 4 * q4 + e;
                const float inv = 1.0f / sqrtf(fmaxf(SSP[tl * 2] + SSP[tl * 2 + 1], 1e-24f));
                const float kk = bf2f((bf16)f2bf(kr_[ci][e] * inv));
                const float bb = bf2f((bf16)f2bf(kk * a_[ci][e]));
                const float cl = CL[tl * 64 + k], clp = tl > 0 ? CL[(tl - 1) * 64 + k] : 0.f;
                const float en = __expf(-cl), eh = __expf(clL - cl);
                AT[tl * 72 + k] = (bf16)f2bf(-kk * __expf(clp)); RT[tl * 72 + k] = (bf16)f2bf(r_s[ci][e] * __expf(cl));
                BT[tl * 72 + k] = (bf16)f2bf(bb * en); KT[tl * 72 + k] = (bf16)f2bf(kp_[ci][e] * en);
                bh[e] = bb * eh; kh[e] = kp_[ci][e] * eh; vq[e] = v_s[ci][e];
            }
            const int tb = 16 * tt + 4 * q4;
            v2u w; w.x = pk2(bh[0], bh[1]); w.y = pk2(bh[2], bh[3]); *(LAS v2u*)(BHT + k * 72 + tb) = w;
            w.x = pk2(kh[0], kh[1]); w.y = pk2(kh[2], kh[3]); *(LAS v2u*)(KHT + k * 72 + tb) = w;
            w.x = pk2(vq[0], vq[1]); w.y = pk2(vq[2], vq[3]); *(LAS v2u*)(VT + k * 72 + tb) = w;
        }
    }
    __syncthreads();
    {
        const int mi = wave >> 1;
        const LAS bf16* X = (mi == 0 || mi == 2) ? BT : KT; const LAS bf16* Y = (mi < 2) ? AT : RT;
        f32x4 acc[2][4];
#pragma unroll
        for (int a = 0; a < 2; ++a)
#pragma unroll
            for (int b = 0; b < 4; ++b) acc[a][b] = (f32x4){0.f, 0.f, 0.f, 0.f};
#pragma unroll
        for (int ks = 0; ks < 2; ++ks) {
            bf16x8 xf[2], yf[4];
#pragma unroll
            for (int a = 0; a < 2; ++a) xf[a] = *(const LAS bf16x8*)(X + (16 * (2 * par + a) + r) * 72 + ks * 32 + q4 * 8);
#pragma unroll
            for (int b = 0; b < 4; ++b) yf[b] = *(const LAS bf16x8*)(Y + (16 * b + r) * 72 + ks * 32 + q4 * 8);
#pragma unroll
            for (int a = 0; a < 2; ++a)
#pragma unroll
                for (int b = 0; b < 4; ++b) acc[a][b] = MFMA16(xf[a], yf[b], acc[a][b]);
        }
#pragma unroll
        for (int a = 0; a < 2; ++a)
#pragma unroll
            for (int b = 0; b < 4; ++b) {
                const int s0 = 16 * (2 * par + a) + 4 * q4, t = 16 * b + r;
                f32x4 m;
#pragma unroll
                for (int e = 0; e < 4; ++e) m[e] = ((mi < 2) ? (s0 + e < t) : (s0 + e <= t)) ? acc[a][b][e] : 0.f;
                if (mi == 0) { *(LAS f32x4*)(MABF + t * 68 + s0) = m; v2u w; w.x = pk2(m[0], m[1]); w.y = pk2(m[2], m[3]); *(LAS v2u*)(MABB + t * 72 + s0) = w; }
                else { LAS bf16* Mo = (mi == 1) ? MAK : (mi == 2 ? MBR : MKR); v2u w; w.x = pk2(m[0], m[1]); w.y = pk2(m[2], m[3]); *(LAS v2u*)(Mo + t * 72 + s0) = w; }
            }
    }
    __syncthreads();
    {
        const int vt = wave >> 1;
        f32x4 acc[2];
        acc[0] = (f32x4){0.f, 0.f, 0.f, 0.f}; acc[1] = acc[0];
#pragma unroll
        for (int ks = 0; ks < 2; ++ks) {
            const bf16x8 xf = *(const LAS bf16x8*)(VT + (16 * vt + r) * 72 + ks * 32 + q4 * 8);
#pragma unroll
            for (int b = 0; b < 2; ++b) { const bf16x8 yf = *(const LAS bf16x8*)(MAK + (16 * (2 * par + b) + r) * 72 + ks * 32 + q4 * 8); acc[b] = MFMA16(xf, yf, acc[b]); }
        }
#pragma unroll
        for (int b = 0; b < 2; ++b)
#pragma unroll
            for (int e = 0; e < 4; ++e) Y5F[(16 * vt + 4 * q4 + e) * 68 + 16 * (2 * par + b) + r] = acc[b][e];
    }
    __syncthreads();
    if (wave == 0) {
        const int J = lane >> 4, i = lane & 15;
        float tr[16];
#pragma unroll
        for (int t = 0; t < 16; ++t) {
            float acc = (t == i) ? 1.f : 0.f;
#pragma unroll
            for (int s2 = 0; s2 < t; ++s2) acc += tr[s2] * MABF[(16 * J + t) * 68 + 16 * J + s2];
            tr[t] = acc;
        }
#pragma unroll
        for (int t = 0; t < 16; ++t) TJB[(16 * J + t) * 16 + i] = (bf16)f2bf(tr[t]);
    }
    __syncthreads();
    {
        unsigned xb[4][2];
#pragma unroll
        for (int J = 0; J < 4; ++J) {
            f32x4 z;
            if (wave < 4) z = *(const LAS f32x4*)(Y5F + (16 * wave + r) * 68 + 16 * J + 4 * q4);
            else {
#pragma unroll
                for (int e = 0; e < 4; ++e) z[e] = bf2f(AT[(16 * J + 4 * q4 + e) * 72 + 16 * (wave - 4) + r]);
            }
#pragma unroll
            for (int I = 0; I < J; I += 2) {
                const bool two = (I + 1 < J);
                const v2u m0 = *(const LAS v2u*)(MABB + (16 * J + r) * 72 + 16 * I + 4 * q4);
                v2u m1; m1.x = 0u; m1.y = 0u;
                if (two) m1 = *(const LAS v2u*)(MABB + (16 * J + r) * 72 + 16 * (I + 1) + 4 * q4);
                v4u fa; fa.x = m0.x; fa.y = m0.y; fa.z = m1.x; fa.w = m1.y;
                v4u fb; fb.x = xb[I][0]; fb.y = xb[I][1]; fb.z = two ? xb[I + 1 < 4 ? I + 1 : 3][0] : 0u; fb.w = two ? xb[I + 1 < 4 ? I + 1 : 3][1] : 0u;
                z = MFMA16(__builtin_bit_cast(bf16x8, fa), __builtin_bit_cast(bf16x8, fb), z);
            }
            const unsigned zh0 = pk2(z[0], z[1]), zh1 = pk2(z[2], z[3]);
            const unsigned zl0 = pk2(z[0] - __uint_as_float(zh0 << 16), z[1] - __uint_as_float(zh0 & 0xffff0000u)), zl1 = pk2(z[2] - __uint_as_float(zh1 << 16), z[3] - __uint_as_float(zh1 & 0xffff0000u));
            const v2u tw = *(const LAS v2u*)(TJB + (16 * J + r) * 16 + 4 * q4);
            v4u ft; ft.x = tw.x; ft.y = tw.y; ft.z = 0u; ft.w = 0u;
            v4u fh; fh.x = zh0; fh.y = zh1; fh.z = 0u; fh.w = 0u;
            v4u fl; fl.x = zl0; fl.y = zl1; fl.z = 0u; fl.w = 0u;
            f32x4 x = (f32x4){0.f, 0.f, 0.f, 0.f};
            x = MFMA16(__builtin_bit_cast(bf16x8, ft), __builtin_bit_cast(bf16x8, fh), x);
            x = MFMA16(__builtin_bit_cast(bf16x8, ft), __builtin_bit_cast(bf16x8, fl), x);
            xb[J][0] = pk2(x[0], x[1]); xb[J][1] = pk2(x[2], x[3]);
            LAS bf16* Xo = (wave < 4) ? (UB + (16 * wave + r) * 72) : (WB + (16 * (wave - 4) + r) * 72);
            v2u w; w.x = xb[J][0]; w.y = xb[J][1];
            *(LAS v2u*)(Xo + 16 * J + 4 * q4) = w;
        }
    }
    __syncthreads();
    {
        const int kind = wave >> 1;
        const LAS bf16* X1; const LAS bf16* Y1; const LAS bf16* X2 = nullptr; const LAS bf16* Y2 = nullptr;
        if (kind == 0) { X1 = UB; Y1 = MBR; X2 = VT; Y2 = MKR; }
        else if (kind == 1) { X1 = BHT; Y1 = UB; X2 = KHT; Y2 = VT; }
        else if (kind == 2) { X1 = WB; Y1 = MBR; }
        else { X1 = WB; Y1 = BHT; }
        f32x4 acc[2][4];
#pragma unroll
        for (int a = 0; a < 2; ++a)
#pragma unroll
            for (int b = 0; b < 4; ++b) acc[a][b] = (f32x4){0.f, 0.f, 0.f, 0.f};
#pragma unroll
        for (int ks = 0; ks < 2; ++ks) {
            bf16x8 xf[2], yf[4];
#pragma unroll
            for (int a = 0; a < 2; ++a) xf[a] = *(const LAS bf16x8*)(X1 + (16 * (2 * par + a) + r) * 72 + ks * 32 + q4 * 8);
#pragma unroll
            for (int b = 0; b < 4; ++b) yf[b] = *(const LAS bf16x8*)(Y1 + (16 * b + r) * 72 + ks * 32 + q4 * 8);
#pragma unroll
            for (int a = 0; a < 2; ++a)
#pragma unroll
                for (int b = 0; b < 4; ++b) acc[a][b] = MFMA16(xf[a], yf[b], acc[a][b]);
        }
        if (kind < 2) {
#pragma unroll
            for (int ks = 0; ks < 2; ++ks) {
                bf16x8 xf[2], yf[4];
#pragma unroll
                for (int a = 0; a < 2; ++a) xf[a] = *(const LAS bf16x8*)(X2 + (16 * (2 * par + a) + r) * 72 + ks * 32 + q4 * 8);
#pragma unroll
                for (int b = 0; b < 4; ++b) yf[b] = *(const LAS bf16x8*)(Y2 + (16 * b + r) * 72 + ks * 32 + q4 * 8);
#pragma unroll
                for (int a = 0; a < 2; ++a)
#pragma unroll
                    for (int b = 0; b < 4; ++b) acc[a][b] = MFMA16(xf[a], yf[b], acc[a][b]);
            }
        }
#pragma unroll
        for (int a = 0; a < 2; ++a)
#pragma unroll
            for (int b = 0; b < 4; ++b) {
                const int i0 = 16 * (2 * par + a) + 4 * q4, j = 16 * b + r;
                if (kind == 0) *(f32x4*)(OLT + ((size_t)item * 64 + j) * 64 + i0) = acc[a][b];
                else if (kind == 1) *(f32x4*)(SLOC + ((size_t)item * 64 + j) * 64 + i0) = acc[a][b];
                else if (kind == 2) {
                    const v2u rw = *(const LAS v2u*)(RT + j * 72 + i0);
                    v2u w; w.x = pk2(acc[a][b][0] + __uint_as_float(rw.x << 16), acc[a][b][1] + __uint_as_float(rw.x & 0xffff0000u));
                    w.y = pk2(acc[a][b][2] + __uint_as_float(rw.y << 16), acc[a][b][3] + __uint_as_float(rw.y & 0xffff0000u));
                    *(v2u*)(QT + ((size_t)item * 64 + j) * 64 + i0) = w;
                } else {
                    f32x4 m = acc[a][b];
#pragma unroll
                    for (int e = 0; e < 4; ++e) if (i0 + e == j) m[e] += GL[j];
                    v2u w; w.x = pk2(m[0], m[1]); w.y = pk2(m[2], m[3]);
                    *(v2u*)(PMT + ((size_t)item * 64 + j) * 64 + i0) = w;
                }
            }
    }
    __syncthreads();
}

struct ScanOps { bf16x8 pf[4][2]; f32x4 sl[4]; };
__device__ __forceinline__ void scan_ops_load(ScanOps& o, int it, int v, int r, int q4, const bf16* PMT, const float* SLOC) {
#pragma unroll
    for (int kt = 0; kt < 4; ++kt) {
        o.sl[kt] = *(const f32x4*)(SLOC + ((size_t)it * 64 + v) * 64 + 16 * kt + 4 * q4);
#pragma unroll
        for (int ks = 0; ks < 2; ++ks) {
            const bf16* p = PMT + ((size_t)it * 64 + 16 * kt + r) * 64 + 32 * ks + 4 * q4;
            const v2u lo = *(const v2u*)p, hi = *(const v2u*)(p + 16);
            v4u w; w.x = lo.x; w.y = lo.y; w.z = hi.x; w.w = hi.y;
            o.pf[kt][ks] = __builtin_bit_cast(bf16x8, w);
        }
    }
}
__device__ __forceinline__ void scan_step(const ScanOps& o, int c, int it, int v, int q4, int lane, LAS unsigned char* lds, bf16* SC) {
    volatile LAS int* flag = (volatile LAS int*)(lds + 16384);
    LAS v4u* slot_in = (LAS v4u*)(lds + (c & 1) * 8192);
    LAS v4u* slot_out = (LAS v4u*)(lds + ((c + 1) & 1) * 8192);
    while (*flag != c) __builtin_amdgcn_s_sleep(1);
    asm volatile("" ::: "memory");
    const v4u h0 = slot_in[lane], h1 = slot_in[64 + lane], l0 = slot_in[128 + lane], l1 = slot_in[192 + lane];
    { bf16* sc = SC + ((size_t)it * 64 + v) * 64 + 4 * q4;
      v2u w; w.x = h0.x; w.y = h0.y; *(v2u*)(sc) = w; w.x = h0.z; w.y = h0.w; *(v2u*)(sc + 16) = w;
      w.x = h1.x; w.y = h1.y; *(v2u*)(sc + 32) = w; w.x = h1.z; w.y = h1.w; *(v2u*)(sc + 48) = w; }
    const bf16x8 sh0 = __builtin_bit_cast(bf16x8, h0), sh1 = __builtin_bit_cast(bf16x8, h1), sl0 = __builtin_bit_cast(bf16x8, l0), sl1 = __builtin_bit_cast(bf16x8, l1);
    unsigned hw[4][2], lw[4][2];
#pragma unroll
    for (int kt = 0; kt < 4; ++kt) {
        f32x4 n = o.sl[kt];
        n = MFMA16(o.pf[kt][0], sh0, n); n = MFMA16(o.pf[kt][1], sh1, n);
        n = MFMA16(o.pf[kt][0], sl0, n); n = MFMA16(o.pf[kt][1], sl1, n);
        hw[kt][0] = pk2(n[0], n[1]); hw[kt][1] = pk2(n[2], n[3]);
        lw[kt][0] = pk2(n[0] - __uint_as_float(hw[kt][0] << 16), n[1] - __uint_as_float(hw[kt][0] & 0xffff0000u));
        lw[kt][1] = pk2(n[2] - __uint_as_float(hw[kt][1] << 16), n[3] - __uint_as_float(hw[kt][1] & 0xffff0000u));
    }
    v4u o0, o1, o2, o3;
    o0.x = hw[0][0]; o0.y = hw[0][1]; o0.z = hw[1][0]; o0.w = hw[1][1];
    o1.x = hw[2][0]; o1.y = hw[2][1]; o1.z = hw[3][0]; o1.w = hw[3][1];
    o2.x = lw[0][0]; o2.y = lw[0][1]; o2.z = lw[1][0]; o2.w = lw[1][1];
    o3.x = lw[2][0]; o3.y = lw[2][1]; o3.z = lw[3][0]; o3.w = lw[3][1];
    slot_out[lane] = o0; slot_out[64 + lane] = o1; slot_out[128 + lane] = o2; slot_out[192 + lane] = o3;
    asm volatile("s_waitcnt lgkmcnt(0)" ::: "memory");
    if (lane == 0) *flag = c + 1;
}
__device__ __forceinline__ void rwkv_state_scan_wg(LAS unsigned char* lds, int hv, int tid, int wave, int lane, const bf16* PMT, const float* SLOC, bf16* SC) {
    const int h = hv >> 2, vt = hv & 3, r = lane & 15, q4 = lane >> 4, v = 16 * vt + r;
    constexpr int NC = M / 64;
    for (int i = tid; i < 16384 / 4 + 16; i += 512) ((LAS unsigned*)lds)[i] = 0u;
    __syncthreads();
    ScanOps A, B;
    scan_ops_load(A, wave * 8 + h, v, r, q4, PMT, SLOC);
    scan_ops_load(B, (wave + 8) * 8 + h, v, r, q4, PMT, SLOC);
    for (int j = 0; j < NC / 8; j += 2) {
        const int cA = wave + 8 * j, cB = cA + 8;
        scan_step(A, cA, cA * 8 + h, v, q4, lane, lds, SC);
        if (j + 2 < NC / 8) scan_ops_load(A, (cA + 16) * 8 + h, v, r, q4, PMT, SLOC);
        scan_step(B, cB, cB * 8 + h, v, q4, lane, lds, SC);
        if (j + 3 < NC / 8) scan_ops_load(B, (cB + 16) * 8 + h, v, r, q4, PMT, SLOC);
    }
    __syncthreads();
}
__device__ __forceinline__ void rwkv_chunk_out(int item, int lane, const bf16* SC, const bf16* QT, const float* OLT, const float* BS, const bf16* VV, const bf16* GG,
                                               const float* gn_g, const float* gn_b, bf16* Y) {
    const int c = item >> 3, h = item & 7, r = lane & 15, q4 = lane >> 4;
    bf16x8 sf[4][2];
#pragma unroll
    for (int vt = 0; vt < 4; ++vt)
#pragma unroll
        for (int ks = 0; ks < 2; ++ks) sf[vt][ks] = *(const bf16x8*)(SC + ((size_t)item * 64 + 16 * vt + r) * 64 + 32 * ks + 8 * q4);
    f32x4 gg4[4], gb4[4];
#pragma unroll
    for (int vt = 0; vt < 4; ++vt) { gg4[vt] = *(const f32x4*)(gn_g + h * 64 + 16 * vt + 4 * q4); gb4[vt] = *(const f32x4*)(gn_b + h * 64 + 16 * vt + 4 * q4); }
    for (int tt = 0; tt < 4; ++tt) {
        const int tl = 16 * tt + r, t = c * 64 + tl;
        bf16x8 qf[2];
#pragma unroll
        for (int ks = 0; ks < 2; ++ks) qf[ks] = *(const bf16x8*)(QT + ((size_t)item * 64 + tl) * 64 + 32 * ks + 8 * q4);
        f32x4 o[4]; float s = 0.f;
#pragma unroll
        for (int vt = 0; vt < 4; ++vt) {
            o[vt] = *(const f32x4*)(OLT + ((size_t)item * 64 + tl) * 64 + 16 * vt + 4 * q4);
            o[vt] = MFMA16(sf[vt][0], qf[0], o[vt]); o[vt] = MFMA16(sf[vt][1], qf[1], o[vt]);
            s += (o[vt][0] + o[vt][1]) + (o[vt][2] + o[vt][3]);
        }
        s += __shfl_xor(s, 16); s += __shfl_xor(s, 32);
        const float mean = s * (1.f / 64.f);
        float qv = 0.f;
#pragma unroll
        for (int vt = 0; vt < 4; ++vt) { o[vt] = o[vt] - mean; qv += (o[vt][0] * o[vt][0] + o[vt][1] * o[vt][1]) + (o[vt][2] * o[vt][2] + o[vt][3] * o[vt][3]); }
        qv += __shfl_xor(qv, 16); qv += __shfl_xor(qv, 32);
        const float rstd = 1.0f / sqrtf(qv * (1.f / 64.f) + 64e-5f);
        const float bon = BS[(size_t)t * 8 + h];
#pragma unroll
        for (int vt = 0; vt < 4; ++vt) {
            const size_t oo = (size_t)t * BW + h * 64 + 16 * vt + 4 * q4;
            const v2u vr = *(const v2u*)(VV + oo), gr = *(const v2u*)(GG + oo);
            const float v0 = __uint_as_float(vr.x << 16), v1 = __uint_as_float(vr.x & 0xffff0000u), v2 = __uint_as_float(vr.y << 16), v3 = __uint_as_float(vr.y & 0xffff0000u);
            const float g0 = __uint_as_float(gr.x << 16), g1 = __uint_as_float(gr.x & 0xffff0000u), g2 = __uint_as_float(gr.y << 16), g3 = __uint_as_float(gr.y & 0xffff0000u);
            const f32x4 y = o[vt] * rstd * gg4[vt] + gb4[vt];
            v2u w; w.x = pk2((y[0] + bon * v0) * g0, (y[1] + bon * v1) * g1); w.y = pk2((y[2] + bon * v2) * g2, (y[3] + bon * v3) * g3);
            *(v2u*)(Y + (size_t)t * D + 512 + h * 64 + 16 * vt + 4 * q4) = w;
        }
    }
}
#define XB_TMO      128
#define XB_XCNT(j)  (256  + 64 * (j))
#define XB_XSUB(j)  (1280 + 64 * (j))
#define XB_XGEN(j)  (2304 + 64 * (j))
#define XB_TOP      3328
#define XB_TOPGEN   3392
#define XCD_BAR_WORDS 3456
#define XB_SPIN_CAP (1u << 18)

__device__ __forceinline__ unsigned xb_ld(unsigned* p)              { return __hip_atomic_load(p, __ATOMIC_RELAXED, __HIP_MEMORY_SCOPE_AGENT); }
__device__ __forceinline__ unsigned xb_add(unsigned* p, unsigned v) { return __hip_atomic_fetch_add(p, v, __ATOMIC_RELAXED, __HIP_MEMORY_SCOPE_AGENT); }
__device__ __forceinline__ unsigned xb_xcc_id() { return (unsigned)__builtin_amdgcn_s_getreg((3 << 11) | 20) & 0xFu; }
#define XB_SPIN(cond, bar) do { unsigned _sp = 0; while (cond) { __builtin_amdgcn_s_sleep(1); \
    if ((++_sp & 255u) == 0u) { if (xb_ld(&(bar)[XB_TMO])) break; if (_sp > XB_SPIN_CAP) { atomicAdd(&(bar)[XB_TMO], 1u); break; } } } } while (0)

struct XcdBarrier {
    unsigned* bar; unsigned x;
    volatile LAS unsigned* st;
};

__device__ __forceinline__ XcdBarrier xcd_barrier_post(unsigned* bar, volatile LAS unsigned* st) {
    XcdBarrier b; b.bar = bar; b.x = xb_xcc_id(); b.st = st;
    if (threadIdx.x == 0) (void)xb_add(&bar[XB_XCNT(b.x)], 1u);
    return b;
}
__device__ __forceinline__ void xcd_barrier_complete(unsigned* bar, unsigned x, unsigned& nloc, unsigned& nx) {
    const unsigned G = gridDim.x * gridDim.y * gridDim.z;
    unsigned sum, cnt, mine, sp = 0u;
    for (;;) {
        sum = 0u; cnt = 0u; mine = 0u;
#pragma unroll
        for (unsigned j = 0; j < 16; ++j) { const unsigned c = xb_ld(&bar[XB_XCNT(j)]); sum += c; cnt += (c > 0u) ? 1u : 0u; mine = (j == x) ? c : mine; }
        if (sum == G) break;
        __builtin_amdgcn_s_sleep(1);
        if ((++sp & 255u) == 0u) { if (xb_ld(&bar[XB_TMO])) break; if (sp > XB_SPIN_CAP) { atomicAdd(&bar[XB_TMO], 1u); break; } }
    }
    nloc = mine > 0u ? mine : 1u; nx = cnt > 0u ? cnt : 1u;
}

__device__ __forceinline__ void xcd_barrier(const XcdBarrier& b) {
    asm volatile("s_waitcnt vmcnt(0)" ::: "memory");
    __syncthreads();
    if (threadIdx.x == 0) {
        unsigned* bar = b.bar;
        __builtin_amdgcn_s_waitcnt(0);
        unsigned nloc = b.st[0], nx = b.st[1];
        if (nloc == 0u) { xcd_barrier_complete(bar, b.x, nloc, nx); b.st[0] = nloc; b.st[1] = nx; }
        const unsigned old = xb_add(&bar[XB_XSUB(b.x)], 1u);
        const unsigned gen = old / nloc;
        if (old + 1u == (gen + 1u) * nloc) {
            __builtin_amdgcn_fence(__ATOMIC_RELEASE, "agent");
            asm volatile("s_waitcnt vmcnt(0)" ::: "memory");
            const unsigned og = xb_add(&bar[XB_TOP], 1u);
            const unsigned tg = og / nx;
            if (og + 1u == (tg + 1u) * nx) xb_add(&bar[XB_TOPGEN], 1u);
            else XB_SPIN(xb_ld(&bar[XB_TOPGEN]) == tg, bar);
            __builtin_amdgcn_fence(__ATOMIC_ACQUIRE, "agent");
            xb_add(&bar[XB_XGEN(b.x)], 1u);
            asm volatile("s_waitcnt vmcnt(0)" ::: "memory");
        } else {
            XB_SPIN(xb_ld(&bar[XB_XGEN(b.x)]) == gen, bar);
            __builtin_amdgcn_fence(__ATOMIC_ACQUIRE, "agent");
            asm volatile("s_waitcnt vmcnt(0)" ::: "memory");
        }
    }
    __syncthreads();
}
struct Args { const float* in[28]; float* out; unsigned char* ws; };
#define GRID_SYNC() xcd_barrier(xbar)
#define PHASE_VARS int tid = threadIdx.x; asm volatile("" : "+v"(tid)); const int lane = tid & 63; const int wave = __builtin_amdgcn_readfirstlane(tid >> 6); \
    int G = gridDim.x; asm volatile("" : "+s"(G)); int bx = blockIdx.x; asm volatile("" : "+s"(bx)); const int gw = bx * NWAVES + wave, NGW = G * NWAVES; (void)lane; (void)gw; (void)NGW; (void)tid
#define WSP(T, off) ((T*)(args.ws + (off)))
#define XIN (args.in[0])
#define OUTF (args.out)
#define WA WSP(bf16, WS_WA)
#define WB WSP(bf16, WS_WB)
#define XN WSP(bf16, WS_XN)
#define P WSP(bf16, WS_P)
#define LD WSP(float, WS_LD)
#define KK WSP(bf16, WS_KK)
#define BB WSP(bf16, WS_BB)
#define KP WSP(bf16, WS_KP)
#define RR WSP(bf16, WS_RR)
#define VV WSP(bf16, WS_VV)
#define GG ((bf16*)args.out)
#define SCB ((bf16*)((unsigned char*)args.out + 16 * MiB))
#define OLT ((float*)((unsigned char*)args.out + 32 * MiB))
#define PMT WSP(bf16, WS_LD)
#define SLOC WSP(float, WS_LD + 16 * MiB)
#define QTB WSP(bf16, WS_LD + 48 * MiB)
#define BS WSP(float, WS_BS)
#define W2T WSP(bf16, WS_W2T)
#define A2T WSP(bf16, WS_A2T)
#define G2T WSP(bf16, WS_G2T)
#define YC WSP(bf16, WS_XN)
#define ACT WSP(bf16, WS_GEN)
#define QKV WSP(bf16, WS_QKV)
#define VT1 WSP(bf16, WS_VT1)
#define VT4 WSP(bf16, WS_VT4)
#define VT16 WSP(bf16, WS_VT16)
__global__ void __launch_bounds__(NWAVES * 64, 2) hybrid_fwd(Args args) {
    extern __shared__ __attribute__((aligned(16))) unsigned char lds_raw[];
    LAS unsigned char* lds = (LAS unsigned char*)lds_raw;
    if (threadIdx.x < 16) ((LAS unsigned*)(lds + LDS_BYTES - 64))[threadIdx.x] = 0u;
    __syncthreads();
    const XcdBarrier xbar = xcd_barrier_post((unsigned*)args.ws, (volatile LAS unsigned*)(lds + LDS_BYTES - 64));

    { PHASE_VARS;
    {
        LAS float* scr = (LAS float*)(lds + wave * 16384);
        const int IL = 16 + 16 + 32;
        for (int it = gw; it < IL; it += NGW) {
            if (it < 16) transpose_item(args.in[9], 64, 512, W2T, scr, it, lane);
            else if (it < 32) transpose_item(args.in[11], 64, 512, A2T, scr, it - 16, lane);
            else transpose_item(args.in[12], 128, 512, G2T, scr, it - 32, lane);
        }
        norm_phase(lds, gw, NGW, wave, lane, XIN, args.in[1], XN, args.in[2], D, EIN, WA, args.in[18], D, D, WB);
    }

    }
    cg::this_grid().sync();
    { PHASE_VARS;

    {
        pg8::Gemm g{XN, WA, M, EIN, D, 256L * D * 2, 128L * D * 2, 256L * D * 2, 128L * D * 2, 0}; pg8::StaticOrder S; S.init(M, EIN, G, bx);
        pg8::EpiBf16<0> E{P, EIN, nullptr, 0, 0, 1.f};
        pg8::gemm_phase<pg8::EpiBf16<0>, pg8::StaticOrder, true, true>(lds, g, S, E);
    }

    }
    GRID_SYNC();
    { PHASE_VARS;
        RwkvW W{args.in[7], args.in[8], args.in[10], args.in[13], args.in[14], args.in[15], W2T, A2T, G2T};
        for (int it = bx; it < (M / 64) * 8; it += G) rwkv_chunk_item(lds, it, tid, wave, lane, P, W, VV, GG, BS, PMT, SLOC, QTB, OLT);
    }
    GRID_SYNC();
    { PHASE_VARS;
        if (bx < 32) rwkv_state_scan_wg(lds, bx, tid, wave, lane, PMT, SLOC, SCB);
        else for (int it = bx - 32; it < (M / 128) * 4; it += G - 32) gmlp_item(lds, it, tid, wave, lane, P, args.in[3], args.in[4], args.in[5], args.in[6], YC);
    }
    GRID_SYNC();
    { PHASE_VARS;
        for (int it = gw; it < (M / 64) * 8; it += NGW) rwkv_chunk_out(it, lane, SCB, QTB, OLT, BS, VV, GG, args.in[16], args.in[17], YC);
    }
    GRID_SYNC();
    { PHASE_VARS;

    {
        pg8::Gemm g{YC, WB, M, D, D, 256L * D * 2, 128L * D * 2, 256L * D * 2, 128L * D * 2, 0}; pg8::StaticOrder S; S.init(M, D, G, bx);
        pg8::EpiRes E{XIN, OUTF, D};
        pg8::gemm_phase<pg8::EpiRes, pg8::StaticOrder, true, true>(lds, g, S, E);
    }

    }
    GRID_SYNC();
    { PHASE_VARS;
        norm_phase(lds, gw, NGW, wave, lane, OUTF, args.in[22] + 0 * D, XN, args.in[23] + (size_t)0 * D * FF2, D, FF2, WA, args.in[26] + (size_t)0 * FF * D, FF, D, WB);
    }
    GRID_SYNC();
    { PHASE_VARS;
        pg8::Gemm g{XN - 2 * D, WA, M, FF2, D, 248L * D * 2, 124L * D * 2, 128L * D * 2, 2816L * D * 2, 1}; pg8::StaticOrder S; S.init2(67, 22, G, bx);
        pg8::EpiConvGlu E{ACT, args.in[24] + (size_t)0 * 3 * FF2, args.in[25] + (size_t)0 * FF2, M};
        pg8::gemm_phase<pg8::EpiConvGlu, pg8::StaticOrder, true, true>(lds, g, S, E);
    }
    GRID_SYNC();
    { PHASE_VARS;
        pg8::Gemm g{ACT, WB, M, D, FF, 256L * FF * 2, 128L * FF * 2, 256L * FF * 2, 128L * FF * 2, 0}; pg8::StaticOrder S; S.init(M, D, G, bx);
        pg8::EpiRes E{OUTF, OUTF, D};
        pg8::gemm_phase<pg8::EpiRes, pg8::StaticOrder, true, true>(lds, g, S, E);
    }
    GRID_SYNC();
    { PHASE_VARS;
        norm_phase(lds, gw, NGW, wave, lane, OUTF, args.in[19], XN, args.in[20], D, NQKV, WA, args.in[21], D, D, WB);
    }
    GRID_SYNC();
    { PHASE_VARS;
        pg8::Gemm g{XN, WA, M, NQKV, D, 256L * D * 2, 128L * D * 2, 256L * D * 2, 128L * D * 2, 0}; pg8::StaticOrder S; S.init(M, NQKV, G, bx);
        pg8::EpiBf16<0> E{QKV, NQKV, nullptr, 0, 0, 1.f};
        pg8::gemm_phase<pg8::EpiBf16<0>, pg8::StaticOrder, true, true>(lds, g, S, E);
    }
    GRID_SYNC();
    { PHASE_VARS;
        for (int it = bx; it < 16 * 64; it += G) vtrans_item(lds, it, tid, QKV, VT1, VT4, VT16);
    }
    GRID_SYNC();
    { PHASE_VARS;
        for (int it = bx; it < 16 * 64; it += G) {
            const int h = it >> 6, blk = it & 63;
            attn_wave_item(QKV, VT1, VT4, VT16, YC, h, blk, 2 * wave, lane);
            attn_wave_item(QKV, VT1, VT4, VT16, YC, h, blk, 2 * wave + 1, lane);
        }
    }
    GRID_SYNC();
    { PHASE_VARS;
        pg8::Gemm g{YC, WB, M, D, D, 256L * D * 2, 128L * D * 2, 256L * D * 2, 128L * D * 2, 0}; pg8::StaticOrder S; S.init(M, D, G, bx);
        pg8::EpiRes E{OUTF, OUTF, D};
        pg8::gemm_phase<pg8::EpiRes, pg8::StaticOrder, true, true>(lds, g, S, E);
    }
    GRID_SYNC();
    { PHASE_VARS;
        norm_phase(lds, gw, NGW, wave, lane, OUTF, args.in[22] + 1 * D, XN, args.in[23] + (size_t)1 * D * FF2, D, FF2, WA, args.in[26] + (size_t)1 * FF * D, FF, D, WB);
    }
    GRID_SYNC();
    { PHASE_VARS;
        pg8::Gemm g{XN - 2 * D, WA, M, FF2, D, 248L * D * 2, 124L * D * 2, 128L * D * 2, 2816L * D * 2, 1}; pg8::StaticOrder S; S.init2(67, 22, G, bx);
        pg8::EpiConvGlu E{ACT, args.in[24] + (size_t)1 * 3 * FF2, args.in[25] + (size_t)1 * FF2, M};
        pg8::gemm_phase<pg8::EpiConvGlu, pg8::StaticOrder, true, true>(lds, g, S, E);
    }
    GRID_SYNC();
    { PHASE_VARS;
        pg8::Gemm g{ACT, WB, M, D, FF, 256L * FF * 2, 128L * FF * 2, 256L * FF * 2, 128L * FF * 2, 0}; pg8::StaticOrder S; S.init(M, D, G, bx);
        pg8::EpiRes E{OUTF, OUTF, D};
        pg8::gemm_phase<pg8::EpiRes, pg8::StaticOrder, true, true>(lds, g, S, E);
    }
    GRID_SYNC();
    { PHASE_VARS;
        for (int m = gw; m < M; m += NGW) rms_row_inplace(OUTF + (size_t)m * D, args.in[27], lane);
    }
}

#undef WSP
#undef XIN
#undef OUTF
#undef WA
#undef WB
#undef XN
#undef P
#undef LD
#undef KK
#undef BB
#undef KP
#undef RR
#undef VV
#undef GG
#undef SCB
#undef OLT
#undef PMT
#undef SLOC
#undef QTB
#undef BS
#undef W2T
#undef A2T
#undef G2T
#undef YC
#undef ACT
#undef QKV
#undef VT1
#undef VT4
#undef VT16
extern "C" void kernel_launch(void* const* d_in, const int* in_sizes, int n_in, void* d_out, int out_size, void* d_ws, size_t ws_size, hipStream_t stream) {
    static int grid = 0;
    if (grid == 0) {
        if (n_in != 28 || in_sizes[0] != M * D || out_size != M * D || ws_size < WS_END) { fprintf(stderr, "kernel_launch: unexpected shapes (n_in %d, in0 %d, out %d, ws %zu)\n", n_in, n_in > 0 ? in_sizes[0] : -1, out_size, ws_size); grid = -1; return; }
        int dev = 0, cus = 0, per_cu = 0;
        if (hipGetDevice(&dev) != hipSuccess || hipDeviceGetAttribute(&cus, hipDeviceAttributeMultiprocessorCount, dev) != hipSuccess) { grid = -1; return; }
        if (hipFuncSetAttribute((const void*)hybrid_fwd, hipFuncAttributeMaxDynamicSharedMemorySize, LDS_BYTES) != hipSuccess) { fprintf(stderr, "kernel_launch: hipFuncSetAttribute failed\n"); grid = -1; return; }
        if (hipOccupancyMaxActiveBlocksPerMultiprocessor(&per_cu, (const void*)hybrid_fwd, NWAVES * 64, LDS_BYTES) != hipSuccess || per_cu < 1) { fprintf(stderr, "kernel_launch: occupancy query says %d\n", per_cu); per_cu = 1; }
        (void)hipGetLastError();
        grid = cus;
    }
    if (grid < 0) return;
    if (hipMemsetAsync(d_ws, 0, 65536, stream) != hipSuccess) { fprintf(stderr, "kernel_launch: hipMemsetAsync failed\n"); return; }
    Args a{};
    for (int i = 0; i < 28; ++i) a.in[i] = (const float*)d_in[i];
    a.out = (float*)d_out; a.ws = (unsigned char*)d_ws;
    void* kargs[] = {&a};
    hipError_t e = hipLaunchCooperativeKernel((const void*)hybrid_fwd, dim3(grid), dim3(NWAVES * 64), kargs, LDS_BYTES, stream);
    if (e != hipSuccess) fprintf(stderr, "kernel_launch: cooperative launch failed: %s (grid %d)\n", hipGetErrorString(e), grid);
}
```

```cpp
#include <hip/hip_runtime.h>
#include <hip/hip_cooperative_groups.h>
#include <cstdio>
#include <cstdint>
namespace cg = cooperative_groups;
namespace pg8 {
#define PG8_LAS __attribute__((address_space(3)))
typedef unsigned short bf16_t;
typedef short bf16x8 __attribute__((ext_vector_type(8)));
typedef float f32x4 __attribute__((ext_vector_type(4)));
typedef unsigned u32x4 __attribute__((ext_vector_type(4)));
constexpr int BM = 256, BK = 64, HALF = 128, HTB = HALF * BK * 2  , STAGE_BYTES = 8 * HTB, NXCD = 8, WGM = 8;

__host__ __device__ __forceinline__ int lds_byte(int r, int c) { const int st = (r >> 4) * 2 + (c >> 5), rr = r & 15, cc = c & 31, ob = rr * 64 + cc * 2; return st * 1024 + (ob ^ (((ob >> 9) & 1) << 5)); }
__host__ __device__ __forceinline__ void stage_rc(int b, int& R, int& C) { const int st = b / 1024, sb = b % 1024, swz = sb ^ (((sb >> 9) & 1) << 5); R = (st >> 1) * 16 + swz / 64; C = (st & 1) * 32 + (swz % 64) / 2; }
__host__ __device__ __forceinline__ int perm32(int rho) { const int n = rho >> 4, i = rho & 15; return 8 * (i >> 2) + 4 * n + (i & 3); }

struct Unit { int pm, pn; };
struct Gemm { const bf16_t* A; const bf16_t* Bt; int M, N, K; long tA, hA, tB, hB; int remapA; };

struct StaticOrder {
    int nM, nN, nwg, G, c;
    __host__ __device__ void init(int M, int N, int G_, int c_) { nM = M / BM; nN = N / BM; nwg = nM * nN; G = G_; c = c_; }
    __host__ __device__ void init2(int nM_, int nN_, int G_, int c_) { nM = nM_; nN = nN_; nwg = nM * nN; G = G_; c = c_; }
    __host__ __device__ bool next(int i, Unit& u) const {
        const long L = (long)i * G + c; if (L >= nwg) return false;
        int wgid = (int)L; { const int q = nwg / NXCD, r = nwg % NXCD, xcd = wgid % NXCD, off = wgid / NXCD; wgid = (xcd < r ? xcd * (q + 1) : r * (q + 1) + (xcd - r) * q) + off; }
        const int nig = WGM * nN, gid = wgid / nig, fm = gid * WGM, gsz = (nM - fm) < WGM ? (nM - fm) : WGM;
        u.pm = fm + ((wgid % nig) % gsz); u.pn = (wgid % nig) / gsz; return true;
    }
    __device__ __forceinline__ void a_ready(const Unit&) const {}
    __device__ __forceinline__ void done(const Unit&) const {}
};

__device__ __forceinline__ unsigned cvt_pk_bf16(float lo, float hi) { unsigned r; asm volatile("v_cvt_pk_bf16_f32 %0, %1, %2" : "=v"(r) : "v"(lo), "v"(hi)); return r; }
typedef float f32x2 __attribute__((ext_vector_type(2)));
__device__ __forceinline__ f32x2 gelu_pk(f32x2 v) {
    const f32x2 av = __builtin_elementwise_abs(v), d = av * 0.2316418882f + 1.0f;
    f32x2 t; t.x = __builtin_amdgcn_rcpf(d.x); t.y = __builtin_amdgcn_rcpf(d.y);
    f32x2 q = t * 0.5307027145f + (-0.7265760135f); q = q * t + 0.7107068705f; q = q * t + (-0.142248368f); q = q * t + 0.127414796f; q = q * t;
    const f32x2 s = (v * v) * (-0.72134752044f);
    f32x2 e; e.x = __builtin_amdgcn_exp2f(s.x); e.y = __builtin_amdgcn_exp2f(s.y);
    const f32x2 m = v * (q * e), r = v - m;
    f32x2 o; o.x = v.x < 0.f ? m.x : r.x; o.y = v.y < 0.f ? m.y : r.y; return o;
}

template <int ACT  > struct EpiBf16 {
    static constexpr bool PERM = true, AFTER_DRAIN = false; static_assert(ACT == 0 || ACT == 1, "EpiBf16: ACT is 0 (none) or 1 (gelu_pk)");
    bf16_t* O; int ldc; const float* bias; int split_cols; size_t split_stride; float scale0;
    __device__ __forceinline__ void operator()(const f32x4 (&acc)[2][2][4][2], const Unit& u, int wr, int wc, int fr, int fq) const {
        const int row0 = u.pm * BM + wr * 64 + fr; int colt = u.pn * BM; bf16_t* base = O;
        float sc = 1.f; if (split_cols) { const int t = colt / split_cols; base += (size_t)t * split_stride; colt -= t * split_cols; if (t == 0) sc = scale0; }
        const int col0 = colt + wc * 32 + 8 * fq, bcol0 = u.pn * BM + wc * 32 + 8 * fq;
        f32x4 bv[2][2];
#pragma unroll
        for (int bj = 0; bj < 2; ++bj)
#pragma unroll
            for (int n = 0; n < 2; ++n) bv[bj][n] = bias ? *(const f32x4*)(bias + bcol0 + bj * HALF + 4 * n) : (f32x4){0.f, 0.f, 0.f, 0.f};
#pragma unroll
        for (int ai = 0; ai < 2; ++ai)
#pragma unroll
            for (int m = 0; m < 4; ++m) { bf16_t* rowp = base + (size_t)(row0 + ai * HALF + m * 16) * ldc + col0;
#pragma unroll
                for (int bj = 0; bj < 2; ++bj) { f32x4 v0 = acc[ai][bj][m][0] + bv[bj][0], v1 = acc[ai][bj][m][1] + bv[bj][1];
                    if (ACT == 1) { f32x2 a = gelu_pk((f32x2){v0[0], v0[1]}), b = gelu_pk((f32x2){v0[2], v0[3]}), c = gelu_pk((f32x2){v1[0], v1[1]}), d = gelu_pk((f32x2){v1[2], v1[3]});
                        v0 = (f32x4){a.x, a.y, b.x, b.y}; v1 = (f32x4){c.x, c.y, d.x, d.y}; }
                    v0 = v0 * sc; v1 = v1 * sc; u32x4 w; w.x = cvt_pk_bf16(v0[0], v0[1]); w.y = cvt_pk_bf16(v0[2], v0[3]); w.z = cvt_pk_bf16(v1[0], v1[1]); w.w = cvt_pk_bf16(v1[2], v1[3]);
                    *(u32x4*)(rowp + bj * HALF) = w; } }
    }
};

template <class Epi, class Sched, bool ALIGN_EPI = false, bool SP2 = false>
__device__ __forceinline__ void gemm_phase(PG8_LAS unsigned char* lds, const Gemm g, const Sched& S, const Epi& E) {
    const int tid = threadIdx.x, wid = __builtin_amdgcn_readfirstlane(tid >> 6), lane = tid & 63, wr = wid >> 2, wc = wid & 3, fr = lane & 15, fq = lane >> 4;
    const int K = g.K, nt = K / BK;
    unsigned voffA[2], voffB[2];
#pragma unroll
    for (int i = 0; i < 2; ++i) { int R, C; stage_rc(tid * 16 + i * 8192, R, C); const int Rb = Epi::PERM ? ((R & ~31) + perm32(R & 31)) : R;
        const int Ra = g.remapA ? (R - (R >= 64 ? 2 : 0)) : R; voffA[i] = (unsigned)(Ra * K + C) * 2u; voffB[i] = (unsigned)(Rb * K + C) * 2u; }
    const size_t kstep = (size_t)(BK * 2);
    const size_t hA = (size_t)g.hA, hB = (size_t)g.hB, tA = (size_t)g.tA, tB = (size_t)g.tB;
    const unsigned ldsw = (unsigned)wid * 1024u;
    const int aoff = lds_byte(wr * 64 + fr, fq * 8), boff = lds_byte(wc * 32 + fr, fq * 8);
#define PG8_SA(b, h) (((b) * 2 + (h)) * HTB)
#define PG8_SB(b, h) ((4 + (b) * 2 + (h)) * HTB)
#define PG8_STAGE(bufoff, gbase, voff) do { _Pragma("unroll") for (int _i = 0; _i < 2; ++_i) \
        __builtin_amdgcn_global_load_lds((const unsigned*)((const char*)(gbase) + (voff)[_i]), (PG8_LAS unsigned*)(lds + (bufoff) + ldsw + _i * 8192), 16, 0, 0); } while (0)
#define PG8_LDA(dst, b, h) do { _Pragma("unroll") for (int m = 0; m < 4; ++m) _Pragma("unroll") for (int k = 0; k < 2; ++k) dst[m][k] = *(const PG8_LAS bf16x8*)(lds + PG8_SA(b, h) + aoff + m * 2048 + k * 1024); } while (0)
#define PG8_LDB(dst, b, h) do { _Pragma("unroll") for (int n = 0; n < 2; ++n) _Pragma("unroll") for (int k = 0; k < 2; ++k) dst[n][k] = *(const PG8_LAS bf16x8*)(lds + PG8_SB(b, h) + boff + n * 2048 + k * 1024); } while (0)
#define PG8_MMA(ai, bj, At, Bt) do { __builtin_amdgcn_s_setprio(1); _Pragma("unroll") for (int m = 0; m < 4; ++m) _Pragma("unroll") for (int n = 0; n < 2; ++n) _Pragma("unroll") for (int k = 0; k < 2; ++k) \
        acc[ai][bj][m][n] = __builtin_amdgcn_mfma_f32_16x16x32_bf16(Bt[n][k], At[m][k], acc[ai][bj][m][n], 0, 0, 0); __builtin_amdgcn_s_setprio(0); } while (0)
#define PG8_WAIT_V(n) asm volatile("s_waitcnt vmcnt(" #n ")" ::: "memory")
#define PG8_WAIT_L(n) asm volatile("s_waitcnt lgkmcnt(" #n ")" ::: "memory")
#define PG8_BAR __builtin_amdgcn_s_barrier()
#define PG8_SCHED __builtin_amdgcn_sched_barrier(0)
    Unit cur, nxt; int ui = 0;
    if (!S.next(0, cur)) return;
    f32x4 acc[2][2][4][2];
#pragma unroll
    for (int a = 0; a < 2; ++a)
#pragma unroll
        for (int b = 0; b < 2; ++b)
#pragma unroll
            for (int m = 0; m < 4; ++m)
#pragma unroll
                for (int n = 0; n < 2; ++n) acc[a][b][m][n] = (f32x4){0.f, 0.f, 0.f, 0.f};
    bf16x8 At[4][2], B0[2][2], B1[2][2];
    const char* cA = (const char*)g.A + (size_t)cur.pm * tA; const char* cB = (const char*)g.Bt + (size_t)cur.pn * tB;
    S.a_ready(cur);
    if constexpr (SP2) {
        PG8_STAGE(PG8_SB(0, 0), cB, voffB); PG8_STAGE(PG8_SB(0, 1), cB + hB, voffB); PG8_STAGE(PG8_SA(0, 0), cA, voffA); PG8_STAGE(PG8_SA(0, 1), cA + hA, voffA);
        if (wr == 1) PG8_BAR;
        PG8_WAIT_V(2); PG8_BAR;
        PG8_STAGE(PG8_SB(1, 0), cB + kstep, voffB); PG8_STAGE(PG8_SA(1, 0), cA + kstep, voffA); PG8_STAGE(PG8_SB(1, 1), cB + hB + kstep, voffB);
        PG8_WAIT_V(6); PG8_BAR;
    } else {
        PG8_STAGE(PG8_SB(0, 0), cB, voffB); PG8_STAGE(PG8_SA(0, 0), cA, voffA); PG8_STAGE(PG8_SB(0, 1), cB + hB, voffB); PG8_STAGE(PG8_SA(0, 1), cA + hA, voffA);
        if (wr == 1) PG8_BAR;
        PG8_WAIT_V(4); PG8_BAR;
        PG8_STAGE(PG8_SB(1, 0), cB + kstep, voffB); PG8_STAGE(PG8_SA(1, 0), cA + kstep, voffA); PG8_STAGE(PG8_SB(1, 1), cB + hB + kstep, voffB);
        PG8_WAIT_V(6); PG8_BAR;
    }
    for (;;) {
        const bool has_next = S.next(ui + 1, nxt);
        const char* nA = has_next ? (const char*)g.A + (size_t)nxt.pm * tA : cA; const char* nB = has_next ? (const char*)g.Bt + (size_t)nxt.pn * tB : cB;
        for (int t = 0; t < nt; t += 2) {
            const bool last = (t == nt - 2);
            const char* a1 = cA + (size_t)(t + 1) * kstep;
            const char* a2 = last ? nA : cA + (size_t)(t + 2) * kstep; const char* b2 = last ? nB : cB + (size_t)(t + 2) * kstep;
            const char* a3 = a2 + kstep; const char* b3 = b2 + kstep;
            if (last && has_next) S.a_ready(nxt);
            if constexpr (SP2) {
            PG8_LDB(B0, 0, 0); PG8_LDB(B1, 0, 1); PG8_SCHED; PG8_LDA(At, 0, 0); PG8_STAGE(PG8_SA(1, 1), a1 + hA, voffA);
            PG8_WAIT_V(8); PG8_WAIT_L(0); PG8_BAR; PG8_MMA(0, 0, At, B0); PG8_MMA(0, 1, At, B1); PG8_BAR; PG8_SCHED;
            PG8_LDA(At, 0, 1); PG8_STAGE(PG8_SB(0, 0), b2, voffB); PG8_STAGE(PG8_SB(0, 1), b2 + hB, voffB); PG8_STAGE(PG8_SA(0, 0), a2, voffA);
            PG8_WAIT_V(8); PG8_WAIT_L(0); PG8_BAR; PG8_MMA(1, 0, At, B0); PG8_MMA(1, 1, At, B1); PG8_BAR; PG8_SCHED;
            PG8_LDB(B0, 1, 0); PG8_LDB(B1, 1, 1); PG8_SCHED; PG8_LDA(At, 1, 0); PG8_STAGE(PG8_SA(0, 1), a2 + hA, voffA);
            PG8_WAIT_V(8); PG8_WAIT_L(0); PG8_BAR; PG8_MMA(0, 0, At, B0); PG8_MMA(0, 1, At, B1); PG8_BAR; PG8_SCHED;
            PG8_LDA(At, 1, 1); PG8_STAGE(PG8_SB(1, 0), b3, voffB); PG8_STAGE(PG8_SB(1, 1), b3 + hB, voffB); PG8_STAGE(PG8_SA(1, 0), a3, voffA);
            PG8_WAIT_V(8); PG8_WAIT_L(0); PG8_BAR; PG8_MMA(1, 0, At, B0); PG8_MMA(1, 1, At, B1); PG8_BAR; PG8_SCHED;
            } else {
            PG8_LDB(B0, 0, 0); PG8_SCHED; PG8_LDA(At, 0, 0); PG8_STAGE(PG8_SA(1, 1), a1 + hA, voffA);
            PG8_WAIT_L(8); PG8_BAR; PG8_WAIT_L(0); PG8_MMA(0, 0, At, B0); PG8_BAR; PG8_SCHED;
            PG8_LDB(B1, 0, 1); PG8_STAGE(PG8_SB(0, 0), b2, voffB);
            PG8_BAR; PG8_WAIT_L(0); PG8_MMA(0, 1, At, B1); PG8_BAR;
            PG8_LDA(At, 0, 1); PG8_STAGE(PG8_SA(0, 0), a2, voffA);
            PG8_BAR; PG8_WAIT_L(0); PG8_MMA(1, 0, At, B0); PG8_BAR; PG8_SCHED;
            PG8_STAGE(PG8_SB(0, 1), b2 + hB, voffB);
            PG8_WAIT_V(6); PG8_BAR; PG8_MMA(1, 1, At, B1); PG8_BAR;
            PG8_LDB(B0, 1, 0); PG8_SCHED; PG8_LDA(At, 1, 0); PG8_STAGE(PG8_SA(0, 1), a2 + hA, voffA);
            PG8_WAIT_L(8); PG8_BAR; PG8_WAIT_L(0); PG8_MMA(0, 0, At, B0); PG8_BAR; PG8_SCHED;
            PG8_LDB(B1, 1, 1); PG8_STAGE(PG8_SB(1, 0), b3, voffB);
            PG8_BAR; PG8_WAIT_L(0); PG8_MMA(0, 1, At, B1); PG8_BAR;
            PG8_LDA(At, 1, 1); PG8_STAGE(PG8_SA(1, 0), a3, voffA);
            PG8_BAR; PG8_WAIT_L(0); PG8_MMA(1, 0, At, B0); PG8_BAR; PG8_SCHED;
            PG8_STAGE(PG8_SB(1, 1), b3 + hB, voffB);
            PG8_WAIT_V(6); PG8_BAR; PG8_MMA(1, 1, At, B1); PG8_BAR;
            }
        }
        if constexpr (ALIGN_EPI) { if (wr == 0) PG8_BAR; }
        if constexpr (!Epi::AFTER_DRAIN) { E(acc, cur, wr, wc, fr, fq); S.done(cur); }
        if (!has_next) break;
#pragma unroll
        for (int a = 0; a < 2; ++a)
#pragma unroll
            for (int b = 0; b < 2; ++b)
#pragma unroll
                for (int m = 0; m < 4; ++m)
#pragma unroll
                    for (int n = 0; n < 2; ++n) acc[a][b][m][n] = (f32x4){0.f, 0.f, 0.f, 0.f};
        cur = nxt; cA = nA; cB = nB; ++ui;
        if constexpr (ALIGN_EPI) { if (wr == 1) PG8_BAR; }
    }
    PG8_WAIT_V(0);
    if constexpr (!ALIGN_EPI) { if (wr == 0) PG8_BAR; }
    PG8_BAR;
    if constexpr (Epi::AFTER_DRAIN) { E.fused(acc, cur, wr, wc, fr, fq, lds, wid, lane); S.done(cur); }
#undef PG8_SA
#undef PG8_SB
#undef PG8_STAGE
#undef PG8_LDA
#undef PG8_LDB
#undef PG8_MMA
#undef PG8_WAIT_V
#undef PG8_WAIT_L
#undef PG8_BAR
#undef PG8_SCHED
}
}
namespace pg8 {
template <int N> __device__ __forceinline__ float row_ror(float v) {
    const int iv = __builtin_bit_cast(int, v);
    const int a = __builtin_amdgcn_update_dpp(0, iv, 0x110 + N, 0xf, 0xf, true);
    const int b = __builtin_amdgcn_update_dpp(0, iv, 0x100 + (16 - N), 0xf, 0xf, true);
    return __builtin_bit_cast(float, a | b);
}
}
namespace pg8 {
struct EpiRes {
    static constexpr bool PERM = false, AFTER_DRAIN = false;
    const float* base; float* out; int ldc;
    __device__ __forceinline__ void operator()(const f32x4 (&acc)[2][2][4][2], const Unit& u, int wr, int wc, int fr, int fq) const {
        const int col0 = u.pn * BM + wc * 32 + 4 * fq;
#pragma unroll
        for (int ai = 0; ai < 2; ++ai)
#pragma unroll
            for (int m = 0; m < 4; ++m) { const size_t off = (size_t)(u.pm * BM + ai * HALF + wr * 64 + m * 16 + fr) * ldc + col0;
#pragma unroll
                for (int bj = 0; bj < 2; ++bj)
#pragma unroll
                    for (int n = 0; n < 2; ++n) { const f32x4 b = *(const f32x4*)(base + off + bj * HALF + n * 16); *(f32x4*)(out + off + bj * HALF + n * 16) = b + acc[ai][bj][m][n]; } }
    }
};
struct EpiConvGlu {
    static constexpr bool PERM = false, AFTER_DRAIN = false;
    bf16_t* O; const float* cw; const float* cb; int M;
    __device__ __forceinline__ void operator()(const f32x4 (&acc)[2][2][4][2], const Unit& u, int wr, int wc, int fr, int fq) const {
        const int lane = fq * 16 + fr;
        const int src1 = fq * 16 + ((fr + 15) & 15), src2 = fq * 16 + ((fr + 14) & 15);
#pragma unroll
        for (int ai = 0; ai < 2; ++ai) {
            const int pb = 248 * u.pm + 62 * (2 * ai + wr) - 2;
#pragma unroll
            for (int n = 0; n < 2; ++n) {
                const int jg = 128 * u.pn + 32 * wc + 16 * n + 4 * fq;
                const f32x4 g0 = *(const f32x4*)(cw + jg), g1 = *(const f32x4*)(cw + 5632 + jg), g2 = *(const f32x4*)(cw + 2 * 5632 + jg), gb = *(const f32x4*)(cb + jg);
                const f32x4 v0 = *(const f32x4*)(cw + 2816 + jg), v1 = *(const f32x4*)(cw + 5632 + 2816 + jg), v2 = *(const f32x4*)(cw + 2 * 5632 + 2816 + jg), vb = *(const f32x4*)(cb + 2816 + jg);
                f32x4 pg1, pg2, pv1, pv2;
#pragma unroll
                for (int m = 0; m < 4; ++m) {
                    f32x4 zg = acc[ai][0][m][n], zv = acc[ai][1][m][n];
                    const int pos = pb + 16 * m + fr;
                    if (pos < 0) { zg = (f32x4){0.f, 0.f, 0.f, 0.f}; zv = zg; }
                    f32x4 rg1, rg2, rv1, rv2;
#pragma unroll
                    for (int e = 0; e < 4; ++e) { rg1[e] = row_ror<1>(zg[e]); rg2[e] = row_ror<2>(zg[e]); rv1[e] = row_ror<1>(zv[e]); rv2[e] = row_ror<2>(zv[e]); }
                    f32x4 zg1, zg2, zv1, zv2;
                    if (m == 0) { zg1 = rg1; zg2 = rg2; zv1 = rv1; zv2 = rv2; }
                    else {
#pragma unroll
                        for (int e = 0; e < 4; ++e) { zg1[e] = fr >= 1 ? rg1[e] : pg1[e]; zg2[e] = fr >= 2 ? rg2[e] : pg2[e]; zv1[e] = fr >= 1 ? rv1[e] : pv1[e]; zv2[e] = fr >= 2 ? rv2[e] : pv2[e]; }
                    }
                    pg1 = rg1; pg2 = rg2; pv1 = rv1; pv2 = rv2;
                    const f32x4 cg = g0 * zg2 + g1 * zg1 + g2 * zg + gb;
                    const f32x4 cv = v0 * zv2 + v1 * zv1 + v2 * zv + vb;
                    f32x4 a;
#pragma unroll
                    for (int e = 0; e < 4; ++e) a[e] = cg[e] / (1.0f + __expf(-cg[e])) * cv[e];
                    if ((16 * m + fr) >= 2 && pos < M) {
                        typedef unsigned u32x2 __attribute__((ext_vector_type(2)));
                        u32x2 w; w.x = cvt_pk_bf16(a[0], a[1]); w.y = cvt_pk_bf16(a[2], a[3]);
                        *(u32x2*)(O + (size_t)pos * 2816 + jg) = w;
                    }
                }
            }
        }
        (void)lane;
    }
};
}
#define LAS __attribute__((address_space(3)))
typedef unsigned short bf16;
typedef float f32x4 __attribute__((ext_vector_type(4)));
typedef short bf16x8 __attribute__((ext_vector_type(8)));
typedef unsigned v4u __attribute__((ext_vector_type(4)));
typedef unsigned v2u __attribute__((ext_vector_type(2)));
constexpr int NWAVES = 8;
constexpr int M = 16384, D = 1024, EIN = 2816, FF = 2816, FF2 = 5632, NQKV = 3072, BW = 512;
constexpr size_t MiB = 1u << 20;
constexpr size_t WS_W2T = 1 * MiB, WS_A2T = WS_W2T + 65536, WS_G2T = WS_A2T + 65536, WS_BS = WS_G2T + 131072;
constexpr size_t WS_WA = 2 * MiB, WS_WB = 13 * MiB, WS_XN = 20 * MiB, WS_GEN = 52 * MiB, WS_END = 256 * MiB;
constexpr size_t WS_P = WS_GEN, WS_LD = WS_GEN + 88 * MiB, WS_KK = WS_LD + 32 * MiB, WS_BB = WS_KK + 16 * MiB, WS_KP = WS_BB + 16 * MiB, WS_RR = WS_KP + 16 * MiB, WS_VV = WS_RR + 16 * MiB;
static_assert(WS_VV + 16 * MiB <= WS_END, "ws map");
constexpr size_t WS_QKV = WS_GEN, WS_VT1 = WS_GEN + 96 * MiB, WS_VT4 = WS_VT1 + 32 * MiB, WS_VT16 = WS_VT4 + 32 * MiB;
static_assert(WS_VT16 + 33 * MiB <= WS_END, "ws map");
constexpr int LDS_BYTES = 147456;

__device__ __forceinline__ float bf2f(unsigned short v) { return __uint_as_float(((unsigned)v) << 16); }
typedef float f32x2_t __attribute__((ext_vector_type(2))); typedef __bf16 bf16x2_t __attribute__((ext_vector_type(2)));
__device__ __forceinline__ unsigned pk2(float lo, float hi) { f32x2_t v = {lo, hi}; bf16x2_t b = __builtin_convertvector(v, bf16x2_t); return __builtin_bit_cast(unsigned, b); }
__device__ __forceinline__ unsigned f2bf(float f) { return pk2(f, f) & 0xffffu; }
__device__ __forceinline__ float wave_sum(float v) {
#pragma unroll
    for (int o = 1; o < 64; o <<= 1) v += __shfl_xor(v, o);
    return v;
}
__device__ __forceinline__ float dpp_row_shr(float v, int n) {
    const int iv = __builtin_bit_cast(int, v); int r;
    switch (n) { case 1: r = __builtin_amdgcn_update_dpp(0, iv, 0x111, 0xf, 0xf, true); break; case 2: r = __builtin_amdgcn_update_dpp(0, iv, 0x112, 0xf, 0xf, true); break;
                 case 4: r = __builtin_amdgcn_update_dpp(0, iv, 0x114, 0xf, 0xf, true); break; default: r = __builtin_amdgcn_update_dpp(0, iv, 0x118, 0xf, 0xf, true); break; }
    return __builtin_bit_cast(float, r);
}
__device__ __forceinline__ float wave_sum_uniform(float v) {
    v += dpp_row_shr(v, 1); v += dpp_row_shr(v, 2); v += dpp_row_shr(v, 4); v += dpp_row_shr(v, 8);
    v += __builtin_bit_cast(float, __builtin_amdgcn_update_dpp(0, __builtin_bit_cast(int, v), 0x142, 0xa, 0xf, false));
    v += __builtin_bit_cast(float, __builtin_amdgcn_update_dpp(0, __builtin_bit_cast(int, v), 0x143, 0xc, 0xf, false));
    return __builtin_bit_cast(float, __builtin_amdgcn_readlane(__builtin_bit_cast(int, v), 63));
}
#define MFMA16(a, b, c) __builtin_amdgcn_mfma_f32_16x16x32_bf16((a), (b), (c), 0, 0, 0)

__device__ __forceinline__ void transpose_item(const float* W, int K, int N, bf16* WT, LAS float* scr, int item, int lane) {
    const int nblk = N / 32, kb = item / nblk, nb = item % nblk, k0 = 64 * kb, n0 = 32 * nb;
#pragma unroll 8
    for (int i = 0; i < 32; ++i) { const int kk = 2 * i + (lane >> 5); scr[kk * 33 + (lane & 31)] = W[(size_t)(k0 + kk) * N + n0 + (lane & 31)]; }
    asm volatile("s_waitcnt lgkmcnt(0)" ::: "memory");
    const int c = lane & 7;
#pragma unroll
    for (int j = 0; j < 4; ++j) { const int n = (lane >> 3) + 8 * j; const LAS float* s = scr + (8 * c) * 33 + n;
        v4u o; o.x = pk2(s[0 * 33], s[1 * 33]); o.y = pk2(s[2 * 33], s[3 * 33]); o.z = pk2(s[4 * 33], s[5 * 33]); o.w = pk2(s[6 * 33], s[7 * 33]);
        *(v4u*)(WT + (size_t)(n0 + n) * K + k0 + 8 * c) = o; }
    asm volatile("s_waitcnt lgkmcnt(0)" ::: "memory");
}
__device__ __forceinline__ void rms_row_to_bf16(const float* xrow, const float* gain, bf16* orow, int lane) {
    const f32x4* xr = (const f32x4*)xrow + lane; const f32x4* gr = (const f32x4*)gain + lane;
    f32x4 v[4]; float s = 0.f;
#pragma unroll
    for (int j = 0; j < 4; ++j) { v[j] = xr[64 * j]; s += (v[j].x * v[j].x + v[j].y * v[j].y) + (v[j].z * v[j].z + v[j].w * v[j].w); }
    const float rstd = 1.0f / sqrtf(wave_sum(s) * (1.f / D) + 1e-6f);
    v2u* o8 = (v2u*)orow + lane;
#pragma unroll
    for (int j = 0; j < 4; ++j) { const f32x4 g = gr[64 * j]; v2u w; w.x = pk2(v[j].x * rstd * g.x, v[j].y * rstd * g.y); w.y = pk2(v[j].z * rstd * g.z, v[j].w * rstd * g.w); o8[64 * j] = w; }
}
__device__ __forceinline__ void rms_row_inplace(float* xrow, const float* gain, int lane) {
    f32x4* xr = (f32x4*)xrow + lane; const f32x4* gr = (const f32x4*)gain + lane;
    f32x4 v[4]; float s = 0.f;
#pragma unroll
    for (int j = 0; j < 4; ++j) { v[j] = xr[64 * j]; s += (v[j].x * v[j].x + v[j].y * v[j].y) + (v[j].z * v[j].z + v[j].w * v[j].w); }
    const float rstd = 1.0f / sqrtf(wave_sum(s) * (1.f / D) + 1e-6f);
#pragma unroll
    for (int j = 0; j < 4; ++j) { const f32x4 g = gr[64 * j]; xr[64 * j] = v[j] * rstd * g; }
}
__device__ __forceinline__ void norm_phase(LAS unsigned char* lds, int gw, int NGW, int wave, int lane, const float* x, const float* gain, bf16* XN,
                                           const float* W1, int K1, int N1, bf16* W1t, const float* W2, int K2, int N2, bf16* W2t) {
    LAS float* scr = (LAS float*)(lds + wave * 16384);
    const int I1 = (K1 / 64) * (N1 / 32), I2 = (K2 / 64) * (N2 / 32);
    for (int it = gw; it < I1 + I2; it += NGW) {
        if (it < I1) transpose_item(W1, K1, N1, W1t, scr, it, lane); else transpose_item(W2, K2, N2, W2t, scr, it - I1, lane);
    }
    for (int m = gw; m < M; m += NGW) rms_row_to_bf16(x + (size_t)m * D, gain, XN + (size_t)m * D, lane);
}

__device__ __forceinline__ void gmlp_item(LAS unsigned char* lds, int item, int tid, int wave, int lane, const bf16* P, const float* ln_g, const float* ln_b,
                                          const float* w_s, const float* b_s, bf16* Y) {
    const int chunk = item >> 2, g = item & 3, t0 = chunk * 128;
    LAS bf16* Wm = (LAS bf16*)lds;
    LAS bf16* Vt = (LAS bf16*)(lds + 128 * 136 * 2);
    for (int i = 0; i < 16; ++i) {
        const int s = wave * 16 + i;
        const v4u raw = *(const v4u*)(P + (size_t)(t0 + s) * EIN + 512 + lane * 8);
        float v[8];
        v[0] = __uint_as_float(raw.x << 16); v[1] = __uint_as_float(raw.x & 0xffff0000u); v[2] = __uint_as_float(raw.y << 16); v[3] = __uint_as_float(raw.y & 0xffff0000u);
        v[4] = __uint_as_float(raw.z << 16); v[5] = __uint_as_float(raw.z & 0xffff0000u); v[6] = __uint_as_float(raw.w << 16); v[7] = __uint_as_float(raw.w & 0xffff0000u);
        float sum = 0.f;
#pragma unroll
        for (int e = 0; e < 8; ++e) sum += v[e];
        const float mean = wave_sum(sum) * (1.f / 512.f);
        float q = 0.f;
#pragma unroll
        for (int e = 0; e < 8; ++e) { v[e] -= mean; q += v[e] * v[e]; }
        const float rstd = 1.0f / sqrtf(wave_sum(q) * (1.f / 512.f) + 1e-5f);
        if ((lane >> 4) == g) {
#pragma unroll
            for (int e = 0; e < 8; ++e) { const int c = (lane & 15) * 8 + e, ch = g * 128 + c; Vt[c * 136 + s] = (bf16)f2bf(v[e] * rstd * ln_g[ch] + ln_b[ch]); }
        }
    }
    for (int idx = tid; idx < 128 * 32; idx += 512) {
        const int t = idx >> 5, s4 = (idx & 31) * 4;
        const f32x4 w = *(const f32x4*)(w_s + ((size_t)g * 128 + t) * 128 + s4);
        v2u o; o.x = pk2(s4 + 0 <= t ? w.x : 0.f, s4 + 1 <= t ? w.y : 0.f); o.y = pk2(s4 + 2 <= t ? w.z : 0.f, s4 + 3 <= t ? w.w : 0.f);
        *(LAS v2u*)(Wm + t * 136 + s4) = o;
    }
    __syncthreads();
    const int r = lane & 15, q4 = lane >> 4;
    f32x4 acc[8];
#pragma unroll
    for (int ct = 0; ct < 8; ++ct) acc[ct] = (f32x4){0.f, 0.f, 0.f, 0.f};
    const int nks = (16 * wave + 15) / 32 + 1;
    for (int ks = 0; ks < nks; ++ks) {
        const bf16x8 af = *(const LAS bf16x8*)(Wm + (16 * wave + r) * 136 + ks * 32 + q4 * 8);
#pragma unroll
        for (int ct = 0; ct < 8; ++ct) { const bf16x8 bfr = *(const LAS bf16x8*)(Vt + (16 * ct + r) * 136 + ks * 32 + q4 * 8); acc[ct] = MFMA16(af, bfr, acc[ct]); }
    }
#pragma unroll
    for (int ct = 0; ct < 8; ++ct)
#pragma unroll
        for (int e = 0; e < 4; ++e) {
            const int t = 16 * wave + 4 * q4 + e, c = 16 * ct + r;
            const float mixed = acc[ct][e] + b_s[g * 128 + t];
            const float u = bf2f(P[(size_t)(t0 + t) * EIN + g * 128 + c]);
            Y[(size_t)(t0 + t) * D + g * 128 + c] = (bf16)f2bf(u * mixed);
        }
    __syncthreads();
}

struct RwkvW { const float *mu, *w0, *a0, *k_k, *k_a, *r_k; const bf16 *w2t, *a2t, *g2t; };
__device__ __forceinline__ float shifted(const bf16* P, int t, int col, float mu) {
    const float cur = bf2f(P[(size_t)t * EIN + col]); const float prev = t > 0 ? bf2f(P[(size_t)(t - 1) * EIN + col]) : 0.f; return cur + (prev - cur) * mu;
}
__device__ __forceinline__ void rwkv_prep_item(LAS unsigned char* lds, int item, int tid, int wave, int lane, const bf16* P, const RwkvW& W,
                                               float* LD, bf16* KK, bf16* BB, bf16* KP, bf16* RR, bf16* VV, bf16* GG, float* BS) {
    const int t0 = item * 64;
    LAS bf16* Xl = (LAS bf16*)lds;
    for (int idx = tid; idx < 64 * 256; idx += 512) {
        const int t = idx >> 8, j = idx & 255;
        const float ps = shifted(P, t0 + t, 1024 + 1536 + j, W.mu[1536 + j]);
        const float val = j < 64 ? tanhf(ps) : (j < 128 ? ps : 1.0f / (1.0f + __expf(-ps)));
        Xl[t * 264 + j] = (bf16)f2bf(val);
    }
    __syncthreads();
    const int h = wave, r = lane & 15, q4 = lane >> 4;
    for (int tt = 0; tt < 4; ++tt) {
        f32x4 aW[4], aA[4], aG[4];
#pragma unroll
        for (int ct = 0; ct < 4; ++ct) { aW[ct] = (f32x4){0.f, 0.f, 0.f, 0.f}; aA[ct] = aW[ct]; aG[ct] = aW[ct]; }
#pragma unroll
        for (int ks = 0; ks < 2; ++ks) {
            const bf16x8 xw = *(const LAS bf16x8*)(Xl + (16 * tt + r) * 264 + ks * 32 + q4 * 8);
            const bf16x8 xa = *(const LAS bf16x8*)(Xl + (16 * tt + r) * 264 + 64 + ks * 32 + q4 * 8);
#pragma unroll
            for (int ct = 0; ct < 4; ++ct) {
                const bf16x8 yw = *(const bf16x8*)(W.w2t + (size_t)(h * 64 + 16 * ct + r) * 64 + ks * 32 + q4 * 8);
                const bf16x8 ya = *(const bf16x8*)(W.a2t + (size_t)(h * 64 + 16 * ct + r) * 64 + ks * 32 + q4 * 8);
                aW[ct] = MFMA16(xw, yw, aW[ct]); aA[ct] = MFMA16(xa, ya, aA[ct]);
            }
        }
#pragma unroll
        for (int ks = 0; ks < 4; ++ks) {
            const bf16x8 xg = *(const LAS bf16x8*)(Xl + (16 * tt + r) * 264 + 128 + ks * 32 + q4 * 8);
#pragma unroll
            for (int ct = 0; ct < 4; ++ct) {
                const bf16x8 yg = *(const bf16x8*)(W.g2t + (size_t)(h * 64 + 16 * ct + r) * 128 + ks * 32 + q4 * 8);
                aG[ct] = MFMA16(xg, yg, aG[ct]);
            }
        }
#pragma unroll
        for (int e = 0; e < 4; ++e) {
            const int t = t0 + 16 * tt + 4 * q4 + e;
            float kkr[4], av[4]; float ss = 0.f, bon = 0.f;
#pragma unroll
            for (int ct = 0; ct < 4; ++ct) {
                const int c = h * 64 + 16 * ct + r;
                const float r_ = shifted(P, t, 1024 + c, W.mu[c]);
                const float k_ = shifted(P, t, 1024 + 512 + c, W.mu[512 + c]);
                const float v_ = shifted(P, t, 1024 + 1024 + c, W.mu[1024 + c]);
                const float xw = -(W.w0[c] + aW[ct][e]);
                const float sp = xw > 20.f ? xw : log1pf(__expf(xw));
                const float wv = -sp - 0.5f;
                const float ld = -__expf(wv);
                const float a = 1.0f / (1.0f + __expf(-(W.a0[c] + aA[ct][e])));
                const float kr = k_ * W.k_k[c];
                const float kp = k_ * (1.0f + (a - 1.0f) * W.k_a[c]);
                kkr[ct] = kr; av[ct] = a; ss += kr * kr; bon += r_ * kp * W.r_k[c];
                const size_t o = (size_t)t * BW + c;
                LD[o] = ld; KP[o] = (bf16)f2bf(kp); RR[o] = (bf16)f2bf(r_); VV[o] = (bf16)f2bf(v_); GG[o] = (bf16)f2bf(aG[ct][e]);
            }
#pragma unroll
            for (int o = 1; o < 16; o <<= 1) { ss += __shfl_xor(ss, o); bon += __shfl_xor(bon, o); }
            const float inv = 1.0f / sqrtf(fmaxf(ss, 1e-24f));
#pragma unroll
            for (int ct = 0; ct < 4; ++ct) {
                const int c = h * 64 + 16 * ct + r; const size_t o = (size_t)t * BW + c;
                const float kk = kkr[ct] * inv;
                KK[o] = (bf16)f2bf(kk); BB[o] = (bf16)f2bf(kk * av[ct]);
            }
            if (r == 0) BS[(size_t)t * 8 + h] = bon;
        }
    }
    __syncthreads();
}

struct ScanRegs { unsigned short kk[8], bb[8], kp[8], rr[8], vv[8]; float ld[8]; };
__device__ __forceinline__ void scan_load(ScanRegs& R, int t0, int hc, int hv, const float* LD, const bf16* KK, const bf16* BB, const bf16* KP, const bf16* RR, const bf16* VV) {
#pragma unroll
    for (int i = 0; i < 8; ++i) { const size_t o = (size_t)(t0 + i) * BW;
        R.kk[i] = KK[o + hc]; R.bb[i] = BB[o + hc]; R.kp[i] = KP[o + hc]; R.rr[i] = RR[o + hc]; R.ld[i] = LD[o + hc]; R.vv[i] = VV[o + hv]; }
}
__device__ __forceinline__ void rwkv_scan_wave(int gwv, int lane, const float* LD, const bf16* KK, const bf16* BB, const bf16* KP, const bf16* RR, const bf16* VV, float* OSC) {
    const int h = gwv >> 6, v = gwv & 63, hc = h * 64 + lane, hv = h * 64 + v;
    float S = 0.f;
    ScanRegs cur, nxt;
    scan_load(cur, 0, hc, hv, LD, KK, BB, KP, RR, VV);
    for (int t0 = 0; t0 < M; t0 += 8) {
        const int tn = (t0 + 8 < M) ? t0 + 8 : t0;
        scan_load(nxt, tn, hc, hv, LD, KK, BB, KP, RR, VV);
#pragma unroll
        for (int i = 0; i < 8; ++i) {
            const float kk = bf2f(cur.kk[i]), bb = bf2f(cur.bb[i]), kp = bf2f(cur.kp[i]), rr = bf2f(cur.rr[i]), vv = bf2f(cur.vv[i]);
            const float dec = __expf(cur.ld[i]);
            const float sa = wave_sum_uniform(S * kk);
            S = S * dec - sa * bb + vv * kp;
            const float o = wave_sum_uniform(S * rr);
            if (lane == 0) OSC[(size_t)(t0 + i) * BW + hv] = o;
        }
        cur = nxt;
    }
}
__device__ __forceinline__ void rwkv_out_row(int t, int lane, const float* OSC, const float* BS, const bf16* VV, const bf16* GG, const float* gn_g, const float* gn_b, bf16* Y) {
    const int c0 = lane * 8;
    const f32x4 o0 = *(const f32x4*)(OSC + (size_t)t * BW + c0), o1 = *(const f32x4*)(OSC + (size_t)t * BW + c0 + 4);
    float v[8] = {o0.x, o0.y, o0.z, o0.w, o1.x, o1.y, o1.z, o1.w};
    float s = 0.f;
#pragma unroll
    for (int e = 0; e < 8; ++e) s += v[e];
    s += __shfl_xor(s, 1); s += __shfl_xor(s, 2); s += __shfl_xor(s, 4);
    const float mean = s * (1.f / 64.f);
    float q = 0.f;
#pragma unroll
    for (int e = 0; e < 8; ++e) { v[e] -= mean; q += v[e] * v[e]; }
    q += __shfl_xor(q, 1); q += __shfl_xor(q, 2); q += __shfl_xor(q, 4);
    const float rstd = 1.0f / sqrtf(q * (1.f / 64.f) + 64e-5f);
    const float bon = BS[(size_t)t * 8 + (lane >> 3)];
    const v4u vraw = *(const v4u*)(VV + (size_t)t * BW + c0), graw = *(const v4u*)(GG + (size_t)t * BW + c0);
    const unsigned vr[4] = {vraw.x, vraw.y, vraw.z, vraw.w}, gr[4] = {graw.x, graw.y, graw.z, graw.w};
    float outv[8];
#pragma unroll
    for (int e = 0; e < 8; ++e) {
        const float vv = (e & 1) ? __uint_as_float(vr[e >> 1] & 0xffff0000u) : __uint_as_float(vr[e >> 1] << 16);
        const float gg = (e & 1) ? __uint_as_float(gr[e >> 1] & 0xffff0000u) : __uint_as_float(gr[e >> 1] << 16);
        outv[e] = (v[e] * rstd * gn_g[c0 + e] + gn_b[c0 + e] + bon * vv) * gg;
    }
    v4u w; w.x = pk2(outv[0], outv[1]); w.y = pk2(outv[2], outv[3]); w.z = pk2(outv[4], outv[5]); w.w = pk2(outv[6], outv[7]);
    *(v4u*)(Y + (size_t)t * D + 512 + c0) = w;
}

__device__ __forceinline__ void vtrans_item(LAS unsigned char* lds, int item, int tid, const bf16* QKV, bf16* VT1, bf16* VT4, bf16* VT16) {
    const int h = item >> 6, blk = item & 63, t0 = blk * 256;
    LAS bf16* Vl = (LAS bf16*)lds;
#pragma unroll
    for (int i = 0; i < 4; ++i) { const int idx = tid + 512 * i, t = idx >> 3, ch = idx & 7;
        *(LAS v4u*)(Vl + t * 72 + ch * 8) = *(const v4u*)(QKV + (size_t)(t0 + t) * NQKV + 2048 + h * 64 + ch * 8); }
    __syncthreads();
#pragma unroll
    for (int i = 0; i < 4; ++i) {
        const int idx = tid + 512 * i, half = idx & 1, dd = (idx >> 1) & 63;
        { const int nbl = idx >> 7; unsigned short e[8];
#pragma unroll
          for (int k = 0; k < 8; ++k) e[k] = Vl[(16 * nbl + 8 * half + k) * 72 + dd];
          v4u o; o.x = e[0] | ((unsigned)e[1] << 16); o.y = e[2] | ((unsigned)e[3] << 16); o.z = e[4] | ((unsigned)e[5] << 16); o.w = e[6] | ((unsigned)e[7] << 16);
          *(v4u*)(VT1 + ((((size_t)h * 1024 + 16 * blk + nbl) * 64 + dd) * 16 + 8 * half)) = o; }
        { const int nbl = (idx >> 7) & 3, c4 = idx >> 9; unsigned short e[8];
#pragma unroll
          for (int k = 0; k < 8; ++k) e[k] = Vl[(4 * (16 * nbl + 8 * half + k) + c4) * 72 + dd];
          v4u o; o.x = e[0] | ((unsigned)e[1] << 16); o.y = e[2] | ((unsigned)e[3] << 16); o.z = e[4] | ((unsigned)e[5] << 16); o.w = e[6] | ((unsigned)e[7] << 16);
          *(v4u*)(VT4 + (((((size_t)h * 4 + c4) * 256 + 4 * blk + nbl) * 64 + dd) * 16 + 8 * half)) = o; }
        { const int c16 = idx >> 7; unsigned short e[8];
#pragma unroll
          for (int k = 0; k < 8; ++k) e[k] = Vl[(16 * (8 * half + k) + c16) * 72 + dd];
          v4u o; o.x = e[0] | ((unsigned)e[1] << 16); o.y = e[2] | ((unsigned)e[3] << 16); o.z = e[4] | ((unsigned)e[5] << 16); o.w = e[6] | ((unsigned)e[7] << 16);
          *(v4u*)(VT16 + (((((size_t)h * 16 + c16) * 64 + blk) * 64 + dd) * 16 + 8 * half)) = o; }
    }
    __syncthreads();
}

struct AttnFrags { bf16x8 ka0, ka1, kb0, kb1, vf[4]; };
template <int DIL>
__device__ __forceinline__ void attn_load(AttnFrags& f, const bf16* Kb, const bf16* VTc, int cp, int nb, int kA, int r, int q4) {
    constexpr int NB16 = M / DIL / 16;
    int posA = cp + DIL * (nb + kA), posB = posA + 4 * DIL;
    posA = posA < 0 ? 0 : (posA > M - 1 ? M - 1 : posA); posB = posB < 0 ? 0 : (posB > M - 1 ? M - 1 : posB);
    f.ka0 = *(const bf16x8*)(Kb + (size_t)posA * NQKV); f.ka1 = *(const bf16x8*)(Kb + (size_t)posA * NQKV + 32);
    f.kb0 = *(const bf16x8*)(Kb + (size_t)posB * NQKV); f.kb1 = *(const bf16x8*)(Kb + (size_t)posB * NQKV + 32);
    int bi = (nb >> 4) + (q4 >> 1); bi = bi < 0 ? 0 : (bi > NB16 - 1 ? NB16 - 1 : bi);
    const bf16* vp = VTc + ((size_t)bi * 64 + r) * 16 + 8 * (q4 & 1);
#pragma unroll
    for (int dt = 0; dt < 4; ++dt) f.vf[dt] = *(const bf16x8*)(vp + dt * 256);
}
__device__ __forceinline__ void attn_group(const AttnFrags& f, int nb, int nlo, int nhi, int q4, const bf16x8 (&qf)[2], f32x4 (&o)[4], float& lrun) {
    const float C = 0.125f * 1.4426950408889634f;
    f32x4 sA = (f32x4){0.f, 0.f, 0.f, 0.f}, sB = sA;
    sA = MFMA16(f.ka0, qf[0], sA); sA = MFMA16(f.ka1, qf[1], sA);
    sB = MFMA16(f.kb0, qf[0], sB); sB = MFMA16(f.kb1, qf[1], sB);
    float p[8]; float ps = 0.f;
    const int n0 = nb + 8 * q4;
#pragma unroll
    for (int e = 0; e < 8; ++e) {
        const int n = n0 + e;
        const float ex = __builtin_amdgcn_exp2f(fminf((e < 4 ? sA[e & 3] : sB[e & 3]) * C, 100.f));
        p[e] = (n >= nlo && n <= nhi) ? ex : 0.f; ps += p[e];
    }
    lrun += ps;
    v4u pw; pw.x = pk2(p[0], p[1]); pw.y = pk2(p[2], p[3]); pw.z = pk2(p[4], p[5]); pw.w = pk2(p[6], p[7]);
    const bf16x8 pf = __builtin_bit_cast(bf16x8, pw);
#pragma unroll
    for (int dt = 0; dt < 4; ++dt) o[dt] = MFMA16(f.vf[dt], pf, o[dt]);
}
template <int DIL, bool FIRST>
__device__ __forceinline__ void attn_tile(LAS float* OACC, LAS float* LACC, const bf16* QKV, const bf16* VT, int h, int blk, int cp, int nq0, int qloc0, int qstep, int lane) {
    constexpr int NB16 = M / DIL / 16;
    const int r = lane & 15, q4 = lane >> 4;
    const int qloc = qloc0 + qstep * r, pos = 256 * blk + qloc;
    bf16x8 qf[2];
    qf[0] = *(const bf16x8*)(QKV + (size_t)pos * NQKV + h * 64 + q4 * 8);
    qf[1] = *(const bf16x8*)(QKV + (size_t)pos * NQKV + h * 64 + 32 + q4 * 8);
    const int nq = nq0 + r, nlo = nq - 128 < 0 ? 0 : nq - 128, nhi = nq, ns = nq0 - 128;
    const int kA = 8 * (r >> 2) + (r & 3);
    const bf16* Kb = QKV + 1024 + h * 64 + q4 * 8;
    const bf16* VTc = VT + (size_t)(h * DIL + cp) * NB16 * 1024;
    f32x4 o[4];
#pragma unroll
    for (int dt = 0; dt < 4; ++dt) o[dt] = (f32x4){0.f, 0.f, 0.f, 0.f};
    float lrun = 0.f;
    AttnFrags fa, fb;
    attn_load<DIL>(fa, Kb, VTc, cp, ns, kA, r, q4);
    attn_load<DIL>(fb, Kb, VTc, cp, ns + 32, kA, r, q4);
    attn_group(fa, ns, nlo, nhi, q4, qf, o, lrun);
    attn_load<DIL>(fa, Kb, VTc, cp, ns + 64, kA, r, q4);
    attn_group(fb, ns + 32, nlo, nhi, q4, qf, o, lrun);
    attn_load<DIL>(fb, Kb, VTc, cp, ns + 96, kA, r, q4);
    attn_group(fa, ns + 64, nlo, nhi, q4, qf, o, lrun);
    attn_load<DIL>(fa, Kb, VTc, cp, ns + 128, kA, r, q4);
    attn_group(fb, ns + 96, nlo, nhi, q4, qf, o, lrun);
    attn_group(fa, ns + 128, nlo, nhi, q4, qf, o, lrun);
    lrun += __shfl_xor(lrun, 16); lrun += __shfl_xor(lrun, 32);
    LAS float* orow = OACC + qloc * 68 + 4 * q4;
#pragma unroll
    for (int dt = 0; dt < 4; ++dt) {
        if (FIRST) *(LAS f32x4*)(orow + 16 * dt) = o[dt];
        else { const f32x4 prev = *(const LAS f32x4*)(orow + 16 * dt); *(LAS f32x4*)(orow + 16 * dt) = prev + o[dt]; }
    }
    if (q4 == 0) { if (FIRST) LACC[qloc] = lrun; else LACC[qloc] += lrun; }
}
__device__ __forceinline__ void attn_item(LAS unsigned char* lds, int item, int tid, int wave, int lane, const bf16* QKV, const bf16* VT1, const bf16* VT4, const bf16* VT16, bf16* AO) {
    const int h = item >> 6, blk = item & 63;
    LAS float* OACC = (LAS float*)lds;
    LAS float* LACC = (LAS float*)(lds + 256 * 68 * 4);
#pragma unroll 1
    for (int a = 0; a < 2; ++a) { const int ti = 2 * wave + a; attn_tile<1, true>(OACC, LACC, QKV, VT1, h, blk, 0, 256 * blk + 16 * ti, 16 * ti, 1, lane); }
    __syncthreads();
#pragma unroll 1
    for (int a = 0; a < 2; ++a) { const int ti = 2 * wave + a, c4 = ti >> 2, jj = ti & 3; attn_tile<4, false>(OACC, LACC, QKV, VT4, h, blk, c4, 64 * blk + 16 * jj, c4 + 64 * jj, 4, lane); }
    __syncthreads();
#pragma unroll 1
    for (int a = 0; a < 2; ++a) { const int ti = 2 * wave + a; attn_tile<16, false>(OACC, LACC, QKV, VT16, h, blk, ti, 16 * blk, ti, 16, lane); }
    __syncthreads();
#pragma unroll
    for (int i = 0; i < 4; ++i) {
        const int idx = tid + 512 * i, q = idx >> 3, j = idx & 7;
        const float inv = 1.0f / LACC[q];
        const f32x4 a0 = *(const LAS f32x4*)(OACC + q * 68 + 8 * j), a1 = *(const LAS f32x4*)(OACC + q * 68 + 8 * j + 4);
        v4u w; w.x = pk2(a0[0] * inv, a0[1] * inv); w.y = pk2(a0[2] * inv, a0[3] * inv); w.z = pk2(a1[0] * inv, a1[1] * inv); w.w = pk2(a1[2] * inv, a1[3] * inv);
        *(v4u*)(AO + (size_t)(256 * blk + q) * D + h * 64 + 8 * j) = w;
    }
    __syncthreads();
}
constexpr int CH_CL = 0, CH_AT = 17408, CH_RT = CH_AT + 9216, CH_BT = CH_RT + 9216, CH_KT = CH_BT + 9216, CH_BHT = CH_KT + 9216, CH_KHT = CH_BHT + 9216, CH_VT = CH_KHT + 9216,
              CH_MABF = CH_VT + 9216, CH_MAK = CH_MABF + 17408, CH_MBR = CH_MAK + 9216, CH_MKR = CH_MBR + 9216, CH_GL = CH_MKR + 9216, CH_MABB = CH_GL + 256, CH_TJ = CH_MABB + 9216, CH_END = CH_TJ + 2048;
static_assert(CH_END <= 147456, "chunk LDS map");
__device__ __forceinline__ void unpack8(const v4u raw, float (&v)[8]) {
    v[0] = __uint_as_float(raw.x << 16); v[1] = __uint_as_float(raw.x & 0xffff0000u); v[2] = __uint_as_float(raw.y << 16); v[3] = __uint_as_float(raw.y & 0xffff0000u);
    v[4] = __uint_as_float(raw.z << 16); v[5] = __uint_as_float(raw.z & 0xffff0000u); v[6] = __uint_as_float(raw.w << 16); v[7] = __uint_as_float(raw.w & 0xffff0000u);
}
__device__ __forceinline__ v4u pack8(const float (&v)[8]) { v4u o; o.x = pk2(v[0], v[1]); o.y = pk2(v[2], v[3]); o.z = pk2(v[4], v[5]); o.w = pk2(v[6], v[7]); return o; }

__device__ __forceinline__ void rwkv_chunk_item(LAS unsigned char* lds, int item, int tid, int wave, int lane, const bf16* P, const RwkvW& W, bf16* VV, bf16* GG, float* BS,
                                                bf16* PMT, float* SLOC, bf16* QT, float* OLT) {
    const int c = item >> 3, h = item & 7, t0 = c * 64;
    LAS float* CL = (LAS float*)(lds + CH_CL); LAS float* Y5F = (LAS float*)(lds + CH_CL);
    LAS bf16* AT = (LAS bf16*)(lds + CH_AT); LAS bf16* RT = (LAS bf16*)(lds + CH_RT); LAS bf16* BT = (LAS bf16*)(lds + CH_BT); LAS bf16* KT = (LAS bf16*)(lds + CH_KT);
    LAS bf16* UB = BT; LAS bf16* WB = KT;
    LAS bf16* BHT = (LAS bf16*)(lds + CH_BHT); LAS bf16* KHT = (LAS bf16*)(lds + CH_KHT); LAS bf16* VT = (LAS bf16*)(lds + CH_VT);
    LAS float* MABF = (LAS float*)(lds + CH_MABF); LAS bf16* MAK = (LAS bf16*)(lds + CH_MAK); LAS bf16* MBR = (LAS bf16*)(lds + CH_MBR); LAS bf16* MKR = (LAS bf16*)(lds + CH_MKR);
    LAS float* GL = (LAS float*)(lds + CH_GL); LAS bf16* MABB = (LAS bf16*)(lds + CH_MABB); LAS bf16* TJB = (LAS bf16*)(lds + CH_TJ);
    LAS bf16* Xl = (LAS bf16*)(lds + CH_MABF);
    LAS float* LDv = (LAS float*)(lds + CH_AT);
    LAS float* SSP = (LAS float*)(lds + CH_TJ);
    const int r = lane & 15, q4 = lane >> 4, par = wave & 1;
    for (int idx = tid; idx < 64 * 256; idx += 512) {
        const int t = idx >> 8, j = idx & 255;
        const float ps = shifted(P, t0 + t, 1024 + 1536 + j, W.mu[1536 + j]);
        const float val = j < 64 ? tanhf(ps) : (j < 128 ? ps : 1.0f / (1.0f + __expf(-ps)));
        Xl[t * 264 + j] = (bf16)f2bf(val);
    }
    __syncthreads();
    const int tt = wave >> 1;
    float kr_[2][4], a_[2][4], kp_[2][4], r_s[2][4], v_s[2][4];
    {
        f32x4 aW[2], aA[2], aG[2];
#pragma unroll
        for (int ci = 0; ci < 2; ++ci) { aW[ci] = (f32x4){0.f, 0.f, 0.f, 0.f}; aA[ci] = aW[ci]; aG[ci] = aW[ci]; }
#pragma unroll
        for (int ks = 0; ks < 2; ++ks) {
            const bf16x8 xw = *(const LAS bf16x8*)(Xl + (16 * tt + r) * 264 + ks * 32 + q4 * 8);
            const bf16x8 xa = *(const LAS bf16x8*)(Xl + (16 * tt + r) * 264 + 64 + ks * 32 + q4 * 8);
#pragma unroll
            for (int ci = 0; ci < 2; ++ci) {
                const int crow = h * 64 + 16 * (2 * par + ci) + r;
                const bf16x8 yw = *(const bf16x8*)(W.w2t + (size_t)crow * 64 + ks * 32 + q4 * 8);
                const bf16x8 ya = *(const bf16x8*)(W.a2t + (size_t)crow * 64 + ks * 32 + q4 * 8);
                aW[ci] = MFMA16(xw, yw, aW[ci]); aA[ci] = MFMA16(xa, ya, aA[ci]);
            }
        }
#pragma unroll
        for (int ks = 0; ks < 4; ++ks) {
            const bf16x8 xg = *(const LAS bf16x8*)(Xl + (16 * tt + r) * 264 + 128 + ks * 32 + q4 * 8);
#pragma unroll
            for (int ci = 0; ci < 2; ++ci) {
                const bf16x8 yg = *(const bf16x8*)(W.g2t + (size_t)(h * 64 + 16 * (2 * par + ci) + r) * 128 + ks * 32 + q4 * 8);
                aG[ci] = MFMA16(xg, yg, aG[ci]);
            }
        }
#pragma unroll
        for (int e = 0; e < 4; ++e) {
            const int tl = 16 * tt + 4 * q4 + e, t = t0 + tl;
            float ss = 0.f, bon = 0.f;
#pragma unroll
            for (int ci = 0; ci < 2; ++ci) {
                const int cl_ = 16 * (2 * par + ci) + r, cc = h * 64 + cl_;
                const float rv = shifted(P, t, 1024 + cc, W.mu[cc]);
                const float kv = shifted(P, t, 1024 + 512 + cc, W.mu[512 + cc]);
                const float vv = shifted(P, t, 1024 + 1024 + cc, W.mu[1024 + cc]);
                const float xw = -(W.w0[cc] + aW[ci][e]);
                const float sp = xw > 20.f ? xw : log1pf(__expf(xw));
                const float ld = -__expf(-sp - 0.5f);
                const float a = 1.0f / (1.0f + __expf(-(W.a0[cc] + aA[ci][e])));
                const float kr = kv * W.k_k[cc];
                const float kp = kv * (1.0f + (a - 1.0f) * W.k_a[cc]);
                kr_[ci][e] = kr; a_[ci][e] = a; kp_[ci][e] = bf2f((bf16)f2bf(kp)); r_s[ci][e] = bf2f((bf16)f2bf(rv)); v_s[ci][e] = vv;
                ss += kr * kr; bon += rv * kp * W.r_k[cc];
                LDv[tl * 64 + cl_] = ld;
                const size_t o = (size_t)t * BW + cc;
                VV[o] = (bf16)f2bf(vv); GG[o] = (bf16)f2bf(aG[ci][e]);
            }
#pragma unroll
            for (int o = 1; o < 16; o <<= 1) { ss += __shfl_xor(ss, o); bon += __shfl_xor(bon, o); }
            if (r == 0) { SSP[tl * 2 + par] = ss; SSP[128 + tl * 2 + par] = bon; }
        }
    }
    __syncthreads();
    if (tid < 64) {
        float run = 0.f;
#pragma unroll 16
        for (int t = 0; t < 64; ++t) { run += LDv[t * 64 + tid]; CL[t * 64 + tid] = run; }
        GL[tid] = __expf(run);
    } else if (tid < 128) {
        const int tl = tid - 64;
        BS[(size_t)(t0 + tl) * 8 + h] = SSP[128 + tl * 2] + SSP[128 + tl * 2 + 1];
    }
    __syncthreads();
    {
#pragma unroll
        for (int ci = 0; ci < 2; ++ci) {
            const int k = 16 * (2 * par + ci) + r;
            const float clL = CL[63 * 64 + k];
            float bh[4], kh[4], vq[4];
#pragma unroll
            for (int e = 0; e < 4; ++e) {
                const int tl = 16 * tt + 4 * q4 + e;
                const float inv = 1.0f / sqrtf(fmaxf(SSP[tl * 2] + SSP[tl * 2 + 1], 1e-24f));
                const float kk = bf2f((bf16)f2bf(kr_[ci][e] * inv));
                const float bb = bf2f((bf16)f2bf(kk * a_[ci][e]));
                const float cl = CL[tl * 64 + k], clp = tl > 0 ? CL[(tl - 1) * 64 + k] : 0.f;
                const float en = __expf(-cl), eh = __expf(clL - cl);
                AT[tl * 72 + k] = (bf16)f2bf(-kk * __expf(clp)); RT[tl * 72 + k] = (bf16)f2bf(r_s[ci][e] * __expf(cl));
                BT[tl * 72 + k] = (bf16)f2bf(bb * en); KT[tl * 72 + k] = (bf16)f2bf(kp_[ci][e] * en);
                bh[e] = bb * eh; kh[e] = kp_[ci][e] * eh; vq[e] = v_s[ci][e];
            }
            const int tb = 16 * tt + 4 * q4;
            v2u w; w.x = pk2(bh[0], bh[1]); w.y = pk2(bh[2], bh[3]); *(LAS v2u*)(BHT + k * 72 + tb) = w;
            w.x = pk2(kh[0], kh[1]); w.y = pk2(kh[2], kh[3]); *(LAS v2u*)(KHT + k * 72 + tb) = w;
            w.x = pk2(vq[0], vq[1]); w.y = pk2(vq[2], vq[3]); *(LAS v2u*)(VT + k * 72 + tb) = w;
        }
    }
    __syncthreads();
    {
        const int mi = wave >> 1;
        const LAS bf16* X = (mi == 0 || mi == 2) ? BT : KT; const LAS bf16* Y = (mi < 2) ? AT : RT;
        f32x4 acc[2][4];
#pragma unroll
        for (int a = 0; a < 2; ++a)
#pragma unroll
            for (int b = 0; b < 4; ++b) acc[a][b] = (f32x4){0.f, 0.f, 0.f, 0.f};
#pragma unroll
        for (int ks = 0; ks < 2; ++ks) {
            bf16x8 xf[2], yf[4];
#pragma unroll
            for (int a = 0; a < 2; ++a) xf[a] = *(const LAS bf16x8*)(X + (16 * (2 * par + a) + r) * 72 + ks * 32 + q4 * 8);
#pragma unroll
            for (int b = 0; b < 4; ++b) yf[b] = *(const LAS bf16x8*)(Y + (16 * b + r) * 72 + ks * 32 + q4 * 8);
#pragma unroll
            for (int a = 0; a < 2; ++a)
#pragma unroll
                for (int b = 0; b < 4; ++b) acc[a][b] = MFMA16(xf[a], yf[b], acc[a][b]);
        }
#pragma unroll
        for (int a = 0; a < 2; ++a)
#pragma unroll
            for (int b = 0; b < 4; ++b) {
                const int s0 = 16 * (2 * par + a) + 4 * q4, t = 16 * b + r;
                f32x4 m;
#pragma unroll
                for (int e = 0; e < 4; ++e) m[e] = ((mi < 2) ? (s0 + e < t) : (s0 + e <= t)) ? acc[a][b][e] : 0.f;
                if (mi == 0) { *(LAS f32x4*)(MABF + t * 68 + s0) = m; v2u w; w.x = pk2(m[0], m[1]); w.y = pk2(m[2], m[3]); *(LAS v2u*)(MABB + t * 72 + s0) = w; }
                else { LAS bf16* Mo = (mi == 1) ? MAK : (mi == 2 ? MBR : MKR); v2u w; w.x = pk2(m[0], m[1]); w.y = pk2(m[2], m[3]); *(LAS v2u*)(Mo + t * 72 + s0) = w; }
            }
    }
    __syncthreads();
    {
        const int vt = wave >> 1;
        f32x4 acc[2];
        acc[0] = (f32x4){0.f, 0.f, 0.f, 0.f}; acc[1] = acc[0];
#pragma unroll
        for (int ks = 0; ks < 2; ++ks) {
            const bf16x8 xf = *(const LAS bf16x8*)(VT + (16 * vt + r) * 72 + ks * 32 + q4 * 8);
#pragma unroll
            for (int b = 0; b < 2; ++b) { const bf16x8 yf = *(const LAS bf16x8*)(MAK + (16 * (2 * par + b) + r) * 72 + ks * 32 + q4 * 8); acc[b] = MFMA16(xf, yf, acc[b]); }
        }
#pragma unroll
        for (int b = 0; b < 2; ++b)
#pragma unroll
            for (int e = 0; e < 4; ++e) Y5F[(16 * vt + 4 * q4 + e) * 68 + 16 * (2 * par + b) + r] = acc[b][e];
    }
    __syncthreads();
    if (wave == 0) {
        const int J = lane >> 4, i = lane & 15;
        float tr[16];
#pragma unroll
        for (int t = 0; t < 16; ++t) {
            float acc = (t == i) ? 1.f : 0.f;
#pragma unroll
            for (int s2 = 0; s2 < t; ++s2) acc += tr[s2] * MABF[(16 * J + t) * 68 + 16 * J + s2];
            tr[t] = acc;
        }
#pragma unroll
        for (int t = 0; t < 16; ++t) TJB[(16 * J + t) * 16 + i] = (bf16)f2bf(tr[t]);
    }
    __syncthreads();
    {
        unsigned xb[4][2];
#pragma unroll
        for (int J = 0; J < 4; ++J) {
            f32x4 z;
            if (wave < 4) z = *(const LAS f32x4*)(Y5F + (16 * wave + r) * 68 + 16 * J + 4 * q4);
            else {
#pragma unroll
                for (int e = 0; e < 4; ++e) z[e] = bf2f(AT[(16 * J + 4 * q4 + e) * 72 + 16 * (wave - 4) + r]);
            }
#pragma unroll
            for (int I = 0; I < J; I += 2) {
                const bool two = (I + 1 < J);
                const v2u m0 = *(const LAS v2u*)(MABB + (16 * J + r) * 72 + 16 * I + 4 * q4);
                v2u m1; m1.x = 0u; m1.y = 0u;
                if (two) m1 = *(const LAS v2u*)(MABB + (16 * J + r) * 72 + 16 * (I + 1) + 4 * q4);
                v4u fa; fa.x = m0.x; fa.y = m0.y; fa.z = m1.x; fa.w = m1.y;
                v4u fb; fb.x = xb[I][0]; fb.y = xb[I][1]; fb.z = two ? xb[I + 1 < 4 ? I + 1 : 3][0] : 0u; fb.w = two ? xb[I + 1 < 4 ? I + 1 : 3][1] : 0u;
                z = MFMA16(__builtin_bit_cast(bf16x8, fa), __builtin_bit_cast(bf16x8, fb), z);
            }
            const unsigned zh0 = pk2(z[0], z[1]), zh1 = pk2(z[2], z[3]);
            const unsigned zl0 = pk2(z[0] - __uint_as_float(zh0 << 16), z[1] - __uint_as_float(zh0 & 0xffff0000u)), zl1 = pk2(z[2] - __uint_as_float(zh1 << 16), z[3] - __uint_as_float(zh1 & 0xffff0000u));
            const v2u tw = *(const LAS v2u*)(TJB + (16 * J + r) * 16 + 4 * q4);
            v4u ft; ft.x = tw.x; ft.y = tw.y; ft.z = 0u; ft.w = 0u;
            v4u fh; fh.x = zh0; fh.y = zh1; fh.z = 0u; fh.w = 0u;
            v4u fl; fl.x = zl0; fl.y = zl1; fl.z = 0u; fl.w = 0u;
            f32x4 x = (f32x4){0.f, 0.f, 0.f, 0.f};
            x = MFMA16(__builtin_bit_cast(bf16x8, ft), __builtin_bit_cast(bf16x8, fh), x);
            x = MFMA16(__builtin_bit_cast(bf16x8, ft), __builtin_bit_cast(bf16x8, fl), x);
            xb[J][0] = pk2(x[0], x[1]); xb[J][1] = pk2(x[2], x[3]);
            LAS bf16* Xo = (wave < 4) ? (UB + (16 * wave + r) * 72) : (WB + (16 * (wave - 4) + r) * 72);
            v2u w; w.x = xb[J][0]; w.y = xb[J][1];
            *(LAS v2u*)(Xo + 16 * J + 4 * q4) = w;
        }
    }
    __syncthreads();
    {
        const int kind = wave >> 1;
        const LAS bf16* X1; const LAS bf16* Y1; const LAS bf16* X2 = nullptr; const LAS bf16* Y2 = nullptr;
        if (kind == 0) { X1 = UB; Y1 = MBR; X2 = VT; Y2 = MKR; }
        else if (kind == 1) { X1 = BHT; Y1 = UB; X2 = KHT; Y2 = VT; }
        else if (kind == 2) { X1 = WB; Y1 = MBR; }
        else { X1 = WB; Y1 = BHT; }
        f32x4 acc[2][4];
#pragma unroll
        for (int a = 0; a < 2; ++a)
#pragma unroll
            for (int b = 0; b < 4; ++b) acc[a][b] = (f32x4){0.f, 0.f, 0.f, 0.f};
#pragma unroll
        for (int ks = 0; ks < 2; ++ks) {
            bf16x8 xf[2], yf[4];
#pragma unroll
            for (int a = 0; a < 2; ++a) xf[a] = *(const LAS bf16x8*)(X1 + (16 * (2 * par + a) + r) * 72 + ks * 32 + q4 * 8);
#pragma unroll
            for (int b = 0; b < 4; ++b) yf[b] = *(const LAS bf16x8*)(Y1 + (16 * b + r) * 72 + ks * 32 + q4 * 8);
#pragma unroll
            for (int a = 0; a < 2; ++a)
#pragma unroll
                for (int b = 0; b < 4; ++b) acc[a][b] = MFMA16(xf[a], yf[b], acc[a][b]);
        }
        if (kind < 2) {
#pragma unroll
            for (int ks = 0; ks < 2; ++ks) {
                bf16x8 xf[2], yf[4];
#pragma unroll
                for (int a = 0; a < 2; ++a) xf[a] = *(const LAS bf16x8*)(X2 + (16 * (2 * par + a) + r) * 72 + ks * 32 + q4 * 8);
#pragma unroll
                for (int b = 0; b < 4; ++b) yf[b] = *(const LAS bf16x8*)(Y2 + (16 * b + r) * 72 + ks * 32 + q4 * 8);
#pragma unroll
                for (int a = 0; a < 2; ++a)
#pragma unroll
                    for (int b = 0; b < 4; ++b) acc[a][b] = MFMA16(xf[a], yf[b], acc[a][b]);
            }
        }
#pragma unroll
        for (int a = 0; a < 2; ++a)
#pragma unroll
            for (int b = 0; b < 4; ++b) {
                const int i0 = 16 * (2 * par + a) + 4 * q4, j = 16 * b + r;
                if (kind == 0) *(f32x4*)(OLT + ((size_t)item * 64 + j) * 64 + i0) = acc[a][b];
                else if (kind == 1) *(f32x4*)(SLOC + ((size_t)item * 64 + j) * 64 + i0) = acc[a][b];
                else if (kind == 2) {
                    const v2u rw = *(const LAS v2u*)(RT + j * 72 + i0);
                    v2u w; w.x = pk2(acc[a][b][0] + __uint_as_float(rw.x << 16), acc[a][b][1] + __uint_as_float(rw.x & 0xffff0000u));
                    w.y = pk2(acc[a][b][2] + __uint_as_float(rw.y << 16), acc[a][b][3] + __uint_as_float(rw.y & 0xffff0000u));
                    *(v2u*)(QT + ((size_t)item * 64 + j) * 64 + i0) = w;
                } else {
                    f32x4 m = acc[a][b];
#pragma unroll
                    for (int e = 0; e < 4; ++e) if (i0 + e == j) m[e] += GL[j];
                    v2u w; w.x = pk2(m[0], m[1]); w.y = pk2(m[2], m[3]);
                    *(v2u*)(PMT + ((size_t)item * 64 + j) * 64 + i0) = w;
                }
            }
    }
    __syncthreads();
}

struct ScanOps { bf16x8 pf[4][2]; f32x4 sl[4]; };
__device__ __forceinline__ void scan_ops_load(ScanOps& o, int it, int v, int r, int q4, const bf16* PMT, const float* SLOC) {
#pragma unroll
    for (int kt = 0; kt < 4; ++kt) {
        o.sl[kt] = *(const f32x4*)(SLOC + ((size_t)it * 64 + v) * 64 + 16 * kt + 4 * q4);
#pragma unroll
        for (int ks = 0; ks < 2; ++ks) {
            const bf16* p = PMT + ((size_t)it * 64 + 16 * kt + r) * 64 + 32 * ks + 4 * q4;
            const v2u lo = *(const v2u*)p, hi = *(const v2u*)(p + 16);
            v4u w; w.x = lo.x; w.y = lo.y; w.z = hi.x; w.w = hi.y;
            o.pf[kt][ks] = __builtin_bit_cast(bf16x8, w);
        }
    }
}
__device__ __forceinline__ void scan_step(const ScanOps& o, int c, int it, int v, int q4, int lane, LAS unsigned char* lds, bf16* SC) {
    volatile LAS int* flag = (volatile LAS int*)(lds + 16384);
    LAS v4u* slot_in = (LAS v4u*)(lds + (c & 1) * 8192);
    LAS v4u* slot_out = (LAS v4u*)(lds + ((c + 1) & 1) * 8192);
    while (*flag != c) __builtin_amdgcn_s_sleep(1);
    asm volatile("" ::: "memory");
    const v4u h0 = slot_in[lane], h1 = slot_in[64 + lane], l0 = slot_in[128 + lane], l1 = slot_in[192 + lane];
    { bf16* sc = SC + ((size_t)it * 64 + v) * 64 + 4 * q4;
      v2u w; w.x = h0.x; w.y = h0.y; *(v2u*)(sc) = w; w.x = h0.z; w.y = h0.w; *(v2u*)(sc + 16) = w;
      w.x = h1.x; w.y = h1.y; *(v2u*)(sc + 32) = w; w.x = h1.z; w.y = h1.w; *(v2u*)(sc + 48) = w; }
    const bf16x8 sh0 = __builtin_bit_cast(bf16x8, h0), sh1 = __builtin_bit_cast(bf16x8, h1), sl0 = __builtin_bit_cast(bf16x8, l0), sl1 = __builtin_bit_cast(bf16x8, l1);
    unsigned hw[4][2], lw[4][2];
#pragma unroll
    for (int kt = 0; kt < 4; ++kt) {
        f32x4 n = o.sl[kt];
        n = MFMA16(o.pf[kt][0], sh0, n); n = MFMA16(o.pf[kt][1], sh1, n);
        n = MFMA16(o.pf[kt][0], sl0, n); n = MFMA16(o.pf[kt][1], sl1, n);
        hw[kt][0] = pk2(n[0], n[1]); hw[kt][1] = pk2(n[2], n[3]);
        lw[kt][0] = pk2(n[0] - __uint_as_float(hw[kt][0] << 16), n[1] - __uint_as_float(hw[kt][0] & 0xffff0000u));
        lw[kt][1] = pk2(n[2] - __uint_as_float(hw[kt][1] << 16), n[3] - __uint_as_float(hw[kt][1] & 0xffff0000u));
    }
    v4u o0, o1, o2, o3;
    o0.x = hw[0][0]; o0.y = hw[0][1]; o0.z = hw[1][0]; o0.w = hw[1][1];
    o1.x = hw[2][0]; o1.y = hw[2][1]; o1.z = hw[3][0]; o1.w = hw[3][1];
    o2.x = lw[0][0]; o2.y = lw[0][1]; o2.z = lw[1][0]; o2.w = lw[1][1];
    o3.x = lw[2][0]; o3.y = lw[2][1]; o3.z = lw[3][0]; o3.w = lw[3][1];
    slot_out[lane] = o0; slot_out[64 + lane] = o1; slot_out[128 + lane] = o2; slot_out[192 + lane] = o3;
    asm volatile("s_waitcnt lgkmcnt(0)" ::: "memory");
    if (lane == 0) *flag = c + 1;
}
__device__ __forceinline__ void rwkv_state_scan_wg(LAS unsigned char* lds, int hv, int tid, int wave, int lane, const bf16* PMT, const float* SLOC, bf16* SC) {
    const int h = hv >> 2, vt = hv & 3, r = lane & 15, q4 = lane >> 4, v = 16 * vt + r;
    constexpr int NC = M / 64;
    for (int i = tid; i < 16384 / 4 + 16; i += 512) ((LAS unsigned*)lds)[i] = 0u;
    __syncthreads();
    ScanOps A, B;
    scan_ops_load(A, wave * 8 + h, v, r, q4, PMT, SLOC);
    scan_ops_load(B, (wave + 8) * 8 + h, v, r, q4, PMT, SLOC);
    for (int j = 0; j < NC / 8; j += 2) {
        const int cA = wave + 8 * j, cB = cA + 8;
        scan_step(A, cA, cA * 8 + h, v, q4, lane, lds, SC);
        if (j + 2 < NC / 8) scan_ops_load(A, (cA + 16) * 8 + h, v, r, q4, PMT, SLOC);
        scan_step(B, cB, cB * 8 + h, v, q4, lane, lds, SC);
        if (j + 3 < NC / 8) scan_ops_load(B, (cB + 16) * 8 + h, v, r, q4, PMT, SLOC);
    }
    __syncthreads();
}
__device__ __forceinline__ void rwkv_chunk_out(int item, int lane, const bf16* SC, const bf16* QT, const float* OLT, const float* BS, const bf16* VV, const bf16* GG,
                                               const float* gn_g, const float* gn_b, bf16* Y) {
    const int c = item >> 3, h = item & 7, r = lane & 15, q4 = lane >> 4;
    bf16x8 sf[4][2];
#pragma unroll
    for (int vt = 0; vt < 4; ++vt)
#pragma unroll
        for (int ks = 0; ks < 2; ++ks) sf[vt][ks] = *(const bf16x8*)(SC + ((size_t)item * 64 + 16 * vt + r) * 64 + 32 * ks + 8 * q4);
    f32x4 gg4[4], gb4[4];
#pragma unroll
    for (int vt = 0; vt < 4; ++vt) { gg4[vt] = *(const f32x4*)(gn_g + h * 64 + 16 * vt + 4 * q4); gb4[vt] = *(const f32x4*)(gn_b + h * 64 + 16 * vt + 4 * q4); }
    for (int tt = 0; tt < 4; ++tt) {
        const int tl = 16 * tt + r, t = c * 64 + tl;
        bf16x8 qf[2];
#pragma unroll
        for (int ks = 0; ks < 2; ++ks) qf[ks] = *(const bf16x8*)(QT + ((size_t)item * 64 + tl) * 64 + 32 * ks + 8 * q4);
        f32x4 o[4]; float s = 0.f;
#pragma unroll
        for (int vt = 0; vt < 4; ++vt) {
            o[vt] = *(const f32x4*)(OLT + ((size_t)item * 64 + tl) * 64 + 16 * vt + 4 * q4);
            o[vt] = MFMA16(sf[vt][0], qf[0], o[vt]); o[vt] = MFMA16(sf[vt][1], qf[1], o[vt]);
            s += (o[vt][0] + o[vt][1]) + (o[vt][2] + o[vt][3]);
        }
        s += __shfl_xor(s, 16); s += __shfl_xor(s, 32);
        const float mean = s * (1.f / 64.f);
        float qv = 0.f;
#pragma unroll
        for (int vt = 0; vt < 4; ++vt) { o[vt] = o[vt] - mean; qv += (o[vt][0] * o[vt][0] + o[vt][1] * o[vt][1]) + (o[vt][2] * o[vt][2] + o[vt][3] * o[vt][3]); }
        qv += __shfl_xor(qv, 16); qv += __shfl_xor(qv, 32);
        const float rstd = 1.0f / sqrtf(qv * (1.f / 64.f) + 64e-5f);
        const float bon = BS[(size_t)t * 8 + h];
#pragma unroll
        for (int vt = 0; vt < 4; ++vt) {
            const size_t oo = (size_t)t * BW + h * 64 + 16 * vt + 4 * q4;
            const v2u vr = *(const v2u*)(VV + oo), gr = *(const v2u*)(GG + oo);
            const float v0 = __uint_as_float(vr.x << 16), v1 = __uint_as_float(vr.x & 0xffff0000u), v2 = __uint_as_float(vr.y << 16), v3 = __uint_as_float(vr.y & 0xffff0000u);
            const float g0 = __uint_as_float(gr.x << 16), g1 = __uint_as_float(gr.x & 0xffff0000u), g2 = __uint_as_float(gr.y << 16), g3 = __uint_as_float(gr.y & 0xffff0000u);
            const f32x4 y = o[vt] * rstd * gg4[vt] + gb4[vt];
            v2u w; w.x = pk2((y[0] + bon * v0) * g0, (y[1] + bon * v1) * g1); w.y = pk2((y[2] + bon * v2) * g2, (y[3] + bon * v3) * g3);
            *(v2u*)(Y + (size_t)t * D + 512 + h * 64 + 16 * vt + 4 * q4) = w;
        }
    }
}
#define XB_TMO      128
#define XB_XCNT(j)  (256  + 64 * (j))
#define XB_XSUB(j)  (1280 + 64 * (j))
#define XB_XGEN(j)  (2304 + 64 * (j))
#define XB_TOP      3328
#define XB_TOPGEN   3392
#define XCD_BAR_WORDS 3456
#define XB_SPIN_CAP (1u << 18)

__device__ __forceinline__ unsigned xb_ld(unsigned* p)              { return __hip_atomic_load(p, __ATOMIC_RELAXED, __HIP_MEMORY_SCOPE_AGENT); }
__device__ __forceinline__ unsigned xb_add(unsigned* p, unsigned v) { return __hip_atomic_fetch_add(p, v, __ATOMIC_RELAXED, __HIP_MEMORY_SCOPE_AGENT); }
__device__ __forceinline__ unsigned xb_xcc_id() { return (unsigned)__builtin_amdgcn_s_getreg((3 << 11) | 20) & 0xFu; }
#define XB_SPIN(cond, bar) do { unsigned _sp = 0; while (cond) { __builtin_amdgcn_s_sleep(1); \
    if ((++_sp & 255u) == 0u) { if (xb_ld(&(bar)[XB_TMO])) break; if (_sp > XB_SPIN_CAP) { atomicAdd(&(bar)[XB_TMO], 1u); break; } } } } while (0)

struct XcdBarrier {
    unsigned* bar; unsigned x;
    volatile LAS unsigned* st;
};

__device__ __forceinline__ XcdBarrier xcd_barrier_post(unsigned* bar, volatile LAS unsigned* st) {
    XcdBarrier b; b.bar = bar; b.x = xb_xcc_id(); b.st = st;
    if (threadIdx.x == 0) (void)xb_add(&bar[XB_XCNT(b.x)], 1u);
    return b;
}
__device__ __forceinline__ void xcd_barrier_complete(unsigned* bar, unsigned x, unsigned& nloc, unsigned& nx) {
    const unsigned G = gridDim.x * gridDim.y * gridDim.z;
    unsigned sum, cnt, mine, sp = 0u;
    for (;;) {
        sum = 0u; cnt = 0u; mine = 0u;
#pragma unroll
        for (unsigned j = 0; j < 16; ++j) { const unsigned c = xb_ld(&bar[XB_XCNT(j)]); sum += c; cnt += (c > 0u) ? 1u : 0u; mine = (j == x) ? c : mine; }
        if (sum == G) break;
        __builtin_amdgcn_s_sleep(1);
        if ((++sp & 255u) == 0u) { if (xb_ld(&bar[XB_TMO])) break; if (sp > XB_SPIN_CAP) { atomicAdd(&bar[XB_TMO], 1u); break; } }
    }
    nloc = mine > 0u ? mine : 1u; nx = cnt > 0u ? cnt : 1u;
}

__device__ __forceinline__ void xcd_barrier(const XcdBarrier& b) {
    asm volatile("s_waitcnt vmcnt(0)" ::: "memory");
    __syncthreads();
    if (threadIdx.x == 0) {
        unsigned* bar = b.bar;
        __builtin_amdgcn_s_waitcnt(0);
        unsigned nloc = b.st[0], nx = b.st[1];
        if (nloc == 0u) { xcd_barrier_complete(bar, b.x, nloc, nx); b.st[0] = nloc; b.st[1] = nx; }
        const unsigned old = xb_add(&bar[XB_XSUB(b.x)], 1u);
        const unsigned gen = old / nloc;
        if (old + 1u == (gen + 1u) * nloc) {
            __builtin_amdgcn_fence(__ATOMIC_RELEASE, "agent");
            asm volatile("s_waitcnt vmcnt(0)" ::: "memory");
            const unsigned og = xb_add(&bar[XB_TOP], 1u);
            const unsigned tg = og / nx;
            if (og + 1u == (tg + 1u) * nx) xb_add(&bar[XB_TOPGEN], 1u);
            else XB_SPIN(xb_ld(&bar[XB_TOPGEN]) == tg, bar);
            __builtin_amdgcn_fence(__ATOMIC_ACQUIRE, "agent");
            xb_add(&bar[XB_XGEN(b.x)], 1u);
            asm volatile("s_waitcnt vmcnt(0)" ::: "memory");
        } else {
            XB_SPIN(xb_ld(&bar[XB_XGEN(b.x)]) == gen, bar);
            __builtin_amdgcn_fence(__ATOMIC_ACQUIRE, "agent");
            asm volatile("s_waitcnt vmcnt(0)" ::: "memory");
        }
    }
    __syncthreads();
}
struct Args { const float* in[28]; float* out; unsigned char* ws; };
#define GRID_SYNC() xcd_barrier(xbar)
#define PHASE_VARS int tid = threadIdx.x; asm volatile("" : "+v"(tid)); const int lane = tid & 63; const int wave = __builtin_amdgcn_readfirstlane(tid >> 6); \
    int G = gridDim.x; asm volatile("" : "+s"(G)); int bx = blockIdx.x; asm volatile("" : "+s"(bx)); const int gw = bx * NWAVES + wave, NGW = G * NWAVES; (void)lane; (void)gw; (void)NGW; (void)tid
#define WSP(T, off) ((T*)(args.ws + (off)))
#define XIN (args.in[0])
#define OUTF (args.out)
#define WA WSP(bf16, WS_WA)
#define WB WSP(bf16, WS_WB)
#define XN WSP(bf16, WS_XN)
#define P WSP(bf16, WS_P)
#define LD WSP(float, WS_LD)
#define KK WSP(bf16, WS_KK)
#define BB WSP(bf16, WS_BB)
#define KP WSP(bf16, WS_KP)
#define RR WSP(bf16, WS_RR)
#define VV WSP(bf16, WS_VV)
#define GG ((bf16*)args.out)
#define SCB ((bf16*)((unsigned char*)args.out + 16 * MiB))
#define OLT ((float*)((unsigned char*)args.out + 32 * MiB))
#define PMT WSP(bf16, WS_LD)
#define SLOC WSP(float, WS_LD + 16 * MiB)
#define QTB WSP(bf16, WS_LD + 48 * MiB)
#define BS WSP(float, WS_BS)
#define W2T WSP(bf16, WS_W2T)
#define A2T WSP(bf16, WS_A2T)
#define G2T WSP(bf16, WS_G2T)
#define YC WSP(bf16, WS_XN)
#define ACT WSP(bf16, WS_GEN)
#define QKV WSP(bf16, WS_QKV)
#define VT1 WSP(bf16, WS_VT1)
#define VT4 WSP(bf16, WS_VT4)
#define VT16 WSP(bf16, WS_VT16)
__global__ void __launch_bounds__(NWAVES * 64, 2) hybrid_fwd(Args args) {
    extern __shared__ __attribute__((aligned(16))) unsigned char lds_raw[];
    LAS unsigned char* lds = (LAS unsigned char*)lds_raw;
    if (threadIdx.x < 16) ((LAS unsigned*)(lds + LDS_BYTES - 64))[threadIdx.x] = 0u;
    __syncthreads();
    const XcdBarrier xbar = xcd_barrier_post((unsigned*)args.ws, (volatile LAS unsigned*)(lds + LDS_BYTES - 64));

    { PHASE_VARS;
    {
        LAS float* scr = (LAS float*)(lds + wave * 16384);
        const int IL = 16 + 16 + 32;
        for (int it = gw; it < IL; it += NGW) {
            if (it < 16) transpose_item(args.in[9], 64, 512, W2T, scr, it, lane);
            else if (it < 32) transpose_item(args.in[11], 64, 512, A2T, scr, it - 16, lane);
            else transpose_item(args.in[12], 128, 512, G2T, scr, it - 32, lane);
        }
        norm_phase(lds, gw, NGW, wave, lane, XIN, args.in[1], XN, args.in[2], D, EIN, WA, args.in[18], D, D, WB);
    }

    }
    cg::this_grid().sync();
    { PHASE_VARS;

    {
        pg8::Gemm g{XN, WA, M, EIN, D, 256L * D * 2, 128L * D * 2, 256L * D * 2, 128L * D * 2, 0}; pg8::StaticOrder S; S.init(M, EIN, G, bx);
        pg8::EpiBf16<0> E{P, EIN, nullptr, 0, 0, 1.f};
        pg8::gemm_phase<pg8::EpiBf16<0>, pg8::StaticOrder, true, true>(lds, g, S, E);
    }

    }
    GRID_SYNC();
    { PHASE_VARS;
        RwkvW W{args.in[7], args.in[8], args.in[10], args.in[13], args.in[14], args.in[15], W2T, A2T, G2T};
        for (int it = bx; it < (M / 64) * 8; it += G) rwkv_chunk_item(lds, it, tid, wave, lane, P, W, VV, GG, BS, PMT, SLOC, QTB, OLT);
    }
    GRID_SYNC();
    { PHASE_VARS;
        if (bx < 32) rwkv_state_scan_wg(lds, bx, tid, wave, lane, PMT, SLOC, SCB);
        else for (int it = bx - 32; it < (M / 128) * 4; it += G - 32) gmlp_item(lds, it, tid, wave, lane, P, args.in[3], args.in[4], args.in[5], args.in[6], YC);
    }
    GRID_SYNC();
    { PHASE_VARS;
        for (int it = gw; it < (M / 64) * 8; it += NGW) rwkv_chunk_out(it, lane, SCB, QTB, OLT, BS, VV, GG, args.in[16], args.in[17], YC);
    }
    GRID_SYNC();
    { PHASE_VARS;

    {
        pg8::Gemm g{YC, WB, M, D, D, 256L * D * 2, 128L * D * 2, 256L * D * 2, 128L * D * 2, 0}; pg8::StaticOrder S; S.init(M, D, G, bx);
        pg8::EpiRes E{XIN, OUTF, D};
        pg8::gemm_phase<pg8::EpiRes, pg8::StaticOrder, true, true>(lds, g, S, E);
    }

    }
    GRID_SYNC();
    { PHASE_VARS;
        norm_phase(lds, gw, NGW, wave, lane, OUTF, args.in[22] + 0 * D, XN, args.in[23] + (size_t)0 * D * FF2, D, FF2, WA, args.in[26] + (size_t)0 * FF * D, FF, D, WB);
    }
    GRID_SYNC();
    { PHASE_VARS;
        pg8::Gemm g{XN - 2 * D, WA, M, FF2, D, 248L * D * 2, 124L * D * 2, 128L * D * 2, 2816L * D * 2, 1}; pg8::StaticOrder S; S.init2(67, 22, G, bx);
        pg8::EpiConvGlu E{ACT, args.in[24] + (size_t)0 * 3 * FF2, args.in[25] + (size_t)0 * FF2, M};
        pg8::gemm_phase<pg8::EpiConvGlu, pg8::StaticOrder, true, true>(lds, g, S, E);
    }
    GRID_SYNC();
    { PHASE_VARS;
        pg8::Gemm g{ACT, WB, M, D, FF, 256L * FF * 2, 128L * FF * 2, 256L * FF * 2, 128L * FF * 2, 0}; pg8::StaticOrder S; S.init(M, D, G, bx);
        pg8::EpiRes E{OUTF, OUTF, D};
        pg8::gemm_phase<pg8::EpiRes, pg8::StaticOrder, true, true>(lds, g, S, E);
    }
    GRID_SYNC();
    { PHASE_VARS;
        norm_phase(lds, gw, NGW, wave, lane, OUTF, args.in[19], XN, args.in[20], D, NQKV, WA, args.in[21], D, D, WB);
    }
    GRID_SYNC();
    { PHASE_VARS;
        pg8::Gemm g{XN, WA, M, NQKV, D, 256L * D * 2, 128L * D * 2, 256L * D * 2, 128L * D * 2, 0}; pg8::StaticOrder S; S.init(M, NQKV, G, bx);
        pg8::EpiBf16<0> E{QKV, NQKV, nullptr, 0, 0, 1.f};
        pg8::gemm_phase<pg8::EpiBf16<0>, pg8::StaticOrder, true, true>(lds, g, S, E);
    }
    GRID_SYNC();
    { PHASE_VARS;
        for (int it = bx; it < 16 * 64; it += G) vtrans_item(lds, it, tid, QKV, VT1, VT4, VT16);
    }
    GRID_SYNC();
    { PHASE_VARS;
        for (int it = bx; it < 16 * 64; it += G) attn_item(lds, it, tid, wave, lane, QKV, VT1, VT4, VT16, YC);
    }
    GRID_SYNC();
    { PHASE_VARS;
        pg8::Gemm g{YC, WB, M, D, D, 256L * D * 2, 128L * D * 2, 256L * D * 2, 128L * D * 2, 0}; pg8::StaticOrder S; S.init(M, D, G, bx);
        pg8::EpiRes E{OUTF, OUTF, D};
        pg8::gemm_phase<pg8::EpiRes, pg8::StaticOrder, true, true>(lds, g, S, E);
    }
    GRID_SYNC();
    { PHASE_VARS;
        norm_phase(lds, gw, NGW, wave, lane, OUTF, args.in[22] + 1 * D, XN, args.in[23] + (size_t)1 * D * FF2, D, FF2, WA, args.in[26] + (size_t)1 * FF * D, FF, D, WB);
    }
    GRID_SYNC();
    { PHASE_VARS;
        pg8::Gemm g{XN - 2 * D, WA, M, FF2, D, 248L * D * 2, 124L * D * 2, 128L * D * 2, 2816L * D * 2, 1}; pg8::StaticOrder S; S.init2(67, 22, G, bx);
        pg8::EpiConvGlu E{ACT, args.in[24] + (size_t)1 * 3 * FF2, args.in[25] + (size_t)1 * FF2, M};
        pg8::gemm_phase<pg8::EpiConvGlu, pg8::StaticOrder, true, true>(lds, g, S, E);
    }
    GRID_SYNC();
    { PHASE_VARS;
        pg8::Gemm g{ACT, WB, M, D, FF, 256L * FF * 2, 128L * FF * 2, 256L * FF * 2, 128L * FF * 2, 0}; pg8::StaticOrder S; S.init(M, D, G, bx);
        pg8::EpiRes E{OUTF, OUTF, D};
        pg8::gemm_phase<pg8::EpiRes, pg8::StaticOrder, true, true>(lds, g, S, E);
    }
    GRID_SYNC();
    { PHASE_VARS;
        for (int m = gw; m < M; m += NGW) rms_row_inplace(OUTF + (size_t)m * D, args.in[27], lane);
    }
}

#undef WSP
#undef XIN
#undef OUTF
#undef WA
#undef WB
#undef XN
#undef P
#undef LD
#undef KK
#undef BB
#undef KP
#undef RR
#undef VV
#undef GG
#undef SCB
#undef OLT
#undef PMT
#undef SLOC
#undef QTB
#undef BS
#undef W2T
#undef A2T
#undef G2T
#undef YC
#undef ACT
#undef QKV
#undef VT1
#undef VT4
#undef VT16
extern "C" void kernel_launch(void* const* d_in, const int* in_sizes, int n_in, void* d_out, int out_size, void* d_ws, size_t ws_size, hipStream_t stream) {
    static int grid = 0;
    if (grid == 0) {
        if (n_in != 28 || in_sizes[0] != M * D || out_size != M * D || ws_size < WS_END) { fprintf(stderr, "kernel_launch: unexpected shapes (n_in %d, in0 %d, out %d, ws %zu)\n", n_in, n_in > 0 ? in_sizes[0] : -1, out_size, ws_size); grid = -1; return; }
        int dev = 0, cus = 0, per_cu = 0;
        if (hipGetDevice(&dev) != hipSuccess || hipDeviceGetAttribute(&cus, hipDeviceAttributeMultiprocessorCount, dev) != hipSuccess) { grid = -1; return; }
        if (hipFuncSetAttribute((const void*)hybrid_fwd, hipFuncAttributeMaxDynamicSharedMemorySize, LDS_BYTES) != hipSuccess) { fprintf(stderr, "kernel_launch: hipFuncSetAttribute failed\n"); grid = -1; return; }
        if (hipOccupancyMaxActiveBlocksPerMultiprocessor(&per_cu, (const void*)hybrid_fwd, NWAVES * 64, LDS_BYTES) != hipSuccess || per_cu < 1) { fprintf(stderr, "kernel_launch: occupancy query says %d\n", per_cu); per_cu = 1; }
        (void)hipGetLastError();
        grid = cus;
    }
    if (grid < 0) return;
    if (hipMemsetAsync(d_ws, 0, 65536, stream) != hipSuccess) { fprintf(stderr, "kernel_launch: hipMemsetAsync failed\n"); return; }
    Args a{};
    for (int i = 0; i < 28; ++i) a.in[i] = (const float*)d_in[i];
    a.out = (float*)d_out; a.ws = (unsigned char*)d_ws;
    void* kargs[] = {&a};
    hipError_t e = hipLaunchCooperativeKernel((const void*)hybrid_fwd, dim3(grid), dim3(NWAVES * 64), kargs, LDS_BYTES, stream);
    if (e != hipSuccess) fprintf(stderr, "kernel_launch: cooperative launch failed: %s (grid %d)\n", hipGetErrorString(e), grid);
}
```

```cpp
#include <hip/hip_runtime.h>
#include <hip/hip_cooperative_groups.h>
#include <cstdio>
#include <cstdint>
namespace cg = cooperative_groups;
namespace pg8 {
#define PG8_LAS __attribute__((address_space(3)))
typedef unsigned short bf16_t;
typedef short bf16x8 __attribute__((ext_vector_type(8)));
typedef float f32x4 __attribute__((ext_vector_type(4)));
typedef unsigned u32x4 __attribute__((ext_vector_type(4)));
constexpr int BM = 256, BK = 64, HALF = 128, HTB = HALF * BK * 2  , STAGE_BYTES = 8 * HTB, NXCD = 8, WGM = 8;

__host__ __device__ __forceinline__ int lds_byte(int r, int c) { const int st = (r >> 4) * 2 + (c >> 5), rr = r & 15, cc = c & 31, ob = rr * 64 + cc * 2; return st * 1024 + (ob ^ (((ob >> 9) & 1) << 5)); }
__host__ __device__ __forceinline__ void stage_rc(int b, int& R, int& C) { const int st = b / 1024, sb = b % 1024, swz = sb ^ (((sb >> 9) & 1) << 5); R = (st >> 1) * 16 + swz / 64; C = (st & 1) * 32 + (swz % 64) / 2; }
__host__ __device__ __forceinline__ int perm32(int rho) { const int n = rho >> 4, i = rho & 15; return 8 * (i >> 2) + 4 * n + (i & 3); }

struct Unit { int pm, pn; };
struct Gemm { const bf16_t* A; const bf16_t* Bt; int M, N, K; long tA, hA, tB, hB; int remapA; };

struct StaticOrder {
    int nM, nN, nwg, G, c;
    __host__ __device__ void init(int M, int N, int G_, int c_) { nM = M / BM; nN = N / BM; nwg = nM * nN; G = G_; c = c_; }
    __host__ __device__ void init2(int nM_, int nN_, int G_, int c_) { nM = nM_; nN = nN_; nwg = nM * nN; G = G_; c = c_; }
    __host__ __device__ bool next(int i, Unit& u) const {
        const long L = (long)i * G + c; if (L >= nwg) return false;
        int wgid = (int)L; { const int q = nwg / NXCD, r = nwg % NXCD, xcd = wgid % NXCD, off = wgid / NXCD; wgid = (xcd < r ? xcd * (q + 1) : r * (q + 1) + (xcd - r) * q) + off; }
        const int nig = WGM * nN, gid = wgid / nig, fm = gid * WGM, gsz = (nM - fm) < WGM ? (nM - fm) : WGM;
        u.pm = fm + ((wgid % nig) % gsz); u.pn = (wgid % nig) / gsz; return true;
    }
    __device__ __forceinline__ void a_ready(const Unit&) const {}
    __device__ __forceinline__ void done(const Unit&) const {}
};

__device__ __forceinline__ unsigned cvt_pk_bf16(float lo, float hi) { unsigned r; asm volatile("v_cvt_pk_bf16_f32 %0, %1, %2" : "=v"(r) : "v"(lo), "v"(hi)); return r; }
typedef float f32x2 __attribute__((ext_vector_type(2)));
__device__ __forceinline__ f32x2 gelu_pk(f32x2 v) {
    const f32x2 av = __builtin_elementwise_abs(v), d = av * 0.2316418882f + 1.0f;
    f32x2 t; t.x = __builtin_amdgcn_rcpf(d.x); t.y = __builtin_amdgcn_rcpf(d.y);
    f32x2 q = t * 0.5307027145f + (-0.7265760135f); q = q * t + 0.7107068705f; q = q * t + (-0.142248368f); q = q * t + 0.127414796f; q = q * t;
    const f32x2 s = (v * v) * (-0.72134752044f);
    f32x2 e; e.x = __builtin_amdgcn_exp2f(s.x); e.y = __builtin_amdgcn_exp2f(s.y);
    const f32x2 m = v * (q * e), r = v - m;
    f32x2 o; o.x = v.x < 0.f ? m.x : r.x; o.y = v.y < 0.f ? m.y : r.y; return o;
}

template <int ACT  > struct EpiBf16 {
    static constexpr bool PERM = true, AFTER_DRAIN = false; static_assert(ACT == 0 || ACT == 1, "EpiBf16: ACT is 0 (none) or 1 (gelu_pk)");
    bf16_t* O; int ldc; const float* bias; int split_cols; size_t split_stride; float scale0;
    __device__ __forceinline__ void operator()(const f32x4 (&acc)[2][2][4][2], const Unit& u, int wr, int wc, int fr, int fq) const {
        const int row0 = u.pm * BM + wr * 64 + fr; int colt = u.pn * BM; bf16_t* base = O;
        float sc = 1.f; if (split_cols) { const int t = colt / split_cols; base += (size_t)t * split_stride; colt -= t * split_cols; if (t == 0) sc = scale0; }
        const int col0 = colt + wc * 32 + 8 * fq, bcol0 = u.pn * BM + wc * 32 + 8 * fq;
        f32x4 bv[2][2];
#pragma unroll
        for (int bj = 0; bj < 2; ++bj)
#pragma unroll
            for (int n = 0; n < 2; ++n) bv[bj][n] = bias ? *(const f32x4*)(bias + bcol0 + bj * HALF + 4 * n) : (f32x4){0.f, 0.f, 0.f, 0.f};
#pragma unroll
        for (int ai = 0; ai < 2; ++ai)
#pragma unroll
            for (int m = 0; m < 4; ++m) { bf16_t* rowp = base + (size_t)(row0 + ai * HALF + m * 16) * ldc + col0;
#pragma unroll
                for (int bj = 0; bj < 2; ++bj) { f32x4 v0 = acc[ai][bj][m][0] + bv[bj][0], v1 = acc[ai][bj][m][1] + bv[bj][1];
                    if (ACT == 1) { f32x2 a = gelu_pk((f32x2){v0[0], v0[1]}), b = gelu_pk((f32x2){v0[2], v0[3]}), c = gelu_pk((f32x2){v1[0], v1[1]}), d = gelu_pk((f32x2){v1[2], v1[3]});
                        v0 = (f32x4){a.x, a.y, b.x, b.y}; v1 = (f32x4){c.x, c.y, d.x, d.y}; }
                    v0 = v0 * sc; v1 = v1 * sc; u32x4 w; w.x = cvt_pk_bf16(v0[0], v0[1]); w.y = cvt_pk_bf16(v0[2], v0[3]); w.z = cvt_pk_bf16(v1[0], v1[1]); w.w = cvt_pk_bf16(v1[2], v1[3]);
                    *(u32x4*)(rowp + bj * HALF) = w; } }
    }
};

template <class Epi, class Sched, bool ALIGN_EPI = false, bool SP2 = false>
__device__ __forceinline__ void gemm_phase(PG8_LAS unsigned char* lds, const Gemm g, const Sched& S, const Epi& E) {
    int tid_ = threadIdx.x; asm volatile("" : "+v"(tid_));
    const int tid = tid_, wid = __builtin_amdgcn_readfirstlane(tid >> 6), lane = tid & 63, wr = wid >> 2, wc = wid & 3, fr = lane & 15, fq = lane >> 4;
    const int K = g.K, nt = K / BK;
    unsigned voffA[2], voffB[2];
#pragma unroll
    for (int i = 0; i < 2; ++i) { int R, C; stage_rc(tid * 16 + i * 8192, R, C); const int Rb = Epi::PERM ? ((R & ~31) + perm32(R & 31)) : R;
        const int Ra = g.remapA ? (R - (R >= 64 ? 2 : 0)) : R; voffA[i] = (unsigned)(Ra * K + C) * 2u; voffB[i] = (unsigned)(Rb * K + C) * 2u; }
    const size_t kstep = (size_t)(BK * 2);
    const size_t hA = (size_t)g.hA, hB = (size_t)g.hB, tA = (size_t)g.tA, tB = (size_t)g.tB;
    const unsigned ldsw = (unsigned)wid * 1024u;
    const int aoff = lds_byte(wr * 64 + fr, fq * 8), boff = lds_byte(wc * 32 + fr, fq * 8);
#define PG8_SA(b, h) (((b) * 2 + (h)) * HTB)
#define PG8_SB(b, h) ((4 + (b) * 2 + (h)) * HTB)
#define PG8_STAGE(bufoff, gbase, voff) do { _Pragma("unroll") for (int _i = 0; _i < 2; ++_i) \
        __builtin_amdgcn_global_load_lds((const unsigned*)((const char*)(gbase) + (voff)[_i]), (PG8_LAS unsigned*)(lds + (bufoff) + ldsw + _i * 8192), 16, 0, 0); } while (0)
#define PG8_LDA(dst, b, h) do { _Pragma("unroll") for (int m = 0; m < 4; ++m) _Pragma("unroll") for (int k = 0; k < 2; ++k) dst[m][k] = *(const PG8_LAS bf16x8*)(lds + PG8_SA(b, h) + aoff + m * 2048 + k * 1024); } while (0)
#define PG8_LDB(dst, b, h) do { _Pragma("unroll") for (int n = 0; n < 2; ++n) _Pragma("unroll") for (int k = 0; k < 2; ++k) dst[n][k] = *(const PG8_LAS bf16x8*)(lds + PG8_SB(b, h) + boff + n * 2048 + k * 1024); } while (0)
#define PG8_MMA(ai, bj, At, Bt) do { __builtin_amdgcn_s_setprio(1); _Pragma("unroll") for (int m = 0; m < 4; ++m) _Pragma("unroll") for (int n = 0; n < 2; ++n) _Pragma("unroll") for (int k = 0; k < 2; ++k) \
        acc[ai][bj][m][n] = __builtin_amdgcn_mfma_f32_16x16x32_bf16(Bt[n][k], At[m][k], acc[ai][bj][m][n], 0, 0, 0); __builtin_amdgcn_s_setprio(0); } while (0)
#define PG8_WAIT_V(n) asm volatile("s_waitcnt vmcnt(" #n ")" ::: "memory")
#define PG8_WAIT_L(n) asm volatile("s_waitcnt lgkmcnt(" #n ")" ::: "memory")
#define PG8_BAR __builtin_amdgcn_s_barrier()
#define PG8_SCHED __builtin_amdgcn_sched_barrier(0)
    Unit cur, nxt; int ui = 0;
    if (!S.next(0, cur)) return;
    f32x4 acc[2][2][4][2];
#pragma unroll
    for (int a = 0; a < 2; ++a)
#pragma unroll
        for (int b = 0; b < 2; ++b)
#pragma unroll
            for (int m = 0; m < 4; ++m)
#pragma unroll
                for (int n = 0; n < 2; ++n) acc[a][b][m][n] = (f32x4){0.f, 0.f, 0.f, 0.f};
    bf16x8 At[4][2], B0[2][2], B1[2][2];
    const char* cA = (const char*)g.A + (size_t)cur.pm * tA; const char* cB = (const char*)g.Bt + (size_t)cur.pn * tB;
    S.a_ready(cur);
    if constexpr (SP2) {
        PG8_STAGE(PG8_SB(0, 0), cB, voffB); PG8_STAGE(PG8_SB(0, 1), cB + hB, voffB); PG8_STAGE(PG8_SA(0, 0), cA, voffA); PG8_STAGE(PG8_SA(0, 1), cA + hA, voffA);
        if (wr == 1) PG8_BAR;
        PG8_WAIT_V(2); PG8_BAR;
        PG8_STAGE(PG8_SB(1, 0), cB + kstep, voffB); PG8_STAGE(PG8_SA(1, 0), cA + kstep, voffA); PG8_STAGE(PG8_SB(1, 1), cB + hB + kstep, voffB);
        PG8_WAIT_V(6); PG8_BAR;
    } else {
        PG8_STAGE(PG8_SB(0, 0), cB, voffB); PG8_STAGE(PG8_SA(0, 0), cA, voffA); PG8_STAGE(PG8_SB(0, 1), cB + hB, voffB); PG8_STAGE(PG8_SA(0, 1), cA + hA, voffA);
        if (wr == 1) PG8_BAR;
        PG8_WAIT_V(4); PG8_BAR;
        PG8_STAGE(PG8_SB(1, 0), cB + kstep, voffB); PG8_STAGE(PG8_SA(1, 0), cA + kstep, voffA); PG8_STAGE(PG8_SB(1, 1), cB + hB + kstep, voffB);
        PG8_WAIT_V(6); PG8_BAR;
    }
    for (;;) {
        const bool has_next = S.next(ui + 1, nxt);
        const char* nA = has_next ? (const char*)g.A + (size_t)nxt.pm * tA : cA; const char* nB = has_next ? (const char*)g.Bt + (size_t)nxt.pn * tB : cB;
        for (int t = 0; t < nt; t += 2) {
            const bool last = (t == nt - 2);
            const char* a1 = cA + (size_t)(t + 1) * kstep;
            const char* a2 = last ? nA : cA + (size_t)(t + 2) * kstep; const char* b2 = last ? nB : cB + (size_t)(t + 2) * kstep;
            const char* a3 = a2 + kstep; const char* b3 = b2 + kstep;
            if (last && has_next) S.a_ready(nxt);
            if constexpr (SP2) {
            PG8_LDB(B0, 0, 0); PG8_LDB(B1, 0, 1); PG8_SCHED; PG8_LDA(At, 0, 0); PG8_STAGE(PG8_SA(1, 1), a1 + hA, voffA);
            PG8_WAIT_V(8); PG8_WAIT_L(0); PG8_BAR; PG8_MMA(0, 0, At, B0); PG8_MMA(0, 1, At, B1); PG8_BAR; PG8_SCHED;
            PG8_LDA(At, 0, 1); PG8_STAGE(PG8_SB(0, 0), b2, voffB); PG8_STAGE(PG8_SB(0, 1), b2 + hB, voffB); PG8_STAGE(PG8_SA(0, 0), a2, voffA);
            PG8_WAIT_V(8); PG8_WAIT_L(0); PG8_BAR; PG8_MMA(1, 0, At, B0); PG8_MMA(1, 1, At, B1); PG8_BAR; PG8_SCHED;
            PG8_LDB(B0, 1, 0); PG8_LDB(B1, 1, 1); PG8_SCHED; PG8_LDA(At, 1, 0); PG8_STAGE(PG8_SA(0, 1), a2 + hA, voffA);
            PG8_WAIT_V(8); PG8_WAIT_L(0); PG8_BAR; PG8_MMA(0, 0, At, B0); PG8_MMA(0, 1, At, B1); PG8_BAR; PG8_SCHED;
            PG8_LDA(At, 1, 1); PG8_STAGE(PG8_SB(1, 0), b3, voffB); PG8_STAGE(PG8_SB(1, 1), b3 + hB, voffB); PG8_STAGE(PG8_SA(1, 0), a3, voffA);
            PG8_WAIT_V(8); PG8_WAIT_L(0); PG8_BAR; PG8_MMA(1, 0, At, B0); PG8_MMA(1, 1, At, B1); PG8_BAR; PG8_SCHED;
            } else {
            PG8_LDB(B0, 0, 0); PG8_SCHED; PG8_LDA(At, 0, 0); PG8_STAGE(PG8_SA(1, 1), a1 + hA, voffA);
            PG8_WAIT_L(8); PG8_BAR; PG8_WAIT_L(0); PG8_MMA(0, 0, At, B0); PG8_BAR; PG8_SCHED;
            PG8_LDB(B1, 0, 1); PG8_STAGE(PG8_SB(0, 0), b2, voffB);
            PG8_BAR; PG8_WAIT_L(0); PG8_MMA(0, 1, At, B1); PG8_BAR;
            PG8_LDA(At, 0, 1); PG8_STAGE(PG8_SA(0, 0), a2, voffA);
            PG8_BAR; PG8_WAIT_L(0); PG8_MMA(1, 0, At, B0); PG8_BAR; PG8_SCHED;
            PG8_STAGE(PG8_SB(0, 1), b2 + hB, voffB);
            PG8_WAIT_V(6); PG8_BAR; PG8_MMA(1, 1, At, B1); PG8_BAR;
            PG8_LDB(B0, 1, 0); PG8_SCHED; PG8_LDA(At, 1, 0); PG8_STAGE(PG8_SA(0, 1), a2 + hA, voffA);
            PG8_WAIT_L(8); PG8_BAR; PG8_WAIT_L(0); PG8_MMA(0, 0, At, B0); PG8_BAR; PG8_SCHED;
            PG8_LDB(B1, 1, 1); PG8_STAGE(PG8_SB(1, 0), b3, voffB);
            PG8_BAR; PG8_WAIT_L(0); PG8_MMA(0, 1, At, B1); PG8_BAR;
            PG8_LDA(At, 1, 1); PG8_STAGE(PG8_SA(1, 0), a3, voffA);
            PG8_BAR; PG8_WAIT_L(0); PG8_MMA(1, 0, At, B0); PG8_BAR; PG8_SCHED;
            PG8_STAGE(PG8_SB(1, 1), b3 + hB, voffB);
            PG8_WAIT_V(6); PG8_BAR; PG8_MMA(1, 1, At, B1); PG8_BAR;
            }
        }
        if constexpr (ALIGN_EPI) { if (wr == 0) PG8_BAR; }
        if constexpr (!Epi::AFTER_DRAIN) { E(acc, cur, wr, wc, fr, fq); S.done(cur); }
        if (!has_next) break;
#pragma unroll
        for (int a = 0; a < 2; ++a)
#pragma unroll
            for (int b = 0; b < 2; ++b)
#pragma unroll
                for (int m = 0; m < 4; ++m)
#pragma unroll
                    for (int n = 0; n < 2; ++n) acc[a][b][m][n] = (f32x4){0.f, 0.f, 0.f, 0.f};
        cur = nxt; cA = nA; cB = nB; ++ui;
        if constexpr (ALIGN_EPI) { if (wr == 1) PG8_BAR; }
    }
    PG8_WAIT_V(0);
    if constexpr (!ALIGN_EPI) { if (wr == 0) PG8_BAR; }
    PG8_BAR;
    if constexpr (Epi::AFTER_DRAIN) { E.fused(acc, cur, wr, wc, fr, fq, lds, wid, lane); S.done(cur); }
#undef PG8_SA
#undef PG8_SB
#undef PG8_STAGE
#undef PG8_LDA
#undef PG8_LDB
#undef PG8_MMA
#undef PG8_WAIT_V
#undef PG8_WAIT_L
#undef PG8_BAR
#undef PG8_SCHED
}
}
namespace pg8 {
template <int N> __device__ __forceinline__ float row_ror(float v) {
    return __builtin_bit_cast(float, __builtin_amdgcn_update_dpp(0, __builtin_bit_cast(int, v), 0x120 + N, 0xf, 0xf, false));
}
}
namespace pg8 {
struct EpiRes {
    static constexpr bool PERM = false, AFTER_DRAIN = false;
    const float* base; float* out; int ldc;
    __device__ __forceinline__ void operator()(const f32x4 (&acc)[2][2][4][2], const Unit& u, int wr, int wc, int fr, int fq) const {
        const int col0 = u.pn * BM + wc * 32 + 4 * fq;
#pragma unroll
        for (int ai = 0; ai < 2; ++ai)
#pragma unroll
            for (int m = 0; m < 4; ++m) { const size_t off = (size_t)(u.pm * BM + ai * HALF + wr * 64 + m * 16 + fr) * ldc + col0;
#pragma unroll
                for (int bj = 0; bj < 2; ++bj)
#pragma unroll
                    for (int n = 0; n < 2; ++n) { const f32x4 b = *(const f32x4*)(base + off + bj * HALF + n * 16); *(f32x4*)(out + off + bj * HALF + n * 16) = b + acc[ai][bj][m][n]; } }
    }
};
struct EpiConvGlu {
    static constexpr bool PERM = false, AFTER_DRAIN = false;
    bf16_t* O; const float* cw; const float* cb; int M;
    __device__ __forceinline__ void operator()(const f32x4 (&acc)[2][2][4][2], const Unit& u, int wr, int wc, int fr, int fq) const {
        const int lane = fq * 16 + fr;
        const int src1 = fq * 16 + ((fr + 15) & 15), src2 = fq * 16 + ((fr + 14) & 15);
#pragma unroll
        for (int ai = 0; ai < 2; ++ai) {
            const int pb = 248 * u.pm + 62 * (2 * ai + wr) - 2;
#pragma unroll
            for (int n = 0; n < 2; ++n) {
                const int jg = 128 * u.pn + 32 * wc + 16 * n + 4 * fq;
                const f32x4 g0 = *(const f32x4*)(cw + jg), g1 = *(const f32x4*)(cw + 5632 + jg), g2 = *(const f32x4*)(cw + 2 * 5632 + jg), gb = *(const f32x4*)(cb + jg);
                const f32x4 v0 = *(const f32x4*)(cw + 2816 + jg), v1 = *(const f32x4*)(cw + 5632 + 2816 + jg), v2 = *(const f32x4*)(cw + 2 * 5632 + 2816 + jg), vb = *(const f32x4*)(cb + 2816 + jg);
                f32x4 pg1, pg2, pv1, pv2;
#pragma unroll
                for (int m = 0; m < 4; ++m) {
                    f32x4 zg = acc[ai][0][m][n], zv = acc[ai][1][m][n];
                    const int pos = pb + 16 * m + fr;
                    if (pos < 0) { zg = (f32x4){0.f, 0.f, 0.f, 0.f}; zv = zg; }
                    f32x4 rg1, rg2, rv1, rv2;
#pragma unroll
                    for (int e = 0; e < 4; ++e) { rg1[e] = row_ror<1>(zg[e]); rg2[e] = row_ror<2>(zg[e]); rv1[e] = row_ror<1>(zv[e]); rv2[e] = row_ror<2>(zv[e]); }
                    f32x4 zg1, zg2, zv1, zv2;
                    if (m == 0) { zg1 = rg1; zg2 = rg2; zv1 = rv1; zv2 = rv2; }
                    else {
#pragma unroll
                        for (int e = 0; e < 4; ++e) { zg1[e] = fr >= 1 ? rg1[e] : pg1[e]; zg2[e] = fr >= 2 ? rg2[e] : pg2[e]; zv1[e] = fr >= 1 ? rv1[e] : pv1[e]; zv2[e] = fr >= 2 ? rv2[e] : pv2[e]; }
                    }
                    pg1 = rg1; pg2 = rg2; pv1 = rv1; pv2 = rv2;
                    const f32x4 cg = g0 * zg2 + g1 * zg1 + g2 * zg + gb;
                    const f32x4 cv = v0 * zv2 + v1 * zv1 + v2 * zv + vb;
                    f32x4 a;
#pragma unroll
                    for (int e = 0; e < 4; ++e) a[e] = cg[e] / (1.0f + __expf(-cg[e])) * cv[e];
                    if ((16 * m + fr) >= 2 && pos < M) {
                        typedef unsigned u32x2 __attribute__((ext_vector_type(2)));
                        u32x2 w; w.x = cvt_pk_bf16(a[0], a[1]); w.y = cvt_pk_bf16(a[2], a[3]);
                        *(u32x2*)(O + (size_t)pos * 2816 + jg) = w;
                    }
                }
            }
        }
        (void)lane;
    }
};
}
#define LAS __attribute__((address_space(3)))
typedef unsigned short bf16;
typedef float f32x4 __attribute__((ext_vector_type(4)));
typedef short bf16x8 __attribute__((ext_vector_type(8)));
typedef unsigned v4u __attribute__((ext_vector_type(4)));
typedef unsigned v2u __attribute__((ext_vector_type(2)));
constexpr int NWAVES = 8;
constexpr int M = 16384, D = 1024, EIN = 2816, FF = 2816, FF2 = 5632, NQKV = 3072, BW = 512;
constexpr size_t MiB = 1u << 20;
constexpr size_t WS_W2T = 1 * MiB, WS_A2T = WS_W2T + 65536, WS_G2T = WS_A2T + 65536, WS_BS = WS_G2T + 131072;
constexpr size_t WS_WA = 2 * MiB, WS_WB = 13 * MiB, WS_XN = 20 * MiB, WS_GEN = 52 * MiB, WS_END = 256 * MiB;
constexpr size_t WS_P = WS_GEN, WS_LD = WS_GEN + 88 * MiB, WS_KK = WS_LD + 32 * MiB, WS_BB = WS_KK + 16 * MiB, WS_KP = WS_BB + 16 * MiB, WS_RR = WS_KP + 16 * MiB, WS_VV = WS_RR + 16 * MiB;
static_assert(WS_VV + 16 * MiB <= WS_END, "ws map");
constexpr size_t WS_QKV = WS_GEN, WS_VT1 = WS_GEN + 96 * MiB, WS_VT4 = WS_VT1 + 32 * MiB, WS_VT16 = WS_VT4 + 32 * MiB;
static_assert(WS_VT16 + 33 * MiB <= WS_END, "ws map");
constexpr int LDS_BYTES = 147456;

__device__ __forceinline__ float bf2f(unsigned short v) { return __uint_as_float(((unsigned)v) << 16); }
typedef float f32x2_t __attribute__((ext_vector_type(2))); typedef __bf16 bf16x2_t __attribute__((ext_vector_type(2)));
__device__ __forceinline__ unsigned pk2(float lo, float hi) { f32x2_t v = {lo, hi}; bf16x2_t b = __builtin_convertvector(v, bf16x2_t); return __builtin_bit_cast(unsigned, b); }
__device__ __forceinline__ unsigned f2bf(float f) { return pk2(f, f) & 0xffffu; }
__device__ __forceinline__ float wave_sum(float v) {
#pragma unroll
    for (int o = 1; o < 64; o <<= 1) v += __shfl_xor(v, o);
    return v;
}
__device__ __forceinline__ float dpp_row_shr(float v, int n) {
    const int iv = __builtin_bit_cast(int, v); int r;
    switch (n) { case 1: r = __builtin_amdgcn_update_dpp(0, iv, 0x111, 0xf, 0xf, true); break; case 2: r = __builtin_amdgcn_update_dpp(0, iv, 0x112, 0xf, 0xf, true); break;
                 case 4: r = __builtin_amdgcn_update_dpp(0, iv, 0x114, 0xf, 0xf, true); break; default: r = __builtin_amdgcn_update_dpp(0, iv, 0x118, 0xf, 0xf, true); break; }
    return __builtin_bit_cast(float, r);
}
__device__ __forceinline__ float wave_sum_uniform(float v) {
    v += dpp_row_shr(v, 1); v += dpp_row_shr(v, 2); v += dpp_row_shr(v, 4); v += dpp_row_shr(v, 8);
    v += __builtin_bit_cast(float, __builtin_amdgcn_update_dpp(0, __builtin_bit_cast(int, v), 0x142, 0xa, 0xf, false));
    v += __builtin_bit_cast(float, __builtin_amdgcn_update_dpp(0, __builtin_bit_cast(int, v), 0x143, 0xc, 0xf, false));
    return __builtin_bit_cast(float, __builtin_amdgcn_readlane(__builtin_bit_cast(int, v), 63));
}
#define MFMA16(a, b, c) __builtin_amdgcn_mfma_f32_16x16x32_bf16((a), (b), (c), 0, 0, 0)

__device__ __forceinline__ void transpose_item(const float* W, int K, int N, bf16* WT, LAS float* scr, int item, int lane) {
    const int nblk = N / 32, kb = item / nblk, nb = item % nblk, k0 = 64 * kb, n0 = 32 * nb;
    float wv[32];
#pragma unroll
    for (int i = 0; i < 32; ++i) wv[i] = W[(size_t)(k0 + 2 * i + (lane >> 5)) * N + n0 + (lane & 31)];
#pragma unroll
    for (int i = 0; i < 32; ++i) scr[(2 * i + (lane >> 5)) * 33 + (lane & 31)] = wv[i];
    asm volatile("s_waitcnt lgkmcnt(0)" ::: "memory");
    const int c = lane & 7;
#pragma unroll
    for (int j = 0; j < 4; ++j) { const int n = (lane >> 3) + 8 * j; const LAS float* s = scr + (8 * c) * 33 + n;
        v4u o; o.x = pk2(s[0 * 33], s[1 * 33]); o.y = pk2(s[2 * 33], s[3 * 33]); o.z = pk2(s[4 * 33], s[5 * 33]); o.w = pk2(s[6 * 33], s[7 * 33]);
        *(v4u*)(WT + (size_t)(n0 + n) * K + k0 + 8 * c) = o; }
    asm volatile("s_waitcnt lgkmcnt(0)" ::: "memory");
}
__device__ __forceinline__ void rms_row_to_bf16(const float* xrow, const float* gain, bf16* orow, int lane) {
    const f32x4* xr = (const f32x4*)xrow + lane; const f32x4* gr = (const f32x4*)gain + lane;
    f32x4 v[4]; float s = 0.f;
#pragma unroll
    for (int j = 0; j < 4; ++j) { v[j] = xr[64 * j]; s += (v[j].x * v[j].x + v[j].y * v[j].y) + (v[j].z * v[j].z + v[j].w * v[j].w); }
    const float rstd = 1.0f / sqrtf(wave_sum(s) * (1.f / D) + 1e-6f);
    v2u* o8 = (v2u*)orow + lane;
#pragma unroll
    for (int j = 0; j < 4; ++j) { const f32x4 g = gr[64 * j]; v2u w; w.x = pk2(v[j].x * rstd * g.x, v[j].y * rstd * g.y); w.y = pk2(v[j].z * rstd * g.z, v[j].w * rstd * g.w); o8[64 * j] = w; }
}
__device__ __forceinline__ void rms_row2_to_bf16(const float* xa, const float* xb, const float* gain, bf16* oa, bf16* ob, int lane) {
    const f32x4* ra = (const f32x4*)xa + lane; const f32x4* rb = (const f32x4*)xb + lane; const f32x4* gr = (const f32x4*)gain + lane;
    f32x4 va[4], vb[4]; float sa = 0.f, sb = 0.f;
#pragma unroll
    for (int j = 0; j < 4; ++j) { va[j] = ra[64 * j]; vb[j] = rb[64 * j]; }
#pragma unroll
    for (int j = 0; j < 4; ++j) { sa += (va[j].x * va[j].x + va[j].y * va[j].y) + (va[j].z * va[j].z + va[j].w * va[j].w); sb += (vb[j].x * vb[j].x + vb[j].y * vb[j].y) + (vb[j].z * vb[j].z + vb[j].w * vb[j].w); }
#pragma unroll
    for (int o = 1; o < 64; o <<= 1) { sa += __shfl_xor(sa, o); sb += __shfl_xor(sb, o); }
    const float ka = 1.0f / sqrtf(sa * (1.f / D) + 1e-6f), kb = 1.0f / sqrtf(sb * (1.f / D) + 1e-6f);
    v2u* pa = (v2u*)oa + lane; v2u* pb = (v2u*)ob + lane;
#pragma unroll
    for (int j = 0; j < 4; ++j) { const f32x4 g = gr[64 * j];
        v2u w; w.x = pk2(va[j].x * ka * g.x, va[j].y * ka * g.y); w.y = pk2(va[j].z * ka * g.z, va[j].w * ka * g.w); pa[64 * j] = w;
        v2u u; u.x = pk2(vb[j].x * kb * g.x, vb[j].y * kb * g.y); u.y = pk2(vb[j].z * kb * g.z, vb[j].w * kb * g.w); pb[64 * j] = u; }
}
__device__ __forceinline__ void rms_row_inplace(float* xrow, const float* gain, int lane) {
    f32x4* xr = (f32x4*)xrow + lane; const f32x4* gr = (const f32x4*)gain + lane;
    f32x4 v[4]; float s = 0.f;
#pragma unroll
    for (int j = 0; j < 4; ++j) { v[j] = xr[64 * j]; s += (v[j].x * v[j].x + v[j].y * v[j].y) + (v[j].z * v[j].z + v[j].w * v[j].w); }
    const float rstd = 1.0f / sqrtf(wave_sum(s) * (1.f / D) + 1e-6f);
#pragma unroll
    for (int j = 0; j < 4; ++j) { const f32x4 g = gr[64 * j]; xr[64 * j] = v[j] * rstd * g; }
}
__device__ __forceinline__ void norm_phase(LAS unsigned char* lds, int gw, int NGW, int wave, int lane, const float* x, const float* gain, bf16* XN,
                                           const float* W1, int K1, int N1, bf16* W1t, const float* W2, int K2, int N2, bf16* W2t) {
    LAS float* scr = (LAS float*)(lds + wave * 16384);
    const int I1 = (K1 / 64) * (N1 / 32), I2 = (K2 / 64) * (N2 / 32);
    for (int it = gw; it < I1 + I2; it += NGW) {
        if (it < I1) transpose_item(W1, K1, N1, W1t, scr, it, lane); else transpose_item(W2, K2, N2, W2t, scr, it - I1, lane);
    }
    for (int m = gw; m < M; m += 2 * NGW) rms_row2_to_bf16(x + (size_t)m * D, x + (size_t)(m + NGW) * D, gain, XN + (size_t)m * D, XN + (size_t)(m + NGW) * D, lane);
}

__device__ __forceinline__ void gmlp_item(LAS unsigned char* lds, int item, int tid, int wave, int lane, const bf16* P, const float* ln_g, const float* ln_b,
                                          const float* w_s, const float* b_s, bf16* Y) {
    const int chunk = item >> 2, g = item & 3, t0 = chunk * 128;
    LAS bf16* Wm = (LAS bf16*)lds;
    LAS bf16* Vt = (LAS bf16*)(lds + 128 * 136 * 2);
    v4u raws[16];
#pragma unroll
    for (int i = 0; i < 16; ++i) raws[i] = *(const v4u*)(P + (size_t)(t0 + wave * 16 + i) * EIN + 512 + lane * 8);
    float lg8[8], lb8[8];
#pragma unroll
    for (int e = 0; e < 8; ++e) { const int ch = g * 128 + (lane & 15) * 8 + e; lg8[e] = ln_g[ch]; lb8[e] = ln_b[ch]; }
#pragma unroll
    for (int i = 0; i < 16; ++i) {
        const int s = wave * 16 + i;
        const v4u raw = raws[i];
        float v[8];
        v[0] = __uint_as_float(raw.x << 16); v[1] = __uint_as_float(raw.x & 0xffff0000u); v[2] = __uint_as_float(raw.y << 16); v[3] = __uint_as_float(raw.y & 0xffff0000u);
        v[4] = __uint_as_float(raw.z << 16); v[5] = __uint_as_float(raw.z & 0xffff0000u); v[6] = __uint_as_float(raw.w << 16); v[7] = __uint_as_float(raw.w & 0xffff0000u);
        float sum = 0.f;
#pragma unroll
        for (int e = 0; e < 8; ++e) sum += v[e];
        const float mean = wave_sum(sum) * (1.f / 512.f);
        float q = 0.f;
#pragma unroll
        for (int e = 0; e < 8; ++e) { v[e] -= mean; q += v[e] * v[e]; }
        const float rstd = 1.0f / sqrtf(wave_sum(q) * (1.f / 512.f) + 1e-5f);
        if ((lane >> 4) == g) {
#pragma unroll
            for (int e = 0; e < 8; ++e) { const int c = (lane & 15) * 8 + e; Vt[c * 136 + s] = (bf16)f2bf(v[e] * rstd * lg8[e] + lb8[e]); }
        }
    }
    for (int idx = tid; idx < 128 * 32; idx += 512) {
        const int t = idx >> 5, s4 = (idx & 31) * 4;
        const f32x4 w = *(const f32x4*)(w_s + ((size_t)g * 128 + t) * 128 + s4);
        v2u o; o.x = pk2(s4 + 0 <= t ? w.x : 0.f, s4 + 1 <= t ? w.y : 0.f); o.y = pk2(s4 + 2 <= t ? w.z : 0.f, s4 + 3 <= t ? w.w : 0.f);
        *(LAS v2u*)(Wm + t * 136 + s4) = o;
    }
    __syncthreads();
    const int r = lane & 15, q4 = lane >> 4;
    f32x4 acc[8];
#pragma unroll
    for (int ct = 0; ct < 8; ++ct) acc[ct] = (f32x4){0.f, 0.f, 0.f, 0.f};
    const int nks = (16 * wave + 15) / 32 + 1;
    for (int ks = 0; ks < nks; ++ks) {
        const bf16x8 af = *(const LAS bf16x8*)(Wm + (16 * wave + r) * 136 + ks * 32 + q4 * 8);
#pragma unroll
        for (int ct = 0; ct < 8; ++ct) { const bf16x8 bfr = *(const LAS bf16x8*)(Vt + (16 * ct + r) * 136 + ks * 32 + q4 * 8); acc[ct] = MFMA16(af, bfr, acc[ct]); }
    }
#pragma unroll
    for (int ct = 0; ct < 8; ++ct)
#pragma unroll
        for (int e = 0; e < 4; ++e) {
            const int t = 16 * wave + 4 * q4 + e, c = 16 * ct + r;
            const float mixed = acc[ct][e] + b_s[g * 128 + t];
            const float u = bf2f(P[(size_t)(t0 + t) * EIN + g * 128 + c]);
            Y[(size_t)(t0 + t) * D + g * 128 + c] = (bf16)f2bf(u * mixed);
        }
    __syncthreads();
}

struct RwkvW { const float *mu, *w0, *a0, *k_k, *k_a, *r_k; const bf16 *w2t, *a2t, *g2t; };
__device__ __forceinline__ float shifted(const bf16* P, int t, int col, float mu) {
    const float cur = bf2f(P[(size_t)t * EIN + col]); const float prev = t > 0 ? bf2f(P[(size_t)(t - 1) * EIN + col]) : 0.f; return cur + (prev - cur) * mu;
}
__device__ __forceinline__ void rwkv_prep_item(LAS unsigned char* lds, int item, int tid, int wave, int lane, const bf16* P, const RwkvW& W,
                                               float* LD, bf16* KK, bf16* BB, bf16* KP, bf16* RR, bf16* VV, bf16* GG, float* BS) {
    const int t0 = item * 64;
    LAS bf16* Xl = (LAS bf16*)lds;
    for (int idx = tid; idx < 64 * 256; idx += 512) {
        const int t = idx >> 8, j = idx & 255;
        const float ps = shifted(P, t0 + t, 1024 + 1536 + j, W.mu[1536 + j]);
        const float val = j < 64 ? tanhf(ps) : (j < 128 ? ps : 1.0f / (1.0f + __expf(-ps)));
        Xl[t * 264 + j] = (bf16)f2bf(val);
    }
    __syncthreads();
    const int h = wave, r = lane & 15, q4 = lane >> 4;
    for (int tt = 0; tt < 4; ++tt) {
        f32x4 aW[4], aA[4], aG[4];
#pragma unroll
        for (int ct = 0; ct < 4; ++ct) { aW[ct] = (f32x4){0.f, 0.f, 0.f, 0.f}; aA[ct] = aW[ct]; aG[ct] = aW[ct]; }
#pragma unroll
        for (int ks = 0; ks < 2; ++ks) {
            const bf16x8 xw = *(const LAS bf16x8*)(Xl + (16 * tt + r) * 264 + ks * 32 + q4 * 8);
            const bf16x8 xa = *(const LAS bf16x8*)(Xl + (16 * tt + r) * 264 + 64 + ks * 32 + q4 * 8);
#pragma unroll
            for (int ct = 0; ct < 4; ++ct) {
                const bf16x8 yw = *(const bf16x8*)(W.w2t + (size_t)(h * 64 + 16 * ct + r) * 64 + ks * 32 + q4 * 8);
                const bf16x8 ya = *(const bf16x8*)(W.a2t + (size_t)(h * 64 + 16 * ct + r) * 64 + ks * 32 + q4 * 8);
                aW[ct] = MFMA16(xw, yw, aW[ct]); aA[ct] = MFMA16(xa, ya, aA[ct]);
            }
        }
#pragma unroll
        for (int ks = 0; ks < 4; ++ks) {
            const bf16x8 xg = *(const LAS bf16x8*)(Xl + (16 * tt + r) * 264 + 128 + ks * 32 + q4 * 8);
#pragma unroll
            for (int ct = 0; ct < 4; ++ct) {
                const bf16x8 yg = *(const bf16x8*)(W.g2t + (size_t)(h * 64 + 16 * ct + r) * 128 + ks * 32 + q4 * 8);
                aG[ct] = MFMA16(xg, yg, aG[ct]);
            }
        }
#pragma unroll
        for (int e = 0; e < 4; ++e) {
            const int t = t0 + 16 * tt + 4 * q4 + e;
            float kkr[4], av[4]; float ss = 0.f, bon = 0.f;
#pragma unroll
            for (int ct = 0; ct < 4; ++ct) {
                const int c = h * 64 + 16 * ct + r;
                const float r_ = shifted(P, t, 1024 + c, W.mu[c]);
                const float k_ = shifted(P, t, 1024 + 512 + c, W.mu[512 + c]);
                const float v_ = shifted(P, t, 1024 + 1024 + c, W.mu[1024 + c]);
                const float xw = -(W.w0[c] + aW[ct][e]);
                const float sp = xw > 20.f ? xw : log1pf(__expf(xw));
                const float wv = -sp - 0.5f;
                const float ld = -__expf(wv);
                const float a = 1.0f / (1.0f + __expf(-(W.a0[c] + aA[ct][e])));
                const float kr = k_ * W.k_k[c];
                const float kp = k_ * (1.0f + (a - 1.0f) * W.k_a[c]);
                kkr[ct] = kr; av[ct] = a; ss += kr * kr; bon += r_ * kp * W.r_k[c];
                const size_t o = (size_t)t * BW + c;
                LD[o] = ld; KP[o] = (bf16)f2bf(kp); RR[o] = (bf16)f2bf(r_); VV[o] = (bf16)f2bf(v_); GG[o] = (bf16)f2bf(aG[ct][e]);
            }
#pragma unroll
            for (int o = 1; o < 16; o <<= 1) { ss += __shfl_xor(ss, o); bon += __shfl_xor(bon, o); }
            const float inv = 1.0f / sqrtf(fmaxf(ss, 1e-24f));
#pragma unroll
            for (int ct = 0; ct < 4; ++ct) {
                const int c = h * 64 + 16 * ct + r; const size_t o = (size_t)t * BW + c;
                const float kk = kkr[ct] * inv;
                KK[o] = (bf16)f2bf(kk); BB[o] = (bf16)f2bf(kk * av[ct]);
            }
            if (r == 0) BS[(size_t)t * 8 + h] = bon;
        }
    }
    __syncthreads();
}

struct ScanRegs { unsigned short kk[8], bb[8], kp[8], rr[8], vv[8]; float ld[8]; };
__device__ __forceinline__ void scan_load(ScanRegs& R, int t0, int hc, int hv, const float* LD, const bf16* KK, const bf16* BB, const bf16* KP, const bf16* RR, const bf16* VV) {
#pragma unroll
    for (int i = 0; i < 8; ++i) { const size_t o = (size_t)(t0 + i) * BW;
        R.kk[i] = KK[o + hc]; R.bb[i] = BB[o + hc]; R.kp[i] = KP[o + hc]; R.rr[i] = RR[o + hc]; R.ld[i] = LD[o + hc]; R.vv[i] = VV[o + hv]; }
}
__device__ __forceinline__ void rwkv_scan_wave(int gwv, int lane, const float* LD, const bf16* KK, const bf16* BB, const bf16* KP, const bf16* RR, const bf16* VV, float* OSC) {
    const int h = gwv >> 6, v = gwv & 63, hc = h * 64 + lane, hv = h * 64 + v;
    float S = 0.f;
    ScanRegs cur, nxt;
    scan_load(cur, 0, hc, hv, LD, KK, BB, KP, RR, VV);
    for (int t0 = 0; t0 < M; t0 += 8) {
        const int tn = (t0 + 8 < M) ? t0 + 8 : t0;
        scan_load(nxt, tn, hc, hv, LD, KK, BB, KP, RR, VV);
#pragma unroll
        for (int i = 0; i < 8; ++i) {
            const float kk = bf2f(cur.kk[i]), bb = bf2f(cur.bb[i]), kp = bf2f(cur.kp[i]), rr = bf2f(cur.rr[i]), vv = bf2f(cur.vv[i]);
            const float dec = __expf(cur.ld[i]);
            const float sa = wave_sum_uniform(S * kk);
            S = S * dec - sa * bb + vv * kp;
            const float o = wave_sum_uniform(S * rr);
            if (lane == 0) OSC[(size_t)(t0 + i) * BW + hv] = o;
        }
        cur = nxt;
    }
}
__device__ __forceinline__ void rwkv_out_row(int t, int lane, const float* OSC, const float* BS, const bf16* VV, const bf16* GG, const float* gn_g, const float* gn_b, bf16* Y) {
    const int c0 = lane * 8;
    const f32x4 o0 = *(const f32x4*)(OSC + (size_t)t * BW + c0), o1 = *(const f32x4*)(OSC + (size_t)t * BW + c0 + 4);
    float v[8] = {o0.x, o0.y, o0.z, o0.w, o1.x, o1.y, o1.z, o1.w};
    float s = 0.f;
#pragma unroll
    for (int e = 0; e < 8; ++e) s += v[e];
    s += __shfl_xor(s, 1); s += __shfl_xor(s, 2); s += __shfl_xor(s, 4);
    const float mean = s * (1.f / 64.f);
    float q = 0.f;
#pragma unroll
    for (int e = 0; e < 8; ++e) { v[e] -= mean; q += v[e] * v[e]; }
    q += __shfl_xor(q, 1); q += __shfl_xor(q, 2); q += __shfl_xor(q, 4);
    const float rstd = 1.0f / sqrtf(q * (1.f / 64.f) + 64e-5f);
    const float bon = BS[(size_t)t * 8 + (lane >> 3)];
    const v4u vraw = *(const v4u*)(VV + (size_t)t * BW + c0), graw = *(const v4u*)(GG + (size_t)t * BW + c0);
    const unsigned vr[4] = {vraw.x, vraw.y, vraw.z, vraw.w}, gr[4] = {graw.x, graw.y, graw.z, graw.w};
    float outv[8];
#pragma unroll
    for (int e = 0; e < 8; ++e) {
        const float vv = (e & 1) ? __uint_as_float(vr[e >> 1] & 0xffff0000u) : __uint_as_float(vr[e >> 1] << 16);
        const float gg = (e & 1) ? __uint_as_float(gr[e >> 1] & 0xffff0000u) : __uint_as_float(gr[e >> 1] << 16);
        outv[e] = (v[e] * rstd * gn_g[c0 + e] + gn_b[c0 + e] + bon * vv) * gg;
    }
    v4u w; w.x = pk2(outv[0], outv[1]); w.y = pk2(outv[2], outv[3]); w.z = pk2(outv[4], outv[5]); w.w = pk2(outv[6], outv[7]);
    *(v4u*)(Y + (size_t)t * D + 512 + c0) = w;
}

__device__ __forceinline__ void vtrans_item(LAS unsigned char* lds, int item, int tid, const bf16* QKV, bf16* VT1, bf16* VT4, bf16* VT16) {
    const int h = item >> 6, blk = item & 63, t0 = blk * 256;
    LAS bf16* Vl = (LAS bf16*)lds;
#pragma unroll
    for (int i = 0; i < 4; ++i) { const int idx = tid + 512 * i, t = idx >> 3, ch = idx & 7;
        *(LAS v4u*)(Vl + t * 72 + ch * 8) = *(const v4u*)(QKV + (size_t)(t0 + t) * NQKV + 2048 + h * 64 + ch * 8); }
    __syncthreads();
#pragma unroll
    for (int i = 0; i < 4; ++i) {
        const int idx = tid + 512 * i, half = idx & 1, dd = (idx >> 1) & 63;
        { const int nbl = idx >> 7; unsigned short e[8];
#pragma unroll
          for (int k = 0; k < 8; ++k) e[k] = Vl[(16 * nbl + 8 * half + k) * 72 + dd];
          v4u o; o.x = e[0] | ((unsigned)e[1] << 16); o.y = e[2] | ((unsigned)e[3] << 16); o.z = e[4] | ((unsigned)e[5] << 16); o.w = e[6] | ((unsigned)e[7] << 16);
          *(v4u*)(VT1 + ((((size_t)h * 1024 + 16 * blk + nbl) * 64 + dd) * 16 + 8 * half)) = o; }
        { const int nbl = (idx >> 7) & 3, c4 = idx >> 9; unsigned short e[8];
#pragma unroll
          for (int k = 0; k < 8; ++k) e[k] = Vl[(4 * (16 * nbl + 8 * half + k) + c4) * 72 + dd];
          v4u o; o.x = e[0] | ((unsigned)e[1] << 16); o.y = e[2] | ((unsigned)e[3] << 16); o.z = e[4] | ((unsigned)e[5] << 16); o.w = e[6] | ((unsigned)e[7] << 16);
          *(v4u*)(VT4 + (((((size_t)h * 4 + c4) * 256 + 4 * blk + nbl) * 64 + dd) * 16 + 8 * half)) = o; }
        { const int c16 = idx >> 7; unsigned short e[8];
#pragma unroll
          for (int k = 0; k < 8; ++k) e[k] = Vl[(16 * (8 * half + k) + c16) * 72 + dd];
          v4u o; o.x = e[0] | ((unsigned)e[1] << 16); o.y = e[2] | ((unsigned)e[3] << 16); o.z = e[4] | ((unsigned)e[5] << 16); o.w = e[6] | ((unsigned)e[7] << 16);
          *(v4u*)(VT16 + (((((size_t)h * 16 + c16) * 64 + blk) * 64 + dd) * 16 + 8 * half)) = o; }
    }
    __syncthreads();
}

struct AttnFrags { bf16x8 ka0, ka1, kb0, kb1, vf[4]; };
template <int DIL>
__device__ __forceinline__ void attn_load(AttnFrags& f, const bf16* Kb, const bf16* VTc, int cp, int nb, int kA, int r, int q4) {
    constexpr int NB16 = M / DIL / 16;
    int posA = cp + DIL * (nb + kA), posB = posA + 4 * DIL;
    posA = posA < 0 ? 0 : (posA > M - 1 ? M - 1 : posA); posB = posB < 0 ? 0 : (posB > M - 1 ? M - 1 : posB);
    f.ka0 = *(const bf16x8*)(Kb + (size_t)posA * NQKV); f.ka1 = *(const bf16x8*)(Kb + (size_t)posA * NQKV + 32);
    f.kb0 = *(const bf16x8*)(Kb + (size_t)posB * NQKV); f.kb1 = *(const bf16x8*)(Kb + (size_t)posB * NQKV + 32);
    int bi = (nb >> 4) + (q4 >> 1); bi = bi < 0 ? 0 : (bi > NB16 - 1 ? NB16 - 1 : bi);
    const bf16* vp = VTc + ((size_t)bi * 64 + r) * 16 + 8 * (q4 & 1);
#pragma unroll
    for (int dt = 0; dt < 4; ++dt) f.vf[dt] = *(const bf16x8*)(vp + dt * 256);
}
__device__ __forceinline__ void attn_group(const AttnFrags& f, int nb, int nlo, int nhi, int q4, const bf16x8 (&qf)[2], f32x4 (&o)[4], float& lrun) {
    const float C = 0.125f * 1.4426950408889634f;
    f32x4 sA = (f32x4){0.f, 0.f, 0.f, 0.f}, sB = sA;
    sA = MFMA16(f.ka0, qf[0], sA); sA = MFMA16(f.ka1, qf[1], sA);
    sB = MFMA16(f.kb0, qf[0], sB); sB = MFMA16(f.kb1, qf[1], sB);
    float p[8]; float ps = 0.f;
    const int n0 = nb + 8 * q4;
#pragma unroll
    for (int e = 0; e < 8; ++e) {
        const int n = n0 + e;
        const float ex = __builtin_amdgcn_exp2f(fminf((e < 4 ? sA[e & 3] : sB[e & 3]) * C, 100.f));
        p[e] = (n >= nlo && n <= nhi) ? ex : 0.f; ps += p[e];
    }
    lrun += ps;
    v4u pw; pw.x = pk2(p[0], p[1]); pw.y = pk2(p[2], p[3]); pw.z = pk2(p[4], p[5]); pw.w = pk2(p[6], p[7]);
    const bf16x8 pf = __builtin_bit_cast(bf16x8, pw);
#pragma unroll
    for (int dt = 0; dt < 4; ++dt) o[dt] = MFMA16(f.vf[dt], pf, o[dt]);
}
template <int DIL, bool FIRST>
__device__ __forceinline__ void attn_tile(LAS float* OACC, LAS float* LACC, const bf16* QKV, const bf16* VT, int h, int blk, int cp, int nq0, int qloc0, int qstep, int lane) {
    constexpr int NB16 = M / DIL / 16;
    const int r = lane & 15, q4 = lane >> 4;
    const int qloc = qloc0 + qstep * r, pos = 256 * blk + qloc;
    bf16x8 qf[2];
    qf[0] = *(const bf16x8*)(QKV + (size_t)pos * NQKV + h * 64 + q4 * 8);
    qf[1] = *(const bf16x8*)(QKV + (size_t)pos * NQKV + h * 64 + 32 + q4 * 8);
    const int nq = nq0 + r, nlo = nq - 128 < 0 ? 0 : nq - 128, nhi = nq, ns = nq0 - 128;
    const int kA = 8 * (r >> 2) + (r & 3);
    const bf16* Kb = QKV + 1024 + h * 64 + q4 * 8;
    const bf16* VTc = VT + (size_t)(h * DIL + cp) * NB16 * 1024;
    f32x4 o[4];
#pragma unroll
    for (int dt = 0; dt < 4; ++dt) o[dt] = (f32x4){0.f, 0.f, 0.f, 0.f};
    float lrun = 0.f;
    AttnFrags fa, fb;
    attn_load<DIL>(fa, Kb, VTc, cp, ns, kA, r, q4);
    attn_load<DIL>(fb, Kb, VTc, cp, ns + 32, kA, r, q4);
    attn_group(fa, ns, nlo, nhi, q4, qf, o, lrun);
    attn_load<DIL>(fa, Kb, VTc, cp, ns + 64, kA, r, q4);
    attn_group(fb, ns + 32, nlo, nhi, q4, qf, o, lrun);
    attn_load<DIL>(fb, Kb, VTc, cp, ns + 96, kA, r, q4);
    attn_group(fa, ns + 64, nlo, nhi, q4, qf, o, lrun);
    attn_load<DIL>(fa, Kb, VTc, cp, ns + 128, kA, r, q4);
    attn_group(fb, ns + 96, nlo, nhi, q4, qf, o, lrun);
    attn_group(fa, ns + 128, nlo, nhi, q4, qf, o, lrun);
    lrun += __shfl_xor(lrun, 16); lrun += __shfl_xor(lrun, 32);
    LAS float* orow = OACC + qloc * 68 + 4 * q4;
#pragma unroll
    for (int dt = 0; dt < 4; ++dt) {
        if (FIRST) *(LAS f32x4*)(orow + 16 * dt) = o[dt];
        else { const f32x4 prev = *(const LAS f32x4*)(orow + 16 * dt); *(LAS f32x4*)(orow + 16 * dt) = prev + o[dt]; }
    }
    if (q4 == 0) { if (FIRST) LACC[qloc] = lrun; else LACC[qloc] += lrun; }
}
__device__ __forceinline__ void attn_item(LAS unsigned char* lds, int item, int tid, int wave, int lane, const bf16* QKV, const bf16* VT1, const bf16* VT4, const bf16* VT16, bf16* AO) {
    const int h = item >> 6, blk = item & 63;
    LAS float* OACC = (LAS float*)lds;
    LAS float* LACC = (LAS float*)(lds + 256 * 68 * 4);
#pragma unroll 1
    for (int a = 0; a < 2; ++a) { const int ti = 2 * wave + a; attn_tile<1, true>(OACC, LACC, QKV, VT1, h, blk, 0, 256 * blk + 16 * ti, 16 * ti, 1, lane); }
    __syncthreads();
#pragma unroll 1
    for (int a = 0; a < 2; ++a) { const int ti = 2 * wave + a, c4 = ti >> 2, jj = ti & 3; attn_tile<4, false>(OACC, LACC, QKV, VT4, h, blk, c4, 64 * blk + 16 * jj, c4 + 64 * jj, 4, lane); }
    __syncthreads();
#pragma unroll 1
    for (int a = 0; a < 2; ++a) { const int ti = 2 * wave + a; attn_tile<16, false>(OACC, LACC, QKV, VT16, h, blk, ti, 16 * blk, ti, 16, lane); }
    __syncthreads();
#pragma unroll
    for (int i = 0; i < 4; ++i) {
        const int idx = tid + 512 * i, q = idx >> 3, j = idx & 7;
        const float inv = 1.0f / LACC[q];
        const f32x4 a0 = *(const LAS f32x4*)(OACC + q * 68 + 8 * j), a1 = *(const LAS f32x4*)(OACC + q * 68 + 8 * j + 4);
        v4u w; w.x = pk2(a0[0] * inv, a0[1] * inv); w.y = pk2(a0[2] * inv, a0[3] * inv); w.z = pk2(a1[0] * inv, a1[1] * inv); w.w = pk2(a1[2] * inv, a1[3] * inv);
        *(v4u*)(AO + (size_t)(256 * blk + q) * D + h * 64 + 8 * j) = w;
    }
    __syncthreads();
}
constexpr int CH_CL = 0, CH_AT = 17408, CH_RT = CH_AT + 9216, CH_BT = CH_RT + 9216, CH_KT = CH_BT + 9216, CH_BHT = CH_KT + 9216, CH_KHT = CH_BHT + 9216, CH_VT = CH_KHT + 9216,
              CH_MABF = CH_VT + 9216, CH_MAK = CH_MABF + 17408, CH_MBR = CH_MAK + 9216, CH_MKR = CH_MBR + 9216, CH_GL = CH_MKR + 9216, CH_MABB = CH_GL + 256, CH_TJ = CH_MABB + 9216, CH_END = CH_TJ + 2048;
static_assert(CH_END <= 147456, "chunk LDS map");
__device__ __forceinline__ void unpack8(const v4u raw, float (&v)[8]) {
    v[0] = __uint_as_float(raw.x << 16); v[1] = __uint_as_float(raw.x & 0xffff0000u); v[2] = __uint_as_float(raw.y << 16); v[3] = __uint_as_float(raw.y & 0xffff0000u);
    v[4] = __uint_as_float(raw.z << 16); v[5] = __uint_as_float(raw.z & 0xffff0000u); v[6] = __uint_as_float(raw.w << 16); v[7] = __uint_as_float(raw.w & 0xffff0000u);
}
__device__ __forceinline__ v4u pack8(const float (&v)[8]) { v4u o; o.x = pk2(v[0], v[1]); o.y = pk2(v[2], v[3]); o.z = pk2(v[4], v[5]); o.w = pk2(v[6], v[7]); return o; }

__device__ __forceinline__ void rwkv_chunk_block(LAS unsigned char* lds, int c, int tid, int wave, int lane, const bf16* P, const RwkvW& W, bf16* VV, bf16* GG, float* BS,
                                                 bf16* PMT, float* SLOC, bf16* QT, float* OLT, bf16* XLG) {
    const int t0 = c * 64;
    bf16* Xg = XLG + (size_t)c * 64 * 256;
    LAS float* CL = (LAS float*)(lds + CH_CL); LAS float* Y5F = (LAS float*)(lds + CH_CL);
    LAS bf16* AT = (LAS bf16*)(lds + CH_AT); LAS bf16* RT = (LAS bf16*)(lds + CH_RT); LAS bf16* BT = (LAS bf16*)(lds + CH_BT); LAS bf16* KT = (LAS bf16*)(lds + CH_KT);
    LAS bf16* UB = BT; LAS bf16* WB = KT;
    LAS bf16* BHT = (LAS bf16*)(lds + CH_BHT); LAS bf16* KHT = (LAS bf16*)(lds + CH_KHT); LAS bf16* VT = (LAS bf16*)(lds + CH_VT);
    LAS float* MABF = (LAS float*)(lds + CH_MABF); LAS bf16* MAK = (LAS bf16*)(lds + CH_MAK); LAS bf16* MBR = (LAS bf16*)(lds + CH_MBR); LAS bf16* MKR = (LAS bf16*)(lds + CH_MKR);
    LAS float* GL = (LAS float*)(lds + CH_GL); LAS bf16* MABB = (LAS bf16*)(lds + CH_MABB); LAS bf16* TJB = (LAS bf16*)(lds + CH_TJ);
    LAS float* LDv = (LAS float*)(lds + CH_AT);
    LAS float* SSP = (LAS float*)(lds + CH_TJ);
    const int r = lane & 15, q4 = lane >> 4, par = wave & 1;
    {
        v4u cur[4], prv[4];
#pragma unroll
        for (int i = 0; i < 4; ++i) {
            const int idx = tid + 512 * i, t = idx >> 5, j8 = (idx & 31) * 8;
            const bf16* p = P + (size_t)(t0 + t) * EIN + 1024 + 1536 + j8;
            cur[i] = *(const v4u*)p;
            if (t0 + t > 0) prv[i] = *(const v4u*)(p - EIN); else { prv[i].x = 0u; prv[i].y = 0u; prv[i].z = 0u; prv[i].w = 0u; }
        }
#pragma unroll
        for (int i = 0; i < 4; ++i) {
            const int idx = tid + 512 * i, t = idx >> 5, j8 = (idx & 31) * 8;
            float cv[8], pv[8], ov[8];
            unpack8(cur[i], cv); unpack8(prv[i], pv);
            const f32x4 m0 = *(const f32x4*)(W.mu + 1536 + j8), m1 = *(const f32x4*)(W.mu + 1536 + j8 + 4);
            const float mu8[8] = {m0.x, m0.y, m0.z, m0.w, m1.x, m1.y, m1.z, m1.w};
#pragma unroll
            for (int e = 0; e < 8; ++e) {
                const float ps = cv[e] + (pv[e] - cv[e]) * mu8[e];
                ov[e] = j8 < 64 ? (1.0f - 2.0f / (1.0f + __expf(2.0f * ps))) : (j8 < 128 ? ps : 1.0f / (1.0f + __expf(-ps)));
            }
            *(v4u*)(Xg + t * 256 + j8) = pack8(ov);
        }
    }
    __threadfence();
    __syncthreads();
    const int tt = wave >> 1;
#pragma unroll 1
    for (int h = 0; h < 8; ++h) {
    const int item = c * 8 + h;
    int tid_o = tid; asm volatile("" : "+v"(tid_o));
    const int tid = tid_o, lane = tid & 63, wave = __builtin_amdgcn_readfirstlane(tid >> 6), r = lane & 15, q4 = lane >> 4, par = wave & 1, tt = wave >> 1;
    (void)lane;
    float kr_[2][4]; unsigned apk[2][2], kpk[2][2], rpk[2][2], vpk[2][2];
    {
        f32x4 aW[2], aA[2], aG[2];
#pragma unroll
        for (int ci = 0; ci < 2; ++ci) { aW[ci] = (f32x4){0.f, 0.f, 0.f, 0.f}; aA[ci] = aW[ci]; aG[ci] = aW[ci]; }
#pragma unroll
        for (int ks = 0; ks < 2; ++ks) {
            const bf16x8 xw = *(const bf16x8*)(Xg + (16 * tt + r) * 256 + ks * 32 + q4 * 8), xa = *(const bf16x8*)(Xg + (16 * tt + r) * 256 + 64 + ks * 32 + q4 * 8);
#pragma unroll
            for (int ci = 0; ci < 2; ++ci) {
                const int crow = h * 64 + 16 * (2 * par + ci) + r;
                const bf16x8 yw = *(const bf16x8*)(W.w2t + (size_t)crow * 64 + ks * 32 + q4 * 8);
                const bf16x8 ya = *(const bf16x8*)(W.a2t + (size_t)crow * 64 + ks * 32 + q4 * 8);
                aW[ci] = MFMA16(xw, yw, aW[ci]); aA[ci] = MFMA16(xa, ya, aA[ci]);
            }
        }
#pragma unroll
        for (int ks = 0; ks < 4; ++ks) {
            const bf16x8 xg = *(const bf16x8*)(Xg + (16 * tt + r) * 256 + 128 + ks * 32 + q4 * 8);
#pragma unroll
            for (int ci = 0; ci < 2; ++ci) {
                const bf16x8 yg = *(const bf16x8*)(W.g2t + (size_t)(h * 64 + 16 * (2 * par + ci) + r) * 128 + ks * 32 + q4 * 8);
                aG[ci] = MFMA16(xg, yg, aG[ci]);
            }
        }
        float ssv[4] = {0.f, 0.f, 0.f, 0.f}, bonv[4] = {0.f, 0.f, 0.f, 0.f};
#pragma unroll
        for (int ci = 0; ci < 2; ++ci) {
            const int cl_ = 16 * (2 * par + ci) + r, cc = h * 64 + cl_;
            unsigned short rc[4], rp[4], kc[4], kpv[4], vc[4], vp[4];
            float av4[4], kp4[4], rv4[4], vv4[4];
            const float w0v = W.w0[cc], a0v = W.a0[cc], kkv = W.k_k[cc], kav = W.k_a[cc], rkv = W.r_k[cc], mur = W.mu[cc], muk = W.mu[512 + cc], muv = W.mu[1024 + cc];
#pragma unroll
            for (int e = 0; e < 4; ++e) {
                const int t = t0 + 16 * tt + 4 * q4 + e;
                const bf16* p = P + (size_t)t * EIN + 1024 + cc;
                const bf16* pp = t > 0 ? p - EIN : p;
                rc[e] = p[0]; kc[e] = p[512]; vc[e] = p[1024];
                rp[e] = pp[0]; kpv[e] = pp[512]; vp[e] = pp[1024];
            }
#pragma unroll
            for (int e = 0; e < 4; ++e) {
                const int tl = 16 * tt + 4 * q4 + e, t = t0 + tl;
                const float rcur = bf2f(rc[e]), kcur = bf2f(kc[e]), vcur = bf2f(vc[e]);
                const float rprev = t > 0 ? bf2f(rp[e]) : 0.f, kprev = t > 0 ? bf2f(kpv[e]) : 0.f, vprev = t > 0 ? bf2f(vp[e]) : 0.f;
                const float rv = rcur + (rprev - rcur) * mur;
                const float kv = kcur + (kprev - kcur) * muk;
                const float vv = vcur + (vprev - vcur) * muv;
                const float xw = -(w0v + aW[ci][e]);
                const float sp = xw > 20.f ? xw : (xw < -10.f ? __expf(xw) : __logf(1.0f + __expf(xw)));
                const float ld = -__expf(-sp - 0.5f);
                const float a = 1.0f / (1.0f + __expf(-(a0v + aA[ci][e])));
                const float kr = kv * kkv;
                const float kp = kv * (1.0f + (a - 1.0f) * kav);
                kr_[ci][e] = kr; av4[e] = a; kp4[e] = kp; rv4[e] = rv; vv4[e] = vv;
                ssv[e] += kr * kr; bonv[e] += rv * kp * rkv;
                LDv[tl * 64 + cl_] = ld;
                const size_t o = (size_t)t * BW + cc;
                VV[o] = (bf16)f2bf(vv); GG[o] = (bf16)f2bf(aG[ci][e]);
            }
            apk[ci][0] = pk2(av4[0], av4[1]); apk[ci][1] = pk2(av4[2], av4[3]); kpk[ci][0] = pk2(kp4[0], kp4[1]); kpk[ci][1] = pk2(kp4[2], kp4[3]);
            rpk[ci][0] = pk2(rv4[0], rv4[1]); rpk[ci][1] = pk2(rv4[2], rv4[3]); vpk[ci][0] = pk2(vv4[0], vv4[1]); vpk[ci][1] = pk2(vv4[2], vv4[3]);
        }
#pragma unroll
        for (int e = 0; e < 4; ++e) {
            const int tl = 16 * tt + 4 * q4 + e;
            float ss = ssv[e], bon = bonv[e];
#pragma unroll
            for (int o = 1; o < 16; o <<= 1) { ss += __shfl_xor(ss, o); bon += __shfl_xor(bon, o); }
            if (r == 0) { SSP[tl * 2 + par] = ss; SSP[128 + tl * 2 + par] = bon; }
        }
    }
    __syncthreads();
    if (tid < 64) {
        float run = 0.f;
#pragma unroll 16
        for (int t = 0; t < 64; ++t) { run += LDv[t * 64 + tid]; CL[t * 64 + tid] = run; }
        GL[tid] = __expf(run);
    } else if (tid < 128) {
        const int tl = tid - 64;
        BS[(size_t)(t0 + tl) * 8 + h] = SSP[128 + tl * 2] + SSP[128 + tl * 2 + 1];
    }
    __syncthreads();
    {
#pragma unroll
        for (int ci = 0; ci < 2; ++ci) {
            const int k = 16 * (2 * par + ci) + r;
            const float clL = CL[63 * 64 + k];
            float bh[4], kh[4];
#pragma unroll
            for (int e = 0; e < 4; ++e) {
                const int tl = 16 * tt + 4 * q4 + e;
                const float inv = 1.0f / sqrtf(fmaxf(SSP[tl * 2] + SSP[tl * 2 + 1], 1e-24f));
                const float kk = bf2f((bf16)f2bf(kr_[ci][e] * inv));
                const float a_e = (e & 1) ? __uint_as_float(apk[ci][e >> 1] & 0xffff0000u) : __uint_as_float(apk[ci][e >> 1] << 16);
                const float kp_e = (e & 1) ? __uint_as_float(kpk[ci][e >> 1] & 0xffff0000u) : __uint_as_float(kpk[ci][e >> 1] << 16);
                const float r_e = (e & 1) ? __uint_as_float(rpk[ci][e >> 1] & 0xffff0000u) : __uint_as_float(rpk[ci][e >> 1] << 16);
                const float bb = bf2f((bf16)f2bf(kk * a_e));
                const float cl = CL[tl * 64 + k], clp = tl > 0 ? CL[(tl - 1) * 64 + k] : 0.f;
                const float en = __expf(-cl), eh = __expf(clL - cl);
                AT[tl * 72 + k] = (bf16)f2bf(-kk * __expf(clp)); RT[tl * 72 + k] = (bf16)f2bf(r_e * __expf(cl));
                BT[tl * 72 + k] = (bf16)f2bf(bb * en); KT[tl * 72 + k] = (bf16)f2bf(kp_e * en);
                bh[e] = bb * eh; kh[e] = kp_e * eh;
            }
            const int tb = 16 * tt + 4 * q4;
            v2u w; w.x = pk2(bh[0], bh[1]); w.y = pk2(bh[2], bh[3]); *(LAS v2u*)(BHT + k * 72 + tb) = w;
            w.x = pk2(kh[0], kh[1]); w.y = pk2(kh[2], kh[3]); *(LAS v2u*)(KHT + k * 72 + tb) = w;
            w.x = vpk[ci][0]; w.y = vpk[ci][1]; *(LAS v2u*)(VT + k * 72 + tb) = w;
        }
    }
    __syncthreads();
    {
        const int mi = wave >> 1;
        const LAS bf16* X = (mi == 0 || mi == 2) ? BT : KT; const LAS bf16* Y = (mi < 2) ? AT : RT;
        f32x4 acc[2][4];
#pragma unroll
        for (int a = 0; a < 2; ++a)
#pragma unroll
            for (int b = 0; b < 4; ++b) acc[a][b] = (f32x4){0.f, 0.f, 0.f, 0.f};
#pragma unroll
        for (int ks = 0; ks < 2; ++ks) {
            bf16x8 xf[2], yf[4];
#pragma unroll
            for (int a = 0; a < 2; ++a) xf[a] = *(const LAS bf16x8*)(X + (16 * (2 * par + a) + r) * 72 + ks * 32 + q4 * 8);
#pragma unroll
            for (int b = 0; b < 4; ++b) yf[b] = *(const LAS bf16x8*)(Y + (16 * b + r) * 72 + ks * 32 + q4 * 8);
#pragma unroll
            for (int a = 0; a < 2; ++a)
#pragma unroll
                for (int b = 0; b < 4; ++b) acc[a][b] = MFMA16(xf[a], yf[b], acc[a][b]);
        }
#pragma unroll
        for (int a = 0; a < 2; ++a)
#pragma unroll
            for (int b = 0; b < 4; ++b) {
                const int s0 = 16 * (2 * par + a) + 4 * q4, t = 16 * b + r;
                f32x4 m;
#pragma unroll
                for (int e = 0; e < 4; ++e) m[e] = ((mi < 2) ? (s0 + e < t) : (s0 + e <= t)) ? acc[a][b][e] : 0.f;
                if (mi == 0) { *(LAS f32x4*)(MABF + t * 68 + s0) = m; v2u w; w.x = pk2(m[0], m[1]); w.y = pk2(m[2], m[3]); *(LAS v2u*)(MABB + t * 72 + s0) = w; }
                else { LAS bf16* Mo = (mi == 1) ? MAK : (mi == 2 ? MBR : MKR); v2u w; w.x = pk2(m[0], m[1]); w.y = pk2(m[2], m[3]); *(LAS v2u*)(Mo + t * 72 + s0) = w; }
            }
    }
    __syncthreads();
    {
        const int vt = wave >> 1;
        f32x4 acc[2];
        acc[0] = (f32x4){0.f, 0.f, 0.f, 0.f}; acc[1] = acc[0];
#pragma unroll
        for (int ks = 0; ks < 2; ++ks) {
            const bf16x8 xf = *(const LAS bf16x8*)(VT + (16 * vt + r) * 72 + ks * 32 + q4 * 8);
#pragma unroll
            for (int b = 0; b < 2; ++b) { const bf16x8 yf = *(const LAS bf16x8*)(MAK + (16 * (2 * par + b) + r) * 72 + ks * 32 + q4 * 8); acc[b] = MFMA16(xf, yf, acc[b]); }
        }
#pragma unroll
        for (int b = 0; b < 2; ++b)
#pragma unroll
            for (int e = 0; e < 4; ++e) Y5F[(16 * vt + 4 * q4 + e) * 68 + 16 * (2 * par + b) + r] = acc[b][e];
    }
    __syncthreads();
    if (wave == 0) {
        const int J = lane >> 4, i = lane & 15;
        float tr[16];
#pragma unroll
        for (int t = 0; t < 16; ++t) {
            float acc = (t == i) ? 1.f : 0.f;
#pragma unroll
            for (int s2 = 0; s2 < t; ++s2) acc += tr[s2] * MABF[(16 * J + t) * 68 + 16 * J + s2];
            tr[t] = acc;
        }
#pragma unroll
        for (int t = 0; t < 16; ++t) TJB[(16 * J + t) * 16 + i] = (bf16)f2bf(tr[t]);
    }
    __syncthreads();
    {
        unsigned xb[4][2];
#pragma unroll
        for (int J = 0; J < 4; ++J) {
            f32x4 z;
            if (wave < 4) z = *(const LAS f32x4*)(Y5F + (16 * wave + r) * 68 + 16 * J + 4 * q4);
            else {
#pragma unroll
                for (int e = 0; e < 4; ++e) z[e] = bf2f(AT[(16 * J + 4 * q4 + e) * 72 + 16 * (wave - 4) + r]);
            }
#pragma unroll
            for (int I = 0; I < J; I += 2) {
                const bool two = (I + 1 < J);
                const v2u m0 = *(const LAS v2u*)(MABB + (16 * J + r) * 72 + 16 * I + 4 * q4);
                v2u m1; m1.x = 0u; m1.y = 0u;
                if (two) m1 = *(const LAS v2u*)(MABB + (16 * J + r) * 72 + 16 * (I + 1) + 4 * q4);
                v4u fa; fa.x = m0.x; fa.y = m0.y; fa.z = m1.x; fa.w = m1.y;
                v4u fb; fb.x = xb[I][0]; fb.y = xb[I][1]; fb.z = two ? xb[I + 1 < 4 ? I + 1 : 3][0] : 0u; fb.w = two ? xb[I + 1 < 4 ? I + 1 : 3][1] : 0u;
                z = MFMA16(__builtin_bit_cast(bf16x8, fa), __builtin_bit_cast(bf16x8, fb), z);
            }
            const unsigned zh0 = pk2(z[0], z[1]), zh1 = pk2(z[2], z[3]);
            const unsigned zl0 = pk2(z[0] - __uint_as_float(zh0 << 16), z[1] - __uint_as_float(zh0 & 0xffff0000u)), zl1 = pk2(z[2] - __uint_as_float(zh1 << 16), z[3] - __uint_as_float(zh1 & 0xffff0000u));
            const v2u tw = *(const LAS v2u*)(TJB + (16 * J + r) * 16 + 4 * q4);
            v4u ft; ft.x = tw.x; ft.y = tw.y; ft.z = 0u; ft.w = 0u;
            v4u fh; fh.x = zh0; fh.y = zh1; fh.z = 0u; fh.w = 0u;
            v4u fl; fl.x = zl0; fl.y = zl1; fl.z = 0u; fl.w = 0u;
            f32x4 x = (f32x4){0.f, 0.f, 0.f, 0.f};
            x = MFMA16(__builtin_bit_cast(bf16x8, ft), __builtin_bit_cast(bf16x8, fh), x);
            x = MFMA16(__builtin_bit_cast(bf16x8, ft), __builtin_bit_cast(bf16x8, fl), x);
            xb[J][0] = pk2(x[0], x[1]); xb[J][1] = pk2(x[2], x[3]);
            LAS bf16* Xo = (wave < 4) ? (UB + (16 * wave + r) * 72) : (WB + (16 * (wave - 4) + r) * 72);
            v2u w; w.x = xb[J][0]; w.y = xb[J][1];
            *(LAS v2u*)(Xo + 16 * J + 4 * q4) = w;
        }
    }
    __syncthreads();
    {
        const int kind = wave >> 1;
        const LAS bf16* X1; const LAS bf16* Y1; const LAS bf16* X2 = nullptr; const LAS bf16* Y2 = nullptr;
        if (kind == 0) { X1 = UB; Y1 = MBR; X2 = VT; Y2 = MKR; }
        else if (kind == 1) { X1 = BHT; Y1 = UB; X2 = KHT; Y2 = VT; }
        else if (kind == 2) { X1 = WB; Y1 = MBR; }
        else { X1 = WB; Y1 = BHT; }
        f32x4 acc[2][4];
#pragma unroll
        for (int a = 0; a < 2; ++a)
#pragma unroll
            for (int b = 0; b < 4; ++b) acc[a][b] = (f32x4){0.f, 0.f, 0.f, 0.f};
#pragma unroll
        for (int ks = 0; ks < 2; ++ks) {
            bf16x8 xf[2], yf[4];
#pragma unroll
            for (int a = 0; a < 2; ++a) xf[a] = *(const LAS bf16x8*)(X1 + (16 * (2 * par + a) + r) * 72 + ks * 32 + q4 * 8);
#pragma unroll
            for (int b = 0; b < 4; ++b) yf[b] = *(const LAS bf16x8*)(Y1 + (16 * b + r) * 72 + ks * 32 + q4 * 8);
#pragma unroll
            for (int a = 0; a < 2; ++a)
#pragma unroll
                for (int b = 0; b < 4; ++b) acc[a][b] = MFMA16(xf[a], yf[b], acc[a][b]);
        }
        if (kind < 2) {
#pragma unroll
            for (int ks = 0; ks < 2; ++ks) {
                bf16x8 xf[2], yf[4];
#pragma unroll
                for (int a = 0; a < 2; ++a) xf[a] = *(const LAS bf16x8*)(X2 + (16 * (2 * par + a) + r) * 72 + ks * 32 + q4 * 8);
#pragma unroll
                for (int b = 0; b < 4; ++b) yf[b] = *(const LAS bf16x8*)(Y2 + (16 * b + r) * 72 + ks * 32 + q4 * 8);
#pragma unroll
                for (int a = 0; a < 2; ++a)
#pragma unroll
                    for (int b = 0; b < 4; ++b) acc[a][b] = MFMA16(xf[a], yf[b], acc[a][b]);
            }
        }
#pragma unroll
        for (int a = 0; a < 2; ++a)
#pragma unroll
            for (int b = 0; b < 4; ++b) {
                const int i0 = 16 * (2 * par + a) + 4 * q4, j = 16 * b + r;
                if (kind == 0) *(f32x4*)(OLT + ((size_t)item * 64 + j) * 64 + i0) = acc[a][b];
                else if (kind == 1) *(f32x4*)(SLOC + ((size_t)item * 64 + j) * 64 + i0) = acc[a][b];
                else if (kind == 2) {
                    const v2u rw = *(const LAS v2u*)(RT + j * 72 + i0);
                    v2u w; w.x = pk2(acc[a][b][0] + __uint_as_float(rw.x << 16), acc[a][b][1] + __uint_as_float(rw.x & 0xffff0000u));
                    w.y = pk2(acc[a][b][2] + __uint_as_float(rw.y << 16), acc[a][b][3] + __uint_as_float(rw.y & 0xffff0000u));
                    *(v2u*)(QT + ((size_t)item * 64 + j) * 64 + i0) = w;
                } else {
                    f32x4 m = acc[a][b];
#pragma unroll
                    for (int e = 0; e < 4; ++e) if (i0 + e == j) m[e] += GL[j];
                    v2u w; w.x = pk2(m[0], m[1]); w.y = pk2(m[2], m[3]);
                    *(v2u*)(PMT + ((size_t)item * 64 + j) * 64 + i0) = w;
                }
            }
    }
    __syncthreads();
    }
}

struct ScanOps { bf16x8 pf[4][2]; f32x4 sl[4]; };
__device__ __forceinline__ void scan_ops_load(ScanOps& o, int it, int v, int r, int q4, const bf16* PMT, const float* SLOC) {
#pragma unroll
    for (int kt = 0; kt < 4; ++kt) {
        o.sl[kt] = *(const f32x4*)(SLOC + ((size_t)it * 64 + v) * 64 + 16 * kt + 4 * q4);
#pragma unroll
        for (int ks = 0; ks < 2; ++ks) {
            const bf16* p = PMT + ((size_t)it * 64 + 16 * kt + r) * 64 + 32 * ks + 4 * q4;
            const v2u lo = *(const v2u*)p, hi = *(const v2u*)(p + 16);
            v4u w; w.x = lo.x; w.y = lo.y; w.z = hi.x; w.w = hi.y;
            o.pf[kt][ks] = __builtin_bit_cast(bf16x8, w);
        }
    }
}
constexpr int SCAN_NS = 8, SCAN_SLOT = 12288, SCAN_FLAGS = SCAN_NS * SCAN_SLOT;
__device__ __forceinline__ void scan_slot_write(const ScanOps& o, LAS unsigned char* slot, int lane) {
    LAS v4u* p = (LAS v4u*)slot;
#pragma unroll
    for (int kt = 0; kt < 4; ++kt) {
        p[(2 * kt) * 64 + lane] = __builtin_bit_cast(v4u, o.pf[kt][0]); p[(2 * kt + 1) * 64 + lane] = __builtin_bit_cast(v4u, o.pf[kt][1]);
        p[(8 + kt) * 64 + lane] = __builtin_bit_cast(v4u, o.sl[kt]);
    }
}
__device__ __forceinline__ void rwkv_state_scan_wg(LAS unsigned char* lds, int hv, int tid, int wave, int lane, const bf16* PMT, const float* SLOC, bf16* SC) {
    const int h = hv >> 2, vt = hv & 3, r = lane & 15, q4 = lane >> 4, v = 16 * vt + r;
    constexpr int NC = M / 64;
    volatile LAS int* ready = (volatile LAS int*)(lds + SCAN_FLAGS);
    volatile LAS int* consumed = (volatile LAS int*)(lds + SCAN_FLAGS + 64);
    if (tid < 32) ((LAS int*)(lds + SCAN_FLAGS))[tid] = 0;
    __syncthreads();
    if (wave == 0) {
        unsigned hw[4][2], lw[4][2];
#pragma unroll
        for (int kt = 0; kt < 4; ++kt) { hw[kt][0] = 0u; hw[kt][1] = 0u; lw[kt][0] = 0u; lw[kt][1] = 0u; }
        for (int c = 0; c < NC; ++c) {
            const int sl = c & (SCAN_NS - 1);
            while (ready[sl] != c + 1) { }
            asm volatile("" ::: "memory");
            const LAS v4u* p = (const LAS v4u*)(lds + sl * SCAN_SLOT);
            v4u pf[4][2], s4[4];
#pragma unroll
            for (int kt = 0; kt < 4; ++kt) { pf[kt][0] = p[(2 * kt) * 64 + lane]; pf[kt][1] = p[(2 * kt + 1) * 64 + lane]; s4[kt] = p[(8 + kt) * 64 + lane]; }
            asm volatile("s_waitcnt lgkmcnt(0)" ::: "memory");
            if (lane == 0) *consumed = c + 1;
            { bf16* sc = SC + ((size_t)(c * 8 + h) * 64 + v) * 64 + 4 * q4;
#pragma unroll
              for (int kt = 0; kt < 4; ++kt) { v2u w; w.x = hw[kt][0]; w.y = hw[kt][1]; *(v2u*)(sc + 16 * kt) = w; } }
            v4u a0, a1, b0, b1;
            a0.x = hw[0][0]; a0.y = hw[0][1]; a0.z = hw[1][0]; a0.w = hw[1][1]; a1.x = hw[2][0]; a1.y = hw[2][1]; a1.z = hw[3][0]; a1.w = hw[3][1];
            b0.x = lw[0][0]; b0.y = lw[0][1]; b0.z = lw[1][0]; b0.w = lw[1][1]; b1.x = lw[2][0]; b1.y = lw[2][1]; b1.z = lw[3][0]; b1.w = lw[3][1];
            const bf16x8 sh0 = __builtin_bit_cast(bf16x8, a0), sh1 = __builtin_bit_cast(bf16x8, a1), sl0 = __builtin_bit_cast(bf16x8, b0), sl1 = __builtin_bit_cast(bf16x8, b1);
#pragma unroll
            for (int kt = 0; kt < 4; ++kt) {
                f32x4 n = __builtin_bit_cast(f32x4, s4[kt]);
                const bf16x8 p0 = __builtin_bit_cast(bf16x8, pf[kt][0]), p1 = __builtin_bit_cast(bf16x8, pf[kt][1]);
                n = MFMA16(p0, sh0, n); n = MFMA16(p1, sh1, n); n = MFMA16(p0, sl0, n); n = MFMA16(p1, sl1, n);
                hw[kt][0] = pk2(n[0], n[1]); hw[kt][1] = pk2(n[2], n[3]);
                lw[kt][0] = pk2(n[0] - __uint_as_float(hw[kt][0] << 16), n[1] - __uint_as_float(hw[kt][0] & 0xffff0000u));
                lw[kt][1] = pk2(n[2] - __uint_as_float(hw[kt][1] << 16), n[3] - __uint_as_float(hw[kt][1] & 0xffff0000u));
            }
        }
    } else {
        const int j = wave - 1;
        ScanOps A, B;
        if (j < NC) scan_ops_load(A, j * 8 + h, v, r, q4, PMT, SLOC);
        if (j + 7 < NC) scan_ops_load(B, (j + 7) * 8 + h, v, r, q4, PMT, SLOC);
        for (int c = j; c < NC; c += 14) {
            while (*consumed < c - (SCAN_NS - 1)) { }
            asm volatile("" ::: "memory");
            scan_slot_write(A, lds + (c & (SCAN_NS - 1)) * SCAN_SLOT, lane);
            asm volatile("s_waitcnt lgkmcnt(0)" ::: "memory");
            if (lane == 0) ready[c & (SCAN_NS - 1)] = c + 1;
            if (c + 14 < NC) scan_ops_load(A, (c + 14) * 8 + h, v, r, q4, PMT, SLOC);
            const int c2 = c + 7;
            if (c2 < NC) {
                while (*consumed < c2 - (SCAN_NS - 1)) { }
                asm volatile("" ::: "memory");
                scan_slot_write(B, lds + (c2 & (SCAN_NS - 1)) * SCAN_SLOT, lane);
                asm volatile("s_waitcnt lgkmcnt(0)" ::: "memory");
                if (lane == 0) ready[c2 & (SCAN_NS - 1)] = c2 + 1;
                if (c2 + 14 < NC) scan_ops_load(B, (c2 + 14) * 8 + h, v, r, q4, PMT, SLOC);
            }
        }
    }
    __syncthreads();
}
__device__ __forceinline__ void rwkv_chunk_out(int item, int lane, const bf16* SC, const bf16* QT, const float* OLT, const float* BS, const bf16* VV, const bf16* GG,
                                               const float* gn_g, const float* gn_b, bf16* Y) {
    const int c = item >> 3, h = item & 7, r = lane & 15, q4 = lane >> 4;
    bf16x8 sf[4][2];
#pragma unroll
    for (int vt = 0; vt < 4; ++vt)
#pragma unroll
        for (int ks = 0; ks < 2; ++ks) sf[vt][ks] = *(const bf16x8*)(SC + ((size_t)item * 64 + 16 * vt + r) * 64 + 32 * ks + 8 * q4);
    f32x4 gg4[4], gb4[4];
#pragma unroll
    for (int vt = 0; vt < 4; ++vt) { gg4[vt] = *(const f32x4*)(gn_g + h * 64 + 16 * vt + 4 * q4); gb4[vt] = *(const f32x4*)(gn_b + h * 64 + 16 * vt + 4 * q4); }
    for (int tt = 0; tt < 4; ++tt) {
        const int tl = 16 * tt + r, t = c * 64 + tl;
        bf16x8 qf[2];
#pragma unroll
        for (int ks = 0; ks < 2; ++ks) qf[ks] = *(const bf16x8*)(QT + ((size_t)item * 64 + tl) * 64 + 32 * ks + 8 * q4);
        f32x4 o[4]; float s = 0.f;
#pragma unroll
        for (int vt = 0; vt < 4; ++vt) {
            o[vt] = *(const f32x4*)(OLT + ((size_t)item * 64 + tl) * 64 + 16 * vt + 4 * q4);
            o[vt] = MFMA16(sf[vt][0], qf[0], o[vt]); o[vt] = MFMA16(sf[vt][1], qf[1], o[vt]);
            s += (o[vt][0] + o[vt][1]) + (o[vt][2] + o[vt][3]);
        }
        s += __shfl_xor(s, 16); s += __shfl_xor(s, 32);
        const float mean = s * (1.f / 64.f);
        float qv = 0.f;
#pragma unroll
        for (int vt = 0; vt < 4; ++vt) { o[vt] = o[vt] - mean; qv += (o[vt][0] * o[vt][0] + o[vt][1] * o[vt][1]) + (o[vt][2] * o[vt][2] + o[vt][3] * o[vt][3]); }
        qv += __shfl_xor(qv, 16); qv += __shfl_xor(qv, 32);
        const float rstd = 1.0f / sqrtf(qv * (1.f / 64.f) + 64e-5f);
        const float bon = BS[(size_t)t * 8 + h];
#pragma unroll
        for (int vt = 0; vt < 4; ++vt) {
            const size_t oo = (size_t)t * BW + h * 64 + 16 * vt + 4 * q4;
            const v2u vr = *(const v2u*)(VV + oo), gr = *(const v2u*)(GG + oo);
            const float v0 = __uint_as_float(vr.x << 16), v1 = __uint_as_float(vr.x & 0xffff0000u), v2 = __uint_as_float(vr.y << 16), v3 = __uint_as_float(vr.y & 0xffff0000u);
            const float g0 = __uint_as_float(gr.x << 16), g1 = __uint_as_float(gr.x & 0xffff0000u), g2 = __uint_as_float(gr.y << 16), g3 = __uint_as_float(gr.y & 0xffff0000u);
            const f32x4 y = o[vt] * rstd * gg4[vt] + gb4[vt];
            v2u w; w.x = pk2((y[0] + bon * v0) * g0, (y[1] + bon * v1) * g1); w.y = pk2((y[2] + bon * v2) * g2, (y[3] + bon * v3) * g3);
            *(v2u*)(Y + (size_t)t * D + 512 + h * 64 + 16 * vt + 4 * q4) = w;
        }
    }
}
#define XB_TMO      128
#define XB_XCNT(j)  (256  + 64 * (j))
#define XB_XSUB(j)  (1280 + 64 * (j))
#define XB_XGEN(j)  (2304 + 64 * (j))
#define XB_TOP      3328
#define XB_TOPGEN   3392
#define XCD_BAR_WORDS 3456
#define XB_SPIN_CAP (1u << 18)

__device__ __forceinline__ unsigned xb_ld(unsigned* p)              { return __hip_atomic_load(p, __ATOMIC_RELAXED, __HIP_MEMORY_SCOPE_AGENT); }
__device__ __forceinline__ unsigned xb_add(unsigned* p, unsigned v) { return __hip_atomic_fetch_add(p, v, __ATOMIC_RELAXED, __HIP_MEMORY_SCOPE_AGENT); }
__device__ __forceinline__ unsigned xb_xcc_id() { return (unsigned)__builtin_amdgcn_s_getreg((3 << 11) | 20) & 0xFu; }
#define XB_SPIN(cond, bar) do { unsigned _sp = 0; while (cond) { __builtin_amdgcn_s_sleep(1); \
    if ((++_sp & 255u) == 0u) { if (xb_ld(&(bar)[XB_TMO])) break; if (_sp > XB_SPIN_CAP) { atomicAdd(&(bar)[XB_TMO], 1u); break; } } } } while (0)

struct XcdBarrier {
    unsigned* bar; unsigned x;
    volatile LAS unsigned* st;
};

__device__ __forceinline__ XcdBarrier xcd_barrier_post(unsigned* bar, volatile LAS unsigned* st) {
    XcdBarrier b; b.bar = bar; b.x = xb_xcc_id(); b.st = st;
    if (threadIdx.x == 0) (void)xb_add(&bar[XB_XCNT(b.x)], 1u);
    return b;
}
__device__ __forceinline__ void xcd_barrier_complete(unsigned* bar, unsigned x, unsigned& nloc, unsigned& nx) {
    const unsigned G = gridDim.x * gridDim.y * gridDim.z;
    unsigned sum, cnt, mine, sp = 0u;
    for (;;) {
        sum = 0u; cnt = 0u; mine = 0u;
#pragma unroll
        for (unsigned j = 0; j < 16; ++j) { const unsigned c = xb_ld(&bar[XB_XCNT(j)]); sum += c; cnt += (c > 0u) ? 1u : 0u; mine = (j == x) ? c : mine; }
        if (sum == G) break;
        __builtin_amdgcn_s_sleep(1);
        if ((++sp & 255u) == 0u) { if (xb_ld(&bar[XB_TMO])) break; if (sp > XB_SPIN_CAP) { atomicAdd(&bar[XB_TMO], 1u); break; } }
    }
    nloc = mine > 0u ? mine : 1u; nx = cnt > 0u ? cnt : 1u;
}

__device__ __forceinline__ void xcd_barrier(const XcdBarrier& b) {
    asm volatile("s_waitcnt vmcnt(0)" ::: "memory");
    __syncthreads();
    if (threadIdx.x == 0) {
        unsigned* bar = b.bar;
        __builtin_amdgcn_s_waitcnt(0);
        unsigned nloc = b.st[0], nx = b.st[1];
        if (nloc == 0u) { xcd_barrier_complete(bar, b.x, nloc, nx); b.st[0] = nloc; b.st[1] = nx; }
        const unsigned old = xb_add(&bar[XB_XSUB(b.x)], 1u);
        const unsigned gen = old / nloc;
        if (old + 1u == (gen + 1u) * nloc) {
            __builtin_amdgcn_fence(__ATOMIC_RELEASE, "agent");
            asm volatile("s_waitcnt vmcnt(0)" ::: "memory");
            const unsigned og = xb_add(&bar[XB_TOP], 1u);
            const unsigned tg = og / nx;
            if (og + 1u == (tg + 1u) * nx) xb_add(&bar[XB_TOPGEN], 1u);
            else XB_SPIN(xb_ld(&bar[XB_TOPGEN]) == tg, bar);
            __builtin_amdgcn_fence(__ATOMIC_ACQUIRE, "agent");
            xb_add(&bar[XB_XGEN(b.x)], 1u);
            asm volatile("s_waitcnt vmcnt(0)" ::: "memory");
        } else {
            XB_SPIN(xb_ld(&bar[XB_XGEN(b.x)]) == gen, bar);
            __builtin_amdgcn_fence(__ATOMIC_ACQUIRE, "agent");
            asm volatile("s_waitcnt vmcnt(0)" ::: "memory");
        }
    }
    __syncthreads();
}
struct Args { const float* in[28]; float* out; unsigned char* ws; };
#define GRID_SYNC() do { XcdBarrier b_; b_.bar = (unsigned*)args.ws; b_.x = xb_xcc_id(); b_.st = (volatile LAS unsigned*)(lds + LDS_BYTES - 64); xcd_barrier(b_); } while (0)
#define PHASE_VARS int tid = threadIdx.x; asm volatile("" : "+v"(tid)); const int lane = tid & 63; const int wave = __builtin_amdgcn_readfirstlane(tid >> 6); \
    int G = gridDim.x; asm volatile("" : "+s"(G)); int bx = blockIdx.x; asm volatile("" : "+s"(bx)); const int gw = bx * NWAVES + wave, NGW = G * NWAVES; (void)lane; (void)gw; (void)NGW; (void)tid
#define WSP(T, off) ((T*)(args.ws + (off)))
#define XIN (args.in[0])
#define OUTF (args.out)
#define WA WSP(bf16, WS_WA)
#define WB WSP(bf16, WS_WB)
#define XN WSP(bf16, WS_XN)
#define P WSP(bf16, WS_P)
#define LD WSP(float, WS_LD)
#define KK WSP(bf16, WS_KK)
#define BB WSP(bf16, WS_BB)
#define KP WSP(bf16, WS_KP)
#define RR WSP(bf16, WS_RR)
#define VV WSP(bf16, WS_VV)
#define GG ((bf16*)args.out)
#define SCB ((bf16*)((unsigned char*)args.out + 16 * MiB))
#define OLT ((float*)((unsigned char*)args.out + 32 * MiB))
#define PMT WSP(bf16, WS_LD)
#define SLOC WSP(float, WS_LD + 16 * MiB)
#define QTB WSP(bf16, WS_LD + 48 * MiB)
#define BS WSP(float, WS_BS)
#define W2T WSP(bf16, WS_W2T)
#define A2T WSP(bf16, WS_A2T)
#define G2T WSP(bf16, WS_G2T)
#define YC WSP(bf16, WS_XN)
#define ACT WSP(bf16, WS_GEN)
#define QKV WSP(bf16, WS_QKV)
#define VT1 WSP(bf16, WS_VT1)
#define VT4 WSP(bf16, WS_VT4)
#define VT16 WSP(bf16, WS_VT16)
__global__ void __launch_bounds__(NWAVES * 64, 2) hybrid_fwd(Args args) {
    extern __shared__ __attribute__((aligned(16))) unsigned char lds_raw[];
    LAS unsigned char* lds = (LAS unsigned char*)lds_raw;
    if (threadIdx.x < 16) ((LAS unsigned*)(lds + LDS_BYTES - 64))[threadIdx.x] = 0u;
    __syncthreads();
    (void)xcd_barrier_post((unsigned*)args.ws, (volatile LAS unsigned*)(lds + LDS_BYTES - 64));

    { PHASE_VARS;
    {
        LAS float* scr = (LAS float*)(lds + wave * 16384);
        const int IL = 16 + 16 + 32;
        for (int it = gw; it < IL; it += NGW) {
            if (it < 16) transpose_item(args.in[9], 64, 512, W2T, scr, it, lane);
            else if (it < 32) transpose_item(args.in[11], 64, 512, A2T, scr, it - 16, lane);
            else transpose_item(args.in[12], 128, 512, G2T, scr, it - 32, lane);
        }
        norm_phase(lds, gw, NGW, wave, lane, XIN, args.in[1], XN, args.in[2], D, EIN, WA, args.in[18], D, D, WB);
    }

    }
    cg::this_grid().sync();
    { PHASE_VARS;

    {
        pg8::Gemm g{XN, WA, M, EIN, D, 256L * D * 2, 128L * D * 2, 256L * D * 2, 128L * D * 2, 0}; pg8::StaticOrder S; S.init(M, EIN, G, bx);
        pg8::EpiBf16<0> E{P, EIN, nullptr, 0, 0, 1.f};
        pg8::gemm_phase<pg8::EpiBf16<0>, pg8::StaticOrder, true, true>(lds, g, S, E);
    }

    }
    GRID_SYNC();
    { PHASE_VARS;
        RwkvW W{args.in[7], args.in[8], args.in[10], args.in[13], args.in[14], args.in[15], W2T, A2T, G2T};
        for (int ck = bx; ck < M / 64; ck += G) rwkv_chunk_block(lds, ck, tid, wave, lane, P, W, VV, GG, BS, PMT, SLOC, QTB, OLT, WSP(bf16, WS_WA));
    }
    GRID_SYNC();
    { PHASE_VARS;
        if (bx < 32) rwkv_state_scan_wg(lds, bx, tid, wave, lane, PMT, SLOC, SCB);
        else for (int it = bx - 32; it < (M / 128) * 4; it += G - 32) gmlp_item(lds, it, tid, wave, lane, P, args.in[3], args.in[4], args.in[5], args.in[6], YC);
    }
    GRID_SYNC();
    { PHASE_VARS;
        for (int it = gw; it < (M / 64) * 8; it += NGW) rwkv_chunk_out(it, lane, SCB, QTB, OLT, BS, VV, GG, args.in[16], args.in[17], YC);
    }
    GRID_SYNC();
    { PHASE_VARS;

    {
        pg8::Gemm g{YC, WB, M, D, D, 256L * D * 2, 128L * D * 2, 256L * D * 2, 128L * D * 2, 0}; pg8::StaticOrder S; S.init(M, D, G, bx);
        pg8::EpiRes E{XIN, OUTF, D};
        pg8::gemm_phase<pg8::EpiRes, pg8::StaticOrder, true, true>(lds, g, S, E);
    }

    }
    GRID_SYNC();
    { PHASE_VARS;
        norm_phase(lds, gw, NGW, wave, lane, OUTF, args.in[22] + 0 * D, XN, args.in[23] + (size_t)0 * D * FF2, D, FF2, WA, args.in[26] + (size_t)0 * FF * D, FF, D, WB);
    }
    GRID_SYNC();
    { PHASE_VARS;
        pg8::Gemm g{XN - 2 * D, WA, M, FF2, D, 248L * D * 2, 124L * D * 2, 128L * D * 2, 2816L * D * 2, 1}; pg8::StaticOrder S; S.init2(67, 22, G, bx);
        pg8::EpiConvGlu E{ACT, args.in[24] + (size_t)0 * 3 * FF2, args.in[25] + (size_t)0 * FF2, M};
        pg8::gemm_phase<pg8::EpiConvGlu, pg8::StaticOrder, true, true>(lds, g, S, E);
    }
    GRID_SYNC();
    { PHASE_VARS;
        pg8::Gemm g{ACT, WB, M, D, FF, 256L * FF * 2, 128L * FF * 2, 256L * FF * 2, 128L * FF * 2, 0}; pg8::StaticOrder S; S.init(M, D, G, bx);
        pg8::EpiRes E{OUTF, OUTF, D};
        pg8::gemm_phase<pg8::EpiRes, pg8::StaticOrder, true, true>(lds, g, S, E);
    }
    GRID_SYNC();
    { PHASE_VARS;
        norm_phase(lds, gw, NGW, wave, lane, OUTF, args.in[19], XN, args.in[20], D, NQKV, WA, args.in[21], D, D, WB);
    }
    GRID_SYNC();
    { PHASE_VARS;
        pg8::Gemm g{XN, WA, M, NQKV, D, 256L * D * 2, 128L * D * 2, 256L * D * 2, 128L * D * 2, 0}; pg8::StaticOrder S; S.init(M, NQKV, G, bx);
        pg8::EpiBf16<0> E{QKV, NQKV, nullptr, 0, 0, 1.f};
        pg8::gemm_phase<pg8::EpiBf16<0>, pg8::StaticOrder, true, true>(lds, g, S, E);
    }
    GRID_SYNC();
    { PHASE_VARS;
        for (int it = bx; it < 16 * 64; it += G) vtrans_item(lds, it, tid, QKV, VT1, VT4, VT16);
    }
    GRID_SYNC();
    { PHASE_VARS;
        for (int it = bx; it < 16 * 64; it += G) attn_item(lds, it, tid, wave, lane, QKV, VT1, VT4, VT16, YC);
    }
    GRID_SYNC();
    { PHASE_VARS;
        pg8::Gemm g{YC, WB, M, D, D, 256L * D * 2, 128L * D * 2, 256L * D * 2, 128L * D * 2, 0}; pg8::StaticOrder S; S.init(M, D, G, bx);
        pg8::EpiRes E{OUTF, OUTF, D};
        pg8::gemm_phase<pg8::EpiRes, pg8::StaticOrder, true, true>(lds, g, S, E);
    }
    GRID_SYNC();
    { PHASE_VARS;
        norm_phase(lds, gw, NGW, wave, lane, OUTF, args.in[22] + 1 * D, XN, args.in[23] + (size_t)1 * D * FF2, D, FF2, WA, args.in[26] + (size_t)1 * FF * D, FF, D, WB);
    }
    GRID_SYNC();
    { PHASE_VARS;
        pg8::Gemm g{XN - 2 * D, WA, M, FF2, D, 248L * D * 2, 124L * D * 2, 128L * D * 2, 2816L * D * 2, 1}; pg8::StaticOrder S; S.init2(67, 22, G, bx);
        pg8::EpiConvGlu E{ACT, args.in[24] + (size_t)1 * 3 * FF2, args.in[25] + (size_t)1 * FF2, M};
        pg8::gemm_phase<pg8::EpiConvGlu, pg8::StaticOrder, true, true>(lds, g, S, E);
    }
    GRID_SYNC();
    { PHASE_VARS;
        pg8::Gemm g{ACT, WB, M, D, FF, 256L * FF * 2, 128L * FF * 2, 256L * FF * 2, 128L * FF * 2, 0}; pg8::StaticOrder S; S.init(M, D, G, bx);
        pg8::EpiRes E{OUTF, OUTF, D};
        pg8::gemm_phase<pg8::EpiRes, pg8::StaticOrder, true, true>(lds, g, S, E);
    }
    GRID_SYNC();
    { PHASE_VARS;
        for (int m = gw; m < M; m += NGW) rms_row_inplace(OUTF + (size_t)m * D, args.in[27], lane);
    }
}

#undef WSP
#undef XIN
#undef OUTF
#undef WA
#undef WB
#undef XN
#undef P
#undef LD
#undef KK
#undef BB
#undef KP
#undef RR
#undef VV
#undef GG
#undef SCB
#undef OLT
#undef PMT
#undef SLOC
#undef QTB
#undef BS
#undef W2T
#undef A2T
#undef G2T
#undef YC
#undef ACT
#undef QKV
#undef VT1
#undef VT4
#undef VT16
extern "C" void kernel_launch(void* const* d_in, const int* in_sizes, int n_in, void* d_out, int out_size, void* d_ws, size_t ws_size, hipStream_t stream) {
    static int grid = 0;
    if (grid == 0) {
        if (n_in != 28 || in_sizes[0] != M * D || out_size != M * D || ws_size < WS_END) { fprintf(stderr, "kernel_launch: unexpected shapes (n_in %d, in0 %d, out %d, ws %zu)\n", n_in, n_in > 0 ? in_sizes[0] : -1, out_size, ws_size); grid = -1; return; }
        int dev = 0, cus = 0, per_cu = 0;
        if (hipGetDevice(&dev) != hipSuccess || hipDeviceGetAttribute(&cus, hipDeviceAttributeMultiprocessorCount, dev) != hipSuccess) { grid = -1; return; }
        if (hipFuncSetAttribute((const void*)hybrid_fwd, hipFuncAttributeMaxDynamicSharedMemorySize, LDS_BYTES) != hipSuccess) { fprintf(stderr, "kernel_launch: hipFuncSetAttribute failed\n"); grid = -1; return; }
        if (hipOccupancyMaxActiveBlocksPerMultiprocessor(&per_cu, (const void*)hybrid_fwd, NWAVES * 64, LDS_BYTES) != hipSuccess || per_cu < 1) { fprintf(stderr, "kernel_launch: occupancy query says %d\n", per_cu); per_cu = 1; }
        (void)hipGetLastError();
        grid = cus;
    }
    if (grid < 0) return;
    if (hipMemsetAsync(d_ws, 0, 65536, stream) != hipSuccess) { fprintf(stderr, "kernel_launch: hipMemsetAsync failed\n"); return; }
    Args a{};
    for (int i = 0; i < 28; ++i) a.in[i] = (const float*)d_in[i];
    a.out = (float*)d_out; a.ws = (unsigned char*)d_ws;
    void* kargs[] = {&a};
    hipError_t e = hipLaunchCooperativeKernel((const void*)hybrid_fwd, dim3(grid), dim3(NWAVES * 64), kargs, LDS_BYTES, stream);
    if (e != hipSuccess) fprintf(stderr, "kernel_launch: cooperative launch failed: %s (grid %d)\n", hipGetErrorString(e), grid);
}
```

```cpp
#include <hip/hip_runtime.h>
#include <hip/hip_cooperative_groups.h>
#include <cstdio>
#include <cstdint>
namespace cg = cooperative_groups;
namespace pg8 {
#define PG8_LAS __attribute__((address_space(3)))
typedef unsigned short bf16_t;
typedef short bf16x8 __attribute__((ext_vector_type(8)));
typedef float f32x4 __attribute__((ext_vector_type(4)));
typedef unsigned u32x4 __attribute__((ext_vector_type(4)));
constexpr int BM = 256, BK = 64, HALF = 128, HTB = HALF * BK * 2  , STAGE_BYTES = 8 * HTB, NXCD = 8, WGM = 8;

__host__ __device__ __forceinline__ int lds_byte(int r, int c) { const int st = (r >> 4) * 2 + (c >> 5), rr = r & 15, cc = c & 31, ob = rr * 64 + cc * 2; return st * 1024 + (ob ^ (((ob >> 9) & 1) << 5)); }
__host__ __device__ __forceinline__ void stage_rc(int b, int& R, int& C) { const int st = b / 1024, sb = b % 1024, swz = sb ^ (((sb >> 9) & 1) << 5); R = (st >> 1) * 16 + swz / 64; C = (st & 1) * 32 + (swz % 64) / 2; }
__host__ __device__ __forceinline__ int perm32(int rho) { const int n = rho >> 4, i = rho & 15; return 8 * (i >> 2) + 4 * n + (i & 3); }

struct Unit { int pm, pn; };
struct Gemm { const bf16_t* A; const bf16_t* Bt; int M, N, K; long tA, hA, tB, hB; int remapA; };

struct StaticOrder {
    int nM, nN, nwg, G, c;
    __host__ __device__ void init(int M, int N, int G_, int c_) { nM = M / BM; nN = N / BM; nwg = nM * nN; G = G_; c = c_; }
    __host__ __device__ void init2(int nM_, int nN_, int G_, int c_) { nM = nM_; nN = nN_; nwg = nM * nN; G = G_; c = c_; }
    __host__ __device__ bool next(int i, Unit& u) const {
        const long L = (long)i * G + c; if (L >= nwg) return false;
        int wgid = (int)L; { const int q = nwg / NXCD, r = nwg % NXCD, xcd = wgid % NXCD, off = wgid / NXCD; wgid = (xcd < r ? xcd * (q + 1) : r * (q + 1) + (xcd - r) * q) + off; }
        const int nig = WGM * nN, gid = wgid / nig, fm = gid * WGM, gsz = (nM - fm) < WGM ? (nM - fm) : WGM;
        u.pm = fm + ((wgid % nig) % gsz); u.pn = (wgid % nig) / gsz; return true;
    }
    __device__ __forceinline__ void a_ready(const Unit&) const {}
    __device__ __forceinline__ void done(const Unit&) const {}
};

__device__ __forceinline__ unsigned cvt_pk_bf16(float lo, float hi) { unsigned r; asm volatile("v_cvt_pk_bf16_f32 %0, %1, %2" : "=v"(r) : "v"(lo), "v"(hi)); return r; }
typedef float f32x2 __attribute__((ext_vector_type(2)));
__device__ __forceinline__ f32x2 gelu_pk(f32x2 v) {
    const f32x2 av = __builtin_elementwise_abs(v), d = av * 0.2316418882f + 1.0f;
    f32x2 t; t.x = __builtin_amdgcn_rcpf(d.x); t.y = __builtin_amdgcn_rcpf(d.y);
    f32x2 q = t * 0.5307027145f + (-0.7265760135f); q = q * t + 0.7107068705f; q = q * t + (-0.142248368f); q = q * t + 0.127414796f; q = q * t;
    const f32x2 s = (v * v) * (-0.72134752044f);
    f32x2 e; e.x = __builtin_amdgcn_exp2f(s.x); e.y = __builtin_amdgcn_exp2f(s.y);
    const f32x2 m = v * (q * e), r = v - m;
    f32x2 o; o.x = v.x < 0.f ? m.x : r.x; o.y = v.y < 0.f ? m.y : r.y; return o;
}

template <int ACT  > struct EpiBf16 {
    static constexpr bool PERM = true, AFTER_DRAIN = false; static_assert(ACT == 0 || ACT == 1, "EpiBf16: ACT is 0 (none) or 1 (gelu_pk)");
    bf16_t* O; int ldc; const float* bias; int split_cols; size_t split_stride; float scale0;
    __device__ __forceinline__ void operator()(const f32x4 (&acc)[2][2][4][2], const Unit& u, int wr, int wc, int fr, int fq) const {
        const int row0 = u.pm * BM + wr * 64 + fr; int colt = u.pn * BM; bf16_t* base = O;
        float sc = 1.f; if (split_cols) { const int t = colt / split_cols; base += (size_t)t * split_stride; colt -= t * split_cols; if (t == 0) sc = scale0; }
        const int col0 = colt + wc * 32 + 8 * fq, bcol0 = u.pn * BM + wc * 32 + 8 * fq;
        f32x4 bv[2][2];
#pragma unroll
        for (int bj = 0; bj < 2; ++bj)
#pragma unroll
            for (int n = 0; n < 2; ++n) bv[bj][n] = bias ? *(const f32x4*)(bias + bcol0 + bj * HALF + 4 * n) : (f32x4){0.f, 0.f, 0.f, 0.f};
#pragma unroll
        for (int ai = 0; ai < 2; ++ai)
#pragma unroll
            for (int m = 0; m < 4; ++m) { bf16_t* rowp = base + (size_t)(row0 + ai * HALF + m * 16) * ldc + col0;
#pragma unroll
                for (int bj = 0; bj < 2; ++bj) { f32x4 v0 = acc[ai][bj][m][0] + bv[bj][0], v1 = acc[ai][bj][m][1] + bv[bj][1];
                    if (ACT == 1) { f32x2 a = gelu_pk((f32x2){v0[0], v0[1]}), b = gelu_pk((f32x2){v0[2], v0[3]}), c = gelu_pk((f32x2){v1[0], v1[1]}), d = gelu_pk((f32x2){v1[2], v1[3]});
                        v0 = (f32x4){a.x, a.y, b.x, b.y}; v1 = (f32x4){c.x, c.y, d.x, d.y}; }
                    v0 = v0 * sc; v1 = v1 * sc; u32x4 w; w.x = cvt_pk_bf16(v0[0], v0[1]); w.y = cvt_pk_bf16(v0[2], v0[3]); w.z = cvt_pk_bf16(v1[0], v1[1]); w.w = cvt_pk_bf16(v1[2], v1[3]);
                    *(u32x4*)(rowp + bj * HALF) = w; } }
    }
};

template <class Epi, class Sched, bool ALIGN_EPI = false, bool SP2 = false>
__device__ __forceinline__ void gemm_phase(PG8_LAS unsigned char* lds, const Gemm g, const Sched& S, const Epi& E) {
    int tid_ = threadIdx.x; asm volatile("" : "+v"(tid_));
    const int tid = tid_, wid = __builtin_amdgcn_readfirstlane(tid >> 6), lane = tid & 63, wr = wid >> 2, wc = wid & 3, fr = lane & 15, fq = lane >> 4;
    const int K = g.K, nt = K / BK;
    unsigned voffA[2], voffB[2];
#pragma unroll
    for (int i = 0; i < 2; ++i) { int R, C; stage_rc(tid * 16 + i * 8192, R, C); const int Rb = Epi::PERM ? ((R & ~31) + perm32(R & 31)) : R;
        const int Ra = g.remapA ? (R - (R >= 64 ? 2 : 0)) : R; voffA[i] = (unsigned)(Ra * K + C) * 2u; voffB[i] = (unsigned)(Rb * K + C) * 2u; }
    const size_t kstep = (size_t)(BK * 2);
    const size_t hA = (size_t)g.hA, hB = (size_t)g.hB, tA = (size_t)g.tA, tB = (size_t)g.tB;
    const unsigned ldsw = (unsigned)wid * 1024u;
    const int aoff = lds_byte(wr * 64 + fr, fq * 8), boff = lds_byte(wc * 32 + fr, fq * 8);
#define PG8_SA(b, h) (((b) * 2 + (h)) * HTB)
#define PG8_SB(b, h) ((4 + (b) * 2 + (h)) * HTB)
#define PG8_STAGE(bufoff, gbase, voff) do { _Pragma("unroll") for (int _i = 0; _i < 2; ++_i) \
        __builtin_amdgcn_global_load_lds((const unsigned*)((const char*)(gbase) + (voff)[_i]), (PG8_LAS unsigned*)(lds + (bufoff) + ldsw + _i * 8192), 16, 0, 0); } while (0)
#define PG8_LDA(dst, b, h) do { _Pragma("unroll") for (int m = 0; m < 4; ++m) _Pragma("unroll") for (int k = 0; k < 2; ++k) dst[m][k] = *(const PG8_LAS bf16x8*)(lds + PG8_SA(b, h) + aoff + m * 2048 + k * 1024); } while (0)
#define PG8_LDB(dst, b, h) do { _Pragma("unroll") for (int n = 0; n < 2; ++n) _Pragma("unroll") for (int k = 0; k < 2; ++k) dst[n][k] = *(const PG8_LAS bf16x8*)(lds + PG8_SB(b, h) + boff + n * 2048 + k * 1024); } while (0)
#define PG8_MMA(ai, bj, At, Bt) do { __builtin_amdgcn_s_setprio(1); _Pragma("unroll") for (int m = 0; m < 4; ++m) _Pragma("unroll") for (int n = 0; n < 2; ++n) _Pragma("unroll") for (int k = 0; k < 2; ++k) \
        acc[ai][bj][m][n] = __builtin_amdgcn_mfma_f32_16x16x32_bf16(Bt[n][k], At[m][k], acc[ai][bj][m][n], 0, 0, 0); __builtin_amdgcn_s_setprio(0); } while (0)
#define PG8_WAIT_V(n) asm volatile("s_waitcnt vmcnt(" #n ")" ::: "memory")
#define PG8_WAIT_L(n) asm volatile("s_waitcnt lgkmcnt(" #n ")" ::: "memory")
#define PG8_BAR __builtin_amdgcn_s_barrier()
#define PG8_SCHED __builtin_amdgcn_sched_barrier(0)
    Unit cur, nxt; int ui = 0;
    if (!S.next(0, cur)) return;
    f32x4 acc[2][2][4][2];
#pragma unroll
    for (int a = 0; a < 2; ++a)
#pragma unroll
        for (int b = 0; b < 2; ++b)
#pragma unroll
            for (int m = 0; m < 4; ++m)
#pragma unroll
                for (int n = 0; n < 2; ++n) acc[a][b][m][n] = (f32x4){0.f, 0.f, 0.f, 0.f};
    bf16x8 At[4][2], B0[2][2], B1[2][2];
    const char* cA = (const char*)g.A + (size_t)cur.pm * tA; const char* cB = (const char*)g.Bt + (size_t)cur.pn * tB;
    S.a_ready(cur);
    if constexpr (SP2) {
        PG8_STAGE(PG8_SB(0, 0), cB, voffB); PG8_STAGE(PG8_SB(0, 1), cB + hB, voffB); PG8_STAGE(PG8_SA(0, 0), cA, voffA); PG8_STAGE(PG8_SA(0, 1), cA + hA, voffA);
        if (wr == 1) PG8_BAR;
        PG8_WAIT_V(2); PG8_BAR;
        PG8_STAGE(PG8_SB(1, 0), cB + kstep, voffB); PG8_STAGE(PG8_SA(1, 0), cA + kstep, voffA); PG8_STAGE(PG8_SB(1, 1), cB + hB + kstep, voffB);
        PG8_WAIT_V(6); PG8_BAR;
    } else {
        PG8_STAGE(PG8_SB(0, 0), cB, voffB); PG8_STAGE(PG8_SA(0, 0), cA, voffA); PG8_STAGE(PG8_SB(0, 1), cB + hB, voffB); PG8_STAGE(PG8_SA(0, 1), cA + hA, voffA);
        if (wr == 1) PG8_BAR;
        PG8_WAIT_V(4); PG8_BAR;
        PG8_STAGE(PG8_SB(1, 0), cB + kstep, voffB); PG8_STAGE(PG8_SA(1, 0), cA + kstep, voffA); PG8_STAGE(PG8_SB(1, 1), cB + hB + kstep, voffB);
        PG8_WAIT_V(6); PG8_BAR;
    }
    for (;;) {
        const bool has_next = S.next(ui + 1, nxt);
        const char* nA = has_next ? (const char*)g.A + (size_t)nxt.pm * tA : cA; const char* nB = has_next ? (const char*)g.Bt + (size_t)nxt.pn * tB : cB;
        for (int t = 0; t < nt; t += 2) {
            const bool last = (t == nt - 2);
            const char* a1 = cA + (size_t)(t + 1) * kstep;
            const char* a2 = last ? nA : cA + (size_t)(t + 2) * kstep; const char* b2 = last ? nB : cB + (size_t)(t + 2) * kstep;
            const char* a3 = a2 + kstep; const char* b3 = b2 + kstep;
            if (last && has_next) S.a_ready(nxt);
            if constexpr (SP2) {
            PG8_LDB(B0, 0, 0); PG8_LDB(B1, 0, 1); PG8_SCHED; PG8_LDA(At, 0, 0); PG8_STAGE(PG8_SA(1, 1), a1 + hA, voffA);
            PG8_WAIT_V(8); PG8_WAIT_L(0); PG8_BAR; PG8_MMA(0, 0, At, B0); PG8_MMA(0, 1, At, B1); PG8_BAR; PG8_SCHED;
            PG8_LDA(At, 0, 1); PG8_STAGE(PG8_SB(0, 0), b2, voffB); PG8_STAGE(PG8_SB(0, 1), b2 + hB, voffB); PG8_STAGE(PG8_SA(0, 0), a2, voffA);
            PG8_WAIT_V(8); PG8_WAIT_L(0); PG8_BAR; PG8_MMA(1, 0, At, B0); PG8_MMA(1, 1, At, B1); PG8_BAR; PG8_SCHED;
            PG8_LDB(B0, 1, 0); PG8_LDB(B1, 1, 1); PG8_SCHED; PG8_LDA(At, 1, 0); PG8_STAGE(PG8_SA(0, 1), a2 + hA, voffA);
            PG8_WAIT_V(8); PG8_WAIT_L(0); PG8_BAR; PG8_MMA(0, 0, At, B0); PG8_MMA(0, 1, At, B1); PG8_BAR; PG8_SCHED;
            PG8_LDA(At, 1, 1); PG8_STAGE(PG8_SB(1, 0), b3, voffB); PG8_STAGE(PG8_SB(1, 1), b3 + hB, voffB); PG8_STAGE(PG8_SA(1, 0), a3, voffA);
            PG8_WAIT_V(8); PG8_WAIT_L(0); PG8_BAR; PG8_MMA(1, 0, At, B0); PG8_MMA(1, 1, At, B1); PG8_BAR; PG8_SCHED;
            } else {
            PG8_LDB(B0, 0, 0); PG8_SCHED; PG8_LDA(At, 0, 0); PG8_STAGE(PG8_SA(1, 1), a1 + hA, voffA);
            PG8_WAIT_L(8); PG8_BAR; PG8_WAIT_L(0); PG8_MMA(0, 0, At, B0); PG8_BAR; PG8_SCHED;
            PG8_LDB(B1, 0, 1); PG8_STAGE(PG8_SB(0, 0), b2, voffB);
            PG8_BAR; PG8_WAIT_L(0); PG8_MMA(0, 1, At, B1); PG8_BAR;
            PG8_LDA(At, 0, 1); PG8_STAGE(PG8_SA(0, 0), a2, voffA);
            PG8_BAR; PG8_WAIT_L(0); PG8_MMA(1, 0, At, B0); PG8_BAR; PG8_SCHED;
            PG8_STAGE(PG8_SB(0, 1), b2 + hB, voffB);
            PG8_WAIT_V(6); PG8_BAR; PG8_MMA(1, 1, At, B1); PG8_BAR;
            PG8_LDB(B0, 1, 0); PG8_SCHED; PG8_LDA(At, 1, 0); PG8_STAGE(PG8_SA(0, 1), a2 + hA, voffA);
            PG8_WAIT_L(8); PG8_BAR; PG8_WAIT_L(0); PG8_MMA(0, 0, At, B0); PG8_BAR; PG8_SCHED;
            PG8_LDB(B1, 1, 1); PG8_STAGE(PG8_SB(1, 0), b3, voffB);
            PG8_BAR; PG8_WAIT_L(0); PG8_MMA(0, 1, At, B1); PG8_BAR;
            PG8_LDA(At, 1, 1); PG8_STAGE(PG8_SA(1, 0), a3, voffA);
            PG8_BAR; PG8_WAIT_L(0); PG8_MMA(1, 0, At, B0); PG8_BAR; PG8_SCHED;
            PG8_STAGE(PG8_SB(1, 1), b3 + hB, voffB);
            PG8_WAIT_V(6); PG8_BAR; PG8_MMA(1, 1, At, B1); PG8_BAR;
            }
        }
        if constexpr (ALIGN_EPI) { if (wr == 0) PG8_BAR; }
        if constexpr (!Epi::AFTER_DRAIN) { E(acc, cur, wr, wc, fr, fq); S.done(cur); }
        if (!has_next) break;
#pragma unroll
        for (int a = 0; a < 2; ++a)
#pragma unroll
            for (int b = 0; b < 2; ++b)
#pragma unroll
                for (int m = 0; m < 4; ++m)
#pragma unroll
                    for (int n = 0; n < 2; ++n) acc[a][b][m][n] = (f32x4){0.f, 0.f, 0.f, 0.f};
        cur = nxt; cA = nA; cB = nB; ++ui;
        if constexpr (ALIGN_EPI) { if (wr == 1) PG8_BAR; }
    }
    PG8_WAIT_V(0);
    if constexpr (!ALIGN_EPI) { if (wr == 0) PG8_BAR; }
    PG8_BAR;
    if constexpr (Epi::AFTER_DRAIN) { E.fused(acc, cur, wr, wc, fr, fq, lds, wid, lane); S.done(cur); }
#undef PG8_SA
#undef PG8_SB
#undef PG8_STAGE
#undef PG8_LDA
#undef PG8_LDB
#undef PG8_MMA
#undef PG8_WAIT_V
#undef PG8_WAIT_L
#undef PG8_BAR
#undef PG8_SCHED
}
}
namespace pg8 {
template <int N> __device__ __forceinline__ float row_ror(float v) {
    return __builtin_bit_cast(float, __builtin_amdgcn_update_dpp(0, __builtin_bit_cast(int, v), 0x120 + N, 0xf, 0xf, false));
}
}
namespace pg8 {
struct EpiRes {
    static constexpr bool PERM = false, AFTER_DRAIN = false;
    const float* base; float* out; int ldc;
    __device__ __forceinline__ void operator()(const f32x4 (&acc)[2][2][4][2], const Unit& u, int wr, int wc, int fr, int fq) const {
        const int col0 = u.pn * BM + wc * 32 + 4 * fq;
#pragma unroll
        for (int ai = 0; ai < 2; ++ai)
#pragma unroll
            for (int m = 0; m < 4; ++m) { const size_t off = (size_t)(u.pm * BM + ai * HALF + wr * 64 + m * 16 + fr) * ldc + col0;
#pragma unroll
                for (int bj = 0; bj < 2; ++bj)
#pragma unroll
                    for (int n = 0; n < 2; ++n) { const f32x4 b = *(const f32x4*)(base + off + bj * HALF + n * 16); *(f32x4*)(out + off + bj * HALF + n * 16) = b + acc[ai][bj][m][n]; } }
    }
};
struct EpiConvGlu {
    static constexpr bool PERM = false, AFTER_DRAIN = false;
    bf16_t* O; const float* cw; const float* cb; int M;
    __device__ __forceinline__ void operator()(const f32x4 (&acc)[2][2][4][2], const Unit& u, int wr, int wc, int fr, int fq) const {
        const int lane = fq * 16 + fr;
        const int src1 = fq * 16 + ((fr + 15) & 15), src2 = fq * 16 + ((fr + 14) & 15);
#pragma unroll
        for (int ai = 0; ai < 2; ++ai) {
            const int pb = 248 * u.pm + 62 * (2 * ai + wr) - 2;
#pragma unroll
            for (int n = 0; n < 2; ++n) {
                const int jg = 128 * u.pn + 32 * wc + 16 * n + 4 * fq;
                const f32x4 g0 = *(const f32x4*)(cw + jg), g1 = *(const f32x4*)(cw + 5632 + jg), g2 = *(const f32x4*)(cw + 2 * 5632 + jg), gb = *(const f32x4*)(cb + jg);
                const f32x4 v0 = *(const f32x4*)(cw + 2816 + jg), v1 = *(const f32x4*)(cw + 5632 + 2816 + jg), v2 = *(const f32x4*)(cw + 2 * 5632 + 2816 + jg), vb = *(const f32x4*)(cb + 2816 + jg);
                f32x4 pg1, pg2, pv1, pv2;
#pragma unroll
                for (int m = 0; m < 4; ++m) {
                    f32x4 zg = acc[ai][0][m][n], zv = acc[ai][1][m][n];
                    const int pos = pb + 16 * m + fr;
                    if (pos < 0) { zg = (f32x4){0.f, 0.f, 0.f, 0.f}; zv = zg; }
                    f32x4 rg1, rg2, rv1, rv2;
#pragma unroll
                    for (int e = 0; e < 4; ++e) { rg1[e] = row_ror<1>(zg[e]); rg2[e] = row_ror<2>(zg[e]); rv1[e] = row_ror<1>(zv[e]); rv2[e] = row_ror<2>(zv[e]); }
                    f32x4 zg1, zg2, zv1, zv2;
                    if (m == 0) { zg1 = rg1; zg2 = rg2; zv1 = rv1; zv2 = rv2; }
                    else {
#pragma unroll
                        for (int e = 0; e < 4; ++e) { zg1[e] = fr >= 1 ? rg1[e] : pg1[e]; zg2[e] = fr >= 2 ? rg2[e] : pg2[e]; zv1[e] = fr >= 1 ? rv1[e] : pv1[e]; zv2[e] = fr >= 2 ? rv2[e] : pv2[e]; }
                    }
                    pg1 = rg1; pg2 = rg2; pv1 = rv1; pv2 = rv2;
                    const f32x4 cg = g0 * zg2 + g1 * zg1 + g2 * zg + gb;
                    const f32x4 cv = v0 * zv2 + v1 * zv1 + v2 * zv + vb;
                    f32x4 a;
#pragma unroll
                    for (int e = 0; e < 4; ++e) a[e] = cg[e] / (1.0f + __expf(-cg[e])) * cv[e];
                    if ((16 * m + fr) >= 2 && pos < M) {
                        typedef unsigned u32x2 __attribute__((ext_vector_type(2)));
                        u32x2 w; w.x = cvt_pk_bf16(a[0], a[1]); w.y = cvt_pk_bf16(a[2], a[3]);
                        *(u32x2*)(O + (size_t)pos * 2816 + jg) = w;
                    }
                }
            }
        }
        (void)lane;
    }
};
}
#define LAS __attribute__((address_space(3)))
typedef unsigned short bf16;
typedef float f32x4 __attribute__((ext_vector_type(4)));
typedef short bf16x8 __attribute__((ext_vector_type(8)));
typedef unsigned v4u __attribute__((ext_vector_type(4)));
typedef unsigned v2u __attribute__((ext_vector_type(2)));
constexpr int NWAVES = 8;
constexpr int M = 16384, D = 1024, EIN = 2816, FF = 2816, FF2 = 5632, NQKV = 3072, BW = 512;
constexpr size_t MiB = 1u << 20;
constexpr size_t WS_W2T = 1 * MiB, WS_A2T = WS_W2T + 65536, WS_G2T = WS_A2T + 65536, WS_BS = WS_G2T + 131072;
constexpr size_t WS_WA = 2 * MiB, WS_WB = 13 * MiB, WS_XN = 20 * MiB, WS_GEN = 52 * MiB, WS_END = 256 * MiB;
constexpr size_t WS_P = WS_GEN, WS_LD = WS_GEN + 88 * MiB, WS_KK = WS_LD + 32 * MiB, WS_BB = WS_KK + 16 * MiB, WS_KP = WS_BB + 16 * MiB, WS_RR = WS_KP + 16 * MiB, WS_VV = WS_RR + 16 * MiB;
static_assert(WS_VV + 16 * MiB <= WS_END, "ws map");
constexpr size_t WS_QKV = WS_GEN, WS_VT1 = WS_GEN + 96 * MiB, WS_VT4 = WS_VT1 + 32 * MiB, WS_VT16 = WS_VT4 + 32 * MiB;
static_assert(WS_VT16 + 33 * MiB <= WS_END, "ws map");
constexpr int LDS_BYTES = 147456;

__device__ __forceinline__ float bf2f(unsigned short v) { return __uint_as_float(((unsigned)v) << 16); }
typedef float f32x2_t __attribute__((ext_vector_type(2))); typedef __bf16 bf16x2_t __attribute__((ext_vector_type(2)));
__device__ __forceinline__ unsigned pk2(float lo, float hi) { f32x2_t v = {lo, hi}; bf16x2_t b = __builtin_convertvector(v, bf16x2_t); return __builtin_bit_cast(unsigned, b); }
__device__ __forceinline__ unsigned f2bf(float f) { return pk2(f, f) & 0xffffu; }
__device__ __forceinline__ float wave_sum(float v) {
#pragma unroll
    for (int o = 1; o < 64; o <<= 1) v += __shfl_xor(v, o);
    return v;
}
__device__ __forceinline__ float dpp_row_shr(float v, int n) {
    const int iv = __builtin_bit_cast(int, v); int r;
    switch (n) { case 1: r = __builtin_amdgcn_update_dpp(0, iv, 0x111, 0xf, 0xf, true); break; case 2: r = __builtin_amdgcn_update_dpp(0, iv, 0x112, 0xf, 0xf, true); break;
                 case 4: r = __builtin_amdgcn_update_dpp(0, iv, 0x114, 0xf, 0xf, true); break; default: r = __builtin_amdgcn_update_dpp(0, iv, 0x118, 0xf, 0xf, true); break; }
    return __builtin_bit_cast(float, r);
}
__device__ __forceinline__ float wave_sum_uniform(float v) {
    v += dpp_row_shr(v, 1); v += dpp_row_shr(v, 2); v += dpp_row_shr(v, 4); v += dpp_row_shr(v, 8);
    v += __builtin_bit_cast(float, __builtin_amdgcn_update_dpp(0, __builtin_bit_cast(int, v), 0x142, 0xa, 0xf, false));
    v += __builtin_bit_cast(float, __builtin_amdgcn_update_dpp(0, __builtin_bit_cast(int, v), 0x143, 0xc, 0xf, false));
    return __builtin_bit_cast(float, __builtin_amdgcn_readlane(__builtin_bit_cast(int, v), 63));
}
#define MFMA16(a, b, c) __builtin_amdgcn_mfma_f32_16x16x32_bf16((a), (b), (c), 0, 0, 0)

__device__ __forceinline__ void transpose_item(const float* W, int K, int N, bf16* WT, LAS float* scr, int item, int lane) {
    const int nblk = N / 32, kb = item / nblk, nb = item % nblk, k0 = 64 * kb, n0 = 32 * nb;
    float wv[32];
#pragma unroll
    for (int i = 0; i < 32; ++i) wv[i] = W[(size_t)(k0 + 2 * i + (lane >> 5)) * N + n0 + (lane & 31)];
#pragma unroll
    for (int i = 0; i < 32; ++i) scr[(2 * i + (lane >> 5)) * 33 + (lane & 31)] = wv[i];
    asm volatile("s_waitcnt lgkmcnt(0)" ::: "memory");
    const int c = lane & 7;
#pragma unroll
    for (int j = 0; j < 4; ++j) { const int n = (lane >> 3) + 8 * j; const LAS float* s = scr + (8 * c) * 33 + n;
        v4u o; o.x = pk2(s[0 * 33], s[1 * 33]); o.y = pk2(s[2 * 33], s[3 * 33]); o.z = pk2(s[4 * 33], s[5 * 33]); o.w = pk2(s[6 * 33], s[7 * 33]);
        *(v4u*)(WT + (size_t)(n0 + n) * K + k0 + 8 * c) = o; }
    asm volatile("s_waitcnt lgkmcnt(0)" ::: "memory");
}
__device__ __forceinline__ void rms_row_to_bf16(const float* xrow, const float* gain, bf16* orow, int lane) {
    const f32x4* xr = (const f32x4*)xrow + lane; const f32x4* gr = (const f32x4*)gain + lane;
    f32x4 v[4]; float s = 0.f;
#pragma unroll
    for (int j = 0; j < 4; ++j) { v[j] = xr[64 * j]; s += (v[j].x * v[j].x + v[j].y * v[j].y) + (v[j].z * v[j].z + v[j].w * v[j].w); }
    const float rstd = 1.0f / sqrtf(wave_sum(s) * (1.f / D) + 1e-6f);
    v2u* o8 = (v2u*)orow + lane;
#pragma unroll
    for (int j = 0; j < 4; ++j) { const f32x4 g = gr[64 * j]; v2u w; w.x = pk2(v[j].x * rstd * g.x, v[j].y * rstd * g.y); w.y = pk2(v[j].z * rstd * g.z, v[j].w * rstd * g.w); o8[64 * j] = w; }
}
__device__ __forceinline__ void rms_row2_to_bf16(const float* xa, const float* xb, const float* gain, bf16* oa, bf16* ob, int lane) {
    const f32x4* ra = (const f32x4*)xa + lane; const f32x4* rb = (const f32x4*)xb + lane; const f32x4* gr = (const f32x4*)gain + lane;
    f32x4 va[4], vb[4]; float sa = 0.f, sb = 0.f;
#pragma unroll
    for (int j = 0; j < 4; ++j) { va[j] = ra[64 * j]; vb[j] = rb[64 * j]; }
#pragma unroll
    for (int j = 0; j < 4; ++j) { sa += (va[j].x * va[j].x + va[j].y * va[j].y) + (va[j].z * va[j].z + va[j].w * va[j].w); sb += (vb[j].x * vb[j].x + vb[j].y * vb[j].y) + (vb[j].z * vb[j].z + vb[j].w * vb[j].w); }
#pragma unroll
    for (int o = 1; o < 64; o <<= 1) { sa += __shfl_xor(sa, o); sb += __shfl_xor(sb, o); }
    const float ka = 1.0f / sqrtf(sa * (1.f / D) + 1e-6f), kb = 1.0f / sqrtf(sb * (1.f / D) + 1e-6f);
    v2u* pa = (v2u*)oa + lane; v2u* pb = (v2u*)ob + lane;
#pragma unroll
    for (int j = 0; j < 4; ++j) { const f32x4 g = gr[64 * j];
        v2u w; w.x = pk2(va[j].x * ka * g.x, va[j].y * ka * g.y); w.y = pk2(va[j].z * ka * g.z, va[j].w * ka * g.w); pa[64 * j] = w;
        v2u u; u.x = pk2(vb[j].x * kb * g.x, vb[j].y * kb * g.y); u.y = pk2(vb[j].z * kb * g.z, vb[j].w * kb * g.w); pb[64 * j] = u; }
}
__device__ __forceinline__ void rms_row_inplace(float* xrow, const float* gain, int lane) {
    f32x4* xr = (f32x4*)xrow + lane; const f32x4* gr = (const f32x4*)gain + lane;
    f32x4 v[4]; float s = 0.f;
#pragma unroll
    for (int j = 0; j < 4; ++j) { v[j] = xr[64 * j]; s += (v[j].x * v[j].x + v[j].y * v[j].y) + (v[j].z * v[j].z + v[j].w * v[j].w); }
    const float rstd = 1.0f / sqrtf(wave_sum(s) * (1.f / D) + 1e-6f);
#pragma unroll
    for (int j = 0; j < 4; ++j) { const f32x4 g = gr[64 * j]; xr[64 * j] = v[j] * rstd * g; }
}
__device__ __forceinline__ void norm_phase(LAS unsigned char* lds, int gw, int NGW, int wave, int lane, const float* x, const float* gain, bf16* XN,
                                           const float* W1, int K1, int N1, bf16* W1t, const float* W2, int K2, int N2, bf16* W2t) {
    LAS float* scr = (LAS float*)(lds + wave * 16384);
    const int I1 = (K1 / 64) * (N1 / 32), I2 = (K2 / 64) * (N2 / 32);
    for (int it = gw; it < I1 + I2; it += NGW) {
        if (it < I1) transpose_item(W1, K1, N1, W1t, scr, it, lane); else transpose_item(W2, K2, N2, W2t, scr, it - I1, lane);
    }
    for (int m = gw; m < M; m += 2 * NGW) {
        if (m + NGW < M) rms_row2_to_bf16(x + (size_t)m * D, x + (size_t)(m + NGW) * D, gain, XN + (size_t)m * D, XN + (size_t)(m + NGW) * D, lane);
        else rms_row_to_bf16(x + (size_t)m * D, gain, XN + (size_t)m * D, lane);
    }
}

__device__ __forceinline__ void gmlp_item(LAS unsigned char* lds, int item, int tid, int wave, int lane, const bf16* P, const float* ln_g, const float* ln_b,
                                          const float* w_s, const float* b_s, bf16* Y) {
    const int chunk = item >> 2, g = item & 3, t0 = chunk * 128;
    LAS bf16* Wm = (LAS bf16*)lds;
    LAS bf16* Vt = (LAS bf16*)(lds + 128 * 136 * 2);
    v4u raws[16];
#pragma unroll
    for (int i = 0; i < 16; ++i) raws[i] = *(const v4u*)(P + (size_t)(t0 + wave * 16 + i) * EIN + 512 + lane * 8);
    float lg8[8], lb8[8];
#pragma unroll
    for (int e = 0; e < 8; ++e) { const int ch = g * 128 + (lane & 15) * 8 + e; lg8[e] = ln_g[ch]; lb8[e] = ln_b[ch]; }
#pragma unroll
    for (int i = 0; i < 16; ++i) {
        const int s = wave * 16 + i;
        const v4u raw = raws[i];
        float v[8];
        v[0] = __uint_as_float(raw.x << 16); v[1] = __uint_as_float(raw.x & 0xffff0000u); v[2] = __uint_as_float(raw.y << 16); v[3] = __uint_as_float(raw.y & 0xffff0000u);
        v[4] = __uint_as_float(raw.z << 16); v[5] = __uint_as_float(raw.z & 0xffff0000u); v[6] = __uint_as_float(raw.w << 16); v[7] = __uint_as_float(raw.w & 0xffff0000u);
        float sum = 0.f;
#pragma unroll
        for (int e = 0; e < 8; ++e) sum += v[e];
        const float mean = wave_sum(sum) * (1.f / 512.f);
        float q = 0.f;
#pragma unroll
        for (int e = 0; e < 8; ++e) { v[e] -= mean; q += v[e] * v[e]; }
        const float rstd = 1.0f / sqrtf(wave_sum(q) * (1.f / 512.f) + 1e-5f);
        if ((lane >> 4) == g) {
#pragma unroll
            for (int e = 0; e < 8; ++e) { const int c = (lane & 15) * 8 + e; Vt[c * 136 + s] = (bf16)f2bf(v[e] * rstd * lg8[e] + lb8[e]); }
        }
    }
    for (int idx = tid; idx < 128 * 32; idx += 512) {
        const int t = idx >> 5, s4 = (idx & 31) * 4;
        const f32x4 w = *(const f32x4*)(w_s + ((size_t)g * 128 + t) * 128 + s4);
        v2u o; o.x = pk2(s4 + 0 <= t ? w.x : 0.f, s4 + 1 <= t ? w.y : 0.f); o.y = pk2(s4 + 2 <= t ? w.z : 0.f, s4 + 3 <= t ? w.w : 0.f);
        *(LAS v2u*)(Wm + t * 136 + s4) = o;
    }
    __syncthreads();
    const int r = lane & 15, q4 = lane >> 4;
    f32x4 acc[8];
#pragma unroll
    for (int ct = 0; ct < 8; ++ct) acc[ct] = (f32x4){0.f, 0.f, 0.f, 0.f};
    const int nks = (16 * wave + 15) / 32 + 1;
    for (int ks = 0; ks < nks; ++ks) {
        const bf16x8 af = *(const LAS bf16x8*)(Wm + (16 * wave + r) * 136 + ks * 32 + q4 * 8);
#pragma unroll
        for (int ct = 0; ct < 8; ++ct) { const bf16x8 bfr = *(const LAS bf16x8*)(Vt + (16 * ct + r) * 136 + ks * 32 + q4 * 8); acc[ct] = MFMA16(af, bfr, acc[ct]); }
    }
#pragma unroll
    for (int ct = 0; ct < 8; ++ct)
#pragma unroll
        for (int e = 0; e < 4; ++e) {
            const int t = 16 * wave + 4 * q4 + e, c = 16 * ct + r;
            const float mixed = acc[ct][e] + b_s[g * 128 + t];
            const float u = bf2f(P[(size_t)(t0 + t) * EIN + g * 128 + c]);
            Y[(size_t)(t0 + t) * D + g * 128 + c] = (bf16)f2bf(u * mixed);
        }
    __syncthreads();
}

struct RwkvW { const float *mu, *w0, *a0, *k_k, *k_a, *r_k; const bf16 *w2t, *a2t, *g2t; };
__device__ __forceinline__ float shifted(const bf16* P, int t, int col, float mu) {
    const float cur = bf2f(P[(size_t)t * EIN + col]); const float prev = t > 0 ? bf2f(P[(size_t)(t - 1) * EIN + col]) : 0.f; return cur + (prev - cur) * mu;
}
__device__ __forceinline__ void rwkv_prep_item(LAS unsigned char* lds, int item, int tid, int wave, int lane, const bf16* P, const RwkvW& W,
                                               float* LD, bf16* KK, bf16* BB, bf16* KP, bf16* RR, bf16* VV, bf16* GG, float* BS) {
    const int t0 = item * 64;
    LAS bf16* Xl = (LAS bf16*)lds;
    for (int idx = tid; idx < 64 * 256; idx += 512) {
        const int t = idx >> 8, j = idx & 255;
        const float ps = shifted(P, t0 + t, 1024 + 1536 + j, W.mu[1536 + j]);
        const float val = j < 64 ? tanhf(ps) : (j < 128 ? ps : 1.0f / (1.0f + __expf(-ps)));
        Xl[t * 264 + j] = (bf16)f2bf(val);
    }
    __syncthreads();
    const int h = wave, r = lane & 15, q4 = lane >> 4;
    for (int tt = 0; tt < 4; ++tt) {
        f32x4 aW[4], aA[4], aG[4];
#pragma unroll
        for (int ct = 0; ct < 4; ++ct) { aW[ct] = (f32x4){0.f, 0.f, 0.f, 0.f}; aA[ct] = aW[ct]; aG[ct] = aW[ct]; }
#pragma unroll
        for (int ks = 0; ks < 2; ++ks) {
            const bf16x8 xw = *(const LAS bf16x8*)(Xl + (16 * tt + r) * 264 + ks * 32 + q4 * 8);
            const bf16x8 xa = *(const LAS bf16x8*)(Xl + (16 * tt + r) * 264 + 64 + ks * 32 + q4 * 8);
#pragma unroll
            for (int ct = 0; ct < 4; ++ct) {
                const bf16x8 yw = *(const bf16x8*)(W.w2t + (size_t)(h * 64 + 16 * ct + r) * 64 + ks * 32 + q4 * 8);
                const bf16x8 ya = *(const bf16x8*)(W.a2t + (size_t)(h * 64 + 16 * ct + r) * 64 + ks * 32 + q4 * 8);
                aW[ct] = MFMA16(xw, yw, aW[ct]); aA[ct] = MFMA16(xa, ya, aA[ct]);
            }
        }
#pragma unroll
        for (int ks = 0; ks < 4; ++ks) {
            const bf16x8 xg = *(const LAS bf16x8*)(Xl + (16 * tt + r) * 264 + 128 + ks * 32 + q4 * 8);
#pragma unroll
            for (int ct = 0; ct < 4; ++ct) {
                const bf16x8 yg = *(const bf16x8*)(W.g2t + (size_t)(h * 64 + 16 * ct + r) * 128 + ks * 32 + q4 * 8);
                aG[ct] = MFMA16(xg, yg, aG[ct]);
            }
        }
#pragma unroll
        for (int e = 0; e < 4; ++e) {
            const int t = t0 + 16 * tt + 4 * q4 + e;
            float kkr[4], av[4]; float ss = 0.f, bon = 0.f;
#pragma unroll
            for (int ct = 0; ct < 4; ++ct) {
                const int c = h * 64 + 16 * ct + r;
                const float r_ = shifted(P, t, 1024 + c, W.mu[c]);
                const float k_ = shifted(P, t, 1024 + 512 + c, W.mu[512 + c]);
                const float v_ = shifted(P, t, 1024 + 1024 + c, W.mu[1024 + c]);
                const float xw = -(W.w0[c] + aW[ct][e]);
                const float sp = xw > 20.f ? xw : log1pf(__expf(xw));
                const float wv = -sp - 0.5f;
                const float ld = -__expf(wv);
                const float a = 1.0f / (1.0f + __expf(-(W.a0[c] + aA[ct][e])));
                const float kr = k_ * W.k_k[c];
                const float kp = k_ * (1.0f + (a - 1.0f) * W.k_a[c]);
                kkr[ct] = kr; av[ct] = a; ss += kr * kr; bon += r_ * kp * W.r_k[c];
                const size_t o = (size_t)t * BW + c;
                LD[o] = ld; KP[o] = (bf16)f2bf(kp); RR[o] = (bf16)f2bf(r_); VV[o] = (bf16)f2bf(v_); GG[o] = (bf16)f2bf(aG[ct][e]);
            }
#pragma unroll
            for (int o = 1; o < 16; o <<= 1) { ss += __shfl_xor(ss, o); bon += __shfl_xor(bon, o); }
            const float inv = 1.0f / sqrtf(fmaxf(ss, 1e-24f));
#pragma unroll
            for (int ct = 0; ct < 4; ++ct) {
                const int c = h * 64 + 16 * ct + r; const size_t o = (size_t)t * BW + c;
                const float kk = kkr[ct] * inv;
                KK[o] = (bf16)f2bf(kk); BB[o] = (bf16)f2bf(kk * av[ct]);
            }
            if (r == 0) BS[(size_t)t * 8 + h] = bon;
        }
    }
    __syncthreads();
}

struct ScanRegs { unsigned short kk[8], bb[8], kp[8], rr[8], vv[8]; float ld[8]; };
__device__ __forceinline__ void scan_load(ScanRegs& R, int t0, int hc, int hv, const float* LD, const bf16* KK, const bf16* BB, const bf16* KP, const bf16* RR, const bf16* VV) {
#pragma unroll
    for (int i = 0; i < 8; ++i) { const size_t o = (size_t)(t0 + i) * BW;
        R.kk[i] = KK[o + hc]; R.bb[i] = BB[o + hc]; R.kp[i] = KP[o + hc]; R.rr[i] = RR[o + hc]; R.ld[i] = LD[o + hc]; R.vv[i] = VV[o + hv]; }
}
__device__ __forceinline__ void rwkv_scan_wave(int gwv, int lane, const float* LD, const bf16* KK, const bf16* BB, const bf16* KP, const bf16* RR, const bf16* VV, float* OSC) {
    const int h = gwv >> 6, v = gwv & 63, hc = h * 64 + lane, hv = h * 64 + v;
    float S = 0.f;
    ScanRegs cur, nxt;
    scan_load(cur, 0, hc, hv, LD, KK, BB, KP, RR, VV);
    for (int t0 = 0; t0 < M; t0 += 8) {
        const int tn = (t0 + 8 < M) ? t0 + 8 : t0;
        scan_load(nxt, tn, hc, hv, LD, KK, BB, KP, RR, VV);
#pragma unroll
        for (int i = 0; i < 8; ++i) {
            const float kk = bf2f(cur.kk[i]), bb = bf2f(cur.bb[i]), kp = bf2f(cur.kp[i]), rr = bf2f(cur.rr[i]), vv = bf2f(cur.vv[i]);
            const float dec = __expf(cur.ld[i]);
            const float sa = wave_sum_uniform(S * kk);
            S = S * dec - sa * bb + vv * kp;
            const float o = wave_sum_uniform(S * rr);
            if (lane == 0) OSC[(size_t)(t0 + i) * BW + hv] = o;
        }
        cur = nxt;
    }
}
__device__ __forceinline__ void rwkv_out_row(int t, int lane, const float* OSC, const float* BS, const bf16* VV, const bf16* GG, const float* gn_g, const float* gn_b, bf16* Y) {
    const int c0 = lane * 8;
    const f32x4 o0 = *(const f32x4*)(OSC + (size_t)t * BW + c0), o1 = *(const f32x4*)(OSC + (size_t)t * BW + c0 + 4);
    float v[8] = {o0.x, o0.y, o0.z, o0.w, o1.x, o1.y, o1.z, o1.w};
    float s = 0.f;
#pragma unroll
    for (int e = 0; e < 8; ++e) s += v[e];
    s += __shfl_xor(s, 1); s += __shfl_xor(s, 2); s += __shfl_xor(s, 4);
    const float mean = s * (1.f / 64.f);
    float q = 0.f;
#pragma unroll
    for (int e = 0; e < 8; ++e) { v[e] -= mean; q += v[e] * v[e]; }
    q += __shfl_xor(q, 1); q += __shfl_xor(q, 2); q += __shfl_xor(q, 4);
    const float rstd = 1.0f / sqrtf(q * (1.f / 64.f) + 64e-5f);
    const float bon = BS[(size_t)t * 8 + (lane >> 3)];
    const v4u vraw = *(const v4u*)(VV + (size_t)t * BW + c0), graw = *(const v4u*)(GG + (size_t)t * BW + c0);
    const unsigned vr[4] = {vraw.x, vraw.y, vraw.z, vraw.w}, gr[4] = {graw.x, graw.y, graw.z, graw.w};
    float outv[8];
#pragma unroll
    for (int e = 0; e < 8; ++e) {
        const float vv = (e & 1) ? __uint_as_float(vr[e >> 1] & 0xffff0000u) : __uint_as_float(vr[e >> 1] << 16);
        const float gg = (e & 1) ? __uint_as_float(gr[e >> 1] & 0xffff0000u) : __uint_as_float(gr[e >> 1] << 16);
        outv[e] = (v[e] * rstd * gn_g[c0 + e] + gn_b[c0 + e] + bon * vv) * gg;
    }
    v4u w; w.x = pk2(outv[0], outv[1]); w.y = pk2(outv[2], outv[3]); w.z = pk2(outv[4], outv[5]); w.w = pk2(outv[6], outv[7]);
    *(v4u*)(Y + (size_t)t * D + 512 + c0) = w;
}

__device__ __forceinline__ void vtrans_item(LAS unsigned char* lds, int item, int tid, const bf16* QKV, bf16* VT1, bf16* VT4, bf16* VT16) {
    const int h = item >> 6, blk = item & 63, t0 = blk * 256;
    LAS bf16* Vl = (LAS bf16*)lds;
#pragma unroll
    for (int i = 0; i < 4; ++i) { const int idx = tid + 512 * i, t = idx >> 3, ch = idx & 7;
        *(LAS v4u*)(Vl + t * 72 + ch * 8) = *(const v4u*)(QKV + (size_t)(t0 + t) * NQKV + 2048 + h * 64 + ch * 8); }
    __syncthreads();
#pragma unroll
    for (int i = 0; i < 4; ++i) {
        const int idx = tid + 512 * i, half = idx & 1, dd = (idx >> 1) & 63;
        { const int nbl = idx >> 7; unsigned short e[8];
#pragma unroll
          for (int k = 0; k < 8; ++k) e[k] = Vl[(16 * nbl + 8 * half + k) * 72 + dd];
          v4u o; o.x = e[0] | ((unsigned)e[1] << 16); o.y = e[2] | ((unsigned)e[3] << 16); o.z = e[4] | ((unsigned)e[5] << 16); o.w = e[6] | ((unsigned)e[7] << 16);
          *(v4u*)(VT1 + ((((size_t)h * 1024 + 16 * blk + nbl) * 64 + dd) * 16 + 8 * half)) = o; }
        { const int nbl = (idx >> 7) & 3, c4 = idx >> 9; unsigned short e[8];
#pragma unroll
          for (int k = 0; k < 8; ++k) e[k] = Vl[(4 * (16 * nbl + 8 * half + k) + c4) * 72 + dd];
          v4u o; o.x = e[0] | ((unsigned)e[1] << 16); o.y = e[2] | ((unsigned)e[3] << 16); o.z = e[4] | ((unsigned)e[5] << 16); o.w = e[6] | ((unsigned)e[7] << 16);
          *(v4u*)(VT4 + (((((size_t)h * 4 + c4) * 256 + 4 * blk + nbl) * 64 + dd) * 16 + 8 * half)) = o; }
        { const int c16 = idx >> 7; unsigned short e[8];
#pragma unroll
          for (int k = 0; k < 8; ++k) e[k] = Vl[(16 * (8 * half + k) + c16) * 72 + dd];
          v4u o; o.x = e[0] | ((unsigned)e[1] << 16); o.y = e[2] | ((unsigned)e[3] << 16); o.z = e[4] | ((unsigned)e[5] << 16); o.w = e[6] | ((unsigned)e[7] << 16);
          *(v4u*)(VT16 + (((((size_t)h * 16 + c16) * 64 + blk) * 64 + dd) * 16 + 8 * half)) = o; }
    }
    __syncthreads();
}

struct AttnFrags { bf16x8 ka0, ka1, kb0, kb1, vf[4]; };
template <int DIL>
__device__ __forceinline__ void attn_load(AttnFrags& f, const bf16* Kb, const bf16* VTc, int cp, int nb, int kA, int r, int q4) {
    constexpr int NB16 = M / DIL / 16;
    int posA = cp + DIL * (nb + kA), posB = posA + 4 * DIL;
    posA = posA < 0 ? 0 : (posA > M - 1 ? M - 1 : posA); posB = posB < 0 ? 0 : (posB > M - 1 ? M - 1 : posB);
    f.ka0 = *(const bf16x8*)(Kb + (size_t)posA * NQKV); f.ka1 = *(const bf16x8*)(Kb + (size_t)posA * NQKV + 32);
    f.kb0 = *(const bf16x8*)(Kb + (size_t)posB * NQKV); f.kb1 = *(const bf16x8*)(Kb + (size_t)posB * NQKV + 32);
    int bi = (nb >> 4) + (q4 >> 1); bi = bi < 0 ? 0 : (bi > NB16 - 1 ? NB16 - 1 : bi);
    const bf16* vp = VTc + ((size_t)bi * 64 + r) * 16 + 8 * (q4 & 1);
#pragma unroll
    for (int dt = 0; dt < 4; ++dt) f.vf[dt] = *(const bf16x8*)(vp + dt * 256);
}
__device__ __forceinline__ void attn_group(const AttnFrags& f, int nb, int nlo, int nhi, int q4, const bf16x8 (&qf)[2], f32x4 (&o)[4], float& lrun) {
    const float C = 0.125f * 1.4426950408889634f;
    f32x4 sA = (f32x4){0.f, 0.f, 0.f, 0.f}, sB = sA;
    sA = MFMA16(f.ka0, qf[0], sA); sA = MFMA16(f.ka1, qf[1], sA);
    sB = MFMA16(f.kb0, qf[0], sB); sB = MFMA16(f.kb1, qf[1], sB);
    float p[8]; float ps = 0.f;
    const int n0 = nb + 8 * q4;
#pragma unroll
    for (int e = 0; e < 8; ++e) {
        const int n = n0 + e;
        const float ex = __builtin_amdgcn_exp2f(fminf((e < 4 ? sA[e & 3] : sB[e & 3]) * C, 100.f));
        p[e] = (n >= nlo && n <= nhi) ? ex : 0.f; ps += p[e];
    }
    lrun += ps;
    v4u pw; pw.x = pk2(p[0], p[1]); pw.y = pk2(p[2], p[3]); pw.z = pk2(p[4], p[5]); pw.w = pk2(p[6], p[7]);
    const bf16x8 pf = __builtin_bit_cast(bf16x8, pw);
#pragma unroll
    for (int dt = 0; dt < 4; ++dt) o[dt] = MFMA16(f.vf[dt], pf, o[dt]);
}
template <int DIL, bool FIRST>
__device__ __forceinline__ void attn_tile(LAS float* OACC, LAS float* LACC, const bf16* QKV, const bf16* VT, int h, int blk, int cp, int nq0, int qloc0, int qstep, int lane) {
    constexpr int NB16 = M / DIL / 16;
    const int r = lane & 15, q4 = lane >> 4;
    const int qloc = qloc0 + qstep * r, pos = 256 * blk + qloc;
    bf16x8 qf[2];
    qf[0] = *(const bf16x8*)(QKV + (size_t)pos * NQKV + h * 64 + q4 * 8);
    qf[1] = *(const bf16x8*)(QKV + (size_t)pos * NQKV + h * 64 + 32 + q4 * 8);
    const int nq = nq0 + r, nlo = nq - 128 < 0 ? 0 : nq - 128, nhi = nq, ns = nq0 - 128;
    const int kA = 8 * (r >> 2) + (r & 3);
    const bf16* Kb = QKV + 1024 + h * 64 + q4 * 8;
    const bf16* VTc = VT + (size_t)(h * DIL + cp) * NB16 * 1024;
    f32x4 o[4];
#pragma unroll
    for (int dt = 0; dt < 4; ++dt) o[dt] = (f32x4){0.f, 0.f, 0.f, 0.f};
    float lrun = 0.f;
    AttnFrags fa, fb;
    attn_load<DIL>(fa, Kb, VTc, cp, ns, kA, r, q4);
    attn_load<DIL>(fb, Kb, VTc, cp, ns + 32, kA, r, q4);
    attn_group(fa, ns, nlo, nhi, q4, qf, o, lrun);
    attn_load<DIL>(fa, Kb, VTc, cp, ns + 64, kA, r, q4);
    attn_group(fb, ns + 32, nlo, nhi, q4, qf, o, lrun);
    attn_load<DIL>(fb, Kb, VTc, cp, ns + 96, kA, r, q4);
    attn_group(fa, ns + 64, nlo, nhi, q4, qf, o, lrun);
    attn_load<DIL>(fa, Kb, VTc, cp, ns + 128, kA, r, q4);
    attn_group(fb, ns + 96, nlo, nhi, q4, qf, o, lrun);
    attn_group(fa, ns + 128, nlo, nhi, q4, qf, o, lrun);
    lrun += __shfl_xor(lrun, 16); lrun += __shfl_xor(lrun, 32);
    LAS float* orow = OACC + qloc * 68 + 4 * q4;
#pragma unroll
    for (int dt = 0; dt < 4; ++dt) {
        if (FIRST) *(LAS f32x4*)(orow + 16 * dt) = o[dt];
        else { const f32x4 prev = *(const LAS f32x4*)(orow + 16 * dt); *(LAS f32x4*)(orow + 16 * dt) = prev + o[dt]; }
    }
    if (q4 == 0) { if (FIRST) LACC[qloc] = lrun; else LACC[qloc] += lrun; }
}
__device__ __forceinline__ void attn_item(LAS unsigned char* lds, int item, int tid, int wave, int lane, const bf16* QKV, const bf16* VT1, const bf16* VT4, const bf16* VT16, bf16* AO) {
    const int h = item >> 6, blk = item & 63;
    LAS float* OACC = (LAS float*)lds;
    LAS float* LACC = (LAS float*)(lds + 256 * 68 * 4);
#pragma unroll 1
    for (int a = 0; a < 2; ++a) { const int ti = 2 * wave + a; attn_tile<1, true>(OACC, LACC, QKV, VT1, h, blk, 0, 256 * blk + 16 * ti, 16 * ti, 1, lane); }
    __syncthreads();
#pragma unroll 1
    for (int a = 0; a < 2; ++a) { const int ti = 2 * wave + a, c4 = ti >> 2, jj = ti & 3; attn_tile<4, false>(OACC, LACC, QKV, VT4, h, blk, c4, 64 * blk + 16 * jj, c4 + 64 * jj, 4, lane); }
    __syncthreads();
#pragma unroll 1
    for (int a = 0; a < 2; ++a) { const int ti = 2 * wave + a; attn_tile<16, false>(OACC, LACC, QKV, VT16, h, blk, ti, 16 * blk, ti, 16, lane); }
    __syncthreads();
#pragma unroll
    for (int i = 0; i < 4; ++i) {
        const int idx = tid + 512 * i, q = idx >> 3, j = idx & 7;
        const float inv = 1.0f / LACC[q];
        const f32x4 a0 = *(const LAS f32x4*)(OACC + q * 68 + 8 * j), a1 = *(const LAS f32x4*)(OACC + q * 68 + 8 * j + 4);
        v4u w; w.x = pk2(a0[0] * inv, a0[1] * inv); w.y = pk2(a0[2] * inv, a0[3] * inv); w.z = pk2(a1[0] * inv, a1[1] * inv); w.w = pk2(a1[2] * inv, a1[3] * inv);
        *(v4u*)(AO + (size_t)(256 * blk + q) * D + h * 64 + 8 * j) = w;
    }
    __syncthreads();
}
constexpr int CH_CL = 0, CH_AT = 17408, CH_RT = CH_AT + 9216, CH_BT = CH_RT + 9216, CH_KT = CH_BT + 9216, CH_BHT = CH_KT + 9216, CH_KHT = CH_BHT + 9216, CH_VT = CH_KHT + 9216,
              CH_MABF = CH_VT + 9216, CH_MAK = CH_MABF + 17408, CH_MBR = CH_MAK + 9216, CH_MKR = CH_MBR + 9216, CH_GL = CH_MKR + 9216, CH_MABB = CH_GL + 256, CH_TJ = CH_MABB + 9216, CH_END = CH_TJ + 2048;
static_assert(CH_END <= 147456, "chunk LDS map");
__device__ __forceinline__ void unpack8(const v4u raw, float (&v)[8]) {
    v[0] = __uint_as_float(raw.x << 16); v[1] = __uint_as_float(raw.x & 0xffff0000u); v[2] = __uint_as_float(raw.y << 16); v[3] = __uint_as_float(raw.y & 0xffff0000u);
    v[4] = __uint_as_float(raw.z << 16); v[5] = __uint_as_float(raw.z & 0xffff0000u); v[6] = __uint_as_float(raw.w << 16); v[7] = __uint_as_float(raw.w & 0xffff0000u);
}
__device__ __forceinline__ v4u pack8(const float (&v)[8]) { v4u o; o.x = pk2(v[0], v[1]); o.y = pk2(v[2], v[3]); o.z = pk2(v[4], v[5]); o.w = pk2(v[6], v[7]); return o; }

__device__ __forceinline__ void rwkv_chunk_block(LAS unsigned char* lds, int c, int tid, int wave, int lane, const bf16* P, const RwkvW& W, bf16* VV, bf16* GG, float* BS,
                                                 bf16* PMT, float* SLOC, bf16* QT, float* OLT, bf16* XLG) {
    const int t0 = c * 64;
    bf16* Xg = XLG + (size_t)c * 64 * 256;
    LAS float* CL = (LAS float*)(lds + CH_CL); LAS float* Y5F = (LAS float*)(lds + CH_CL);
    LAS bf16* AT = (LAS bf16*)(lds + CH_AT); LAS bf16* RT = (LAS bf16*)(lds + CH_RT); LAS bf16* BT = (LAS bf16*)(lds + CH_BT); LAS bf16* KT = (LAS bf16*)(lds + CH_KT);
    LAS bf16* UB = BT; LAS bf16* WB = KT;
    LAS bf16* BHT = (LAS bf16*)(lds + CH_BHT); LAS bf16* KHT = (LAS bf16*)(lds + CH_KHT); LAS bf16* VT = (LAS bf16*)(lds + CH_VT);
    LAS float* MABF = (LAS float*)(lds + CH_MABF); LAS bf16* MAK = (LAS bf16*)(lds + CH_MAK); LAS bf16* MBR = (LAS bf16*)(lds + CH_MBR); LAS bf16* MKR = (LAS bf16*)(lds + CH_MKR);
    LAS float* GL = (LAS float*)(lds + CH_GL); LAS bf16* MABB = (LAS bf16*)(lds + CH_MABB); LAS bf16* TJB = (LAS bf16*)(lds + CH_TJ);
    LAS float* LDv = (LAS float*)(lds + CH_AT);
    LAS float* SSP = (LAS float*)(lds + CH_TJ);
    const int r = lane & 15, q4 = lane >> 4, par = wave & 1;
    {
        v4u cur[4], prv[4];
#pragma unroll
        for (int i = 0; i < 4; ++i) {
            const int idx = tid + 512 * i, t = idx >> 5, j8 = (idx & 31) * 8;
            const bf16* p = P + (size_t)(t0 + t) * EIN + 1024 + 1536 + j8;
            cur[i] = *(const v4u*)p;
            if (t0 + t > 0) prv[i] = *(const v4u*)(p - EIN); else { prv[i].x = 0u; prv[i].y = 0u; prv[i].z = 0u; prv[i].w = 0u; }
        }
#pragma unroll
        for (int i = 0; i < 4; ++i) {
            const int idx = tid + 512 * i, t = idx >> 5, j8 = (idx & 31) * 8;
            float cv[8], pv[8], ov[8];
            unpack8(cur[i], cv); unpack8(prv[i], pv);
            const f32x4 m0 = *(const f32x4*)(W.mu + 1536 + j8), m1 = *(const f32x4*)(W.mu + 1536 + j8 + 4);
            const float mu8[8] = {m0.x, m0.y, m0.z, m0.w, m1.x, m1.y, m1.z, m1.w};
#pragma unroll
            for (int e = 0; e < 8; ++e) {
                const float ps = cv[e] + (pv[e] - cv[e]) * mu8[e];
                ov[e] = j8 < 64 ? (1.0f - 2.0f / (1.0f + __expf(2.0f * ps))) : (j8 < 128 ? ps : 1.0f / (1.0f + __expf(-ps)));
            }
            *(v4u*)(Xg + t * 256 + j8) = pack8(ov);
        }
    }
    __threadfence();
    __syncthreads();
    const int tt = wave >> 1;
#pragma unroll 1
    for (int h = 0; h < 8; ++h) {
    const int item = c * 8 + h;
    int tid_o = tid; asm volatile("" : "+v"(tid_o));
    const int tid = tid_o, lane = tid & 63, wave = __builtin_amdgcn_readfirstlane(tid >> 6), r = lane & 15, q4 = lane >> 4, par = wave & 1, tt = wave >> 1;
    (void)lane;
    float kr_[2][4]; unsigned apk[2][2], kpk[2][2], rpk[2][2], vpk[2][2];
    {
        f32x4 aW[2], aA[2], aG[2];
#pragma unroll
        for (int ci = 0; ci < 2; ++ci) { aW[ci] = (f32x4){0.f, 0.f, 0.f, 0.f}; aA[ci] = aW[ci]; aG[ci] = aW[ci]; }
#pragma unroll
        for (int ks = 0; ks < 2; ++ks) {
            const bf16x8 xw = *(const bf16x8*)(Xg + (16 * tt + r) * 256 + ks * 32 + q4 * 8), xa = *(const bf16x8*)(Xg + (16 * tt + r) * 256 + 64 + ks * 32 + q4 * 8);
#pragma unroll
            for (int ci = 0; ci < 2; ++ci) {
                const int crow = h * 64 + 16 * (2 * par + ci) + r;
                const bf16x8 yw = *(const bf16x8*)(W.w2t + (size_t)crow * 64 + ks * 32 + q4 * 8);
                const bf16x8 ya = *(const bf16x8*)(W.a2t + (size_t)crow * 64 + ks * 32 + q4 * 8);
                aW[ci] = MFMA16(xw, yw, aW[ci]); aA[ci] = MFMA16(xa, ya, aA[ci]);
            }
        }
#pragma unroll
        for (int ks = 0; ks < 4; ++ks) {
            const bf16x8 xg = *(const bf16x8*)(Xg + (16 * tt + r) * 256 + 128 + ks * 32 + q4 * 8);
#pragma unroll
            for (int ci = 0; ci < 2; ++ci) {
                const bf16x8 yg = *(const bf16x8*)(W.g2t + (size_t)(h * 64 + 16 * (2 * par + ci) + r) * 128 + ks * 32 + q4 * 8);
                aG[ci] = MFMA16(xg, yg, aG[ci]);
            }
        }
        float ssv[4] = {0.f, 0.f, 0.f, 0.f}, bonv[4] = {0.f, 0.f, 0.f, 0.f};
#pragma unroll
        for (int ci = 0; ci < 2; ++ci) {
            const int cl_ = 16 * (2 * par + ci) + r, cc = h * 64 + cl_;
            unsigned short rc[4], rp[4], kc[4], kpv[4], vc[4], vp[4];
            float av4[4], kp4[4], rv4[4], vv4[4];
            const float w0v = W.w0[cc], a0v = W.a0[cc], kkv = W.k_k[cc], kav = W.k_a[cc], rkv = W.r_k[cc], mur = W.mu[cc], muk = W.mu[512 + cc], muv = W.mu[1024 + cc];
#pragma unroll
            for (int e = 0; e < 4; ++e) {
                const int t = t0 + 16 * tt + 4 * q4 + e;
                const bf16* p = P + (size_t)t * EIN + 1024 + cc;
                const bf16* pp = t > 0 ? p - EIN : p;
                rc[e] = p[0]; kc[e] = p[512]; vc[e] = p[1024];
                rp[e] = pp[0]; kpv[e] = pp[512]; vp[e] = pp[1024];
            }
#pragma unroll
            for (int e = 0; e < 4; ++e) {
                const int tl = 16 * tt + 4 * q4 + e, t = t0 + tl;
                const float rcur = bf2f(rc[e]), kcur = bf2f(kc[e]), vcur = bf2f(vc[e]);
                const float rprev = t > 0 ? bf2f(rp[e]) : 0.f, kprev = t > 0 ? bf2f(kpv[e]) : 0.f, vprev = t > 0 ? bf2f(vp[e]) : 0.f;
                const float rv = rcur + (rprev - rcur) * mur;
                const float kv = kcur + (kprev - kcur) * muk;
                const float vv = vcur + (vprev - vcur) * muv;
                const float xw = -(w0v + aW[ci][e]);
                const float sp = xw > 20.f ? xw : (xw < -10.f ? __expf(xw) : __logf(1.0f + __expf(xw)));
                const float ld = -__expf(-sp - 0.5f);
                const float a = 1.0f / (1.0f + __expf(-(a0v + aA[ci][e])));
                const float kr = kv * kkv;
                const float kp = kv * (1.0f + (a - 1.0f) * kav);
                kr_[ci][e] = kr; av4[e] = a; kp4[e] = kp; rv4[e] = rv; vv4[e] = vv;
                ssv[e] += kr * kr; bonv[e] += rv * kp * rkv;
                LDv[tl * 64 + cl_] = ld;
                const size_t o = (size_t)t * BW + cc;
                VV[o] = (bf16)f2bf(vv); GG[o] = (bf16)f2bf(aG[ci][e]);
            }
            apk[ci][0] = pk2(av4[0], av4[1]); apk[ci][1] = pk2(av4[2], av4[3]); kpk[ci][0] = pk2(kp4[0], kp4[1]); kpk[ci][1] = pk2(kp4[2], kp4[3]);
            rpk[ci][0] = pk2(rv4[0], rv4[1]); rpk[ci][1] = pk2(rv4[2], rv4[3]); vpk[ci][0] = pk2(vv4[0], vv4[1]); vpk[ci][1] = pk2(vv4[2], vv4[3]);
        }
#pragma unroll
        for (int e = 0; e < 4; ++e) {
            const int tl = 16 * tt + 4 * q4 + e;
            float ss = ssv[e], bon = bonv[e];
#pragma unroll
            for (int o = 1; o < 16; o <<= 1) { ss += __shfl_xor(ss, o); bon += __shfl_xor(bon, o); }
            if (r == 0) { SSP[tl * 2 + par] = ss; SSP[128 + tl * 2 + par] = bon; }
        }
    }
    __syncthreads();
    if (tid < 64) {
        float run = 0.f;
#pragma unroll 16
        for (int t = 0; t < 64; ++t) { run += LDv[t * 64 + tid]; CL[t * 64 + tid] = run; }
        GL[tid] = __expf(run);
    } else if (tid < 128) {
        const int tl = tid - 64;
        BS[(size_t)(t0 + tl) * 8 + h] = SSP[128 + tl * 2] + SSP[128 + tl * 2 + 1];
    }
    __syncthreads();
    {
#pragma unroll
        for (int ci = 0; ci < 2; ++ci) {
            const int k = 16 * (2 * par + ci) + r;
            const float clL = CL[63 * 64 + k];
            float bh[4], kh[4];
#pragma unroll
            for (int e = 0; e < 4; ++e) {
                const int tl = 16 * tt + 4 * q4 + e;
                const float inv = 1.0f / sqrtf(fmaxf(SSP[tl * 2] + SSP[tl * 2 + 1], 1e-24f));
                const float kk = bf2f((bf16)f2bf(kr_[ci][e] * inv));
                const float a_e = (e & 1) ? __uint_as_float(apk[ci][e >> 1] & 0xffff0000u) : __uint_as_float(apk[ci][e >> 1] << 16);
                const float kp_e = (e & 1) ? __uint_as_float(kpk[ci][e >> 1] & 0xffff0000u) : __uint_as_float(kpk[ci][e >> 1] << 16);
                const float r_e = (e & 1) ? __uint_as_float(rpk[ci][e >> 1] & 0xffff0000u) : __uint_as_float(rpk[ci][e >> 1] << 16);
                const float bb = bf2f((bf16)f2bf(kk * a_e));
                const float cl = CL[tl * 64 + k], clp = tl > 0 ? CL[(tl - 1) * 64 + k] : 0.f;
                const float en = __expf(-cl), eh = __expf(clL - cl);
                AT[tl * 72 + k] = (bf16)f2bf(-kk * __expf(clp)); RT[tl * 72 + k] = (bf16)f2bf(r_e * __expf(cl));
                BT[tl * 72 + k] = (bf16)f2bf(bb * en); KT[tl * 72 + k] = (bf16)f2bf(kp_e * en);
                bh[e] = bb * eh; kh[e] = kp_e * eh;
            }
            const int tb = 16 * tt + 4 * q4;
            v2u w; w.x = pk2(bh[0], bh[1]); w.y = pk2(bh[2], bh[3]); *(LAS v2u*)(BHT + k * 72 + tb) = w;
            w.x = pk2(kh[0], kh[1]); w.y = pk2(kh[2], kh[3]); *(LAS v2u*)(KHT + k * 72 + tb) = w;
            w.x = vpk[ci][0]; w.y = vpk[ci][1]; *(LAS v2u*)(VT + k * 72 + tb) = w;
        }
    }
    __syncthreads();
    {
        const int mi = wave >> 1;
        const LAS bf16* X = (mi == 0 || mi == 2) ? BT : KT; const LAS bf16* Y = (mi < 2) ? AT : RT;
        f32x4 acc[2][4];
#pragma unroll
        for (int a = 0; a < 2; ++a)
#pragma unroll
            for (int b = 0; b < 4; ++b) acc[a][b] = (f32x4){0.f, 0.f, 0.f, 0.f};
#pragma unroll
        for (int ks = 0; ks < 2; ++ks) {
            bf16x8 xf[2], yf[4];
#pragma unroll
            for (int a = 0; a < 2; ++a) xf[a] = *(const LAS bf16x8*)(X + (16 * (2 * par + a) + r) * 72 + ks * 32 + q4 * 8);
#pragma unroll
            for (int b = 0; b < 4; ++b) yf[b] = *(const LAS bf16x8*)(Y + (16 * b + r) * 72 + ks * 32 + q4 * 8);
#pragma unroll
            for (int a = 0; a < 2; ++a)
#pragma unroll
                for (int b = 0; b < 4; ++b) acc[a][b] = MFMA16(xf[a], yf[b], acc[a][b]);
        }
#pragma unroll
        for (int a = 0; a < 2; ++a)
#pragma unroll
            for (int b = 0; b < 4; ++b) {
                const int s0 = 16 * (2 * par + a) + 4 * q4, t = 16 * b + r;
                f32x4 m;
#pragma unroll
                for (int e = 0; e < 4; ++e) m[e] = ((mi < 2) ? (s0 + e < t) : (s0 + e <= t)) ? acc[a][b][e] : 0.f;
                if (mi == 0) { *(LAS f32x4*)(MABF + t * 68 + s0) = m; v2u w; w.x = pk2(m[0], m[1]); w.y = pk2(m[2], m[3]); *(LAS v2u*)(MABB + t * 72 + s0) = w; }
                else { LAS bf16* Mo = (mi == 1) ? MAK : (mi == 2 ? MBR : MKR); v2u w; w.x = pk2(m[0], m[1]); w.y = pk2(m[2], m[3]); *(LAS v2u*)(Mo + t * 72 + s0) = w; }
            }
    }
    __syncthreads();
    {
        const int vt = wave >> 1;
        f32x4 acc[2];
        acc[0] = (f32x4){0.f, 0.f, 0.f, 0.f}; acc[1] = acc[0];
#pragma unroll
        for (int ks = 0; ks < 2; ++ks) {
            const bf16x8 xf = *(const LAS bf16x8*)(VT + (16 * vt + r) * 72 + ks * 32 + q4 * 8);
#pragma unroll
            for (int b = 0; b < 2; ++b) { const bf16x8 yf = *(const LAS bf16x8*)(MAK + (16 * (2 * par + b) + r) * 72 + ks * 32 + q4 * 8); acc[b] = MFMA16(xf, yf, acc[b]); }
        }
#pragma unroll
        for (int b = 0; b < 2; ++b)
#pragma unroll
            for (int e = 0; e < 4; ++e) Y5F[(16 * vt + 4 * q4 + e) * 68 + 16 * (2 * par + b) + r] = acc[b][e];
    }
    __syncthreads();
    if (wave == 0) {
        const int J = lane >> 4, i = lane & 15;
        float tr[16];
#pragma unroll
        for (int t = 0; t < 16; ++t) {
            float acc = (t == i) ? 1.f : 0.f;
#pragma unroll
            for (int s2 = 0; s2 < t; ++s2) acc += tr[s2] * MABF[(16 * J + t) * 68 + 16 * J + s2];
            tr[t] = acc;
        }
#pragma unroll
        for (int t = 0; t < 16; ++t) TJB[(16 * J + t) * 16 + i] = (bf16)f2bf(tr[t]);
    }
    __syncthreads();
    {
        unsigned xb[4][2];
#pragma unroll
        for (int J = 0; J < 4; ++J) {
            f32x4 z;
            if (wave < 4) z = *(const LAS f32x4*)(Y5F + (16 * wave + r) * 68 + 16 * J + 4 * q4);
            else {
#pragma unroll
                for (int e = 0; e < 4; ++e) z[e] = bf2f(AT[(16 * J + 4 * q4 + e) * 72 + 16 * (wave - 4) + r]);
            }
#pragma unroll
            for (int I = 0; I < J; I += 2) {
                const bool two = (I + 1 < J);
                const v2u m0 = *(const LAS v2u*)(MABB + (16 * J + r) * 72 + 16 * I + 4 * q4);
                v2u m1; m1.x = 0u; m1.y = 0u;
                if (two) m1 = *(const LAS v2u*)(MABB + (16 * J + r) * 72 + 16 * (I + 1) + 4 * q4);
                v4u fa; fa.x = m0.x; fa.y = m0.y; fa.z = m1.x; fa.w = m1.y;
                v4u fb; fb.x = xb[I][0]; fb.y = xb[I][1]; fb.z = two ? xb[I + 1 < 4 ? I + 1 : 3][0] : 0u; fb.w = two ? xb[I + 1 < 4 ? I + 1 : 3][1] : 0u;
                z = MFMA16(__builtin_bit_cast(bf16x8, fa), __builtin_bit_cast(bf16x8, fb), z);
            }
            const unsigned zh0 = pk2(z[0], z[1]), zh1 = pk2(z[2], z[3]);
            const unsigned zl0 = pk2(z[0] - __uint_as_float(zh0 << 16), z[1] - __uint_as_float(zh0 & 0xffff0000u)), zl1 = pk2(z[2] - __uint_as_float(zh1 << 16), z[3] - __uint_as_float(zh1 & 0xffff0000u));
            const v2u tw = *(const LAS v2u*)(TJB + (16 * J + r) * 16 + 4 * q4);
            v4u ft; ft.x = tw.x; ft.y = tw.y; ft.z = 0u; ft.w = 0u;
            v4u fh; fh.x = zh0; fh.y = zh1; fh.z = 0u; fh.w = 0u;
            v4u fl; fl.x = zl0; fl.y = zl1; fl.z = 0u; fl.w = 0u;
            f32x4 x = (f32x4){0.f, 0.f, 0.f, 0.f};
            x = MFMA16(__builtin_bit_cast(bf16x8, ft), __builtin_bit_cast(bf16x8, fh), x);
            x = MFMA16(__builtin_bit_cast(bf16x8, ft), __builtin_bit_cast(bf16x8, fl), x);
            xb[J][0] = pk2(x[0], x[1]); xb[J][1] = pk2(x[2], x[3]);
            LAS bf16* Xo = (wave < 4) ? (UB + (16 * wave + r) * 72) : (WB + (16 * (wave - 4) + r) * 72);
            v2u w; w.x = xb[J][0]; w.y = xb[J][1];
            *(LAS v2u*)(Xo + 16 * J + 4 * q4) = w;
        }
    }
    __syncthreads();
    {
        const int kind = wave >> 1;
        const LAS bf16* X1; const LAS bf16* Y1; const LAS bf16* X2 = nullptr; const LAS bf16* Y2 = nullptr;
        if (kind == 0) { X1 = UB; Y1 = MBR; X2 = VT; Y2 = MKR; }
        else if (kind == 1) { X1 = BHT; Y1 = UB; X2 = KHT; Y2 = VT; }
        else if (kind == 2) { X1 = WB; Y1 = MBR; }
        else { X1 = WB; Y1 = BHT; }
        f32x4 acc[2][4];
#pragma unroll
        for (int a = 0; a < 2; ++a)
#pragma unroll
            for (int b = 0; b < 4; ++b) acc[a][b] = (f32x4){0.f, 0.f, 0.f, 0.f};
#pragma unroll
        for (int ks = 0; ks < 2; ++ks) {
            bf16x8 xf[2], yf[4];
#pragma unroll
            for (int a = 0; a < 2; ++a) xf[a] = *(const LAS bf16x8*)(X1 + (16 * (2 * par + a) + r) * 72 + ks * 32 + q4 * 8);
#pragma unroll
            for (int b = 0; b < 4; ++b) yf[b] = *(const LAS bf16x8*)(Y1 + (16 * b + r) * 72 + ks * 32 + q4 * 8);
#pragma unroll
            for (int a = 0; a < 2; ++a)
#pragma unroll
                for (int b = 0; b < 4; ++b) acc[a][b] = MFMA16(xf[a], yf[b], acc[a][b]);
        }
        if (kind < 2) {
#pragma unroll
            for (int ks = 0; ks < 2; ++ks) {
                bf16x8 xf[2], yf[4];
#pragma unroll
                for (int a = 0; a < 2; ++a) xf[a] = *(const LAS bf16x8*)(X2 + (16 * (2 * par + a) + r) * 72 + ks * 32 + q4 * 8);
#pragma unroll
                for (int b = 0; b < 4; ++b) yf[b] = *(const LAS bf16x8*)(Y2 + (16 * b + r) * 72 + ks * 32 + q4 * 8);
#pragma unroll
                for (int a = 0; a < 2; ++a)
#pragma unroll
                    for (int b = 0; b < 4; ++b) acc[a][b] = MFMA16(xf[a], yf[b], acc[a][b]);
            }
        }
#pragma unroll
        for (int a = 0; a < 2; ++a)
#pragma unroll
            for (int b = 0; b < 4; ++b) {
                const int i0 = 16 * (2 * par + a) + 4 * q4, j = 16 * b + r;
                if (kind == 0) *(f32x4*)(OLT + ((size_t)item * 64 + j) * 64 + i0) = acc[a][b];
                else if (kind == 1) *(f32x4*)(SLOC + ((size_t)item * 64 + j) * 64 + i0) = acc[a][b];
                else if (kind == 2) {
                    const v2u rw = *(const LAS v2u*)(RT + j * 72 + i0);
                    v2u w; w.x = pk2(acc[a][b][0] + __uint_as_float(rw.x << 16), acc[a][b][1] + __uint_as_float(rw.x & 0xffff0000u));
                    w.y = pk2(acc[a][b][2] + __uint_as_float(rw.y << 16), acc[a][b][3] + __uint_as_float(rw.y & 0xffff0000u));
                    *(v2u*)(QT + ((size_t)item * 64 + j) * 64 + i0) = w;
                } else {
                    f32x4 m = acc[a][b];
#pragma unroll
                    for (int e = 0; e < 4; ++e) if (i0 + e == j) m[e] += GL[j];
                    v2u w; w.x = pk2(m[0], m[1]); w.y = pk2(m[2], m[3]);
                    *(v2u*)(PMT + ((size_t)item * 64 + j) * 64 + i0) = w;
                }
            }
    }
    __syncthreads();
    }
}

struct ScanOps { bf16x8 pf[4][2]; f32x4 sl[4]; };
__device__ __forceinline__ void scan_ops_load(ScanOps& o, int it, int v, int r, int q4, const bf16* PMT, const float* SLOC) {
#pragma unroll
    for (int kt = 0; kt < 4; ++kt) {
        o.sl[kt] = *(const f32x4*)(SLOC + ((size_t)it * 64 + v) * 64 + 16 * kt + 4 * q4);
#pragma unroll
        for (int ks = 0; ks < 2; ++ks) {
            const bf16* p = PMT + ((size_t)it * 64 + 16 * kt + r) * 64 + 32 * ks + 4 * q4;
            const v2u lo = *(const v2u*)p, hi = *(const v2u*)(p + 16);
            v4u w; w.x = lo.x; w.y = lo.y; w.z = hi.x; w.w = hi.y;
            o.pf[kt][ks] = __builtin_bit_cast(bf16x8, w);
        }
    }
}
constexpr int SCAN_NS = 8, SCAN_SLOT = 12288, SCAN_FLAGS = SCAN_NS * SCAN_SLOT;
__device__ __forceinline__ void scan_slot_write(const ScanOps& o, LAS unsigned char* slot, int lane) {
    LAS v4u* p = (LAS v4u*)slot;
#pragma unroll
    for (int kt = 0; kt < 4; ++kt) {
        p[(2 * kt) * 64 + lane] = __builtin_bit_cast(v4u, o.pf[kt][0]); p[(2 * kt + 1) * 64 + lane] = __builtin_bit_cast(v4u, o.pf[kt][1]);
        p[(8 + kt) * 64 + lane] = __builtin_bit_cast(v4u, o.sl[kt]);
    }
}
__device__ __forceinline__ void rwkv_state_scan_wg(LAS unsigned char* lds, int hv, int tid, int wave, int lane, const bf16* PMT, const float* SLOC, bf16* SC) {
    const int h = hv >> 2, vt = hv & 3, r = lane & 15, q4 = lane >> 4, v = 16 * vt + r;
    constexpr int NC = M / 64;
    volatile LAS int* ready = (volatile LAS int*)(lds + SCAN_FLAGS);
    volatile LAS int* consumed = (volatile LAS int*)(lds + SCAN_FLAGS + 64);
    if (tid < 32) ((LAS int*)(lds + SCAN_FLAGS))[tid] = 0;
    __syncthreads();
    if (wave == 0) {
        unsigned hw[4][2], lw[4][2];
#pragma unroll
        for (int kt = 0; kt < 4; ++kt) { hw[kt][0] = 0u; hw[kt][1] = 0u; lw[kt][0] = 0u; lw[kt][1] = 0u; }
        for (int c = 0; c < NC; ++c) {
            const int sl = c & (SCAN_NS - 1);
            while (ready[sl] != c + 1) { }
            asm volatile("" ::: "memory");
            const LAS v4u* p = (const LAS v4u*)(lds + sl * SCAN_SLOT);
            v4u pf[4][2], s4[4];
#pragma unroll
            for (int kt = 0; kt < 4; ++kt) { pf[kt][0] = p[(2 * kt) * 64 + lane]; pf[kt][1] = p[(2 * kt + 1) * 64 + lane]; s4[kt] = p[(8 + kt) * 64 + lane]; }
            asm volatile("s_waitcnt lgkmcnt(0)" ::: "memory");
            if (lane == 0) *consumed = c + 1;
            { bf16* sc = SC + ((size_t)(c * 8 + h) * 64 + v) * 64 + 4 * q4;
#pragma unroll
              for (int kt = 0; kt < 4; ++kt) { v2u w; w.x = hw[kt][0]; w.y = hw[kt][1]; *(v2u*)(sc + 16 * kt) = w; } }
            v4u a0, a1, b0, b1;
            a0.x = hw[0][0]; a0.y = hw[0][1]; a0.z = hw[1][0]; a0.w = hw[1][1]; a1.x = hw[2][0]; a1.y = hw[2][1]; a1.z = hw[3][0]; a1.w = hw[3][1];
            b0.x = lw[0][0]; b0.y = lw[0][1]; b0.z = lw[1][0]; b0.w = lw[1][1]; b1.x = lw[2][0]; b1.y = lw[2][1]; b1.z = lw[3][0]; b1.w = lw[3][1];
            const bf16x8 sh0 = __builtin_bit_cast(bf16x8, a0), sh1 = __builtin_bit_cast(bf16x8, a1), sl0 = __builtin_bit_cast(bf16x8, b0), sl1 = __builtin_bit_cast(bf16x8, b1);
#pragma unroll
            for (int kt = 0; kt < 4; ++kt) {
                f32x4 n = __builtin_bit_cast(f32x4, s4[kt]);
                const bf16x8 p0 = __builtin_bit_cast(bf16x8, pf[kt][0]), p1 = __builtin_bit_cast(bf16x8, pf[kt][1]);
                n = MFMA16(p0, sh0, n); n = MFMA16(p1, sh1, n); n = MFMA16(p0, sl0, n); n = MFMA16(p1, sl1, n);
                hw[kt][0] = pk2(n[0], n[1]); hw[kt][1] = pk2(n[2], n[3]);
                lw[kt][0] = pk2(n[0] - __uint_as_float(hw[kt][0] << 16), n[1] - __uint_as_float(hw[kt][0] & 0xffff0000u));
                lw[kt][1] = pk2(n[2] - __uint_as_float(hw[kt][1] << 16), n[3] - __uint_as_float(hw[kt][1] & 0xffff0000u));
            }
        }
    } else {
        const int j = wave - 1;
        ScanOps A, B, C;
        scan_ops_load(A, j * 8 + h, v, r, q4, PMT, SLOC);
        scan_ops_load(B, (j + 7) * 8 + h, v, r, q4, PMT, SLOC);
        scan_ops_load(C, (j + 14) * 8 + h, v, r, q4, PMT, SLOC);
#define SCAN_PUBLISH(BUF, cc) do { const int c_ = (cc); if (c_ < NC) { \
            while (*consumed < c_ - (SCAN_NS - 1)) __builtin_amdgcn_s_sleep(8);     \
            asm volatile("" ::: "memory"); \
            scan_slot_write(BUF, lds + (c_ & (SCAN_NS - 1)) * SCAN_SLOT, lane); \
            asm volatile("s_waitcnt lgkmcnt(0)" ::: "memory"); \
            if (lane == 0) ready[c_ & (SCAN_NS - 1)] = c_ + 1; \
            if (c_ + 21 < NC) scan_ops_load(BUF, (c_ + 21) * 8 + h, v, r, q4, PMT, SLOC); } } while (0)
        for (int c = j; c < NC; c += 21) { SCAN_PUBLISH(A, c); SCAN_PUBLISH(B, c + 7); SCAN_PUBLISH(C, c + 14); }
#undef SCAN_PUBLISH
    }
    __syncthreads();
}
__device__ __forceinline__ void rwkv_chunk_out(int item, int lane, const bf16* SC, const bf16* QT, const float* OLT, const float* BS, const bf16* VV, const bf16* GG,
                                               const float* gn_g, const float* gn_b, bf16* Y) {
    const int c = item >> 3, h = item & 7, r = lane & 15, q4 = lane >> 4;
    bf16x8 sf[4][2];
#pragma unroll
    for (int vt = 0; vt < 4; ++vt)
#pragma unroll
        for (int ks = 0; ks < 2; ++ks) sf[vt][ks] = *(const bf16x8*)(SC + ((size_t)item * 64 + 16 * vt + r) * 64 + 32 * ks + 8 * q4);
    f32x4 gg4[4], gb4[4];
#pragma unroll
    for (int vt = 0; vt < 4; ++vt) { gg4[vt] = *(const f32x4*)(gn_g + h * 64 + 16 * vt + 4 * q4); gb4[vt] = *(const f32x4*)(gn_b + h * 64 + 16 * vt + 4 * q4); }
    for (int tt = 0; tt < 4; ++tt) {
        const int tl = 16 * tt + r, t = c * 64 + tl;
        bf16x8 qf[2];
#pragma unroll
        for (int ks = 0; ks < 2; ++ks) qf[ks] = *(const bf16x8*)(QT + ((size_t)item * 64 + tl) * 64 + 32 * ks + 8 * q4);
        f32x4 o[4]; float s = 0.f;
#pragma unroll
        for (int vt = 0; vt < 4; ++vt) {
            o[vt] = *(const f32x4*)(OLT + ((size_t)item * 64 + tl) * 64 + 16 * vt + 4 * q4);
            o[vt] = MFMA16(sf[vt][0], qf[0], o[vt]); o[vt] = MFMA16(sf[vt][1], qf[1], o[vt]);
            s += (o[vt][0] + o[vt][1]) + (o[vt][2] + o[vt][3]);
        }
        s += __shfl_xor(s, 16); s += __shfl_xor(s, 32);
        const float mean = s * (1.f / 64.f);
        float qv = 0.f;
#pragma unroll
        for (int vt = 0; vt < 4; ++vt) { o[vt] = o[vt] - mean; qv += (o[vt][0] * o[vt][0] + o[vt][1] * o[vt][1]) + (o[vt][2] * o[vt][2] + o[vt][3] * o[vt][3]); }
        qv += __shfl_xor(qv, 16); qv += __shfl_xor(qv, 32);
        const float rstd = 1.0f / sqrtf(qv * (1.f / 64.f) + 64e-5f);
        const float bon = BS[(size_t)t * 8 + h];
#pragma unroll
        for (int vt = 0; vt < 4; ++vt) {
            const size_t oo = (size_t)t * BW + h * 64 + 16 * vt + 4 * q4;
            const v2u vr = *(const v2u*)(VV + oo), gr = *(const v2u*)(GG + oo);
            const float v0 = __uint_as_float(vr.x << 16), v1 = __uint_as_float(vr.x & 0xffff0000u), v2 = __uint_as_float(vr.y << 16), v3 = __uint_as_float(vr.y & 0xffff0000u);
            const float g0 = __uint_as_float(gr.x << 16), g1 = __uint_as_float(gr.x & 0xffff0000u), g2 = __uint_as_float(gr.y << 16), g3 = __uint_as_float(gr.y & 0xffff0000u);
            const f32x4 y = o[vt] * rstd * gg4[vt] + gb4[vt];
            v2u w; w.x = pk2((y[0] + bon * v0) * g0, (y[1] + bon * v1) * g1); w.y = pk2((y[2] + bon * v2) * g2, (y[3] + bon * v3) * g3);
            *(v2u*)(Y + (size_t)t * D + 512 + h * 64 + 16 * vt + 4 * q4) = w;
        }
    }
}
#define XB_TMO      128
#define XB_XCNT(j)  (256  + 64 * (j))
#define XB_XSUB(j)  (1280 + 64 * (j))
#define XB_XGEN(j)  (2304 + 64 * (j))
#define XB_TOP      3328
#define XB_TOPGEN   3392
#define XCD_BAR_WORDS 3456
#define XB_SPIN_CAP (1u << 18)

__device__ __forceinline__ unsigned xb_ld(unsigned* p)              { return __hip_atomic_load(p, __ATOMIC_RELAXED, __HIP_MEMORY_SCOPE_AGENT); }
__device__ __forceinline__ unsigned xb_add(unsigned* p, unsigned v) { return __hip_atomic_fetch_add(p, v, __ATOMIC_RELAXED, __HIP_MEMORY_SCOPE_AGENT); }
__device__ __forceinline__ unsigned xb_xcc_id() { return (unsigned)__builtin_amdgcn_s_getreg((3 << 11) | 20) & 0xFu; }
#define XB_SPIN(cond, bar) do { unsigned _sp = 0; while (cond) { __builtin_amdgcn_s_sleep(1); \
    if ((++_sp & 255u) == 0u) { if (xb_ld(&(bar)[XB_TMO])) break; if (_sp > XB_SPIN_CAP) { atomicAdd(&(bar)[XB_TMO], 1u); break; } } } } while (0)

struct XcdBarrier {
    unsigned* bar; unsigned x;
    volatile LAS unsigned* st;
};

__device__ __forceinline__ XcdBarrier xcd_barrier_post(unsigned* bar, volatile LAS unsigned* st) {
    XcdBarrier b; b.bar = bar; b.x = xb_xcc_id(); b.st = st;
    if (threadIdx.x == 0) (void)xb_add(&bar[XB_XCNT(b.x)], 1u);
    return b;
}
__device__ __forceinline__ void xcd_barrier_complete(unsigned* bar, unsigned x, unsigned& nloc, unsigned& nx) {
    const unsigned G = gridDim.x * gridDim.y * gridDim.z;
    unsigned sum, cnt, mine, sp = 0u;
    for (;;) {
        sum = 0u; cnt = 0u; mine = 0u;
#pragma unroll
        for (unsigned j = 0; j < 16; ++j) { const unsigned c = xb_ld(&bar[XB_XCNT(j)]); sum += c; cnt += (c > 0u) ? 1u : 0u; mine = (j == x) ? c : mine; }
        if (sum == G) break;
        __builtin_amdgcn_s_sleep(1);
        if ((++sp & 255u) == 0u) { if (xb_ld(&bar[XB_TMO])) break; if (sp > XB_SPIN_CAP) { atomicAdd(&bar[XB_TMO], 1u); break; } }
    }
    nloc = mine > 0u ? mine : 1u; nx = cnt > 0u ? cnt : 1u;
}

__device__ __forceinline__ void xcd_barrier(const XcdBarrier& b) {
    asm volatile("s_waitcnt vmcnt(0)" ::: "memory");
    __syncthreads();
    if (threadIdx.x == 0) {
        unsigned* bar = b.bar;
        __builtin_amdgcn_s_waitcnt(0);
        unsigned nloc = b.st[0], nx = b.st[1];
        if (nloc == 0u) { xcd_barrier_complete(bar, b.x, nloc, nx); b.st[0] = nloc; b.st[1] = nx; }
        const unsigned old = xb_add(&bar[XB_XSUB(b.x)], 1u);
        const unsigned gen = old / nloc;
        if (old + 1u == (gen + 1u) * nloc) {
            __builtin_amdgcn_fence(__ATOMIC_RELEASE, "agent");
            asm volatile("s_waitcnt vmcnt(0)" ::: "memory");
            const unsigned og = xb_add(&bar[XB_TOP], 1u);
            const unsigned tg = og / nx;
            if (og + 1u == (tg + 1u) * nx) xb_add(&bar[XB_TOPGEN], 1u);
            else XB_SPIN(xb_ld(&bar[XB_TOPGEN]) == tg, bar);
            __builtin_amdgcn_fence(__ATOMIC_ACQUIRE, "agent");
            xb_add(&bar[XB_XGEN(b.x)], 1u);
            asm volatile("s_waitcnt vmcnt(0)" ::: "memory");
        } else {
            XB_SPIN(xb_ld(&bar[XB_XGEN(b.x)]) == gen, bar);
            __builtin_amdgcn_fence(__ATOMIC_ACQUIRE, "agent");
            asm volatile("s_waitcnt vmcnt(0)" ::: "memory");
        }
    }
    __syncthreads();
}
struct Args { const float* in[28]; float* out; unsigned char* ws; };
#define GRID_SYNC() do { XcdBarrier b_; b_.bar = (unsigned*)args.ws; b_.x = xb_xcc_id(); b_.st = (volatile LAS unsigned*)(lds + LDS_BYTES - 64); xcd_barrier(b_); } while (0)
#define PHASE_VARS int tid = threadIdx.x; asm volatile("" : "+v"(tid)); const int lane = tid & 63; const int wave = __builtin_amdgcn_readfirstlane(tid >> 6); \
    int G = gridDim.x; asm volatile("" : "+s"(G)); int bx = blockIdx.x; asm volatile("" : "+s"(bx)); const int gw = bx * NWAVES + wave, NGW = G * NWAVES; (void)lane; (void)gw; (void)NGW; (void)tid
#define WSP(T, off) ((T*)(args.ws + (off)))
#define XIN (args.in[0])
#define OUTF (args.out)
#define WA WSP(bf16, WS_WA)
#define WB WSP(bf16, WS_WB)
#define XN WSP(bf16, WS_XN)
#define P WSP(bf16, WS_P)
#define LD WSP(float, WS_LD)
#define KK WSP(bf16, WS_KK)
#define BB WSP(bf16, WS_BB)
#define KP WSP(bf16, WS_KP)
#define RR WSP(bf16, WS_RR)
#define VV WSP(bf16, WS_VV)
#define GG ((bf16*)args.out)
#define SCB ((bf16*)((unsigned char*)args.out + 16 * MiB))
#define OLT ((float*)((unsigned char*)args.out + 32 * MiB))
#define PMT WSP(bf16, WS_LD)
#define SLOC WSP(float, WS_LD + 16 * MiB)
#define QTB WSP(bf16, WS_LD + 48 * MiB)
#define BS WSP(float, WS_BS)
#define W2T WSP(bf16, WS_W2T)
#define A2T WSP(bf16, WS_A2T)
#define G2T WSP(bf16, WS_G2T)
#define YC WSP(bf16, WS_XN)
#define ACT WSP(bf16, WS_GEN)
#define QKV WSP(bf16, WS_QKV)
#define VT1 WSP(bf16, WS_VT1)
#define VT4 WSP(bf16, WS_VT4)
#define VT16 WSP(bf16, WS_VT16)
__global__ void __launch_bounds__(NWAVES * 64, 2) hybrid_fwd(Args args) {
    extern __shared__ __attribute__((aligned(16))) unsigned char lds_raw[];
    LAS unsigned char* lds = (LAS unsigned char*)lds_raw;
    if (threadIdx.x < 16) ((LAS unsigned*)(lds + LDS_BYTES - 64))[threadIdx.x] = 0u;
    __syncthreads();
    (void)xcd_barrier_post((unsigned*)args.ws, (volatile LAS unsigned*)(lds + LDS_BYTES - 64));

    { PHASE_VARS;
    {
        LAS float* scr = (LAS float*)(lds + wave * 16384);
        const int IL = 16 + 16 + 32;
        for (int it = gw; it < IL; it += NGW) {
            if (it < 16) transpose_item(args.in[9], 64, 512, W2T, scr, it, lane);
            else if (it < 32) transpose_item(args.in[11], 64, 512, A2T, scr, it - 16, lane);
            else transpose_item(args.in[12], 128, 512, G2T, scr, it - 32, lane);
        }
        norm_phase(lds, gw, NGW, wave, lane, XIN, args.in[1], XN, args.in[2], D, EIN, WA, args.in[18], D, D, WB);
    }

    }
    cg::this_grid().sync();
    { PHASE_VARS;

    {
        pg8::Gemm g{XN, WA, M, EIN, D, 256L * D * 2, 128L * D * 2, 256L * D * 2, 128L * D * 2, 0}; pg8::StaticOrder S; S.init(M, EIN, G, bx);
        pg8::EpiBf16<0> E{P, EIN, nullptr, 0, 0, 1.f};
        pg8::gemm_phase<pg8::EpiBf16<0>, pg8::StaticOrder, true, true>(lds, g, S, E);
    }

    }
    GRID_SYNC();
    { PHASE_VARS;
        RwkvW W{args.in[7], args.in[8], args.in[10], args.in[13], args.in[14], args.in[15], W2T, A2T, G2T};
        for (int ck = bx; ck < M / 64; ck += G) rwkv_chunk_block(lds, ck, tid, wave, lane, P, W, VV, GG, BS, PMT, SLOC, QTB, OLT, WSP(bf16, WS_WA));
    }
    GRID_SYNC();
    { PHASE_VARS;
        if (bx < 32) rwkv_state_scan_wg(lds, bx, tid, wave, lane, PMT, SLOC, SCB);
        else for (int it = bx - 32; it < (M / 128) * 4; it += G - 32) gmlp_item(lds, it, tid, wave, lane, P, args.in[3], args.in[4], args.in[5], args.in[6], YC);
    }
    GRID_SYNC();
    { PHASE_VARS;
        for (int it = gw; it < (M / 64) * 8; it += NGW) rwkv_chunk_out(it, lane, SCB, QTB, OLT, BS, VV, GG, args.in[16], args.in[17], YC);
    }
    GRID_SYNC();
    { PHASE_VARS;

    {
        pg8::Gemm g{YC, WB, M, D, D, 256L * D * 2, 128L * D * 2, 256L * D * 2, 128L * D * 2, 0}; pg8::StaticOrder S; S.init(M, D, G, bx);
        pg8::EpiRes E{XIN, OUTF, D};
        pg8::gemm_phase<pg8::EpiRes, pg8::StaticOrder, true, true>(lds, g, S, E);
    }

    }
    GRID_SYNC();
    { PHASE_VARS;
        norm_phase(lds, gw, NGW, wave, lane, OUTF, args.in[22] + 0 * D, XN, args.in[23] + (size_t)0 * D * FF2, D, FF2, WA, args.in[26] + (size_t)0 * FF * D, FF, D, WB);
    }
    GRID_SYNC();
    { PHASE_VARS;
        pg8::Gemm g{XN - 2 * D, WA, M, FF2, D, 248L * D * 2, 124L * D * 2, 128L * D * 2, 2816L * D * 2, 1}; pg8::StaticOrder S; S.init2(67, 22, G, bx);
        pg8::EpiConvGlu E{ACT, args.in[24] + (size_t)0 * 3 * FF2, args.in[25] + (size_t)0 * FF2, M};
        pg8::gemm_phase<pg8::EpiConvGlu, pg8::StaticOrder, true, true>(lds, g, S, E);
    }
    GRID_SYNC();
    { PHASE_VARS;
        pg8::Gemm g{ACT, WB, M, D, FF, 256L * FF * 2, 128L * FF * 2, 256L * FF * 2, 128L * FF * 2, 0}; pg8::StaticOrder S; S.init(M, D, G, bx);
        pg8::EpiRes E{OUTF, OUTF, D};
        pg8::gemm_phase<pg8::EpiRes, pg8::StaticOrder, true, true>(lds, g, S, E);
    }
    GRID_SYNC();
    { PHASE_VARS;
        norm_phase(lds, gw, NGW, wave, lane, OUTF, args.in[19], XN, args.in[20], D, NQKV, WA, args.in[21], D, D, WB);
    }
    GRID_SYNC();
    { PHASE_VARS;
        pg8::Gemm g{XN, WA, M, NQKV, D, 256L * D * 2, 128L * D * 2, 256L * D * 2, 128L * D * 2, 0}; pg8::StaticOrder S; S.init(M, NQKV, G, bx);
        pg8::EpiBf16<0> E{QKV, NQKV, nullptr, 0, 0, 1.f};
        pg8::gemm_phase<pg8::EpiBf16<0>, pg8::StaticOrder, true, true>(lds, g, S, E);
    }
    GRID_SYNC();
    { PHASE_VARS;
        for (int it = bx; it < 16 * 64; it += G) vtrans_item(lds, it, tid, QKV, VT1, VT4, VT16);
    }
    GRID_SYNC();
    { PHASE_VARS;
        for (int it = bx; it < 16 * 64; it += G) attn_item(lds, it, tid, wave, lane, QKV, VT1, VT4, VT16, YC);
    }
    GRID_SYNC();
    { PHASE_VARS;
        pg8::Gemm g{YC, WB, M, D, D, 256L * D * 2, 128L * D * 2, 256L * D * 2, 128L * D * 2, 0}; pg8::StaticOrder S; S.init(M, D, G, bx);
        pg8::EpiRes E{OUTF, OUTF, D};
        pg8::gemm_phase<pg8::EpiRes, pg8::StaticOrder, true, true>(lds, g, S, E);
    }
    GRID_SYNC();
    { PHASE_VARS;
        norm_phase(lds, gw, NGW, wave, lane, OUTF, args.in[22] + 1 * D, XN, args.in[23] + (size_t)1 * D * FF2, D, FF2, WA, args.in[26] + (size_t)1 * FF * D, FF, D, WB);
    }
    GRID_SYNC();
    { PHASE_VARS;
        pg8::Gemm g{XN - 2 * D, WA, M, FF2, D, 248L * D * 2, 124L * D * 2, 128L * D * 2, 2816L * D * 2, 1}; pg8::StaticOrder S; S.init2(67, 22, G, bx);
        pg8::EpiConvGlu E{ACT, args.in[24] + (size_t)1 * 3 * FF2, args.in[25] + (size_t)1 * FF2, M};
        pg8::gemm_phase<pg8::EpiConvGlu, pg8::StaticOrder, true, true>(lds, g, S, E);
    }
    GRID_SYNC();
    { PHASE_VARS;
        pg8::Gemm g{ACT, WB, M, D, FF, 256L * FF * 2, 128L * FF * 2, 256L * FF * 2, 128L * FF * 2, 0}; pg8::StaticOrder S; S.init(M, D, G, bx);
        pg8::EpiRes E{OUTF, OUTF, D};
        pg8::gemm_phase<pg8::EpiRes, pg8::StaticOrder, true, true>(lds, g, S, E);
    }
    GRID_SYNC();
    { PHASE_VARS;
        for (int m = gw; m < M; m += NGW) rms_row_inplace(OUTF + (size_t)m * D, args.in[27], lane);
    }
}

#undef WSP
#undef XIN
#undef OUTF
#undef WA
#undef WB
#undef XN
#undef P
#undef LD
#undef KK
#undef BB
#undef KP
#undef RR
#undef VV
#undef GG
#undef SCB
#undef OLT
#undef PMT
#undef SLOC
#undef QTB
#undef BS
#undef W2T
#undef A2T
#undef G2T
#undef YC
#undef ACT
#undef QKV
#undef VT1
#undef VT4
#undef VT16
extern "C" void kernel_launch(void* const* d_in, const int* in_sizes, int n_in, void* d_out, int out_size, void* d_ws, size_t ws_size, hipStream_t stream) {
    static int grid = 0;
    if (grid == 0) {
        if (n_in != 28 || in_sizes[0] != M * D || out_size != M * D || ws_size < WS_END) { fprintf(stderr, "kernel_launch: unexpected shapes (n_in %d, in0 %d, out %d, ws %zu)\n", n_in, n_in > 0 ? in_sizes[0] : -1, out_size, ws_size); grid = -1; return; }
        int dev = 0, cus = 0, per_cu = 0;
        if (hipGetDevice(&dev) != hipSuccess || hipDeviceGetAttribute(&cus, hipDeviceAttributeMultiprocessorCount, dev) != hipSuccess) { grid = -1; return; }
        if (hipFuncSetAttribute((const void*)hybrid_fwd, hipFuncAttributeMaxDynamicSharedMemorySize, LDS_BYTES) != hipSuccess) { fprintf(stderr, "kernel_launch: hipFuncSetAttribute failed\n"); grid = -1; return; }
        if (hipOccupancyMaxActiveBlocksPerMultiprocessor(&per_cu, (const void*)hybrid_fwd, NWAVES * 64, LDS_BYTES) != hipSuccess || per_cu < 1) { fprintf(stderr, "kernel_launch: occupancy query says %d\n", per_cu); per_cu = 1; }
        (void)hipGetLastError();
        grid = cus;
    }
    if (grid < 0) return;
    if (hipMemsetAsync(d_ws, 0, 65536, stream) != hipSuccess) { fprintf(stderr, "kernel_launch: hipMemsetAsync failed\n"); return; }
    Args a{};
    for (int i = 0; i < 28; ++i) a.in[i] = (const float*)d_in[i];
    a.out = (float*)d_out; a.ws = (unsigned char*)d_ws;
    void* kargs[] = {&a};
    hipError_t e = hipLaunchCooperativeKernel((const void*)hybrid_fwd, dim3(grid), dim3(NWAVES * 64), kargs, LDS_BYTES, stream);
    if (e != hipSuccess) fprintf(stderr, "kernel_launch: cooperative launch failed: %s (grid %d)\n", hipGetErrorString(e), grid);
}
```

```cpp
#include <hip/hip_runtime.h>
#include <hip/hip_cooperative_groups.h>
#include <cstdio>
#include <cstdint>
namespace cg = cooperative_groups;
namespace pg8 {
#define PG8_LAS __attribute__((address_space(3)))
typedef unsigned short bf16_t;
typedef short bf16x8 __attribute__((ext_vector_type(8)));
typedef float f32x4 __attribute__((ext_vector_type(4)));
typedef unsigned u32x4 __attribute__((ext_vector_type(4)));
constexpr int BM = 256, BK = 64, HALF = 128, HTB = HALF * BK * 2  , STAGE_BYTES = 8 * HTB, NXCD = 8, WGM = 8;

__host__ __device__ __forceinline__ int lds_byte(int r, int c) { const int st = (r >> 4) * 2 + (c >> 5), rr = r & 15, cc = c & 31, ob = rr * 64 + cc * 2; return st * 1024 + (ob ^ (((ob >> 9) & 1) << 5)); }
__host__ __device__ __forceinline__ void stage_rc(int b, int& R, int& C) { const int st = b / 1024, sb = b % 1024, swz = sb ^ (((sb >> 9) & 1) << 5); R = (st >> 1) * 16 + swz / 64; C = (st & 1) * 32 + (swz % 64) / 2; }
__host__ __device__ __forceinline__ int perm32(int rho) { const int n = rho >> 4, i = rho & 15; return 8 * (i >> 2) + 4 * n + (i & 3); }

struct Unit { int pm, pn; };
struct Gemm { const bf16_t* A; const bf16_t* Bt; int M, N, K; long tA, hA, tB, hB; int remapA; };

struct StaticOrder {
    int nM, nN, nwg, G, c;
    __host__ __device__ void init(int M, int N, int G_, int c_) { nM = M / BM; nN = N / BM; nwg = nM * nN; G = G_; c = c_; }
    __host__ __device__ void init2(int nM_, int nN_, int G_, int c_) { nM = nM_; nN = nN_; nwg = nM * nN; G = G_; c = c_; }
    __host__ __device__ bool next(int i, Unit& u) const {
        const long L = (long)i * G + c; if (L >= nwg) return false;
        int wgid = (int)L; { const int q = nwg / NXCD, r = nwg % NXCD, xcd = wgid % NXCD, off = wgid / NXCD; wgid = (xcd < r ? xcd * (q + 1) : r * (q + 1) + (xcd - r) * q) + off; }
        const int nig = WGM * nN, gid = wgid / nig, fm = gid * WGM, gsz = (nM - fm) < WGM ? (nM - fm) : WGM;
        u.pm = fm + ((wgid % nig) % gsz); u.pn = (wgid % nig) / gsz; return true;
    }
    __device__ __forceinline__ void a_ready(const Unit&) const {}
    __device__ __forceinline__ void done(const Unit&) const {}
};

__device__ __forceinline__ unsigned cvt_pk_bf16(float lo, float hi) { unsigned r; asm volatile("v_cvt_pk_bf16_f32 %0, %1, %2" : "=v"(r) : "v"(lo), "v"(hi)); return r; }
typedef float f32x2 __attribute__((ext_vector_type(2)));
__device__ __forceinline__ f32x2 gelu_pk(f32x2 v) {
    const f32x2 av = __builtin_elementwise_abs(v), d = av * 0.2316418882f + 1.0f;
    f32x2 t; t.x = __builtin_amdgcn_rcpf(d.x); t.y = __builtin_amdgcn_rcpf(d.y);
    f32x2 q = t * 0.5307027145f + (-0.7265760135f); q = q * t + 0.7107068705f; q = q * t + (-0.142248368f); q = q * t + 0.127414796f; q = q * t;
    const f32x2 s = (v * v) * (-0.72134752044f);
    f32x2 e; e.x = __builtin_amdgcn_exp2f(s.x); e.y = __builtin_amdgcn_exp2f(s.y);
    const f32x2 m = v * (q * e), r = v - m;
    f32x2 o; o.x = v.x < 0.f ? m.x : r.x; o.y = v.y < 0.f ? m.y : r.y; return o;
}

template <int ACT  > struct EpiBf16 {
    static constexpr bool PERM = true, AFTER_DRAIN = false; static_assert(ACT == 0 || ACT == 1, "EpiBf16: ACT is 0 (none) or 1 (gelu_pk)");
    bf16_t* O; int ldc; const float* bias; int split_cols; size_t split_stride; float scale0;
    __device__ __forceinline__ void operator()(const f32x4 (&acc)[2][2][4][2], const Unit& u, int wr, int wc, int fr, int fq) const {
        const int row0 = u.pm * BM + wr * 64 + fr; int colt = u.pn * BM; bf16_t* base = O;
        float sc = 1.f; if (split_cols) { const int t = colt / split_cols; base += (size_t)t * split_stride; colt -= t * split_cols; if (t == 0) sc = scale0; }
        const int col0 = colt + wc * 32 + 8 * fq, bcol0 = u.pn * BM + wc * 32 + 8 * fq;
        f32x4 bv[2][2];
#pragma unroll
        for (int bj = 0; bj < 2; ++bj)
#pragma unroll
            for (int n = 0; n < 2; ++n) bv[bj][n] = bias ? *(const f32x4*)(bias + bcol0 + bj * HALF + 4 * n) : (f32x4){0.f, 0.f, 0.f, 0.f};
#pragma unroll
        for (int ai = 0; ai < 2; ++ai)
#pragma unroll
            for (int m = 0; m < 4; ++m) { bf16_t* rowp = base + (size_t)(row0 + ai * HALF + m * 16) * ldc + col0;
#pragma unroll
                for (int bj = 0; bj < 2; ++bj) { f32x4 v0 = acc[ai][bj][m][0] + bv[bj][0], v1 = acc[ai][bj][m][1] + bv[bj][1];
                    if (ACT == 1) { f32x2 a = gelu_pk((f32x2){v0[0], v0[1]}), b = gelu_pk((f32x2){v0[2], v0[3]}), c = gelu_pk((f32x2){v1[0], v1[1]}), d = gelu_pk((f32x2){v1[2], v1[3]});
                        v0 = (f32x4){a.x, a.y, b.x, b.y}; v1 = (f32x4){c.x, c.y, d.x, d.y}; }
                    v0 = v0 * sc; v1 = v1 * sc; u32x4 w; w.x = cvt_pk_bf16(v0[0], v0[1]); w.y = cvt_pk_bf16(v0[2], v0[3]); w.z = cvt_pk_bf16(v1[0], v1[1]); w.w = cvt_pk_bf16(v1[2], v1[3]);
                    *(u32x4*)(rowp + bj * HALF) = w; } }
    }
};

template <class Epi, class Sched, bool ALIGN_EPI = false, bool SP2 = false>
__device__ __forceinline__ void gemm_phase(PG8_LAS unsigned char* lds, const Gemm g, const Sched& S, const Epi& E) {
    int tid_ = threadIdx.x; asm volatile("" : "+v"(tid_));
    const int tid = tid_, wid = __builtin_amdgcn_readfirstlane(tid >> 6), lane = tid & 63, wr = wid >> 2, wc = wid & 3, fr = lane & 15, fq = lane >> 4;
    const int K = g.K, nt = K / BK;
    unsigned voffA[2], voffB[2];
#pragma unroll
    for (int i = 0; i < 2; ++i) { int R, C; stage_rc(tid * 16 + i * 8192, R, C); const int Rb = Epi::PERM ? ((R & ~31) + perm32(R & 31)) : R;
        const int Ra = g.remapA ? (R - (R >= 64 ? 2 : 0)) : R; voffA[i] = (unsigned)(Ra * K + C) * 2u; voffB[i] = (unsigned)(Rb * K + C) * 2u; }
    const size_t kstep = (size_t)(BK * 2);
    const size_t hA = (size_t)g.hA, hB = (size_t)g.hB, tA = (size_t)g.tA, tB = (size_t)g.tB;
    const unsigned ldsw = (unsigned)wid * 1024u;
    const int aoff = lds_byte(wr * 64 + fr, fq * 8), boff = lds_byte(wc * 32 + fr, fq * 8);
#define PG8_SA(b, h) (((b) * 2 + (h)) * HTB)
#define PG8_SB(b, h) ((4 + (b) * 2 + (h)) * HTB)
#define PG8_STAGE(bufoff, gbase, voff) do { _Pragma("unroll") for (int _i = 0; _i < 2; ++_i) \
        __builtin_amdgcn_global_load_lds((const unsigned*)((const char*)(gbase) + (voff)[_i]), (PG8_LAS unsigned*)(lds + (bufoff) + ldsw + _i * 8192), 16, 0, 0); } while (0)
#define PG8_LDA(dst, b, h) do { _Pragma("unroll") for (int m = 0; m < 4; ++m) _Pragma("unroll") for (int k = 0; k < 2; ++k) dst[m][k] = *(const PG8_LAS bf16x8*)(lds + PG8_SA(b, h) + aoff + m * 2048 + k * 1024); } while (0)
#define PG8_LDB(dst, b, h) do { _Pragma("unroll") for (int n = 0; n < 2; ++n) _Pragma("unroll") for (int k = 0; k < 2; ++k) dst[n][k] = *(const PG8_LAS bf16x8*)(lds + PG8_SB(b, h) + boff + n * 2048 + k * 1024); } while (0)
#define PG8_MMA(ai, bj, At, Bt) do { __builtin_amdgcn_s_setprio(1); _Pragma("unroll") for (int m = 0; m < 4; ++m) _Pragma("unroll") for (int n = 0; n < 2; ++n) _Pragma("unroll") for (int k = 0; k < 2; ++k) \
        acc[ai][bj][m][n] = __builtin_amdgcn_mfma_f32_16x16x32_bf16(Bt[n][k], At[m][k], acc[ai][bj][m][n], 0, 0, 0); __builtin_amdgcn_s_setprio(0); } while (0)
#define PG8_WAIT_V(n) asm volatile("s_waitcnt vmcnt(" #n ")" ::: "memory")
#define PG8_WAIT_L(n) asm volatile("s_waitcnt lgkmcnt(" #n ")" ::: "memory")
#define PG8_BAR __builtin_amdgcn_s_barrier()
#define PG8_SCHED __builtin_amdgcn_sched_barrier(0)
    Unit cur, nxt; int ui = 0;
    if (!S.next(0, cur)) return;
    f32x4 acc[2][2][4][2];
#pragma unroll
    for (int a = 0; a < 2; ++a)
#pragma unroll
        for (int b = 0; b < 2; ++b)
#pragma unroll
            for (int m = 0; m < 4; ++m)
#pragma unroll
                for (int n = 0; n < 2; ++n) acc[a][b][m][n] = (f32x4){0.f, 0.f, 0.f, 0.f};
    bf16x8 At[4][2], B0[2][2], B1[2][2];
    const char* cA = (const char*)g.A + (size_t)cur.pm * tA; const char* cB = (const char*)g.Bt + (size_t)cur.pn * tB;
    S.a_ready(cur);
    if constexpr (SP2) {
        PG8_STAGE(PG8_SB(0, 0), cB, voffB); PG8_STAGE(PG8_SB(0, 1), cB + hB, voffB); PG8_STAGE(PG8_SA(0, 0), cA, voffA); PG8_STAGE(PG8_SA(0, 1), cA + hA, voffA);
        if (wr == 1) PG8_BAR;
        PG8_WAIT_V(2); PG8_BAR;
        PG8_STAGE(PG8_SB(1, 0), cB + kstep, voffB); PG8_STAGE(PG8_SA(1, 0), cA + kstep, voffA); PG8_STAGE(PG8_SB(1, 1), cB + hB + kstep, voffB);
        PG8_WAIT_V(6); PG8_BAR;
    } else {
        PG8_STAGE(PG8_SB(0, 0), cB, voffB); PG8_STAGE(PG8_SA(0, 0), cA, voffA); PG8_STAGE(PG8_SB(0, 1), cB + hB, voffB); PG8_STAGE(PG8_SA(0, 1), cA + hA, voffA);
        if (wr == 1) PG8_BAR;
        PG8_WAIT_V(4); PG8_BAR;
        PG8_STAGE(PG8_SB(1, 0), cB + kstep, voffB); PG8_STAGE(PG8_SA(1, 0), cA + kstep, voffA); PG8_STAGE(PG8_SB(1, 1), cB + hB + kstep, voffB);
        PG8_WAIT_V(6); PG8_BAR;
    }
    for (;;) {
        const bool has_next = S.next(ui + 1, nxt);
        const char* nA = has_next ? (const char*)g.A + (size_t)nxt.pm * tA : cA; const char* nB = has_next ? (const char*)g.Bt + (size_t)nxt.pn * tB : cB;
        for (int t = 0; t < nt; t += 2) {
            const bool last = (t == nt - 2);
            const char* a1 = cA + (size_t)(t + 1) * kstep;
            const char* a2 = last ? nA : cA + (size_t)(t + 2) * kstep; const char* b2 = last ? nB : cB + (size_t)(t + 2) * kstep;
            const char* a3 = a2 + kstep; const char* b3 = b2 + kstep;
            if (last && has_next) S.a_ready(nxt);
            if constexpr (SP2) {
            PG8_LDB(B0, 0, 0); PG8_LDB(B1, 0, 1); PG8_SCHED; PG8_LDA(At, 0, 0); PG8_STAGE(PG8_SA(1, 1), a1 + hA, voffA);
            PG8_WAIT_V(8); PG8_WAIT_L(0); PG8_BAR; PG8_MMA(0, 0, At, B0); PG8_MMA(0, 1, At, B1); PG8_BAR; PG8_SCHED;
            PG8_LDA(At, 0, 1); PG8_STAGE(PG8_SB(0, 0), b2, voffB); PG8_STAGE(PG8_SB(0, 1), b2 + hB, voffB); PG8_STAGE(PG8_SA(0, 0), a2, voffA);
            PG8_WAIT_V(8); PG8_WAIT_L(0); PG8_BAR; PG8_MMA(1, 0, At, B0); PG8_MMA(1, 1, At, B1); PG8_BAR; PG8_SCHED;
            PG8_LDB(B0, 1, 0); PG8_LDB(B1, 1, 1); PG8_SCHED; PG8_LDA(At, 1, 0); PG8_STAGE(PG8_SA(0, 1), a2 + hA, voffA);
            PG8_WAIT_V(8); PG8_WAIT_L(0); PG8_BAR; PG8_MMA(0, 0, At, B0); PG8_MMA(0, 1, At, B1); PG8_BAR; PG8_SCHED;
            PG8_LDA(At, 1, 1); PG8_STAGE(PG8_SB(1, 0), b3, voffB); PG8_STAGE(PG8_SB(1, 1), b3 + hB, voffB); PG8_STAGE(PG8_SA(1, 0), a3, voffA);
            PG8_WAIT_V(8); PG8_WAIT_L(0); PG8_BAR; PG8_MMA(1, 0, At, B0); PG8_MMA(1, 1, At, B1); PG8_BAR; PG8_SCHED;
            } else {
            PG8_LDB(B0, 0, 0); PG8_SCHED; PG8_LDA(At, 0, 0); PG8_STAGE(PG8_SA(1, 1), a1 + hA, voffA);
            PG8_WAIT_L(8); PG8_BAR; PG8_WAIT_L(0); PG8_MMA(0, 0, At, B0); PG8_BAR; PG8_SCHED;
            PG8_LDB(B1, 0, 1); PG8_STAGE(PG8_SB(0, 0), b2, voffB);
            PG8_BAR; PG8_WAIT_L(0); PG8_MMA(0, 1, At, B1); PG8_BAR;
            PG8_LDA(At, 0, 1); PG8_STAGE(PG8_SA(0, 0), a2, voffA);
            PG8_BAR; PG8_WAIT_L(0); PG8_MMA(1, 0, At, B0); PG8_BAR; PG8_SCHED;
            PG8_STAGE(PG8_SB(0, 1), b2 + hB, voffB);
            PG8_WAIT_V(6); PG8_BAR; PG8_MMA(1, 1, At, B1); PG8_BAR;
            PG8_LDB(B0, 1, 0); PG8_SCHED; PG8_LDA(At, 1, 0); PG8_STAGE(PG8_SA(0, 1), a2 + hA, voffA);
            PG8_WAIT_L(8); PG8_BAR; PG8_WAIT_L(0); PG8_MMA(0, 0, At, B0); PG8_BAR; PG8_SCHED;
            PG8_LDB(B1, 1, 1); PG8_STAGE(PG8_SB(1, 0), b3, voffB);
            PG8_BAR; PG8_WAIT_L(0); PG8_MMA(0, 1, At, B1); PG8_BAR;
            PG8_LDA(At, 1, 1); PG8_STAGE(PG8_SA(1, 0), a3, voffA);
            PG8_BAR; PG8_WAIT_L(0); PG8_MMA(1, 0, At, B0); PG8_BAR; PG8_SCHED;
            PG8_STAGE(PG8_SB(1, 1), b3 + hB, voffB);
            PG8_WAIT_V(6); PG8_BAR; PG8_MMA(1, 1, At, B1); PG8_BAR;
            }
        }
        if constexpr (ALIGN_EPI) { if (wr == 0) PG8_BAR; }
        if constexpr (!Epi::AFTER_DRAIN) { E(acc, cur, wr, wc, fr, fq); S.done(cur); }
        if (!has_next) break;
#pragma unroll
        for (int a = 0; a < 2; ++a)
#pragma unroll
            for (int b = 0; b < 2; ++b)
#pragma unroll
                for (int m = 0; m < 4; ++m)
#pragma unroll
                    for (int n = 0; n < 2; ++n) acc[a][b][m][n] = (f32x4){0.f, 0.f, 0.f, 0.f};
        cur = nxt; cA = nA; cB = nB; ++ui;
        if constexpr (ALIGN_EPI) { if (wr == 1) PG8_BAR; }
    }
    PG8_WAIT_V(0);
    if constexpr (!ALIGN_EPI) { if (wr == 0) PG8_BAR; }
    PG8_BAR;
    if constexpr (Epi::AFTER_DRAIN) { E.fused(acc, cur, wr, wc, fr, fq, lds, wid, lane); S.done(cur); }
#undef PG8_SA
#undef PG8_SB
#undef PG8_STAGE
#undef PG8_LDA
#undef PG8_LDB
#undef PG8_MMA
#undef PG8_WAIT_V
#undef PG8_WAIT_L
#undef PG8_BAR
#undef PG8_SCHED
}
}
namespace pg8 {
template <int N> __device__ __forceinline__ float row_ror(float v) {
    return __builtin_bit_cast(float, __builtin_amdgcn_update_dpp(0, __builtin_bit_cast(int, v), 0x120 + N, 0xf, 0xf, false));
}
}
namespace pg8 {
struct EpiRes {
    static constexpr bool PERM = false, AFTER_DRAIN = false;
    const float* base; float* out; int ldc;
    __device__ __forceinline__ void operator()(const f32x4 (&acc)[2][2][4][2], const Unit& u, int wr, int wc, int fr, int fq) const {
        const int col0 = u.pn * BM + wc * 32 + 4 * fq;
#pragma unroll
        for (int ai = 0; ai < 2; ++ai)
#pragma unroll
            for (int m = 0; m < 4; ++m) { const size_t off = (size_t)(u.pm * BM + ai * HALF + wr * 64 + m * 16 + fr) * ldc + col0;
#pragma unroll
                for (int bj = 0; bj < 2; ++bj)
#pragma unroll
                    for (int n = 0; n < 2; ++n) { const f32x4 b = *(const f32x4*)(base + off + bj * HALF + n * 16); *(f32x4*)(out + off + bj * HALF + n * 16) = b + acc[ai][bj][m][n]; } }
    }
};
struct EpiConvGlu {
    static constexpr bool PERM = false, AFTER_DRAIN = false;
    bf16_t* O; const float* cw; const float* cb; int M;
    __device__ __forceinline__ void operator()(const f32x4 (&acc)[2][2][4][2], const Unit& u, int wr, int wc, int fr, int fq) const {
        const int lane = fq * 16 + fr;
        const int src1 = fq * 16 + ((fr + 15) & 15), src2 = fq * 16 + ((fr + 14) & 15);
#pragma unroll
        for (int ai = 0; ai < 2; ++ai) {
            const int pb = 248 * u.pm + 62 * (2 * ai + wr) - 2;
#pragma unroll
            for (int n = 0; n < 2; ++n) {
                const int jg = 128 * u.pn + 32 * wc + 16 * n + 4 * fq;
                const f32x4 g0 = *(const f32x4*)(cw + jg), g1 = *(const f32x4*)(cw + 5632 + jg), g2 = *(const f32x4*)(cw + 2 * 5632 + jg), gb = *(const f32x4*)(cb + jg);
                const f32x4 v0 = *(const f32x4*)(cw + 2816 + jg), v1 = *(const f32x4*)(cw + 5632 + 2816 + jg), v2 = *(const f32x4*)(cw + 2 * 5632 + 2816 + jg), vb = *(const f32x4*)(cb + 2816 + jg);
                f32x4 pg1, pg2, pv1, pv2;
#pragma unroll
                for (int m = 0; m < 4; ++m) {
                    f32x4 zg = acc[ai][0][m][n], zv = acc[ai][1][m][n];
                    const int pos = pb + 16 * m + fr;
                    if (pos < 0) { zg = (f32x4){0.f, 0.f, 0.f, 0.f}; zv = zg; }
                    f32x4 rg1, rg2, rv1, rv2;
#pragma unroll
                    for (int e = 0; e < 4; ++e) { rg1[e] = row_ror<1>(zg[e]); rg2[e] = row_ror<2>(zg[e]); rv1[e] = row_ror<1>(zv[e]); rv2[e] = row_ror<2>(zv[e]); }
                    f32x4 zg1, zg2, zv1, zv2;
                    if (m == 0) { zg1 = rg1; zg2 = rg2; zv1 = rv1; zv2 = rv2; }
                    else {
#pragma unroll
                        for (int e = 0; e < 4; ++e) { zg1[e] = fr >= 1 ? rg1[e] : pg1[e]; zg2[e] = fr >= 2 ? rg2[e] : pg2[e]; zv1[e] = fr >= 1 ? rv1[e] : pv1[e]; zv2[e] = fr >= 2 ? rv2[e] : pv2[e]; }
                    }
                    pg1 = rg1; pg2 = rg2; pv1 = rv1; pv2 = rv2;
                    const f32x4 cg = g0 * zg2 + g1 * zg1 + g2 * zg + gb;
                    const f32x4 cv = v0 * zv2 + v1 * zv1 + v2 * zv + vb;
                    f32x4 a;
#pragma unroll
                    for (int e = 0; e < 4; ++e) a[e] = cg[e] / (1.0f + __expf(-cg[e])) * cv[e];
                    if ((16 * m + fr) >= 2 && pos < M) {
                        typedef unsigned u32x2 __attribute__((ext_vector_type(2)));
                        u32x2 w; w.x = cvt_pk_bf16(a[0], a[1]); w.y = cvt_pk_bf16(a[2], a[3]);
                        *(u32x2*)(O + (size_t)pos * 2816 + jg) = w;
                    }
                }
            }
        }
        (void)lane;
    }
};
}
#define LAS __attribute__((address_space(3)))
typedef unsigned short bf16;
typedef float f32x4 __attribute__((ext_vector_type(4)));
typedef short bf16x8 __attribute__((ext_vector_type(8)));
typedef unsigned v4u __attribute__((ext_vector_type(4)));
typedef unsigned v2u __attribute__((ext_vector_type(2)));
constexpr int NWAVES = 8;
constexpr int M = 16384, D = 1024, EIN = 2816, FF = 2816, FF2 = 5632, NQKV = 3072, BW = 512;
constexpr size_t MiB = 1u << 20;
constexpr size_t WS_W2T = 1 * MiB, WS_A2T = WS_W2T + 65536, WS_G2T = WS_A2T + 65536, WS_BS = WS_G2T + 131072;
constexpr size_t WS_WA = 2 * MiB, WS_WB = 13 * MiB, WS_XN = 20 * MiB, WS_GEN = 52 * MiB, WS_END = 256 * MiB;
constexpr size_t WS_P = WS_GEN, WS_LD = WS_GEN + 88 * MiB, WS_KK = WS_LD + 32 * MiB, WS_BB = WS_KK + 16 * MiB, WS_KP = WS_BB + 16 * MiB, WS_RR = WS_KP + 16 * MiB, WS_VV = WS_RR + 16 * MiB;
static_assert(WS_VV + 16 * MiB <= WS_END, "ws map");
constexpr size_t WS_QKV = WS_GEN, WS_VT1 = WS_GEN + 96 * MiB, WS_VT4 = WS_VT1 + 32 * MiB, WS_VT16 = WS_VT4 + 32 * MiB;
static_assert(WS_VT16 + 33 * MiB <= WS_END, "ws map");
constexpr int LDS_BYTES = 147456;

__device__ __forceinline__ float bf2f(unsigned short v) { return __uint_as_float(((unsigned)v) << 16); }
typedef float f32x2_t __attribute__((ext_vector_type(2))); typedef __bf16 bf16x2_t __attribute__((ext_vector_type(2)));
__device__ __forceinline__ unsigned pk2(float lo, float hi) { f32x2_t v = {lo, hi}; bf16x2_t b = __builtin_convertvector(v, bf16x2_t); return __builtin_bit_cast(unsigned, b); }
__device__ __forceinline__ unsigned f2bf(float f) { return pk2(f, f) & 0xffffu; }
__device__ __forceinline__ float wave_sum(float v) {
#pragma unroll
    for (int o = 1; o < 64; o <<= 1) v += __shfl_xor(v, o);
    return v;
}
__device__ __forceinline__ float dpp_row_shr(float v, int n) {
    const int iv = __builtin_bit_cast(int, v); int r;
    switch (n) { case 1: r = __builtin_amdgcn_update_dpp(0, iv, 0x111, 0xf, 0xf, true); break; case 2: r = __builtin_amdgcn_update_dpp(0, iv, 0x112, 0xf, 0xf, true); break;
                 case 4: r = __builtin_amdgcn_update_dpp(0, iv, 0x114, 0xf, 0xf, true); break; default: r = __builtin_amdgcn_update_dpp(0, iv, 0x118, 0xf, 0xf, true); break; }
    return __builtin_bit_cast(float, r);
}
__device__ __forceinline__ float wave_sum_uniform(float v) {
    v += dpp_row_shr(v, 1); v += dpp_row_shr(v, 2); v += dpp_row_shr(v, 4); v += dpp_row_shr(v, 8);
    v += __builtin_bit_cast(float, __builtin_amdgcn_update_dpp(0, __builtin_bit_cast(int, v), 0x142, 0xa, 0xf, false));
    v += __builtin_bit_cast(float, __builtin_amdgcn_update_dpp(0, __builtin_bit_cast(int, v), 0x143, 0xc, 0xf, false));
    return __builtin_bit_cast(float, __builtin_amdgcn_readlane(__builtin_bit_cast(int, v), 63));
}
#define MFMA16(a, b, c) __builtin_amdgcn_mfma_f32_16x16x32_bf16((a), (b), (c), 0, 0, 0)

__device__ __forceinline__ void transpose_item(const float* W, int K, int N, bf16* WT, LAS float* scr, int item, int lane) {
    const int nblk = N / 32, kb = item / nblk, nb = item % nblk, k0 = 64 * kb, n0 = 32 * nb;
    float wv[32];
#pragma unroll
    for (int i = 0; i < 32; ++i) wv[i] = W[(size_t)(k0 + 2 * i + (lane >> 5)) * N + n0 + (lane & 31)];
#pragma unroll
    for (int i = 0; i < 32; ++i) scr[(2 * i + (lane >> 5)) * 33 + (lane & 31)] = wv[i];
    asm volatile("s_waitcnt lgkmcnt(0)" ::: "memory");
    const int c = lane & 7;
#pragma unroll
    for (int j = 0; j < 4; ++j) { const int n = (lane >> 3) + 8 * j; const LAS float* s = scr + (8 * c) * 33 + n;
        v4u o; o.x = pk2(s[0 * 33], s[1 * 33]); o.y = pk2(s[2 * 33], s[3 * 33]); o.z = pk2(s[4 * 33], s[5 * 33]); o.w = pk2(s[6 * 33], s[7 * 33]);
        *(v4u*)(WT + (size_t)(n0 + n) * K + k0 + 8 * c) = o; }
    asm volatile("s_waitcnt lgkmcnt(0)" ::: "memory");
}
__device__ __forceinline__ void rms_row_to_bf16(const float* xrow, const float* gain, bf16* orow, int lane) {
    const f32x4* xr = (const f32x4*)xrow + lane; const f32x4* gr = (const f32x4*)gain + lane;
    f32x4 v[4]; float s = 0.f;
#pragma unroll
    for (int j = 0; j < 4; ++j) { v[j] = xr[64 * j]; s += (v[j].x * v[j].x + v[j].y * v[j].y) + (v[j].z * v[j].z + v[j].w * v[j].w); }
    const float rstd = 1.0f / sqrtf(wave_sum(s) * (1.f / D) + 1e-6f);
    v2u* o8 = (v2u*)orow + lane;
#pragma unroll
    for (int j = 0; j < 4; ++j) { const f32x4 g = gr[64 * j]; v2u w; w.x = pk2(v[j].x * rstd * g.x, v[j].y * rstd * g.y); w.y = pk2(v[j].z * rstd * g.z, v[j].w * rstd * g.w); o8[64 * j] = w; }
}
__device__ __forceinline__ void rms_row2_to_bf16(const float* xa, const float* xb, const float* gain, bf16* oa, bf16* ob, int lane) {
    const f32x4* ra = (const f32x4*)xa + lane; const f32x4* rb = (const f32x4*)xb + lane; const f32x4* gr = (const f32x4*)gain + lane;
    f32x4 va[4], vb[4]; float sa = 0.f, sb = 0.f;
#pragma unroll
    for (int j = 0; j < 4; ++j) { va[j] = ra[64 * j]; vb[j] = rb[64 * j]; }
#pragma unroll
    for (int j = 0; j < 4; ++j) { sa += (va[j].x * va[j].x + va[j].y * va[j].y) + (va[j].z * va[j].z + va[j].w * va[j].w); sb += (vb[j].x * vb[j].x + vb[j].y * vb[j].y) + (vb[j].z * vb[j].z + vb[j].w * vb[j].w); }
#pragma unroll
    for (int o = 1; o < 64; o <<= 1) { sa += __shfl_xor(sa, o); sb += __shfl_xor(sb, o); }
    const float ka = 1.0f / sqrtf(sa * (1.f / D) + 1e-6f), kb = 1.0f / sqrtf(sb * (1.f / D) + 1e-6f);
    v2u* pa = (v2u*)oa + lane; v2u* pb = (v2u*)ob + lane;
#pragma unroll
    for (int j = 0; j < 4; ++j) { const f32x4 g = gr[64 * j];
        v2u w; w.x = pk2(va[j].x * ka * g.x, va[j].y * ka * g.y); w.y = pk2(va[j].z * ka * g.z, va[j].w * ka * g.w); pa[64 * j] = w;
        v2u u; u.x = pk2(vb[j].x * kb * g.x, vb[j].y * kb * g.y); u.y = pk2(vb[j].z * kb * g.z, vb[j].w * kb * g.w); pb[64 * j] = u; }
}
__device__ __forceinline__ void rms_row_inplace(float* xrow, const float* gain, int lane) {
    f32x4* xr = (f32x4*)xrow + lane; const f32x4* gr = (const f32x4*)gain + lane;
    f32x4 v[4]; float s = 0.f;
#pragma unroll
    for (int j = 0; j < 4; ++j) { v[j] = xr[64 * j]; s += (v[j].x * v[j].x + v[j].y * v[j].y) + (v[j].z * v[j].z + v[j].w * v[j].w); }
    const float rstd = 1.0f / sqrtf(wave_sum(s) * (1.f / D) + 1e-6f);
#pragma unroll
    for (int j = 0; j < 4; ++j) { const f32x4 g = gr[64 * j]; xr[64 * j] = v[j] * rstd * g; }
}
__device__ __forceinline__ void norm_phase(LAS unsigned char* lds, int gw, int NGW, int wave, int lane, const float* x, const float* gain, bf16* XN,
                                           const float* W1, int K1, int N1, bf16* W1t, const float* W2, int K2, int N2, bf16* W2t) {
    LAS float* scr = (LAS float*)(lds + wave * 16384);
    const int I1 = (K1 / 64) * (N1 / 32), I2 = (K2 / 64) * (N2 / 32);
    for (int it = gw; it < I1 + I2; it += NGW) {
        if (it < I1) transpose_item(W1, K1, N1, W1t, scr, it, lane); else transpose_item(W2, K2, N2, W2t, scr, it - I1, lane);
    }
    for (int m = gw; m < M; m += 2 * NGW) {
        if (m + NGW < M) rms_row2_to_bf16(x + (size_t)m * D, x + (size_t)(m + NGW) * D, gain, XN + (size_t)m * D, XN + (size_t)(m + NGW) * D, lane);
        else rms_row_to_bf16(x + (size_t)m * D, gain, XN + (size_t)m * D, lane);
    }
}

__device__ __forceinline__ void gmlp_item(LAS unsigned char* lds, int item, int tid, int wave, int lane, const bf16* P, const float* ln_g, const float* ln_b,
                                          const float* w_s, const float* b_s, bf16* Y) {
    const int chunk = item >> 2, g = item & 3, t0 = chunk * 128;
    LAS bf16* Wm = (LAS bf16*)lds;
    LAS bf16* Vt = (LAS bf16*)(lds + 128 * 136 * 2);
    v4u raws[16];
#pragma unroll
    for (int i = 0; i < 16; ++i) raws[i] = *(const v4u*)(P + (size_t)(t0 + wave * 16 + i) * EIN + 512 + lane * 8);
    float lg8[8], lb8[8];
#pragma unroll
    for (int e = 0; e < 8; ++e) { const int ch = g * 128 + (lane & 15) * 8 + e; lg8[e] = ln_g[ch]; lb8[e] = ln_b[ch]; }
#pragma unroll
    for (int i = 0; i < 16; ++i) {
        const int s = wave * 16 + i;
        const v4u raw = raws[i];
        float v[8];
        v[0] = __uint_as_float(raw.x << 16); v[1] = __uint_as_float(raw.x & 0xffff0000u); v[2] = __uint_as_float(raw.y << 16); v[3] = __uint_as_float(raw.y & 0xffff0000u);
        v[4] = __uint_as_float(raw.z << 16); v[5] = __uint_as_float(raw.z & 0xffff0000u); v[6] = __uint_as_float(raw.w << 16); v[7] = __uint_as_float(raw.w & 0xffff0000u);
        float sum = 0.f;
#pragma unroll
        for (int e = 0; e < 8; ++e) sum += v[e];
        const float mean = wave_sum(sum) * (1.f / 512.f);
        float q = 0.f;
#pragma unroll
        for (int e = 0; e < 8; ++e) { v[e] -= mean; q += v[e] * v[e]; }
        const float rstd = 1.0f / sqrtf(wave_sum(q) * (1.f / 512.f) + 1e-5f);
        if ((lane >> 4) == g) {
#pragma unroll
            for (int e = 0; e < 8; ++e) { const int c = (lane & 15) * 8 + e; Vt[c * 136 + s] = (bf16)f2bf(v[e] * rstd * lg8[e] + lb8[e]); }
        }
    }
    for (int idx = tid; idx < 128 * 32; idx += 512) {
        const int t = idx >> 5, s4 = (idx & 31) * 4;
        const f32x4 w = *(const f32x4*)(w_s + ((size_t)g * 128 + t) * 128 + s4);
        v2u o; o.x = pk2(s4 + 0 <= t ? w.x : 0.f, s4 + 1 <= t ? w.y : 0.f); o.y = pk2(s4 + 2 <= t ? w.z : 0.f, s4 + 3 <= t ? w.w : 0.f);
        *(LAS v2u*)(Wm + t * 136 + s4) = o;
    }
    __syncthreads();
    const int r = lane & 15, q4 = lane >> 4;
    f32x4 acc[8];
#pragma unroll
    for (int ct = 0; ct < 8; ++ct) acc[ct] = (f32x4){0.f, 0.f, 0.f, 0.f};
    const int nks = (16 * wave + 15) / 32 + 1;
    for (int ks = 0; ks < nks; ++ks) {
        const bf16x8 af = *(const LAS bf16x8*)(Wm + (16 * wave + r) * 136 + ks * 32 + q4 * 8);
#pragma unroll
        for (int ct = 0; ct < 8; ++ct) { const bf16x8 bfr = *(const LAS bf16x8*)(Vt + (16 * ct + r) * 136 + ks * 32 + q4 * 8); acc[ct] = MFMA16(af, bfr, acc[ct]); }
    }
#pragma unroll
    for (int ct = 0; ct < 8; ++ct)
#pragma unroll
        for (int e = 0; e < 4; ++e) {
            const int t = 16 * wave + 4 * q4 + e, c = 16 * ct + r;
            const float mixed = acc[ct][e] + b_s[g * 128 + t];
            const float u = bf2f(P[(size_t)(t0 + t) * EIN + g * 128 + c]);
            Y[(size_t)(t0 + t) * D + g * 128 + c] = (bf16)f2bf(u * mixed);
        }
    __syncthreads();
}

struct RwkvW { const float *mu, *w0, *a0, *k_k, *k_a, *r_k; const bf16 *w2t, *a2t, *g2t; };
__device__ __forceinline__ float shifted(const bf16* P, int t, int col, float mu) {
    const float cur = bf2f(P[(size_t)t * EIN + col]); const float prev = t > 0 ? bf2f(P[(size_t)(t - 1) * EIN + col]) : 0.f; return cur + (prev - cur) * mu;
}
__device__ __forceinline__ void rwkv_prep_item(LAS unsigned char* lds, int item, int tid, int wave, int lane, const bf16* P, const RwkvW& W,
                                               float* LD, bf16* KK, bf16* BB, bf16* KP, bf16* RR, bf16* VV, bf16* GG, float* BS) {
    const int t0 = item * 64;
    LAS bf16* Xl = (LAS bf16*)lds;
    for (int idx = tid; idx < 64 * 256; idx += 512) {
        const int t = idx >> 8, j = idx & 255;
        const float ps = shifted(P, t0 + t, 1024 + 1536 + j, W.mu[1536 + j]);
        const float val = j < 64 ? tanhf(ps) : (j < 128 ? ps : 1.0f / (1.0f + __expf(-ps)));
        Xl[t * 264 + j] = (bf16)f2bf(val);
    }
    __syncthreads();
    const int h = wave, r = lane & 15, q4 = lane >> 4;
    for (int tt = 0; tt < 4; ++tt) {
        f32x4 aW[4], aA[4], aG[4];
#pragma unroll
        for (int ct = 0; ct < 4; ++ct) { aW[ct] = (f32x4){0.f, 0.f, 0.f, 0.f}; aA[ct] = aW[ct]; aG[ct] = aW[ct]; }
#pragma unroll
        for (int ks = 0; ks < 2; ++ks) {
            const bf16x8 xw = *(const LAS bf16x8*)(Xl + (16 * tt + r) * 264 + ks * 32 + q4 * 8);
            const bf16x8 xa = *(const LAS bf16x8*)(Xl + (16 * tt + r) * 264 + 64 + ks * 32 + q4 * 8);
#pragma unroll
            for (int ct = 0; ct < 4; ++ct) {
                const bf16x8 yw = *(const bf16x8*)(W.w2t + (size_t)(h * 64 + 16 * ct + r) * 64 + ks * 32 + q4 * 8);
                const bf16x8 ya = *(const bf16x8*)(W.a2t + (size_t)(h * 64 + 16 * ct + r) * 64 + ks * 32 + q4 * 8);
                aW[ct] = MFMA16(xw, yw, aW[ct]); aA[ct] = MFMA16(xa, ya, aA[ct]);
            }
        }
#pragma unroll
        for (int ks = 0; ks < 4; ++ks) {
            const bf16x8 xg = *(const LAS bf16x8*)(Xl + (16 * tt + r) * 264 + 128 + ks * 32 + q4 * 8);
#pragma unroll
            for (int ct = 0; ct < 4; ++ct) {
                const bf16x8 yg = *(const bf16x8*)(W.g2t + (size_t)(h * 64 + 16 * ct + r) * 128 + ks * 32 + q4 * 8);
                aG[ct] = MFMA16(xg, yg, aG[ct]);
            }
        }
#pragma unroll
        for (int e = 0; e < 4; ++e) {
            const int t = t0 + 16 * tt + 4 * q4 + e;
            float kkr[4], av[4]; float ss = 0.f, bon = 0.f;
#pragma unroll
            for (int ct = 0; ct < 4; ++ct) {
                const int c = h * 64 + 16 * ct + r;
                const float r_ = shifted(P, t, 1024 + c, W.mu[c]);
                const float k_ = shifted(P, t, 1024 + 512 + c, W.mu[512 + c]);
                const float v_ = shifted(P, t, 1024 + 1024 + c, W.mu[1024 + c]);
                const float xw = -(W.w0[c] + aW[ct][e]);
                const float sp = xw > 20.f ? xw : log1pf(__expf(xw));
                const float wv = -sp - 0.5f;
                const float ld = -__expf(wv);
                const float a = 1.0f / (1.0f + __expf(-(W.a0[c] + aA[ct][e])));
                const float kr = k_ * W.k_k[c];
                const float kp = k_ * (1.0f + (a - 1.0f) * W.k_a[c]);
                kkr[ct] = kr; av[ct] = a; ss += kr * kr; bon += r_ * kp * W.r_k[c];
                const size_t o = (size_t)t * BW + c;
                LD[o] = ld; KP[o] = (bf16)f2bf(kp); RR[o] = (bf16)f2bf(r_); VV[o] = (bf16)f2bf(v_); GG[o] = (bf16)f2bf(aG[ct][e]);
            }
#pragma unroll
            for (int o = 1; o < 16; o <<= 1) { ss += __shfl_xor(ss, o); bon += __shfl_xor(bon, o); }
            const float inv = 1.0f / sqrtf(fmaxf(ss, 1e-24f));
#pragma unroll
            for (int ct = 0; ct < 4; ++ct) {
                const int c = h * 64 + 16 * ct + r; const size_t o = (size_t)t * BW + c;
                const float kk = kkr[ct] * inv;
                KK[o] = (bf16)f2bf(kk); BB[o] = (bf16)f2bf(kk * av[ct]);
            }
            if (r == 0) BS[(size_t)t * 8 + h] = bon;
        }
    }
    __syncthreads();
}

struct ScanRegs { unsigned short kk[8], bb[8], kp[8], rr[8], vv[8]; float ld[8]; };
__device__ __forceinline__ void scan_load(ScanRegs& R, int t0, int hc, int hv, const float* LD, const bf16* KK, const bf16* BB, const bf16* KP, const bf16* RR, const bf16* VV) {
#pragma unroll
    for (int i = 0; i < 8; ++i) { const size_t o = (size_t)(t0 + i) * BW;
        R.kk[i] = KK[o + hc]; R.bb[i] = BB[o + hc]; R.kp[i] = KP[o + hc]; R.rr[i] = RR[o + hc]; R.ld[i] = LD[o + hc]; R.vv[i] = VV[o + hv]; }
}
__device__ __forceinline__ void rwkv_scan_wave(int gwv, int lane, const float* LD, const bf16* KK, const bf16* BB, const bf16* KP, const bf16* RR, const bf16* VV, float* OSC) {
    const int h = gwv >> 6, v = gwv & 63, hc = h * 64 + lane, hv = h * 64 + v;
    float S = 0.f;
    ScanRegs cur, nxt;
    scan_load(cur, 0, hc, hv, LD, KK, BB, KP, RR, VV);
    for (int t0 = 0; t0 < M; t0 += 8) {
        const int tn = (t0 + 8 < M) ? t0 + 8 : t0;
        scan_load(nxt, tn, hc, hv, LD, KK, BB, KP, RR, VV);
#pragma unroll
        for (int i = 0; i < 8; ++i) {
            const float kk = bf2f(cur.kk[i]), bb = bf2f(cur.bb[i]), kp = bf2f(cur.kp[i]), rr = bf2f(cur.rr[i]), vv = bf2f(cur.vv[i]);
            const float dec = __expf(cur.ld[i]);
            const float sa = wave_sum_uniform(S * kk);
            S = S * dec - sa * bb + vv * kp;
            const float o = wave_sum_uniform(S * rr);
            if (lane == 0) OSC[(size_t)(t0 + i) * BW + hv] = o;
        }
        cur = nxt;
    }
}
__device__ __forceinline__ void rwkv_out_row(int t, int lane, const float* OSC, const float* BS, const bf16* VV, const bf16* GG, const float* gn_g, const float* gn_b, bf16* Y) {
    const int c0 = lane * 8;
    const f32x4 o0 = *(const f32x4*)(OSC + (size_t)t * BW + c0), o1 = *(const f32x4*)(OSC + (size_t)t * BW + c0 + 4);
    float v[8] = {o0.x, o0.y, o0.z, o0.w, o1.x, o1.y, o1.z, o1.w};
    float s = 0.f;
#pragma unroll
    for (int e = 0; e < 8; ++e) s += v[e];
    s += __shfl_xor(s, 1); s += __shfl_xor(s, 2); s += __shfl_xor(s, 4);
    const float mean = s * (1.f / 64.f);
    float q = 0.f;
#pragma unroll
    for (int e = 0; e < 8; ++e) { v[e] -= mean; q += v[e] * v[e]; }
    q += __shfl_xor(q, 1); q += __shfl_xor(q, 2); q += __shfl_xor(q, 4);
    const float rstd = 1.0f / sqrtf(q * (1.f / 64.f) + 64e-5f);
    const float bon = BS[(size_t)t * 8 + (lane >> 3)];
    const v4u vraw = *(const v4u*)(VV + (size_t)t * BW + c0), graw = *(const v4u*)(GG + (size_t)t * BW + c0);
    const unsigned vr[4] = {vraw.x, vraw.y, vraw.z, vraw.w}, gr[4] = {graw.x, graw.y, graw.z, graw.w};
    float outv[8];
#pragma unroll
    for (int e = 0; e < 8; ++e) {
        const float vv = (e & 1) ? __uint_as_float(vr[e >> 1] & 0xffff0000u) : __uint_as_float(vr[e >> 1] << 16);
        const float gg = (e & 1) ? __uint_as_float(gr[e >> 1] & 0xffff0000u) : __uint_as_float(gr[e >> 1] << 16);
        outv[e] = (v[e] * rstd * gn_g[c0 + e] + gn_b[c0 + e] + bon * vv) * gg;
    }
    v4u w; w.x = pk2(outv[0], outv[1]); w.y = pk2(outv[2], outv[3]); w.z = pk2(outv[4], outv[5]); w.w = pk2(outv[6], outv[7]);
    *(v4u*)(Y + (size_t)t * D + 512 + c0) = w;
}

__device__ __forceinline__ void vtrans_item(LAS unsigned char* lds, int item, int tid, const bf16* QKV, bf16* VT1, bf16* VT4, bf16* VT16) {
    const int h = item >> 6, blk = item & 63, t0 = blk * 256;
    LAS bf16* Vl = (LAS bf16*)lds;
#pragma unroll
    for (int i = 0; i < 4; ++i) { const int idx = tid + 512 * i, t = idx >> 3, ch = idx & 7;
        *(LAS v4u*)(Vl + t * 72 + ch * 8) = *(const v4u*)(QKV + (size_t)(t0 + t) * NQKV + 2048 + h * 64 + ch * 8); }
    __syncthreads();
#pragma unroll
    for (int i = 0; i < 4; ++i) {
        const int idx = tid + 512 * i, half = idx & 1, dd = (idx >> 1) & 63;
        { const int nbl = idx >> 7; unsigned short e[8];
#pragma unroll
          for (int k = 0; k < 8; ++k) e[k] = Vl[(16 * nbl + 8 * half + k) * 72 + dd];
          v4u o; o.x = e[0] | ((unsigned)e[1] << 16); o.y = e[2] | ((unsigned)e[3] << 16); o.z = e[4] | ((unsigned)e[5] << 16); o.w = e[6] | ((unsigned)e[7] << 16);
          *(v4u*)(VT1 + ((((size_t)h * 1024 + 16 * blk + nbl) * 64 + dd) * 16 + 8 * half)) = o; }
        { const int nbl = (idx >> 7) & 3, c4 = idx >> 9; unsigned short e[8];
#pragma unroll
          for (int k = 0; k < 8; ++k) e[k] = Vl[(4 * (16 * nbl + 8 * half + k) + c4) * 72 + dd];
          v4u o; o.x = e[0] | ((unsigned)e[1] << 16); o.y = e[2] | ((unsigned)e[3] << 16); o.z = e[4] | ((unsigned)e[5] << 16); o.w = e[6] | ((unsigned)e[7] << 16);
          *(v4u*)(VT4 + (((((size_t)h * 4 + c4) * 256 + 4 * blk + nbl) * 64 + dd) * 16 + 8 * half)) = o; }
        { const int c16 = idx >> 7; unsigned short e[8];
#pragma unroll
          for (int k = 0; k < 8; ++k) e[k] = Vl[(16 * (8 * half + k) + c16) * 72 + dd];
          v4u o; o.x = e[0] | ((unsigned)e[1] << 16); o.y = e[2] | ((unsigned)e[3] << 16); o.z = e[4] | ((unsigned)e[5] << 16); o.w = e[6] | ((unsigned)e[7] << 16);
          *(v4u*)(VT16 + (((((size_t)h * 16 + c16) * 64 + blk) * 64 + dd) * 16 + 8 * half)) = o; }
    }
    __syncthreads();
}

struct AttnFrags { bf16x8 ka0, ka1, kb0, kb1, vf[4]; };
template <int DIL>
__device__ __forceinline__ void attn_load(AttnFrags& f, const bf16* Kb, const bf16* VTc, int cp, int nb, int kA, int r, int q4) {
    constexpr int NB16 = M / DIL / 16;
    int posA = cp + DIL * (nb + kA), posB = posA + 4 * DIL;
    posA = posA < 0 ? 0 : (posA > M - 1 ? M - 1 : posA); posB = posB < 0 ? 0 : (posB > M - 1 ? M - 1 : posB);
    f.ka0 = *(const bf16x8*)(Kb + (size_t)posA * NQKV); f.ka1 = *(const bf16x8*)(Kb + (size_t)posA * NQKV + 32);
    f.kb0 = *(const bf16x8*)(Kb + (size_t)posB * NQKV); f.kb1 = *(const bf16x8*)(Kb + (size_t)posB * NQKV + 32);
    int bi = (nb >> 4) + (q4 >> 1); bi = bi < 0 ? 0 : (bi > NB16 - 1 ? NB16 - 1 : bi);
    const bf16* vp = VTc + ((size_t)bi * 64 + r) * 16 + 8 * (q4 & 1);
#pragma unroll
    for (int dt = 0; dt < 4; ++dt) f.vf[dt] = *(const bf16x8*)(vp + dt * 256);
}
__device__ __forceinline__ void attn_group(const AttnFrags& f, int nb, int nlo, int nhi, int q4, const bf16x8 (&qf)[2], f32x4 (&o)[4], float& lrun) {
    const float C = 0.125f * 1.4426950408889634f;
    f32x4 sA = (f32x4){0.f, 0.f, 0.f, 0.f}, sB = sA;
    sA = MFMA16(f.ka0, qf[0], sA); sA = MFMA16(f.ka1, qf[1], sA);
    sB = MFMA16(f.kb0, qf[0], sB); sB = MFMA16(f.kb1, qf[1], sB);
    float p[8]; float ps = 0.f;
    const int n0 = nb + 8 * q4;
#pragma unroll
    for (int e = 0; e < 8; ++e) {
        const int n = n0 + e;
        const float ex = __builtin_amdgcn_exp2f(fminf((e < 4 ? sA[e & 3] : sB[e & 3]) * C, 100.f));
        p[e] = (n >= nlo && n <= nhi) ? ex : 0.f; ps += p[e];
    }
    lrun += ps;
    v4u pw; pw.x = pk2(p[0], p[1]); pw.y = pk2(p[2], p[3]); pw.z = pk2(p[4], p[5]); pw.w = pk2(p[6], p[7]);
    const bf16x8 pf = __builtin_bit_cast(bf16x8, pw);
#pragma unroll
    for (int dt = 0; dt < 4; ++dt) o[dt] = MFMA16(f.vf[dt], pf, o[dt]);
}
template <int DIL, bool FIRST>
__device__ __forceinline__ void attn_tile(LAS float* OACC, LAS float* LACC, const bf16* QKV, const bf16* VT, int h, int blk, int cp, int nq0, int qloc0, int qstep, int lane) {
    constexpr int NB16 = M / DIL / 16;
    const int r = lane & 15, q4 = lane >> 4;
    const int qloc = qloc0 + qstep * r, pos = 256 * blk + qloc;
    bf16x8 qf[2];
    qf[0] = *(const bf16x8*)(QKV + (size_t)pos * NQKV + h * 64 + q4 * 8);
    qf[1] = *(const bf16x8*)(QKV + (size_t)pos * NQKV + h * 64 + 32 + q4 * 8);
    const int nq = nq0 + r, nlo = nq - 128 < 0 ? 0 : nq - 128, nhi = nq, ns = nq0 - 128;
    const int kA = 8 * (r >> 2) + (r & 3);
    const bf16* Kb = QKV + 1024 + h * 64 + q4 * 8;
    const bf16* VTc = VT + (size_t)(h * DIL + cp) * NB16 * 1024;
    f32x4 o[4];
#pragma unroll
    for (int dt = 0; dt < 4; ++dt) o[dt] = (f32x4){0.f, 0.f, 0.f, 0.f};
    float lrun = 0.f;
    AttnFrags fa, fb;
    attn_load<DIL>(fa, Kb, VTc, cp, ns, kA, r, q4);
    attn_load<DIL>(fb, Kb, VTc, cp, ns + 32, kA, r, q4);
    attn_group(fa, ns, nlo, nhi, q4, qf, o, lrun);
    attn_load<DIL>(fa, Kb, VTc, cp, ns + 64, kA, r, q4);
    attn_group(fb, ns + 32, nlo, nhi, q4, qf, o, lrun);
    attn_load<DIL>(fb, Kb, VTc, cp, ns + 96, kA, r, q4);
    attn_group(fa, ns + 64, nlo, nhi, q4, qf, o, lrun);
    attn_load<DIL>(fa, Kb, VTc, cp, ns + 128, kA, r, q4);
    attn_group(fb, ns + 96, nlo, nhi, q4, qf, o, lrun);
    attn_group(fa, ns + 128, nlo, nhi, q4, qf, o, lrun);
    lrun += __shfl_xor(lrun, 16); lrun += __shfl_xor(lrun, 32);
    LAS float* orow = OACC + qloc * 68 + 4 * q4;
#pragma unroll
    for (int dt = 0; dt < 4; ++dt) {
        if (FIRST) *(LAS f32x4*)(orow + 16 * dt) = o[dt];
        else { const f32x4 prev = *(const LAS f32x4*)(orow + 16 * dt); *(LAS f32x4*)(orow + 16 * dt) = prev + o[dt]; }
    }
    if (q4 == 0) { if (FIRST) LACC[qloc] = lrun; else LACC[qloc] += lrun; }
}
__device__ __forceinline__ void attn_item(LAS unsigned char* lds, int item, int tid, int wave, int lane, const bf16* QKV, const bf16* VT1, const bf16* VT4, const bf16* VT16, bf16* AO) {
    const int h = item >> 6, blk = item & 63;
    LAS float* OACC = (LAS float*)lds;
    LAS float* LACC = (LAS float*)(lds + 256 * 68 * 4);
#pragma unroll 1
    for (int a = 0; a < 2; ++a) { const int ti = 2 * wave + a; attn_tile<1, true>(OACC, LACC, QKV, VT1, h, blk, 0, 256 * blk + 16 * ti, 16 * ti, 1, lane); }
    __syncthreads();
#pragma unroll 1
    for (int a = 0; a < 2; ++a) { const int ti = 2 * wave + a, c4 = ti >> 2, jj = ti & 3; attn_tile<4, false>(OACC, LACC, QKV, VT4, h, blk, c4, 64 * blk + 16 * jj, c4 + 64 * jj, 4, lane); }
    __syncthreads();
#pragma unroll 1
    for (int a = 0; a < 2; ++a) { const int ti = 2 * wave + a; attn_tile<16, false>(OACC, LACC, QKV, VT16, h, blk, ti, 16 * blk, ti, 16, lane); }
    __syncthreads();
#pragma unroll
    for (int i = 0; i < 4; ++i) {
        const int idx = tid + 512 * i, q = idx >> 3, j = idx & 7;
        const float inv = 1.0f / LACC[q];
        const f32x4 a0 = *(const LAS f32x4*)(OACC + q * 68 + 8 * j), a1 = *(const LAS f32x4*)(OACC + q * 68 + 8 * j + 4);
        v4u w; w.x = pk2(a0[0] * inv, a0[1] * inv); w.y = pk2(a0[2] * inv, a0[3] * inv); w.z = pk2(a1[0] * inv, a1[1] * inv); w.w = pk2(a1[2] * inv, a1[3] * inv);
        *(v4u*)(AO + (size_t)(256 * blk + q) * D + h * 64 + 8 * j) = w;
    }
    __syncthreads();
}
constexpr int CH_CL = 0, CH_AT = 17408, CH_RT = CH_AT + 9216, CH_BT = CH_RT + 9216, CH_KT = CH_BT + 9216, CH_BHT = CH_KT + 9216, CH_KHT = CH_BHT + 9216, CH_VT = CH_KHT + 9216,
              CH_MABF = CH_VT + 9216, CH_MAK = CH_MABF + 17408, CH_MBR = CH_MAK + 9216, CH_MKR = CH_MBR + 9216, CH_GL = CH_MKR + 9216, CH_MABB = CH_GL + 256, CH_TJ = CH_MABB + 9216, CH_END = CH_TJ + 2048;
static_assert(CH_END <= 147456, "chunk LDS map");
__device__ __forceinline__ void unpack8(const v4u raw, float (&v)[8]) {
    v[0] = __uint_as_float(raw.x << 16); v[1] = __uint_as_float(raw.x & 0xffff0000u); v[2] = __uint_as_float(raw.y << 16); v[3] = __uint_as_float(raw.y & 0xffff0000u);
    v[4] = __uint_as_float(raw.z << 16); v[5] = __uint_as_float(raw.z & 0xffff0000u); v[6] = __uint_as_float(raw.w << 16); v[7] = __uint_as_float(raw.w & 0xffff0000u);
}
__device__ __forceinline__ v4u pack8(const float (&v)[8]) { v4u o; o.x = pk2(v[0], v[1]); o.y = pk2(v[2], v[3]); o.z = pk2(v[4], v[5]); o.w = pk2(v[6], v[7]); return o; }

__device__ __forceinline__ void rwkv_chunk_block(LAS unsigned char* lds, int c, int tid, int wave, int lane, const bf16* P, const RwkvW& W, bf16* VV, bf16* GG, float* BS,
                                                 bf16* PMT, float* SLOC, bf16* QT, bf16* OLT, bf16* XLG) {
    const int t0 = c * 64;
    bf16* Xg = XLG + (size_t)c * 64 * 256;
    LAS float* CL = (LAS float*)(lds + CH_CL); LAS float* Y5F = (LAS float*)(lds + CH_CL);
    LAS bf16* AT = (LAS bf16*)(lds + CH_AT); LAS bf16* RT = (LAS bf16*)(lds + CH_RT); LAS bf16* BT = (LAS bf16*)(lds + CH_BT); LAS bf16* KT = (LAS bf16*)(lds + CH_KT);
    LAS bf16* UB = BT; LAS bf16* WB = KT;
    LAS bf16* BHT = (LAS bf16*)(lds + CH_BHT); LAS bf16* KHT = (LAS bf16*)(lds + CH_KHT); LAS bf16* VT = (LAS bf16*)(lds + CH_VT);
    LAS float* MABF = (LAS float*)(lds + CH_MABF); LAS bf16* MAK = (LAS bf16*)(lds + CH_MAK); LAS bf16* MBR = (LAS bf16*)(lds + CH_MBR); LAS bf16* MKR = (LAS bf16*)(lds + CH_MKR);
    LAS float* GL = (LAS float*)(lds + CH_GL); LAS bf16* MABB = (LAS bf16*)(lds + CH_MABB); LAS bf16* TJB = (LAS bf16*)(lds + CH_TJ);
    LAS float* LDv = (LAS float*)(lds + CH_AT);
    LAS float* SSP = (LAS float*)(lds + CH_TJ);
    const int r = lane & 15, q4 = lane >> 4, par = wave & 1;
    {
        v4u cur[4], prv[4];
#pragma unroll
        for (int i = 0; i < 4; ++i) {
            const int idx = tid + 512 * i, t = idx >> 5, j8 = (idx & 31) * 8;
            const bf16* p = P + (size_t)(t0 + t) * EIN + 1024 + 1536 + j8;
            cur[i] = *(const v4u*)p;
            if (t0 + t > 0) prv[i] = *(const v4u*)(p - EIN); else { prv[i].x = 0u; prv[i].y = 0u; prv[i].z = 0u; prv[i].w = 0u; }
        }
#pragma unroll
        for (int i = 0; i < 4; ++i) {
            const int idx = tid + 512 * i, t = idx >> 5, j8 = (idx & 31) * 8;
            float cv[8], pv[8], ov[8];
            unpack8(cur[i], cv); unpack8(prv[i], pv);
            const f32x4 m0 = *(const f32x4*)(W.mu + 1536 + j8), m1 = *(const f32x4*)(W.mu + 1536 + j8 + 4);
            const float mu8[8] = {m0.x, m0.y, m0.z, m0.w, m1.x, m1.y, m1.z, m1.w};
#pragma unroll
            for (int e = 0; e < 8; ++e) {
                const float ps = cv[e] + (pv[e] - cv[e]) * mu8[e];
                ov[e] = j8 < 64 ? (1.0f - 2.0f / (1.0f + __expf(2.0f * ps))) : (j8 < 128 ? ps : 1.0f / (1.0f + __expf(-ps)));
            }
            *(v4u*)(Xg + t * 256 + j8) = pack8(ov);
        }
    }
    __threadfence();
    __syncthreads();
    const int tt = wave >> 1;
#pragma unroll 1
    for (int h = 0; h < 8; ++h) {
    const int item = c * 8 + h;
    int tid_o = tid; asm volatile("" : "+v"(tid_o));
    const int tid = tid_o, lane = tid & 63, wave = __builtin_amdgcn_readfirstlane(tid >> 6), r = lane & 15, q4 = lane >> 4, par = wave & 1, tt = wave >> 1;
    (void)lane;
    float kr_[2][4]; unsigned apk[2][2], kpk[2][2], rpk[2][2], vpk[2][2];
    {
        f32x4 aW[2], aA[2], aG[2];
#pragma unroll
        for (int ci = 0; ci < 2; ++ci) { aW[ci] = (f32x4){0.f, 0.f, 0.f, 0.f}; aA[ci] = aW[ci]; aG[ci] = aW[ci]; }
#pragma unroll
        for (int ks = 0; ks < 2; ++ks) {
            const bf16x8 xw = *(const bf16x8*)(Xg + (16 * tt + r) * 256 + ks * 32 + q4 * 8), xa = *(const bf16x8*)(Xg + (16 * tt + r) * 256 + 64 + ks * 32 + q4 * 8);
#pragma unroll
            for (int ci = 0; ci < 2; ++ci) {
                const int crow = h * 64 + 16 * (2 * par + ci) + r;
                const bf16x8 yw = *(const bf16x8*)(W.w2t + (size_t)crow * 64 + ks * 32 + q4 * 8);
                const bf16x8 ya = *(const bf16x8*)(W.a2t + (size_t)crow * 64 + ks * 32 + q4 * 8);
                aW[ci] = MFMA16(xw, yw, aW[ci]); aA[ci] = MFMA16(xa, ya, aA[ci]);
            }
        }
#pragma unroll
        for (int ks = 0; ks < 4; ++ks) {
            const bf16x8 xg = *(const bf16x8*)(Xg + (16 * tt + r) * 256 + 128 + ks * 32 + q4 * 8);
#pragma unroll
            for (int ci = 0; ci < 2; ++ci) {
                const bf16x8 yg = *(const bf16x8*)(W.g2t + (size_t)(h * 64 + 16 * (2 * par + ci) + r) * 128 + ks * 32 + q4 * 8);
                aG[ci] = MFMA16(xg, yg, aG[ci]);
            }
        }
        float ssv[4] = {0.f, 0.f, 0.f, 0.f}, bonv[4] = {0.f, 0.f, 0.f, 0.f};
#pragma unroll
        for (int ci = 0; ci < 2; ++ci) {
            const int cl_ = 16 * (2 * par + ci) + r, cc = h * 64 + cl_;
            unsigned short rc[4], rp[4], kc[4], kpv[4], vc[4], vp[4];
            float av4[4], kp4[4], rv4[4], vv4[4];
            const float w0v = W.w0[cc], a0v = W.a0[cc], kkv = W.k_k[cc], kav = W.k_a[cc], rkv = W.r_k[cc], mur = W.mu[cc], muk = W.mu[512 + cc], muv = W.mu[1024 + cc];
#pragma unroll
            for (int e = 0; e < 4; ++e) {
                const int t = t0 + 16 * tt + 4 * q4 + e;
                const bf16* p = P + (size_t)t * EIN + 1024 + cc;
                const bf16* pp = t > 0 ? p - EIN : p;
                rc[e] = p[0]; kc[e] = p[512]; vc[e] = p[1024];
                rp[e] = pp[0]; kpv[e] = pp[512]; vp[e] = pp[1024];
            }
#pragma unroll
            for (int e = 0; e < 4; ++e) {
                const int tl = 16 * tt + 4 * q4 + e, t = t0 + tl;
                const float rcur = bf2f(rc[e]), kcur = bf2f(kc[e]), vcur = bf2f(vc[e]);
                const float rprev = t > 0 ? bf2f(rp[e]) : 0.f, kprev = t > 0 ? bf2f(kpv[e]) : 0.f, vprev = t > 0 ? bf2f(vp[e]) : 0.f;
                const float rv = rcur + (rprev - rcur) * mur;
                const float kv = kcur + (kprev - kcur) * muk;
                const float vv = vcur + (vprev - vcur) * muv;
                const float xw = -(w0v + aW[ci][e]);
                const float sp = xw > 20.f ? xw : (xw < -10.f ? __expf(xw) : __logf(1.0f + __expf(xw)));
                const float ld = -__expf(-sp - 0.5f);
                const float a = 1.0f / (1.0f + __expf(-(a0v + aA[ci][e])));
                const float kr = kv * kkv;
                const float kp = kv * (1.0f + (a - 1.0f) * kav);
                kr_[ci][e] = kr; av4[e] = a; kp4[e] = kp; rv4[e] = rv; vv4[e] = vv;
                ssv[e] += kr * kr; bonv[e] += rv * kp * rkv;
                LDv[tl * 64 + cl_] = ld;
                const size_t o = (size_t)t * BW + cc;
                VV[o] = (bf16)f2bf(vv); GG[o] = (bf16)f2bf(aG[ci][e]);
            }
            apk[ci][0] = pk2(av4[0], av4[1]); apk[ci][1] = pk2(av4[2], av4[3]); kpk[ci][0] = pk2(kp4[0], kp4[1]); kpk[ci][1] = pk2(kp4[2], kp4[3]);
            rpk[ci][0] = pk2(rv4[0], rv4[1]); rpk[ci][1] = pk2(rv4[2], rv4[3]); vpk[ci][0] = pk2(vv4[0], vv4[1]); vpk[ci][1] = pk2(vv4[2], vv4[3]);
        }
#pragma unroll
        for (int e = 0; e < 4; ++e) {
            const int tl = 16 * tt + 4 * q4 + e;
            float ss = ssv[e], bon = bonv[e];
#pragma unroll
            for (int o = 1; o < 16; o <<= 1) { ss += __shfl_xor(ss, o); bon += __shfl_xor(bon, o); }
            if (r == 0) { SSP[tl * 2 + par] = ss; SSP[128 + tl * 2 + par] = bon; }
        }
    }
    __syncthreads();
    if (tid < 64) {
        float run = 0.f;
#pragma unroll 16
        for (int t = 0; t < 64; ++t) { run += LDv[t * 64 + tid]; CL[t * 64 + tid] = run; }
        GL[tid] = __expf(run);
    } else if (tid < 128) {
        const int tl = tid - 64;
        BS[(size_t)(t0 + tl) * 8 + h] = SSP[128 + tl * 2] + SSP[128 + tl * 2 + 1];
    }
    __syncthreads();
    {
#pragma unroll
        for (int ci = 0; ci < 2; ++ci) {
            const int k = 16 * (2 * par + ci) + r;
            const float clL = CL[63 * 64 + k];
            float bh[4], kh[4];
#pragma unroll
            for (int e = 0; e < 4; ++e) {
                const int tl = 16 * tt + 4 * q4 + e;
                const float inv = 1.0f / sqrtf(fmaxf(SSP[tl * 2] + SSP[tl * 2 + 1], 1e-24f));
                const float kk = bf2f((bf16)f2bf(kr_[ci][e] * inv));
                const float a_e = (e & 1) ? __uint_as_float(apk[ci][e >> 1] & 0xffff0000u) : __uint_as_float(apk[ci][e >> 1] << 16);
                const float kp_e = (e & 1) ? __uint_as_float(kpk[ci][e >> 1] & 0xffff0000u) : __uint_as_float(kpk[ci][e >> 1] << 16);
                const float r_e = (e & 1) ? __uint_as_float(rpk[ci][e >> 1] & 0xffff0000u) : __uint_as_float(rpk[ci][e >> 1] << 16);
                const float bb = bf2f((bf16)f2bf(kk * a_e));
                const float cl = CL[tl * 64 + k], clp = tl > 0 ? CL[(tl - 1) * 64 + k] : 0.f;
                const float en = __expf(-cl), eh = __expf(clL - cl);
                AT[tl * 72 + k] = (bf16)f2bf(-kk * __expf(clp)); RT[tl * 72 + k] = (bf16)f2bf(r_e * __expf(cl));
                BT[tl * 72 + k] = (bf16)f2bf(bb * en); KT[tl * 72 + k] = (bf16)f2bf(kp_e * en);
                bh[e] = bb * eh; kh[e] = kp_e * eh;
            }
            const int tb = 16 * tt + 4 * q4;
            v2u w; w.x = pk2(bh[0], bh[1]); w.y = pk2(bh[2], bh[3]); *(LAS v2u*)(BHT + k * 72 + tb) = w;
            w.x = pk2(kh[0], kh[1]); w.y = pk2(kh[2], kh[3]); *(LAS v2u*)(KHT + k * 72 + tb) = w;
            w.x = vpk[ci][0]; w.y = vpk[ci][1]; *(LAS v2u*)(VT + k * 72 + tb) = w;
        }
    }
    __syncthreads();
    {
        const int mi = wave >> 1;
        const LAS bf16* X = (mi == 0 || mi == 2) ? BT : KT; const LAS bf16* Y = (mi < 2) ? AT : RT;
        f32x4 acc[2][4];
#pragma unroll
        for (int a = 0; a < 2; ++a)
#pragma unroll
            for (int b = 0; b < 4; ++b) acc[a][b] = (f32x4){0.f, 0.f, 0.f, 0.f};
#pragma unroll
        for (int ks = 0; ks < 2; ++ks) {
            bf16x8 xf[2], yf[4];
#pragma unroll
            for (int a = 0; a < 2; ++a) xf[a] = *(const LAS bf16x8*)(X + (16 * (2 * par + a) + r) * 72 + ks * 32 + q4 * 8);
#pragma unroll
            for (int b = 0; b < 4; ++b) yf[b] = *(const LAS bf16x8*)(Y + (16 * b + r) * 72 + ks * 32 + q4 * 8);
#pragma unroll
            for (int a = 0; a < 2; ++a)
#pragma unroll
                for (int b = 0; b < 4; ++b) acc[a][b] = MFMA16(xf[a], yf[b], acc[a][b]);
        }
#pragma unroll
        for (int a = 0; a < 2; ++a)
#pragma unroll
            for (int b = 0; b < 4; ++b) {
                const int s0 = 16 * (2 * par + a) + 4 * q4, t = 16 * b + r;
                f32x4 m;
#pragma unroll
                for (int e = 0; e < 4; ++e) m[e] = ((mi < 2) ? (s0 + e < t) : (s0 + e <= t)) ? acc[a][b][e] : 0.f;
                if (mi == 0) { *(LAS f32x4*)(MABF + t * 68 + s0) = m; v2u w; w.x = pk2(m[0], m[1]); w.y = pk2(m[2], m[3]); *(LAS v2u*)(MABB + t * 72 + s0) = w; }
                else { LAS bf16* Mo = (mi == 1) ? MAK : (mi == 2 ? MBR : MKR); v2u w; w.x = pk2(m[0], m[1]); w.y = pk2(m[2], m[3]); *(LAS v2u*)(Mo + t * 72 + s0) = w; }
            }
    }
    __syncthreads();
    {
        const int vt = wave >> 1;
        f32x4 acc[2];
        acc[0] = (f32x4){0.f, 0.f, 0.f, 0.f}; acc[1] = acc[0];
#pragma unroll
        for (int ks = 0; ks < 2; ++ks) {
            const bf16x8 xf = *(const LAS bf16x8*)(VT + (16 * vt + r) * 72 + ks * 32 + q4 * 8);
#pragma unroll
            for (int b = 0; b < 2; ++b) { const bf16x8 yf = *(const LAS bf16x8*)(MAK + (16 * (2 * par + b) + r) * 72 + ks * 32 + q4 * 8); acc[b] = MFMA16(xf, yf, acc[b]); }
        }
#pragma unroll
        for (int b = 0; b < 2; ++b)
#pragma unroll
            for (int e = 0; e < 4; ++e) Y5F[(16 * vt + 4 * q4 + e) * 68 + 16 * (2 * par + b) + r] = acc[b][e];
    }
    __syncthreads();
    if (wave == 0) {
        const int J = lane >> 4, i = lane & 15;
        float tr[16];
#pragma unroll
        for (int t = 0; t < 16; ++t) {
            float acc = (t == i) ? 1.f : 0.f;
#pragma unroll
            for (int s2 = 0; s2 < t; ++s2) acc += tr[s2] * MABF[(16 * J + t) * 68 + 16 * J + s2];
            tr[t] = acc;
        }
#pragma unroll
        for (int t = 0; t < 16; ++t) TJB[(16 * J + t) * 16 + i] = (bf16)f2bf(tr[t]);
    }
    __syncthreads();
    {
        unsigned xb[4][2];
#pragma unroll
        for (int J = 0; J < 4; ++J) {
            f32x4 z;
            if (wave < 4) z = *(const LAS f32x4*)(Y5F + (16 * wave + r) * 68 + 16 * J + 4 * q4);
            else {
#pragma unroll
                for (int e = 0; e < 4; ++e) z[e] = bf2f(AT[(16 * J + 4 * q4 + e) * 72 + 16 * (wave - 4) + r]);
            }
#pragma unroll
            for (int I = 0; I < J; I += 2) {
                const bool two = (I + 1 < J);
                const v2u m0 = *(const LAS v2u*)(MABB + (16 * J + r) * 72 + 16 * I + 4 * q4);
                v2u m1; m1.x = 0u; m1.y = 0u;
                if (two) m1 = *(const LAS v2u*)(MABB + (16 * J + r) * 72 + 16 * (I + 1) + 4 * q4);
                v4u fa; fa.x = m0.x; fa.y = m0.y; fa.z = m1.x; fa.w = m1.y;
                v4u fb; fb.x = xb[I][0]; fb.y = xb[I][1]; fb.z = two ? xb[I + 1 < 4 ? I + 1 : 3][0] : 0u; fb.w = two ? xb[I + 1 < 4 ? I + 1 : 3][1] : 0u;
                z = MFMA16(__builtin_bit_cast(bf16x8, fa), __builtin_bit_cast(bf16x8, fb), z);
            }
            const unsigned zh0 = pk2(z[0], z[1]), zh1 = pk2(z[2], z[3]);
            const unsigned zl0 = pk2(z[0] - __uint_as_float(zh0 << 16), z[1] - __uint_as_float(zh0 & 0xffff0000u)), zl1 = pk2(z[2] - __uint_as_float(zh1 << 16), z[3] - __uint_as_float(zh1 & 0xffff0000u));
            const v2u tw = *(const LAS v2u*)(TJB + (16 * J + r) * 16 + 4 * q4);
            v4u ft; ft.x = tw.x; ft.y = tw.y; ft.z = 0u; ft.w = 0u;
            v4u fh; fh.x = zh0; fh.y = zh1; fh.z = 0u; fh.w = 0u;
            v4u fl; fl.x = zl0; fl.y = zl1; fl.z = 0u; fl.w = 0u;
            f32x4 x = (f32x4){0.f, 0.f, 0.f, 0.f};
            x = MFMA16(__builtin_bit_cast(bf16x8, ft), __builtin_bit_cast(bf16x8, fh), x);
            x = MFMA16(__builtin_bit_cast(bf16x8, ft), __builtin_bit_cast(bf16x8, fl), x);
            xb[J][0] = pk2(x[0], x[1]); xb[J][1] = pk2(x[2], x[3]);
            LAS bf16* Xo = (wave < 4) ? (UB + (16 * wave + r) * 72) : (WB + (16 * (wave - 4) + r) * 72);
            v2u w; w.x = xb[J][0]; w.y = xb[J][1];
            *(LAS v2u*)(Xo + 16 * J + 4 * q4) = w;
        }
    }
    __syncthreads();
    {
        const int kind = wave >> 1;
        const LAS bf16* X1; const LAS bf16* Y1; const LAS bf16* X2 = nullptr; const LAS bf16* Y2 = nullptr;
        if (kind == 0) { X1 = UB; Y1 = MBR; X2 = VT; Y2 = MKR; }
        else if (kind == 1) { X1 = BHT; Y1 = UB; X2 = KHT; Y2 = VT; }
        else if (kind == 2) { X1 = WB; Y1 = MBR; }
        else { X1 = WB; Y1 = BHT; }
        f32x4 acc[2][4];
#pragma unroll
        for (int a = 0; a < 2; ++a)
#pragma unroll
            for (int b = 0; b < 4; ++b) acc[a][b] = (f32x4){0.f, 0.f, 0.f, 0.f};
#pragma unroll
        for (int ks = 0; ks < 2; ++ks) {
            bf16x8 xf[2], yf[4];
#pragma unroll
            for (int a = 0; a < 2; ++a) xf[a] = *(const LAS bf16x8*)(X1 + (16 * (2 * par + a) + r) * 72 + ks * 32 + q4 * 8);
#pragma unroll
            for (int b = 0; b < 4; ++b) yf[b] = *(const LAS bf16x8*)(Y1 + (16 * b + r) * 72 + ks * 32 + q4 * 8);
#pragma unroll
            for (int a = 0; a < 2; ++a)
#pragma unroll
                for (int b = 0; b < 4; ++b) acc[a][b] = MFMA16(xf[a], yf[b], acc[a][b]);
        }
        if (kind < 2) {
#pragma unroll
            for (int ks = 0; ks < 2; ++ks) {
                bf16x8 xf[2], yf[4];
#pragma unroll
                for (int a = 0; a < 2; ++a) xf[a] = *(const LAS bf16x8*)(X2 + (16 * (2 * par + a) + r) * 72 + ks * 32 + q4 * 8);
#pragma unroll
                for (int b = 0; b < 4; ++b) yf[b] = *(const LAS bf16x8*)(Y2 + (16 * b + r) * 72 + ks * 32 + q4 * 8);
#pragma unroll
                for (int a = 0; a < 2; ++a)
#pragma unroll
                    for (int b = 0; b < 4; ++b) acc[a][b] = MFMA16(xf[a], yf[b], acc[a][b]);
            }
        }
#pragma unroll
        for (int a = 0; a < 2; ++a)
#pragma unroll
            for (int b = 0; b < 4; ++b) {
                const int i0 = 16 * (2 * par + a) + 4 * q4, j = 16 * b + r;
                if (kind == 0) { v2u w; w.x = pk2(acc[a][b][0], acc[a][b][1]); w.y = pk2(acc[a][b][2], acc[a][b][3]); *(v2u*)(OLT + ((size_t)item * 64 + j) * 64 + i0) = w; }
                else if (kind == 1) *(f32x4*)(SLOC + ((size_t)item * 64 + j) * 64 + i0) = acc[a][b];
                else if (kind == 2) {
                    const v2u rw = *(const LAS v2u*)(RT + j * 72 + i0);
                    v2u w; w.x = pk2(acc[a][b][0] + __uint_as_float(rw.x << 16), acc[a][b][1] + __uint_as_float(rw.x & 0xffff0000u));
                    w.y = pk2(acc[a][b][2] + __uint_as_float(rw.y << 16), acc[a][b][3] + __uint_as_float(rw.y & 0xffff0000u));
                    *(v2u*)(QT + ((size_t)item * 64 + j) * 64 + i0) = w;
                } else {
                    f32x4 m = acc[a][b];
#pragma unroll
                    for (int e = 0; e < 4; ++e) if (i0 + e == j) m[e] += GL[j];
                    v2u w; w.x = pk2(m[0], m[1]); w.y = pk2(m[2], m[3]);
                    *(v2u*)(PMT + ((size_t)item * 64 + j) * 64 + i0) = w;
                }
            }
    }
    __syncthreads();
    }
}

struct ScanOps { bf16x8 pf[4][2]; f32x4 sl[4]; };
__device__ __forceinline__ void scan_ops_load(ScanOps& o, int it, int v, int r, int q4, const bf16* PMT, const float* SLOC) {
#pragma unroll
    for (int kt = 0; kt < 4; ++kt) {
        o.sl[kt] = *(const f32x4*)(SLOC + ((size_t)it * 64 + v) * 64 + 16 * kt + 4 * q4);
#pragma unroll
        for (int ks = 0; ks < 2; ++ks) {
            const bf16* p = PMT + ((size_t)it * 64 + 16 * kt + r) * 64 + 32 * ks + 4 * q4;
            const v2u lo = *(const v2u*)p, hi = *(const v2u*)(p + 16);
            v4u w; w.x = lo.x; w.y = lo.y; w.z = hi.x; w.w = hi.y;
            o.pf[kt][ks] = __builtin_bit_cast(bf16x8, w);
        }
    }
}
constexpr int SCAN_NS = 8, SCAN_SLOT = 12288, SCAN_FLAGS = SCAN_NS * SCAN_SLOT;
__device__ __forceinline__ void scan_slot_write(const ScanOps& o, LAS unsigned char* slot, int lane) {
    LAS v4u* p = (LAS v4u*)slot;
#pragma unroll
    for (int kt = 0; kt < 4; ++kt) {
        p[(2 * kt) * 64 + lane] = __builtin_bit_cast(v4u, o.pf[kt][0]); p[(2 * kt + 1) * 64 + lane] = __builtin_bit_cast(v4u, o.pf[kt][1]);
        p[(8 + kt) * 64 + lane] = __builtin_bit_cast(v4u, o.sl[kt]);
    }
}
__device__ __forceinline__ void rwkv_state_scan_wg(LAS unsigned char* lds, int task, int tid, int wave, int lane, const bf16* PMT, const float* SLOC, bf16* SC, bf16* TC, bf16* SG) {
    const int h = task / 12, sub = task % 12, mode = sub >= 8 ? 1 : 0, vt = sub & 3, c0 = sub >= 4 ? 128 : 0;
    const int r = lane & 15, q4 = lane >> 4, v = 16 * vt + r;
    constexpr int NC = 128;
    bf16* OUT = mode ? TC : SC;
    volatile LAS int* ready = (volatile LAS int*)(lds + SCAN_FLAGS);
    volatile LAS int* consumed = (volatile LAS int*)(lds + SCAN_FLAGS + 64);
    if (tid < 32) ((LAS int*)(lds + SCAN_FLAGS))[tid] = 0;
    __syncthreads();
    if (wave == 0) {
        unsigned hw[4][2], lw[4][2];
#pragma unroll
        for (int kt = 0; kt < 4; ++kt) {
#pragma unroll
            for (int w = 0; w < 2; ++w) {
                lw[kt][w] = 0u;
                hw[kt][w] = (mode == 1 && kt == vt) ? ((4 * q4 + 2 * w == r ? 0x3F80u : 0u) | (4 * q4 + 2 * w + 1 == r ? 0x3F800000u : 0u)) : 0u;
            }
        }
        for (int lc = 0; lc < NC; ++lc) {
            const int sl = lc & (SCAN_NS - 1), c = c0 + lc;
            while (ready[sl] != lc + 1) { }
            asm volatile("" ::: "memory");
            const LAS v4u* p = (const LAS v4u*)(lds + sl * SCAN_SLOT);
            v4u pf[4][2], s4[4];
#pragma unroll
            for (int kt = 0; kt < 4; ++kt) { pf[kt][0] = p[(2 * kt) * 64 + lane]; pf[kt][1] = p[(2 * kt + 1) * 64 + lane]; s4[kt] = p[(8 + kt) * 64 + lane]; }
            asm volatile("s_waitcnt lgkmcnt(0)" ::: "memory");
            if (lane == 0) *consumed = lc + 1;
            { bf16* sc = OUT + ((size_t)(c * 8 + h) * 64 + v) * 64 + 4 * q4;
#pragma unroll
              for (int kt = 0; kt < 4; ++kt) { v2u w; w.x = hw[kt][0]; w.y = hw[kt][1]; *(v2u*)(sc + 16 * kt) = w; } }
            v4u a0, a1, b0, b1;
            a0.x = hw[0][0]; a0.y = hw[0][1]; a0.z = hw[1][0]; a0.w = hw[1][1]; a1.x = hw[2][0]; a1.y = hw[2][1]; a1.z = hw[3][0]; a1.w = hw[3][1];
            b0.x = lw[0][0]; b0.y = lw[0][1]; b0.z = lw[1][0]; b0.w = lw[1][1]; b1.x = lw[2][0]; b1.y = lw[2][1]; b1.z = lw[3][0]; b1.w = lw[3][1];
            const bf16x8 sh0 = __builtin_bit_cast(bf16x8, a0), sh1 = __builtin_bit_cast(bf16x8, a1), sl0 = __builtin_bit_cast(bf16x8, b0), sl1 = __builtin_bit_cast(bf16x8, b1);
#pragma unroll
            for (int kt = 0; kt < 4; ++kt) {
                f32x4 n = __builtin_bit_cast(f32x4, s4[kt]);
                const bf16x8 p0 = __builtin_bit_cast(bf16x8, pf[kt][0]), p1 = __builtin_bit_cast(bf16x8, pf[kt][1]);
                n = MFMA16(p0, sh0, n); n = MFMA16(p1, sh1, n); n = MFMA16(p0, sl0, n); n = MFMA16(p1, sl1, n);
                hw[kt][0] = pk2(n[0], n[1]); hw[kt][1] = pk2(n[2], n[3]);
                lw[kt][0] = pk2(n[0] - __uint_as_float(hw[kt][0] << 16), n[1] - __uint_as_float(hw[kt][0] & 0xffff0000u));
                lw[kt][1] = pk2(n[2] - __uint_as_float(hw[kt][1] << 16), n[3] - __uint_as_float(hw[kt][1] & 0xffff0000u));
            }
        }
        if (sub < 4) {
            bf16* sg = SG + ((size_t)h * 64 + v) * 64 + 4 * q4;
#pragma unroll
            for (int kt = 0; kt < 4; ++kt) { v2u w; w.x = hw[kt][0]; w.y = hw[kt][1]; *(v2u*)(sg + 16 * kt) = w; }
        }
    } else {
        const int j = wave - 1;
        ScanOps A, B, C;
#define SCAN_LOAD(BUF, lc_) do { scan_ops_load(BUF, (c0 + (lc_)) * 8 + h, v, r, q4, PMT, SLOC); if (mode) { _Pragma("unroll") for (int kt_ = 0; kt_ < 4; ++kt_) BUF.sl[kt_] = (f32x4){0.f, 0.f, 0.f, 0.f}; } } while (0)
        SCAN_LOAD(A, j); SCAN_LOAD(B, j + 7); SCAN_LOAD(C, j + 14);
#define SCAN_PUBLISH(BUF, cc) do { const int c_ = (cc); if (c_ < NC) { \
            while (*consumed < c_ - (SCAN_NS - 1)) __builtin_amdgcn_s_sleep(8);     \
            asm volatile("" ::: "memory"); \
            scan_slot_write(BUF, lds + (c_ & (SCAN_NS - 1)) * SCAN_SLOT, lane); \
            asm volatile("s_waitcnt lgkmcnt(0)" ::: "memory"); \
            if (lane == 0) ready[c_ & (SCAN_NS - 1)] = c_ + 1; \
            if (c_ + 21 < NC) SCAN_LOAD(BUF, c_ + 21); } } while (0)
        for (int c = j; c < NC; c += 21) { SCAN_PUBLISH(A, c); SCAN_PUBLISH(B, c + 7); SCAN_PUBLISH(C, c + 14); }
#undef SCAN_PUBLISH
#undef SCAN_LOAD
    }
    __syncthreads();
}
__device__ __forceinline__ void rwkv_chunk_out(int item, int lane, const bf16* SC, const bf16* QT, const bf16* OLT, const bf16* TC, const bf16* SG, const float* BS, const bf16* VV, const bf16* GG,
                                               const float* gn_g, const float* gn_b, bf16* Y) {
    const int c = item >> 3, h = item & 7, r = lane & 15, q4 = lane >> 4;
    bf16x8 sf[4][2];
#pragma unroll
    for (int vt = 0; vt < 4; ++vt)
#pragma unroll
        for (int ks = 0; ks < 2; ++ks) sf[vt][ks] = *(const bf16x8*)(SC + ((size_t)item * 64 + 16 * vt + r) * 64 + 32 * ks + 8 * q4);
    const bool corr = c >= 128;
    bf16x8 tcf[4][2], sgf[4][2];
    if (corr) {
#pragma unroll
        for (int kt = 0; kt < 4; ++kt)
#pragma unroll
            for (int ks = 0; ks < 2; ++ks) {
                tcf[kt][ks] = *(const bf16x8*)(TC + ((size_t)item * 64 + 16 * kt + r) * 64 + 32 * ks + 8 * q4);
                const bf16* p = SG + ((size_t)h * 64 + 16 * kt + r) * 64 + 32 * ks + 4 * q4;
                const v2u lo = *(const v2u*)p, hi = *(const v2u*)(p + 16);
                v4u w; w.x = lo.x; w.y = lo.y; w.z = hi.x; w.w = hi.y; sgf[kt][ks] = __builtin_bit_cast(bf16x8, w);
            }
    }
    f32x4 gg4[4], gb4[4];
#pragma unroll
    for (int vt = 0; vt < 4; ++vt) { gg4[vt] = *(const f32x4*)(gn_g + h * 64 + 16 * vt + 4 * q4); gb4[vt] = *(const f32x4*)(gn_b + h * 64 + 16 * vt + 4 * q4); }
    for (int tt = 0; tt < 4; ++tt) {
        const int tl = 16 * tt + r, t = c * 64 + tl;
        bf16x8 qf[2];
#pragma unroll
        for (int ks = 0; ks < 2; ++ks) qf[ks] = *(const bf16x8*)(QT + ((size_t)item * 64 + tl) * 64 + 32 * ks + 8 * q4);
        f32x4 o[4]; float s = 0.f;
#pragma unroll
        for (int vt = 0; vt < 4; ++vt) {
            { const v2u ow = *(const v2u*)(OLT + ((size_t)item * 64 + tl) * 64 + 16 * vt + 4 * q4);
              o[vt] = (f32x4){__uint_as_float(ow.x << 16), __uint_as_float(ow.x & 0xffff0000u), __uint_as_float(ow.y << 16), __uint_as_float(ow.y & 0xffff0000u)}; }
            o[vt] = MFMA16(sf[vt][0], qf[0], o[vt]); o[vt] = MFMA16(sf[vt][1], qf[1], o[vt]);
        }
        if (corr) {
            f32x4 z[4];
#pragma unroll
            for (int kt = 0; kt < 4; ++kt) { z[kt] = (f32x4){0.f, 0.f, 0.f, 0.f}; z[kt] = MFMA16(tcf[kt][0], qf[0], z[kt]); z[kt] = MFMA16(tcf[kt][1], qf[1], z[kt]); }
            bf16x8 zs[2];
#pragma unroll
            for (int ks = 0; ks < 2; ++ks) { v4u w; w.x = pk2(z[2 * ks][0], z[2 * ks][1]); w.y = pk2(z[2 * ks][2], z[2 * ks][3]); w.z = pk2(z[2 * ks + 1][0], z[2 * ks + 1][1]); w.w = pk2(z[2 * ks + 1][2], z[2 * ks + 1][3]);
                zs[ks] = __builtin_bit_cast(bf16x8, w); }
#pragma unroll
            for (int vt = 0; vt < 4; ++vt) { o[vt] = MFMA16(sgf[vt][0], zs[0], o[vt]); o[vt] = MFMA16(sgf[vt][1], zs[1], o[vt]); }
        }
#pragma unroll
        for (int vt = 0; vt < 4; ++vt) s += (o[vt][0] + o[vt][1]) + (o[vt][2] + o[vt][3]);
        s += __shfl_xor(s, 16); s += __shfl_xor(s, 32);
        const float mean = s * (1.f / 64.f);
        float qv = 0.f;
#pragma unroll
        for (int vt = 0; vt < 4; ++vt) { o[vt] = o[vt] - mean; qv += (o[vt][0] * o[vt][0] + o[vt][1] * o[vt][1]) + (o[vt][2] * o[vt][2] + o[vt][3] * o[vt][3]); }
        qv += __shfl_xor(qv, 16); qv += __shfl_xor(qv, 32);
        const float rstd = 1.0f / sqrtf(qv * (1.f / 64.f) + 64e-5f);
        const float bon = BS[(size_t)t * 8 + h];
#pragma unroll
        for (int vt = 0; vt < 4; ++vt) {
            const size_t oo = (size_t)t * BW + h * 64 + 16 * vt + 4 * q4;
            const v2u vr = *(const v2u*)(VV + oo), gr = *(const v2u*)(GG + oo);
            const float v0 = __uint_as_float(vr.x << 16), v1 = __uint_as_float(vr.x & 0xffff0000u), v2 = __uint_as_float(vr.y << 16), v3 = __uint_as_float(vr.y & 0xffff0000u);
            const float g0 = __uint_as_float(gr.x << 16), g1 = __uint_as_float(gr.x & 0xffff0000u), g2 = __uint_as_float(gr.y << 16), g3 = __uint_as_float(gr.y & 0xffff0000u);
            const f32x4 y = o[vt] * rstd * gg4[vt] + gb4[vt];
            v2u w; w.x = pk2((y[0] + bon * v0) * g0, (y[1] + bon * v1) * g1); w.y = pk2((y[2] + bon * v2) * g2, (y[3] + bon * v3) * g3);
            *(v2u*)(Y + (size_t)t * D + 512 + h * 64 + 16 * vt + 4 * q4) = w;
        }
    }
}
#define XB_TMO      128
#define XB_XCNT(j)  (256  + 64 * (j))
#define XB_XSUB(j)  (1280 + 64 * (j))
#define XB_XGEN(j)  (2304 + 64 * (j))
#define XB_TOP      3328
#define XB_TOPGEN   3392
#define XCD_BAR_WORDS 3456
#define XB_SPIN_CAP (1u << 18)

__device__ __forceinline__ unsigned xb_ld(unsigned* p)              { return __hip_atomic_load(p, __ATOMIC_RELAXED, __HIP_MEMORY_SCOPE_AGENT); }
__device__ __forceinline__ unsigned xb_add(unsigned* p, unsigned v) { return __hip_atomic_fetch_add(p, v, __ATOMIC_RELAXED, __HIP_MEMORY_SCOPE_AGENT); }
__device__ __forceinline__ unsigned xb_xcc_id() { return (unsigned)__builtin_amdgcn_s_getreg((3 << 11) | 20) & 0xFu; }
#define XB_SPIN(cond, bar) do { unsigned _sp = 0; while (cond) { __builtin_amdgcn_s_sleep(1); \
    if ((++_sp & 255u) == 0u) { if (xb_ld(&(bar)[XB_TMO])) break; if (_sp > XB_SPIN_CAP) { atomicAdd(&(bar)[XB_TMO], 1u); break; } } } } while (0)

struct XcdBarrier {
    unsigned* bar; unsigned x;
    volatile LAS unsigned* st;
};

__device__ __forceinline__ XcdBarrier xcd_barrier_post(unsigned* bar, volatile LAS unsigned* st) {
    XcdBarrier b; b.bar = bar; b.x = xb_xcc_id(); b.st = st;
    if (threadIdx.x == 0) (void)xb_add(&bar[XB_XCNT(b.x)], 1u);
    return b;
}
__device__ __forceinline__ void xcd_barrier_complete(unsigned* bar, unsigned x, unsigned& nloc, unsigned& nx) {
    const unsigned G = gridDim.x * gridDim.y * gridDim.z;
    unsigned sum, cnt, mine, sp = 0u;
    for (;;) {
        sum = 0u; cnt = 0u; mine = 0u;
#pragma unroll
        for (unsigned j = 0; j < 16; ++j) { const unsigned c = xb_ld(&bar[XB_XCNT(j)]); sum += c; cnt += (c > 0u) ? 1u : 0u; mine = (j == x) ? c : mine; }
        if (sum == G) break;
        __builtin_amdgcn_s_sleep(1);
        if ((++sp & 255u) == 0u) { if (xb_ld(&bar[XB_TMO])) break; if (sp > XB_SPIN_CAP) { atomicAdd(&bar[XB_TMO], 1u); break; } }
    }
    nloc = mine > 0u ? mine : 1u; nx = cnt > 0u ? cnt : 1u;
}

__device__ __forceinline__ void xcd_barrier(const XcdBarrier& b) {
    asm volatile("s_waitcnt vmcnt(0)" ::: "memory");
    __syncthreads();
    if (threadIdx.x == 0) {
        unsigned* bar = b.bar;
        __builtin_amdgcn_s_waitcnt(0);
        unsigned nloc = b.st[0], nx = b.st[1];
        if (nloc == 0u) { xcd_barrier_complete(bar, b.x, nloc, nx); b.st[0] = nloc; b.st[1] = nx; }
        const unsigned old = xb_add(&bar[XB_XSUB(b.x)], 1u);
        const unsigned gen = old / nloc;
        if (old + 1u == (gen + 1u) * nloc) {
            __builtin_amdgcn_fence(__ATOMIC_RELEASE, "agent");
            asm volatile("s_waitcnt vmcnt(0)" ::: "memory");
            const unsigned og = xb_add(&bar[XB_TOP], 1u);
            const unsigned tg = og / nx;
            if (og + 1u == (tg + 1u) * nx) xb_add(&bar[XB_TOPGEN], 1u);
            else XB_SPIN(xb_ld(&bar[XB_TOPGEN]) == tg, bar);
            __builtin_amdgcn_fence(__ATOMIC_ACQUIRE, "agent");
            xb_add(&bar[XB_XGEN(b.x)], 1u);
            asm volatile("s_waitcnt vmcnt(0)" ::: "memory");
        } else {
            XB_SPIN(xb_ld(&bar[XB_XGEN(b.x)]) == gen, bar);
            __builtin_amdgcn_fence(__ATOMIC_ACQUIRE, "agent");
            asm volatile("s_waitcnt vmcnt(0)" ::: "memory");
        }
    }
    __syncthreads();
}
struct Args { const float* in[28]; float* out; unsigned char* ws; };
#define GRID_SYNC() do { XcdBarrier b_; b_.bar = (unsigned*)args.ws; b_.x = xb_xcc_id(); b_.st = (volatile LAS unsigned*)(lds + LDS_BYTES - 64); xcd_barrier(b_); } while (0)
#define PHASE_VARS int tid = threadIdx.x; asm volatile("" : "+v"(tid)); const int lane = tid & 63; const int wave = __builtin_amdgcn_readfirstlane(tid >> 6); \
    int G = gridDim.x; asm volatile("" : "+s"(G)); int bx = blockIdx.x; asm volatile("" : "+s"(bx)); const int gw = bx * NWAVES + wave, NGW = G * NWAVES; (void)lane; (void)gw; (void)NGW; (void)tid
#define WSP(T, off) ((T*)(args.ws + (off)))
#define XIN (args.in[0])
#define OUTF (args.out)
#define WA WSP(bf16, WS_WA)
#define WB WSP(bf16, WS_WB)
#define XN WSP(bf16, WS_XN)
#define P WSP(bf16, WS_P)
#define LD WSP(float, WS_LD)
#define KK WSP(bf16, WS_KK)
#define BB WSP(bf16, WS_BB)
#define KP WSP(bf16, WS_KP)
#define RR WSP(bf16, WS_RR)
#define VV WSP(bf16, WS_VV)
#define GG ((bf16*)args.out)
#define SCB ((bf16*)((unsigned char*)args.out + 16 * MiB))
#define OLT ((bf16*)((unsigned char*)args.out + 32 * MiB))
#define TCB ((bf16*)((unsigned char*)args.out + 48 * MiB))
#define SGB WSP(bf16, 512 * 1024)
#define PMT WSP(bf16, WS_LD)
#define SLOC WSP(float, WS_LD + 16 * MiB)
#define QTB WSP(bf16, WS_LD + 48 * MiB)
#define BS WSP(float, WS_BS)
#define W2T WSP(bf16, WS_W2T)
#define A2T WSP(bf16, WS_A2T)
#define G2T WSP(bf16, WS_G2T)
#define YC WSP(bf16, WS_XN)
#define ACT WSP(bf16, WS_GEN)
#define QKV WSP(bf16, WS_QKV)
#define VT1 WSP(bf16, WS_VT1)
#define VT4 WSP(bf16, WS_VT4)
#define VT16 WSP(bf16, WS_VT16)
__global__ void __launch_bounds__(NWAVES * 64, 2) hybrid_fwd(Args args) {
    extern __shared__ __attribute__((aligned(16))) unsigned char lds_raw[];
    LAS unsigned char* lds = (LAS unsigned char*)lds_raw;
    if (threadIdx.x < 16) ((LAS unsigned*)(lds + LDS_BYTES - 64))[threadIdx.x] = 0u;
    __syncthreads();
    (void)xcd_barrier_post((unsigned*)args.ws, (volatile LAS unsigned*)(lds + LDS_BYTES - 64));

    { PHASE_VARS;
    {
        LAS float* scr = (LAS float*)(lds + wave * 16384);
        const int IL = 16 + 16 + 32;
        for (int it = gw; it < IL; it += NGW) {
            if (it < 16) transpose_item(args.in[9], 64, 512, W2T, scr, it, lane);
            else if (it < 32) transpose_item(args.in[11], 64, 512, A2T, scr, it - 16, lane);
            else transpose_item(args.in[12], 128, 512, G2T, scr, it - 32, lane);
        }
        norm_phase(lds, gw, NGW, wave, lane, XIN, args.in[1], XN, args.in[2], D, EIN, WA, args.in[18], D, D, WB);
    }

    }
    cg::this_grid().sync();
    { PHASE_VARS;

    {
        pg8::Gemm g{XN, WA, M, EIN, D, 256L * D * 2, 128L * D * 2, 256L * D * 2, 128L * D * 2, 0}; pg8::StaticOrder S; S.init(M, EIN, G, bx);
        pg8::EpiBf16<0> E{P, EIN, nullptr, 0, 0, 1.f};
        pg8::gemm_phase<pg8::EpiBf16<0>, pg8::StaticOrder, true, true>(lds, g, S, E);
    }

    }
    GRID_SYNC();
    { PHASE_VARS;
        RwkvW W{args.in[7], args.in[8], args.in[10], args.in[13], args.in[14], args.in[15], W2T, A2T, G2T};
        for (int ck = bx; ck < M / 64; ck += G) rwkv_chunk_block(lds, ck, tid, wave, lane, P, W, VV, GG, BS, PMT, SLOC, QTB, OLT, WSP(bf16, WS_WA));
    }
    GRID_SYNC();
    { PHASE_VARS;
        if (bx < 96) rwkv_state_scan_wg(lds, bx, tid, wave, lane, PMT, SLOC, SCB, TCB, SGB);
        else for (int it = bx - 96; it < (M / 128) * 4; it += G - 96) gmlp_item(lds, it, tid, wave, lane, P, args.in[3], args.in[4], args.in[5], args.in[6], YC);
    }
    GRID_SYNC();
    { PHASE_VARS;
        for (int it = gw; it < (M / 64) * 8; it += NGW) rwkv_chunk_out(it, lane, SCB, QTB, OLT, TCB, SGB, BS, VV, GG, args.in[16], args.in[17], YC);
    }
    GRID_SYNC();
    { PHASE_VARS;

    {
        pg8::Gemm g{YC, WB, M, D, D, 256L * D * 2, 128L * D * 2, 256L * D * 2, 128L * D * 2, 0}; pg8::StaticOrder S; S.init(M, D, G, bx);
        pg8::EpiRes E{XIN, OUTF, D};
        pg8::gemm_phase<pg8::EpiRes, pg8::StaticOrder, true, true>(lds, g, S, E);
    }

    }
    GRID_SYNC();
    { PHASE_VARS;
        norm_phase(lds, gw, NGW, wave, lane, OUTF, args.in[22] + 0 * D, XN, args.in[23] + (size_t)0 * D * FF2, D, FF2, WA, args.in[26] + (size_t)0 * FF * D, FF, D, WB);
    }
    GRID_SYNC();
    { PHASE_VARS;
        pg8::Gemm g{XN - 2 * D, WA, M, FF2, D, 248L * D * 2, 124L * D * 2, 128L * D * 2, 2816L * D * 2, 1}; pg8::StaticOrder S; S.init2(67, 22, G, bx);
        pg8::EpiConvGlu E{ACT, args.in[24] + (size_t)0 * 3 * FF2, args.in[25] + (size_t)0 * FF2, M};
        pg8::gemm_phase<pg8::EpiConvGlu, pg8::StaticOrder, true, true>(lds, g, S, E);
    }
    GRID_SYNC();
    { PHASE_VARS;
        pg8::Gemm g{ACT, WB, M, D, FF, 256L * FF * 2, 128L * FF * 2, 256L * FF * 2, 128L * FF * 2, 0}; pg8::StaticOrder S; S.init(M, D, G, bx);
        pg8::EpiRes E{OUTF, OUTF, D};
        pg8::gemm_phase<pg8::EpiRes, pg8::StaticOrder, true, true>(lds, g, S, E);
    }
    GRID_SYNC();
    { PHASE_VARS;
        norm_phase(lds, gw, NGW, wave, lane, OUTF, args.in[19], XN, args.in[20], D, NQKV, WA, args.in[21], D, D, WB);
    }
    GRID_SYNC();
    { PHASE_VARS;
        pg8::Gemm g{XN, WA, M, NQKV, D, 256L * D * 2, 128L * D * 2, 256L * D * 2, 128L * D * 2, 0}; pg8::StaticOrder S; S.init(M, NQKV, G, bx);
        pg8::EpiBf16<0> E{QKV, NQKV, nullptr, 0, 0, 1.f};
        pg8::gemm_phase<pg8::EpiBf16<0>, pg8::StaticOrder, true, true>(lds, g, S, E);
    }
    GRID_SYNC();
    { PHASE_VARS;
        for (int it = bx; it < 16 * 64; it += G) vtrans_item(lds, it, tid, QKV, VT1, VT4, VT16);
    }
    GRID_SYNC();
    { PHASE_VARS;
        for (int it = bx; it < 16 * 64; it += G) attn_item(lds, it, tid, wave, lane, QKV, VT1, VT4, VT16, YC);
    }
    GRID_SYNC();
    { PHASE_VARS;
        pg8::Gemm g{YC, WB, M, D, D, 256L * D * 2, 128L * D * 2, 256L * D * 2, 128L * D * 2, 0}; pg8::StaticOrder S; S.init(M, D, G, bx);
        pg8::EpiRes E{OUTF, OUTF, D};
        pg8::gemm_phase<pg8::EpiRes, pg8::StaticOrder, true, true>(lds, g, S, E);
    }
    GRID_SYNC();
    { PHASE_VARS;
        norm_phase(lds, gw, NGW, wave, lane, OUTF, args.in[22] + 1 * D, XN, args.in[23] + (size_t)1 * D * FF2, D, FF2, WA, args.in[26] + (size_t)1 * FF * D, FF, D, WB);
    }
    GRID_SYNC();
    { PHASE_VARS;
        pg8::Gemm g{XN - 2 * D, WA, M, FF2, D, 248L * D * 2, 124L * D * 2, 128L * D * 2, 2816L * D * 2, 1}; pg8::StaticOrder S; S.init2(67, 22, G, bx);
        pg8::EpiConvGlu E{ACT, args.in[24] + (size_t)1 * 3 * FF2, args.in[25] + (size_t)1 * FF2, M};
        pg8::gemm_phase<pg8::EpiConvGlu, pg8::StaticOrder, true, true>(lds, g, S, E);
    }
    GRID_SYNC();
    { PHASE_VARS;
        pg8::Gemm g{ACT, WB, M, D, FF, 256L * FF * 2, 128L * FF * 2, 256L * FF * 2, 128L * FF * 2, 0}; pg8::StaticOrder S; S.init(M, D, G, bx);
        pg8::EpiRes E{OUTF, OUTF, D};
        pg8::gemm_phase<pg8::EpiRes, pg8::StaticOrder, true, true>(lds, g, S, E);
    }
    GRID_SYNC();
    { PHASE_VARS;
        for (int m = gw; m < M; m += NGW) rms_row_inplace(OUTF + (size_t)m * D, args.in[27], lane);
    }
}

#undef WSP
#undef XIN
#undef OUTF
#undef WA
#undef WB
#undef XN
#undef P
#undef LD
#undef KK
#undef BB
#undef KP
#undef RR
#undef VV
#undef GG
#undef SCB
#undef OLT
#undef TCB
#undef SGB
#undef PMT
#undef SLOC
#undef QTB
#undef BS
#undef W2T
#undef A2T
#undef G2T
#undef YC
#undef ACT
#undef QKV
#undef VT1
#undef VT4
#undef VT16
extern "C" void kernel_launch(void* const* d_in, const int* in_sizes, int n_in, void* d_out, int out_size, void* d_ws, size_t ws_size, hipStream_t stream) {
    static int grid = 0;
    if (grid == 0) {
        if (n_in != 28 || in_sizes[0] != M * D || out_size != M * D || ws_size < WS_END) { fprintf(stderr, "kernel_launch: unexpected shapes (n_in %d, in0 %d, out %d, ws %zu)\n", n_in, n_in > 0 ? in_sizes[0] : -1, out_size, ws_size); grid = -1; return; }
        int dev = 0, cus = 0, per_cu = 0;
        if (hipGetDevice(&dev) != hipSuccess || hipDeviceGetAttribute(&cus, hipDeviceAttributeMultiprocessorCount, dev) != hipSuccess) { grid = -1; return; }
        if (hipFuncSetAttribute((const void*)hybrid_fwd, hipFuncAttributeMaxDynamicSharedMemorySize, LDS_BYTES) != hipSuccess) { fprintf(stderr, "kernel_launch: hipFuncSetAttribute failed\n"); grid = -1; return; }
        if (hipOccupancyMaxActiveBlocksPerMultiprocessor(&per_cu, (const void*)hybrid_fwd, NWAVES * 64, LDS_BYTES) != hipSuccess || per_cu < 1) { fprintf(stderr, "kernel_launch: occupancy query says %d\n", per_cu); per_cu = 1; }
        (void)hipGetLastError();
        grid = cus;
    }
    if (grid < 0) return;
    if (hipMemsetAsync(d_ws, 0, 65536, stream) != hipSuccess) { fprintf(stderr, "kernel_launch: hipMemsetAsync failed\n"); return; }
    Args a{};
    for (int i = 0; i < 28; ++i) a.in[i] = (const float*)d_in[i];
    a.out = (float*)d_out; a.ws = (unsigned char*)d_ws;
    void* kargs[] = {&a};
    hipError_t e = hipLaunchCooperativeKernel((const void*)hybrid_fwd, dim3(grid), dim3(NWAVES * 64), kargs, LDS_BYTES, stream);
    if (e != hipSuccess) fprintf(stderr, "kernel_launch: cooperative launch failed: %s (grid %d)\n", hipGetErrorString(e), grid);
}
```
